# Optimizing an MI355X kernel written in HIP

```python
import math
import jax, jax.numpy as jnp
from jax import lax
import numpy as np

D_MODEL = 1024
BATCH = 8
SEQ = 8192
DEPTH = 4

GRID_W = 64
CTX_LEN = 256
N_BRANCH = 3
BRANCH_WIDTH = 512
HY_WIDTH = BRANCH_WIDTH
HY_EMB_DIM = 33
HY_BANDS = (HY_EMB_DIM - 1) // 2
HY_FILTER_WIDTH = 64
HY_DECAY_TARGET = 1e-2
HY_FAST_DECAY = 0.3
HY_SLOW_DECAY = 1.5
GQA_HEADS = 8
GQA_KV_HEADS = 2
GQA_GROUP = GQA_HEADS // GQA_KV_HEADS
GQA_HEAD_DIM = BRANCH_WIDTH // GQA_HEADS
GQA_SCALE = GQA_HEAD_DIM ** -0.5
WINDOW = 128
BLOCK = 128
MLA_HEADS = 8
MLA_Q_RANK = 384
MLA_KV_RANK = 256
MLA_NOPE_DIM = 64
MLA_ROPE_DIM = 32
MLA_V_DIM = BRANCH_WIDTH // MLA_HEADS
MLA_QK_DIM = MLA_NOPE_DIM + MLA_ROPE_DIM
MLA_SCALE = MLA_QK_DIM ** -0.5
D_FF = 4 * D_MODEL
ROPE_BASE = 10000.0
EPS = 1e-6
IN_SIZES = (3 * HY_WIDTH, GQA_HEADS * GQA_HEAD_DIM, GQA_KV_HEADS * GQA_HEAD_DIM, GQA_KV_HEADS * GQA_HEAD_DIM, MLA_Q_RANK, MLA_KV_RANK, MLA_ROPE_DIM, N_BRANCH * D_MODEL)
N_IN = 3 * HY_WIDTH + GQA_HEADS * GQA_HEAD_DIM + 2 * GQA_KV_HEADS * GQA_HEAD_DIM + MLA_Q_RANK + MLA_KV_RANK + MLA_ROPE_DIM + N_BRANCH * D_MODEL

kernel_name = 'hybrid_hyena_swa_mla_prefix_dit'


def rms_norm(x, g):
    xf = x.astype(jnp.float32)
    y = xf * lax.rsqrt(jnp.mean(xf * xf, axis=-1, keepdims=True) + EPS)
    return (y * g.astype(jnp.float32)).astype(x.dtype)


def modulate(x, shift, scale):
    return x * (1 + scale) + shift


def split_cols(p, sizes):
    offs, acc = [], 0
    for s in sizes[:-1]:
        acc += s
        offs.append(acc)
    return jnp.split(p, offs, axis=-1)


def axial_rope(rows, dim, dtype):
    n_freq = dim // 4
    inv = ROPE_BASE ** (-jnp.arange(n_freq, dtype=jnp.float32) / n_freq)
    r = jnp.repeat(jnp.arange(rows, dtype=jnp.float32), GRID_W)
    col = jnp.tile(jnp.arange(GRID_W, dtype=jnp.float32), rows)
    ang = jnp.concatenate([r[:, None] * inv, col[:, None] * inv], axis=-1)
    return jnp.cos(ang).astype(dtype), jnp.sin(ang).astype(dtype)


def apply_rope(x, cos, sin):
    x1, x2 = jnp.split(x, 2, axis=-1)
    cs, sn = cos[:, None, :], sin[:, None, :]
    return jnp.concatenate([x1 * cs - x2 * sn, x1 * sn + x2 * cs], axis=-1)


def hyena_filter(length, f1_w, f1_b, f2_w, f2_b, sin_freq, f3_w):
    f32 = jnp.float32
    t = jnp.linspace(0.0, 1.0, length, dtype=f32)[:, None]
    w = 2.0 * math.pi * jnp.arange(length, dtype=f32)[:, None] / length
    f = jnp.linspace(1e-4, HY_BANDS - 1, HY_BANDS, dtype=f32)[None, :]
    z = jnp.concatenate([t, jnp.cos(f * w), -jnp.sin(f * w)], axis=-1)
    h = jnp.sin(sin_freq[0].astype(f32) * (z @ f1_w.astype(f32) + f1_b.astype(f32)))
    h = jnp.sin(sin_freq[1].astype(f32) * (h @ f2_w.astype(f32) + f2_b.astype(f32)))
    h = (h @ f3_w.astype(f32)).reshape(length, 2, HY_WIDTH)
    max_decay = math.log(HY_DECAY_TARGET) / HY_FAST_DECAY
    min_decay = math.log(HY_DECAY_TARGET) / HY_SLOW_DECAY
    deltas = jnp.abs(jnp.linspace(min_decay, max_decay, HY_WIDTH, dtype=f32))
    h = h * jnp.exp(-t * deltas)[:, None, :]
    k = jnp.concatenate([h[:, 0], jnp.zeros((1, HY_WIDTH), f32), h[:0:-1, 1]], axis=0)
    return k * lax.rsqrt(jnp.sum(k * k, axis=0, keepdims=True) + EPS)


def hyena_mix(u, short_w, kernel, skip):
    L = u.shape[1]
    up = jnp.pad(u, ((0, 0), (1, 1), (0, 0)))
    uc = up[:, :-2] * short_w[0] + up[:, 1:-1] * short_w[1] + up[:, 2:] * short_w[2]
    x0, x1, v = jnp.split(uc, 3, axis=-1)
    z = (x1 * v).astype(jnp.float32)
    zf = jnp.fft.rfft(z, n=2 * L, axis=1)
    kf = jnp.fft.rfft(kernel, axis=0)
    y = jnp.fft.irfft(zf * kf[None], n=2 * L, axis=1)[:, :L] + z * skip.astype(jnp.float32)
    return (x0.astype(jnp.float32) * y).astype(u.dtype)


def joint_attention(q, keys, vals, masks, sink, scale):
    logits = []
    for kk, mm in zip(keys, masks):
        s = jnp.einsum('bqhgd,bkhd->bhgqk', q, kk, preferred_element_type=jnp.float32) * scale
        if mm is not None:
            s = jnp.where(mm, s, -1e30)
        logits.append(s)
    if sink is not None:
        logits.append(jnp.broadcast_to(sink.astype(jnp.float32)[None, :, :, None, None], logits[0].shape[:-1] + (1,)))
    p = jax.nn.softmax(jnp.concatenate(logits, axis=-1), axis=-1)
    out, start = 0, 0
    for vv in vals:
        n = vv.shape[1]
        out = out + jnp.einsum('bhgqk,bkhd->bqhgd', p[..., start:start + n].astype(vv.dtype), vv)
        start += n
    return out


def window_gqa_latent(q, k, v, k_ctx, v_ctx, sink):
    B, L = q.shape[0], q.shape[1]
    nb = L // BLOCK
    span = BLOCK + 2 * WINDOW
    kp = jnp.pad(k, ((0, 0), (WINDOW, WINDOW), (0, 0), (0, 0)))
    vp = jnp.pad(v, ((0, 0), (WINDOW, WINDOW), (0, 0), (0, 0)))
    qi = jnp.arange(BLOCK)[:, None]
    kj = jnp.arange(span)[None, :]
    band = (kj >= qi) & (kj <= qi + 2 * WINDOW)

    def one_block(b):
        start = b * BLOCK
        qb = lax.dynamic_slice_in_dim(q, start, BLOCK, axis=1)
        kb = lax.dynamic_slice_in_dim(kp, start, span, axis=1)
        vb = lax.dynamic_slice_in_dim(vp, start, span, axis=1)
        jpos = start - WINDOW + kj
        mask = band & (jpos >= 0) & (jpos < L)
        return joint_attention(qb, [kb, k_ctx], [vb, v_ctx], [mask, None], sink, GQA_SCALE)

    out = lax.map(one_block, jnp.arange(nb))
    return jnp.moveaxis(out, 0, 1).reshape(B, L, GQA_HEADS * GQA_HEAD_DIM)


def mla_latent(q, k, v, k_ctx, v_ctx):
    B, L = q.shape[0], q.shape[1]
    nb = L // BLOCK

    def one_block(b):
        qb = lax.dynamic_slice_in_dim(q, b * BLOCK, BLOCK, axis=1)
        return joint_attention(qb, [k, k_ctx], [v, v_ctx], [None, None], None, MLA_SCALE)

    out = lax.map(one_block, jnp.arange(nb))
    return jnp.moveaxis(out, 0, 1).reshape(B, L, MLA_HEADS * MLA_V_DIM)


def project_stream(h, w_in, gqa_qn, gqa_kn, mla_qa_n, mla_kva_n, w_q_b, w_kv_b, mla_qn, mla_kn, rope_gqa, rope_mla):
    B, L, _ = h.shape
    u, q, k, v, cq, ckv, kr, g = split_cols(h @ w_in, IN_SIZES)
    q = rms_norm(q.reshape(B, L, GQA_HEADS, GQA_HEAD_DIM), gqa_qn)
    k = rms_norm(k.reshape(B, L, GQA_KV_HEADS, GQA_HEAD_DIM), gqa_kn)
    v = v.reshape(B, L, GQA_KV_HEADS, GQA_HEAD_DIM)
    qm = (rms_norm(cq, mla_qa_n) @ w_q_b).reshape(B, L, MLA_HEADS, MLA_QK_DIM)
    kvm = (rms_norm(ckv, mla_kva_n) @ w_kv_b).reshape(B, L, MLA_HEADS, MLA_NOPE_DIM + MLA_V_DIM)
    k_nope, vm = jnp.split(kvm, [MLA_NOPE_DIM], axis=-1)
    km = jnp.concatenate([k_nope, jnp.broadcast_to(kr[:, :, None, :], (B, L, MLA_HEADS, MLA_ROPE_DIM))], axis=-1)
    qm = rms_norm(qm, mla_qn)
    km = rms_norm(km, mla_kn)
    if rope_gqa is not None:
        q = apply_rope(q, *rope_gqa)
        k = apply_rope(k, *rope_gqa)
        qm = jnp.concatenate([qm[..., :MLA_NOPE_DIM], apply_rope(qm[..., MLA_NOPE_DIM:], *rope_mla)], axis=-1)
        km = jnp.concatenate([km[..., :MLA_NOPE_DIM], apply_rope(km[..., MLA_NOPE_DIM:], *rope_mla)], axis=-1)
    gates = jax.nn.sigmoid(g.astype(jnp.float32)).astype(h.dtype).reshape(B, L, N_BRANCH, D_MODEL)
    q = q.reshape(B, L, GQA_KV_HEADS, GQA_GROUP, GQA_HEAD_DIM)
    qm = qm[:, :, :, None, :]
    return u, q, k, v, qm, km, vm, gates


def merge_branches(y_hy, y_gqa, y_mla, gates, w_branch, w_out):
    ys = (y_hy, y_gqa, y_mla)
    merged = sum(gates[:, :, n] * (ys[n] @ w_branch[n]) for n in range(N_BRANCH))
    return merged @ w_out


def squared_relu_mlp(h, w1, w2):
    return jnp.square(jax.nn.relu(h @ w1)) @ w2


def setup_inputs(seed: int = 0) -> dict:
    key = jax.random.key(seed)
    ks = iter(jax.random.split(key, 32))
    D = D_MODEL

    def nrm(shape, scale):
        return jax.random.normal(next(ks), shape, jnp.float32) * scale

    return {
        'x': nrm((BATCH, SEQ, D), 1.0),
        'c': nrm((BATCH, D), 1.0),
        'ctx': nrm((BATCH, CTX_LEN, D), 1.0),
        'c_ctx': nrm((D,), 1.0),
        'w_mod': nrm((DEPTH, D, 6 * D), 0.5 * D ** -0.5),
        'b_mod': nrm((DEPTH, 6 * D), 0.02),
        'norm_mix_g': 1.0 + nrm((DEPTH, D), 0.02),
        'norm_mlp_g': 1.0 + nrm((DEPTH, D), 0.02),
        'w_in': nrm((DEPTH, D, N_IN), D ** -0.5),
        'hy_short_w': nrm((DEPTH, 3, 3 * HY_WIDTH), 3 ** -0.5),
        'hy_f1_w': nrm((DEPTH, HY_EMB_DIM, HY_FILTER_WIDTH), HY_EMB_DIM ** -0.5),
        'hy_f1_b': nrm((DEPTH, HY_FILTER_WIDTH), 0.1),
        'hy_f2_w': nrm((DEPTH, HY_FILTER_WIDTH, HY_FILTER_WIDTH), HY_FILTER_WIDTH ** -0.5),
        'hy_f2_b': nrm((DEPTH, HY_FILTER_WIDTH), 0.1),
        'hy_sin_freq': 1.0 + nrm((DEPTH, 2, HY_FILTER_WIDTH), 0.1),
        'hy_f3_w': nrm((DEPTH, HY_FILTER_WIDTH, 2 * HY_WIDTH), HY_FILTER_WIDTH ** -0.5),
        'hy_skip': nrm((DEPTH, HY_WIDTH), 0.5),
        'gqa_q_norm': 1.0 + nrm((DEPTH, GQA_HEAD_DIM), 0.02),
        'gqa_k_norm': 1.0 + nrm((DEPTH, GQA_HEAD_DIM), 0.02),
        'gqa_sink': nrm((DEPTH, GQA_HEADS), 0.5),
        'mla_q_a_norm': 1.0 + nrm((DEPTH, MLA_Q_RANK), 0.02),
        'mla_kv_a_norm': 1.0 + nrm((DEPTH, MLA_KV_RANK), 0.02),
        'w_q_b': nrm((DEPTH, MLA_Q_RANK, MLA_HEADS * MLA_QK_DIM), MLA_Q_RANK ** -0.5),
        'w_kv_b': nrm((DEPTH, MLA_KV_RANK, MLA_HEADS * (MLA_NOPE_DIM + MLA_V_DIM)), MLA_KV_RANK ** -0.5),
        'mla_q_norm': 1.0 + nrm((DEPTH, MLA_QK_DIM), 0.02),
        'mla_k_norm': 1.0 + nrm((DEPTH, MLA_QK_DIM), 0.02),
        'w_branch': nrm((DEPTH, N_BRANCH, BRANCH_WIDTH, D), BRANCH_WIDTH ** -0.5),
        'w_out': nrm((DEPTH, D, D), D ** -0.5),
        'w_mlp1': nrm((DEPTH, D, D_FF), D ** -0.5),
        'w_mlp2': nrm((DEPTH, D_FF, D), D_FF ** -0.5),
    }


def reference(x, c, ctx, c_ctx, w_mod, b_mod, norm_mix_g, norm_mlp_g, w_in, hy_short_w, hy_f1_w, hy_f1_b, hy_f2_w, hy_f2_b, hy_sin_freq, hy_f3_w, hy_skip, gqa_q_norm, gqa_k_norm, gqa_sink, mla_q_a_norm, mla_kv_a_norm, w_q_b, w_kv_b, mla_q_norm, mla_k_norm, w_branch, w_out, w_mlp1, w_mlp2):
    B, L, _ = x.shape
    Lc = ctx.shape[1]
    rows = L // GRID_W
    rope_gqa = axial_rope(rows, GQA_HEAD_DIM, x.dtype)
    rope_mla = axial_rope(rows, MLA_ROPE_DIM, x.dtype)
    s_lat = jax.nn.silu(c)[:, None, :]
    s_ctx = jax.nn.silu(c_ctx)[None, None, :]
    for l in range(DEPTH):
        mod = jnp.split(s_lat @ w_mod[l] + b_mod[l], 6, axis=-1)
        mod_c = jnp.split(s_ctx @ w_mod[l] + b_mod[l], 6, axis=-1)
        proj_w = (w_in[l], gqa_q_norm[l], gqa_k_norm[l], mla_q_a_norm[l], mla_kv_a_norm[l], w_q_b[l], w_kv_b[l], mla_q_norm[l], mla_k_norm[l])
        filt_w = (hy_f1_w[l], hy_f1_b[l], hy_f2_w[l], hy_f2_b[l], hy_sin_freq[l], hy_f3_w[l])
        sink = gqa_sink[l].reshape(GQA_KV_HEADS, GQA_GROUP)

        hc = modulate(rms_norm(ctx, norm_mix_g[l]), mod_c[0], mod_c[1])
        u_c, q_c, k_c, v_c, qm_c, km_c, vm_c, gt_c = project_stream(hc, *proj_w, None, None)
        h = modulate(rms_norm(x, norm_mix_g[l]), mod[0], mod[1])
        u, q, k, v, qm, km, vm, gt = project_stream(h, *proj_w, rope_gqa, rope_mla)

        y_hy = hyena_mix(u, hy_short_w[l], hyena_filter(L, *filt_w), hy_skip[l])
        y_gqa = window_gqa_latent(q, k, v, k_c, v_c, sink)
        y_mla = mla_latent(qm, km, vm, km_c, vm_c)
        x = x + mod[2] * merge_branches(y_hy, y_gqa, y_mla, gt, w_branch[l], w_out[l])
        x = x + mod[5] * squared_relu_mlp(modulate(rms_norm(x, norm_mlp_g[l]), mod[3], mod[4]), w_mlp1[l], w_mlp2[l])

        if l < DEPTH - 1:
            yc_hy = hyena_mix(u_c, hy_short_w[l], hyena_filter(Lc, *filt_w), hy_skip[l])
            yc_gqa = joint_attention(q_c, [k_c], [v_c], [None], sink, GQA_SCALE).reshape(B, Lc, GQA_HEADS * GQA_HEAD_DIM)
            yc_mla = joint_attention(qm_c, [km_c], [vm_c], [None], None, MLA_SCALE).reshape(B, Lc, MLA_HEADS * MLA_V_DIM)
            ctx = ctx + mod_c[2] * merge_branches(yc_hy, yc_gqa, yc_mla, gt_c, w_branch[l], w_out[l])
            ctx = ctx + mod_c[5] * squared_relu_mlp(modulate(rms_norm(ctx, norm_mlp_g[l]), mod_c[3], mod_c[4]), w_mlp1[l], w_mlp2[l])
    return x
```

```cpp
#include <hip/hip_runtime.h>
#include <hip/hip_cooperative_groups.h>
#include <cstdio>
namespace cg = cooperative_groups;

typedef unsigned short u16;
typedef short bf16x8 __attribute__((ext_vector_type(8)));
typedef float f32x16 __attribute__((ext_vector_type(16)));
typedef __bf16 bf16x2_t __attribute__((ext_vector_type(2)));
typedef float f32x2_t __attribute__((ext_vector_type(2)));
#define DI __device__ __forceinline__
#define MFMA(a, b, c) __builtin_amdgcn_mfma_f32_32x32x16_bf16((a), (b), (c), 0, 0, 0)

#define DM 1024
#define NBATCH 8
#define LSEQ 8192
#define LCTX 256
#define ML 65536
#define MC 2048
#define MALL 67584
#define NIN 6048
#define FFTN 16384
#define EPSV 1e-6f
#define LOG2E 1.4426950408889634f

#define W_LAYER 17858560ull
#define WO_T1 0ull
#define WO_TG 3145728ull
#define WO_QB 6291456ull
#define WO_KVB 6586368ull
#define WO_BR 6848512ull
#define WO_OUT 8421376ull
#define WO_W1 9469952ull
#define WO_W2 13664256ull
#define OFF_W 0ull
#define OFF_CTX 142868480ull
#define OFF_KF 151257088ull
#define OFF_KC 218365952ull
#define OFF_MODS 219414528ull
#define OFF_SUMSQ 220299264ull
#define OFF_ROPEG 220315648ull
#define OFF_ROPEM 222412800ull
#define OFF_TW 223461376ull
#define OFF_A 223592448ull
#define OFF_B 362004480ull
#define OFF_C 431210496ull
#define OFF_R 569622528ull
#define OFF_Y 777240576ull
#define OFF_KM (OFF_A + 242221056ull)
#define OFF_PART 984858624ull
#define ZC_OFF 33554432

struct Params {
  const float *x, *c, *ctx, *c_ctx, *w_mod, *b_mod, *norm_mix_g, *norm_mlp_g, *w_in, *hy_short_w, *hy_f1_w, *hy_f1_b,
      *hy_f2_w, *hy_f2_b, *hy_sin_freq, *hy_f3_w, *hy_skip, *gqa_q_norm, *gqa_k_norm, *gqa_sink, *mla_q_a_norm,
      *mla_kv_a_norm, *w_q_b, *w_kv_b, *mla_q_norm, *mla_k_norm, *w_branch, *w_out, *w_mlp1, *w_mlp2;
  float* out;
  char* ws;
};

DI int ltid() { int t = threadIdx.x; asm volatile("" : "+v"(t)); return t; }
DI int lbid() { int t = blockIdx.x; asm volatile("" : "+s"(t)); return t; }
DI u16 f2bf(float x) { return __builtin_bit_cast(u16, (__bf16)x); }
DI float bf2f(u16 v) { return __uint_as_float(((unsigned)v) << 16); }
DI unsigned pk2(float a, float b) {
  f32x2_t f = {a, b};
  return __builtin_bit_cast(unsigned, __builtin_convertvector(f, bf16x2_t));
}
DI float wave_sum(float v) {
#pragma unroll
  for (int o = 32; o > 0; o >>= 1) v += __shfl_xor(v, o);
  return v;
}
DI float sigmoidf_(float x) { return 1.0f / (1.0f + __expf(-x)); }
DI const float* mods_ptr(const Params& p, int l, int mrow, int j) {
  return (const float*)(p.ws + OFF_MODS) + ((size_t)(l * 9 + mrow) * 6144 + j * 1024);
}

template <bool LOWREG = false>
DI void gemm_mainloop(const u16* __restrict__ Ag, int lda, const u16* __restrict__ Bg, int ldb, int K,
                      f32x16 (&acc)[2][2], u16* lds) {
  const int tid = ltid(), lane = tid & 63, w = tid >> 6, l32 = lane & 31, hh = lane >> 5;
  const int wm = w >> 1, wn = w & 1;
  u16* As = lds;
  u16* Bs = lds + 2 * 256 * 72;
  const int arow = tid >> 3, ach = tid & 7;
  const u16* ap = Ag + (size_t)arow * lda + ach * 8;
  const u16* bp = Bg + (size_t)arow * ldb + ach * 8;
  uint4 ra[4], rb[2];
#pragma unroll
  for (int i = 0; i < 4; ++i) ra[i] = *(const uint4*)(ap + (size_t)(64 * i) * lda);
#pragma unroll
  for (int i = 0; i < 2; ++i) rb[i] = *(const uint4*)(bp + (size_t)(64 * i) * ldb);
#pragma unroll
  for (int i = 0; i < 4; ++i) *(uint4*)(As + (arow + 64 * i) * 72 + ach * 8) = ra[i];
#pragma unroll
  for (int i = 0; i < 2; ++i) *(uint4*)(Bs + (arow + 64 * i) * 72 + ach * 8) = rb[i];
  __syncthreads();
  const int nk = K >> 6;
  for (int kt = 0; kt < nk; ++kt) {
    const int cur = kt & 1;
    const bool more = (kt + 1 < nk);
    if (more) {
      ap += 64; bp += 64;
#pragma unroll
      for (int i = 0; i < 4; ++i) ra[i] = *(const uint4*)(ap + (size_t)(64 * i) * lda);
#pragma unroll
      for (int i = 0; i < 2; ++i) rb[i] = *(const uint4*)(bp + (size_t)(64 * i) * ldb);
    }
    const u16* as = As + cur * 256 * 72 + (wm * 64 + l32) * 72 + hh * 8;
    const u16* bs = Bs + cur * 128 * 72 + (wn * 64 + l32) * 72 + hh * 8;
#pragma unroll
    for (int s = 0; s < 4; ++s) {
      bf16x8 a0 = *(const bf16x8*)(as + s * 16), a1 = *(const bf16x8*)(as + 32 * 72 + s * 16);
      bf16x8 b0 = *(const bf16x8*)(bs + s * 16), b1 = *(const bf16x8*)(bs + 32 * 72 + s * 16);
      acc[0][0] = MFMA(a0, b0, acc[0][0]);
      acc[0][1] = MFMA(a0, b1, acc[0][1]);
      acc[1][0] = MFMA(a1, b0, acc[1][0]);
      acc[1][1] = MFMA(a1, b1, acc[1][1]);
      if (LOWREG) __builtin_amdgcn_sched_barrier(0);
    }
    if (more) {
      u16* Aw = As + (cur ^ 1) * 256 * 72;
      u16* Bw = Bs + (cur ^ 1) * 128 * 72;
#pragma unroll
      for (int i = 0; i < 4; ++i) *(uint4*)(Aw + (arow + 64 * i) * 72 + ach * 8) = ra[i];
#pragma unroll
      for (int i = 0; i < 2; ++i) *(uint4*)(Bw + (arow + 64 * i) * 72 + ach * 8) = rb[i];
    }
    __syncthreads();
  }
}

#define ACC_ZERO(acc)                                                                      \
  _Pragma("unroll") for (int mi_ = 0; mi_ < 2; ++mi_) _Pragma("unroll") for (int ni_ = 0; ni_ < 2; ++ni_) \
      _Pragma("unroll") for (int r_ = 0; r_ < 16; ++r_) acc[mi_][ni_][r_] = 0.f;

#define ACC_FOREACH(acc, m0, n0, BODY)                                                     \
  {                                                                                        \
    const int lane_ = ltid() & 63, w_ = ltid() >> 6;                             \
    const int l32_ = lane_ & 31, hh_ = lane_ >> 5, wm_ = w_ >> 1, wn_ = w_ & 1;            \
    _Pragma("unroll") for (int mi_ = 0; mi_ < 2; ++mi_) _Pragma("unroll") for (int ni_ = 0; ni_ < 2; ++ni_) { \
        __builtin_amdgcn_sched_barrier(0);                                                 \
        _Pragma("unroll") for (int r_ = 0; r_ < 16; ++r_) {                                \
      const int row = (m0) + wm_ * 64 + mi_ * 32 + (r_ & 3) + 8 * (r_ >> 2) + 4 * hh_;     \
      const int col = (n0) + wn_ * 64 + ni_ * 32 + l32_;                                   \
      const float val = acc[mi_][ni_][r_];                                                    \
      BODY                                                                                 \
    } }                                                                                    \
  }

DI void conv_job(const float* __restrict__ src, int ld, int K, int col0, int nvalid, int npad, u16* __restrict__ dst,
                 int& off, float* ts) {
  const int tid = ltid();
  const int tk = K >> 6, tn = npad >> 6, ntiles = tk * tn;
  const int G = gridDim.x;
  int first = ((int)lbid() - (off % G) + G) % G;
  for (int tile = first; tile < ntiles; tile += G) {
    const int k0 = (tile % tk) * 64, n0 = (tile / tk) * 64;
    {
      const int cc = tid & 63, rg = tid >> 6;
      const bool ok = (n0 + cc) < nvalid;
#pragma unroll
      for (int i = 0; i < 8; ++i) {
        const int rr = rg * 8 + i;
        ts[rr * 65 + cc] = ok ? src[(size_t)(k0 + rr) * ld + col0 + n0 + cc] : 0.f;
      }
    }
    __syncthreads();
    {
      const int kk = tid & 63, ng = tid >> 6;
#pragma unroll
      for (int i = 0; i < 8; ++i) {
        const int nn = ng * 8 + i;
        dst[(size_t)(n0 + nn) * K + k0 + kk] = f2bf(ts[kk * 65 + nn]);
      }
    }
    __syncthreads();
  }
  off += ntiles;
}

DI void phase0(const Params& p, char* ldsc) {
  float* ldsf = (float*)ldsc;
  const int tid = ltid();
  const int G = gridDim.x;
  int off = 0;
  for (int l = 0; l < 4; ++l) {
    u16* wl = (u16*)(p.ws + OFF_W) + (size_t)l * W_LAYER;
    conv_job(p.w_in + (size_t)l * 1024 * NIN, NIN, 1024, 0, 2976, 3072, wl + WO_T1, off, ldsf);
    conv_job(p.w_in + (size_t)l * 1024 * NIN, NIN, 1024, 2976, 3072, 3072, wl + WO_TG, off, ldsf);
    conv_job(p.w_q_b + (size_t)l * 384 * 768, 768, 384, 0, 768, 768, wl + WO_QB, off, ldsf);
    conv_job(p.w_kv_b + (size_t)l * 256 * 1024, 1024, 256, 0, 1024, 1024, wl + WO_KVB, off, ldsf);
    for (int nb = 0; nb < 3; ++nb)
      conv_job(p.w_branch + (size_t)(l * 3 + nb) * 512 * 1024, 1024, 512, 0, 1024, 1024, wl + WO_BR + (size_t)nb * 1024 * 512, off, ldsf);
    conv_job(p.w_out + (size_t)l * 1024 * 1024, 1024, 1024, 0, 1024, 1024, wl + WO_OUT, off, ldsf);
    conv_job(p.w_mlp1 + (size_t)l * 1024 * 4096, 4096, 1024, 0, 4096, 4096, wl + WO_W1, off, ldsf);
    conv_job(p.w_mlp2 + (size_t)l * 4096 * 1024, 1024, 4096, 0, 1024, 1024, wl + WO_W2, off, ldsf);
  }
  {
    float* sc = ldsf;
    float* red = ldsf + 9 * 1024;
    for (int i = tid; i < 9 * 1024; i += 512) {
      float v = (i < 8 * 1024) ? p.c[i] : p.c_ctx[i - 8 * 1024];
      sc[i] = v / (1.0f + expf(-v));
    }
    __syncthreads();
    float* mods = (float*)(p.ws + OFF_MODS);
    const int ol = tid & 63, kg = tid >> 6;
    for (int item = lbid(); item < 384; item += G) {
      const int l = item / 96, o = (item % 96) * 64 + ol;
      const float* wp = p.w_mod + (size_t)l * 1024 * 6144 + o;
      float acc[9];
#pragma unroll
      for (int b = 0; b < 9; ++b) acc[b] = 0.f;
#pragma unroll 4
      for (int k = kg * 128; k < kg * 128 + 128; ++k) {
        const float wv = wp[(size_t)k * 6144];
#pragma unroll
        for (int b = 0; b < 9; ++b) acc[b] += sc[b * 1024 + k] * wv;
      }
#pragma unroll
      for (int b = 0; b < 9; ++b) red[(kg * 9 + b) * 64 + ol] = acc[b];
      __syncthreads();
      for (int i = tid; i < 576; i += 512) {
        const int b = i >> 6, o2 = i & 63;
        float s = 0.f;
#pragma unroll
        for (int g = 0; g < 8; ++g) s += red[(g * 9 + b) * 64 + o2];
        const int oc = (item % 96) * 64 + o2;
        mods[(size_t)(l * 9 + b) * 6144 + oc] = s + p.b_mod[l * 6144 + oc];
      }
      __syncthreads();
    }
  }
  {
    const int gt = lbid() * 512 + tid, GT = G * 512;
    float* rg = (float*)(p.ws + OFF_ROPEG);
    float* rm = (float*)(p.ws + OFF_ROPEM);
    float* tw = (float*)(p.ws + OFF_TW);
    for (int i = gt; i < LSEQ * 32; i += GT) {
      const int t = i >> 5, a = i & 31;
      const float pos = (a < 16) ? (float)(t >> 6) : (float)(t & 63);
      const float inv = powf(10000.0f, -(float)(a & 15) / 16.0f);
      const float ang = pos * inv;
      rg[2 * i] = cosf(ang);
      rg[2 * i + 1] = sinf(ang);
    }
    for (int i = gt; i < LSEQ * 16; i += GT) {
      const int t = i >> 4, a = i & 15;
      const float pos = (a < 8) ? (float)(t >> 6) : (float)(t & 63);
      const float inv = powf(10000.0f, -(float)(a & 7) / 8.0f);
      const float ang = pos * inv;
      rm[2 * i] = cosf(ang);
      rm[2 * i + 1] = sinf(ang);
    }
    for (int i = gt; i < FFTN; i += GT) {
      float sn, cs;
      sincospif(2.0f * (float)i / (float)FFTN, &sn, &cs);
      tw[2 * i] = cs;
      tw[2 * i + 1] = -sn;
    }
  }
}

DI void phase_rownorm(const Params& p, int l, int which, int nrows) {
  const int tid = ltid(), lane = tid & 63, w = tid >> 6;
  u16* hn = (u16*)(p.ws + OFF_A);
  const float* g = (which ? p.norm_mlp_g : p.norm_mix_g) + l * 1024;
  const bool first = (which == 0 && l == 0);
  const float* xs = first ? p.x : p.out;
  const float* cs = first ? p.ctx : (const float*)(p.ws + OFF_CTX);
  for (int r = lbid() * 8 + w; r < nrows; r += gridDim.x * 8) {
    const float* src = (r < ML) ? xs + (size_t)r * 1024 : cs + (size_t)(r - ML) * 1024;
    const int mrow = (r < ML) ? (r >> 13) : 8;
    const float* shift = mods_ptr(p, l, mrow, which ? 3 : 0);
    const float* scale = mods_ptr(p, l, mrow, which ? 4 : 1);
    float4 v[4];
    float ss = 0.f;
#pragma unroll
    for (int i = 0; i < 4; ++i) {
      v[i] = *(const float4*)(src + 4 * (lane + 64 * i));
      ss += v[i].x * v[i].x + v[i].y * v[i].y + v[i].z * v[i].z + v[i].w * v[i].w;
    }
    ss = wave_sum(ss);
    const float rstd = rsqrtf(ss * (1.0f / 1024.0f) + EPSV);
#pragma unroll
    for (int i = 0; i < 4; ++i) {
      const int c0 = 4 * (lane + 64 * i);
      const float4 gg = *(const float4*)(g + c0), sh = *(const float4*)(shift + c0), sc = *(const float4*)(scale + c0);
      const float o0 = v[i].x * rstd * gg.x * (1.f + sc.x) + sh.x;
      const float o1 = v[i].y * rstd * gg.y * (1.f + sc.y) + sh.y;
      const float o2 = v[i].z * rstd * gg.z * (1.f + sc.z) + sh.z;
      const float o3 = v[i].w * rstd * gg.w * (1.f + sc.w) + sh.w;
      uint2 pk;
      pk.x = pk2(o0, o1);
      pk.y = pk2(o2, o3);
      *(uint2*)(hn + (size_t)r * 1024 + c0) = pk;
    }
  }
}

DI void filter_tiles(const Params& p, int l, int Lf, int cstride, float* __restrict__ kdst, float* __restrict__ part, float* lds) {
  const int tid = ltid(), lane = tid & 63, w = tid >> 6;
  float* zs = lds;
  float* h1s = lds + 64 * 33;
  float* h2s = h1s + 64 * 65;
  const float* f1w = p.hy_f1_w + l * 33 * 64;
  const float* f1b = p.hy_f1_b + l * 64;
  const float* f2w = p.hy_f2_w + l * 64 * 64;
  const float* f2b = p.hy_f2_b + l * 64;
  const float* sf = p.hy_sin_freq + l * 128;
  const float* f3w = p.hy_f3_w + (size_t)l * 64 * 1024;
  const int ntile = Lf >> 6;
  const float min_decay = logf(1e-2f) / 1.5f, max_decay = logf(1e-2f) / 0.3f;
  for (int tile = lbid(); tile < ntile; tile += gridDim.x) {
    const int t0 = tile * 64;
    for (int idx = tid; idx < 64 * 33; idx += 512) {
      const int tt = idx / 33, e = idx - tt * 33;
      const int t = t0 + tt;
      float val;
      if (e == 0) {
        val = (float)t / (float)(Lf - 1);
      } else {
        const float wt = 6.283185307179586f * (float)t / (float)Lf;
        const int bi = (e - 1) & 15;
        const float f = 1e-4f + (float)bi * ((15.0f - 1e-4f) / 15.0f);
        val = (e <= 16) ? cosf(f * wt) : -sinf(f * wt);
      }
      zs[idx] = val;
    }
    __syncthreads();
    {
      const int tt = tid & 63, jg = tid >> 6;
#pragma unroll 1
      for (int jj = 0; jj < 8; ++jj) {
        const int j = jg * 8 + jj;
        float a = f1b[j];
#pragma unroll 3
        for (int e = 0; e < 33; ++e) a += zs[tt * 33 + e] * f1w[e * 64 + j];
        h1s[tt * 65 + j] = sinf(sf[j] * a);
      }
    }
    __syncthreads();
    {
      const int tt = tid & 63, jg = tid >> 6;
#pragma unroll 1
      for (int jj = 0; jj < 8; ++jj) {
        const int j = jg * 8 + jj;
        float a = f2b[j];
#pragma unroll 4
        for (int e = 0; e < 64; ++e) a += h1s[tt * 65 + e] * f2w[e * 64 + j];
        h2s[tt * 65 + j] = sinf(sf[64 + j] * a);
      }
    }
    __syncthreads();
    {
      const int tt = lane, t = t0 + tt;
      const float tn = (float)t / (float)(Lf - 1);
#pragma unroll 1
      for (int ob = w * 128; ob < w * 128 + 128; ob += 16) {
        float acc[16];
#pragma unroll
        for (int q = 0; q < 16; ++q) acc[q] = 0.f;
#pragma unroll 2
        for (int i = 0; i < 64; ++i) {
          const float hv = h2s[tt * 65 + i];
          const float* wr = f3w + i * 1024 + ob;
#pragma unroll
          for (int q = 0; q < 16; ++q) acc[q] += hv * wr[q];
        }
#pragma unroll
        for (int q = 0; q < 16; ++q) {
          const int o = ob + q, dir = o >> 9, c = o & 511;
          const float delta = fabsf(min_decay + (float)c * ((max_decay - min_decay) / 511.0f));
          float val = acc[q] * expf(-tn * delta);
          int pos;
          if (dir == 0) pos = t;
          else if (t == 0) { pos = Lf; val = 0.f; }
          else pos = 2 * Lf - t;
          kdst[(size_t)c * cstride + pos] = val;
          const float s2 = wave_sum(val * val);
          if (lane == 0) part[tile * 1024 + o] = s2;
        }
      }
    }
    __syncthreads();
  }
}

DI void fft_fwd(float* re, float* im, const float2* __restrict__ tw) {
  const int tid = ltid();
  for (int s = 0; s < 7; ++s) {
    const int qs = 12 - 2 * s;
    const int q = 1 << qs;
    for (int bi = tid; bi < 4096; bi += 512) {
      const int j = bi & (q - 1), g = bi >> qs;
      const int i0 = (g << (qs + 2)) + j, i1 = i0 + q, i2 = i1 + q, i3 = i2 + q;
      const float ar = re[i0], ai = im[i0], br = re[i1], bi_ = im[i1], cr = re[i2], ci = im[i2], dr = re[i3], di = im[i3];
      const float t0r = ar + cr, t0i = ai + ci, t1r = ar - cr, t1i = ai - ci;
      const float t2r = br + dr, t2i = bi_ + di;
      const float er = br - dr, ei = bi_ - di;
      const float t3r = ei, t3i = -er;
      const float2 w1 = tw[j << (2 * s)];
      const float w2r = w1.x * w1.x - w1.y * w1.y, w2i = 2.f * w1.x * w1.y;
      const float w3r = w2r * w1.x - w2i * w1.y, w3i = w2r * w1.y + w2i * w1.x;
      const float y1r = t1r + t3r, y1i = t1i + t3i, y2r = t0r - t2r, y2i = t0i - t2i, y3r = t1r - t3r, y3i = t1i - t3i;
      re[i0] = t0r + t2r; im[i0] = t0i + t2i;
      re[i1] = y1r * w1.x - y1i * w1.y; im[i1] = y1r * w1.y + y1i * w1.x;
      re[i2] = y2r * w2r - y2i * w2i;   im[i2] = y2r * w2i + y2i * w2r;
      re[i3] = y3r * w3r - y3i * w3i;   im[i3] = y3r * w3i + y3i * w3r;
    }
    __syncthreads();
  }
}
DI void fft_inv(float* re, float* im, const float2* __restrict__ tw) {
  const int tid = ltid();
  for (int s = 6; s >= 0; --s) {
    const int qs = 12 - 2 * s;
    const int q = 1 << qs;
    for (int bi = tid; bi < 4096; bi += 512) {
      const int j = bi & (q - 1), g = bi >> qs;
      const int i0 = (g << (qs + 2)) + j, i1 = i0 + q, i2 = i1 + q, i3 = i2 + q;
      const float2 w1 = tw[j << (2 * s)];
      const float w1r = w1.x, w1i = -w1.y;
      const float w2r = w1r * w1r - w1i * w1i, w2i = 2.f * w1r * w1i;
      const float w3r = w2r * w1r - w2i * w1i, w3i = w2r * w1i + w2i * w1r;
      const float ar = re[i0], ai = im[i0];
      const float xr1 = re[i1], xi1 = im[i1], xr2 = re[i2], xi2 = im[i2], xr3 = re[i3], xi3 = im[i3];
      const float br = xr1 * w1r - xi1 * w1i, bi_ = xr1 * w1i + xi1 * w1r;
      const float cr = xr2 * w2r - xi2 * w2i, ci = xr2 * w2i + xi2 * w2r;
      const float dr = xr3 * w3r - xi3 * w3i, di = xr3 * w3i + xi3 * w3r;
      const float t0r = ar + cr, t0i = ai + ci, t1r = ar - cr, t1i = ai - ci;
      const float t2r = br + dr, t2i = bi_ + di;
      const float er = br - dr, ei = bi_ - di;
      const float t3r = -ei, t3i = er;
      re[i0] = t0r + t2r; im[i0] = t0i + t2i;
      re[i1] = t1r + t3r; im[i1] = t1i + t3i;
      re[i2] = t0r - t2r; im[i2] = t0i - t2i;
      re[i3] = t1r - t3r; im[i3] = t1i - t3i;
    }
    __syncthreads();
  }
}

DI void phase_filter_fft(const Params& p, int l, float* lds) {
  const int tid = ltid();
  float* re = lds;
  float* im = lds + FFTN;
  float* kf = (float*)(p.ws + OFF_KF);
  const float2* tw = (const float2*)(p.ws + OFF_TW);
  const float* part = (const float*)(p.ws + OFF_PART);
  for (int c = lbid(); c < 512; c += gridDim.x) {
    float* slot = kf + (size_t)c * (2 * FFTN);
    float pv = 0.f;
    if (tid < 128) pv = part[tid * 1024 + c] + part[tid * 1024 + 512 + c];
    pv = wave_sum(pv);
    if ((tid & 63) == 0) lds[tid >> 6] = pv;
    __syncthreads();
    const float ssq = lds[0] + lds[1];
    __syncthreads();
    const float sc = rsqrtf(ssq + EPSV) * (1.0f / (float)FFTN);
    for (int i = tid; i < FFTN; i += 512) { re[i] = slot[i] * sc; im[i] = 0.f; }
    __syncthreads();
    fft_fwd(re, im, tw);
    for (int i = tid; i < FFTN; i += 512) { float2 v; v.x = re[i]; v.y = im[i]; ((float2*)slot)[i] = v; }
    __syncthreads();
  }
}

DI void phase_gemm1(const Params& p, int l, u16* lds) {
  const u16* hn = (const u16*)(p.ws + OFF_A);
  const u16* wt = (const u16*)(p.ws + OFF_W) + (size_t)l * W_LAYER + WO_T1;
  const int NT = 24, nitems = (MALL / 256) * NT;
  for (int item = lbid(); item < nitems; item += gridDim.x) {
    const int mt = item / NT, nt = item % NT;
    const int m0 = mt * 256, n0 = nt * 128;
    f32x16 acc[2][2];
    ACC_ZERO(acc);
    gemm_mainloop(hn + (size_t)m0 * 1024, 1024, wt + (size_t)n0 * 1024, 1024, 1024, acc, lds);
    u16* dst; int ld, cofs;
    if (nt < 4) { dst = (u16*)(p.ws + OFF_B); ld = 512; cofs = 0; }
    else if (nt < 12) { dst = (u16*)(p.ws + OFF_C); ld = 1024; cofs = 512; }
    else { dst = (u16*)(p.ws + OFF_R); ld = 1536; cofs = 1536; }
    ACC_FOREACH(acc, m0, n0, { dst[(size_t)row * ld + (col - cofs)] = f2bf(val); });
  }
}

DI void phase_h1(const Params& p, int l, float* lds) {
  const int tid = ltid();
  const u16* U12 = (const u16*)(p.ws + OFF_C);
  float* zT = (float*)(p.ws + OFF_A);
  const float* sw = p.hy_short_w + l * 3 * 1536;
  float* xs = lds;
  float* vs = lds + 66 * 65;
  const int nlat = 8 * 128 * 8, nctx = (l < 3) ? 8 * 4 * 8 : 0;
  for (int item = lbid(); item < nlat + nctx; item += gridDim.x) {
    int b, tt0, c0, Ls, rowbase; size_t zbase;
    if (item < nlat) { b = item >> 10; tt0 = ((item >> 3) & 127) * 64; c0 = (item & 7) * 64; Ls = LSEQ; rowbase = b * LSEQ; zbase = (size_t)b * 512 * LSEQ; }
    else { const int it = item - nlat; b = it >> 5; tt0 = ((it >> 3) & 3) * 64; c0 = (it & 7) * 64; Ls = LCTX; rowbase = ML + b * LCTX; zbase = (size_t)ZC_OFF + (size_t)b * 512 * LCTX; }
    for (int ch = tid; ch < 66 * 16; ch += 512) {
      const int arr = ch / 528, rem = ch - arr * 528;
      const int rr = rem >> 3, cc8 = (rem & 7) * 8;
      const int t = tt0 - 1 + rr;
      float* dstp = (arr ? vs : xs) + rr * 65 + cc8;
      if (t >= 0 && t < Ls) {
        const uint4 v = *(const uint4*)(U12 + (size_t)(rowbase + t) * 1024 + arr * 512 + c0 + cc8);
        const unsigned uu[4] = {v.x, v.y, v.z, v.w};
#pragma unroll
        for (int i = 0; i < 4; ++i) { dstp[2 * i] = __uint_as_float(uu[i] << 16); dstp[2 * i + 1] = __uint_as_float(uu[i] & 0xffff0000u); }
      } else {
#pragma unroll
        for (int i = 0; i < 8; ++i) dstp[i] = 0.f;
      }
    }
    __syncthreads();
    {
      const int tt = tid & 63, cgp = tid >> 6;
#pragma unroll
      for (int i = 0; i < 8; ++i) {
        const int cc = cgp * 8 + i, c = c0 + cc;
        float x1 = 0.f, vv = 0.f;
#pragma unroll
        for (int j = 0; j < 3; ++j) {
          x1 += sw[j * 1536 + 512 + c] * xs[(tt + j) * 65 + cc];
          vv += sw[j * 1536 + 1024 + c] * vs[(tt + j) * 65 + cc];
        }
        zT[zbase + (size_t)c * Ls + tt0 + tt] = x1 * vv;
      }
    }
    __syncthreads();
  }
}

DI void phase_p3(const Params& p, int l, float* lds) {
  const int tid = ltid(), lane = tid & 63, w = tid >> 6;
  u16* R = (u16*)(p.ws + OFF_R);
  float* rb = lds + w * 1472;
  float* hs = rb + 1440;
  const float* qn = p.gqa_q_norm + l * 64;
  const float* kn = p.gqa_k_norm + l * 64;
  const float* qan = p.mla_q_a_norm + l * 384;
  const float* kvan = p.mla_kv_a_norm + l * 256;
  const float* ropeg = (const float*)(p.ws + OFF_ROPEG);
  const float qscale = 0.125f * LOG2E;
  for (int r0 = lbid() * 8; r0 < MALL; r0 += gridDim.x * 8) {
    const int r = r0 + w;
    u16* rowp = R + (size_t)r * 1536;
    for (int ch = lane; ch < 180; ch += 64) {
      const uint4 v = *(const uint4*)(rowp + ch * 8);
      const unsigned uu[4] = {v.x, v.y, v.z, v.w};
#pragma unroll
      for (int i = 0; i < 4; ++i) { rb[ch * 8 + 2 * i] = __uint_as_float(uu[i] << 16); rb[ch * 8 + 2 * i + 1] = __uint_as_float(uu[i] & 0xffff0000u); }
    }
    __syncthreads();
    {
      float s = 0.f;
#pragma unroll
      for (int i = 0; i < 8; ++i) { const float v = rb[lane * 8 + i]; s += v * v; }
      s += __shfl_xor(s, 1); s += __shfl_xor(s, 2); s += __shfl_xor(s, 4);
      if ((lane & 7) == 0) hs[lane >> 3] = rsqrtf(s * (1.0f / 64.0f) + EPSV);
      float s2 = 0.f;
      if (lane < 16) {
#pragma unroll
        for (int i = 0; i < 8; ++i) { const float v = rb[512 + lane * 8 + i]; s2 += v * v; }
      }
      s2 += __shfl_xor(s2, 1); s2 += __shfl_xor(s2, 2); s2 += __shfl_xor(s2, 4);
      if (lane < 16 && (lane & 7) == 0) hs[8 + (lane >> 3)] = rsqrtf(s2 * (1.0f / 64.0f) + EPSV);
      float s3 = 0.f, s4 = 0.f;
#pragma unroll
      for (int i = 0; i < 6; ++i) { const float v = rb[768 + lane * 6 + i]; s3 += v * v; }
#pragma unroll
      for (int i = 0; i < 4; ++i) { const float v = rb[1152 + lane * 4 + i]; s4 += v * v; }
      s3 = wave_sum(s3); s4 = wave_sum(s4);
      if (lane == 0) { hs[10] = rsqrtf(s3 * (1.0f / 384.0f) + EPSV); hs[11] = rsqrtf(s4 * (1.0f / 256.0f) + EPSV); }
    }
    __syncthreads();
    {
      const bool lat = r < ML;
      const int t = r & (LSEQ - 1);
      const int d = lane, a = d & 31;
      float cs = 1.f, sn = 0.f;
      if (lat) { cs = ropeg[(t * 32 + a) * 2]; sn = ropeg[(t * 32 + a) * 2 + 1]; }
#pragma unroll
      for (int hd = 0; hd < 10; ++hd) {
        const float* gq = (hd < 8) ? qn : kn;
        const float rs = hs[hd];
        const float v = rb[hd * 64 + d] * rs * gq[d];
        const int dp = d ^ 32;
        const float vp = rb[hd * 64 + dp] * rs * gq[dp];
        float o = (d < 32) ? (v * cs - vp * sn) : (vp * sn + v * cs);
        if (hd < 8) o *= qscale;
        rowp[hd * 64 + d] = f2bf(o);
      }
#pragma unroll
      for (int i = 0; i < 6; ++i) { const int e = lane + 64 * i; rowp[768 + e] = f2bf(rb[768 + e] * hs[10] * qan[e]); }
#pragma unroll
      for (int i = 0; i < 4; ++i) { const int e = lane + 64 * i; rowp[1152 + e] = f2bf(rb[1152 + e] * hs[11] * kvan[e]); }
    }
    __syncthreads();
  }
}

DI void phase_h2(const Params& p, int l, float* lds) {
  const int tid = ltid(), lane = tid & 63, w = tid >> 6;
  float* zT = (float*)(p.ws + OFF_A);
  const float2* kf = (const float2*)(p.ws + OFF_KF);
  const float2* tw = (const float2*)(p.ws + OFF_TW);
  const float* skip = p.hy_skip + l * 512;
  float* re = lds;
  float* im = lds + FFTN;
  for (int item = lbid(); item < 2048; item += gridDim.x) {
    const int c = item >> 2, bp = item & 3;
    float* z1 = zT + ((size_t)(2 * bp) * 512 + c) * LSEQ;
    float* z2 = zT + ((size_t)(2 * bp + 1) * 512 + c) * LSEQ;
    for (int i = tid; i < LSEQ; i += 512) { re[i] = z1[i]; im[i] = z2[i]; re[i + LSEQ] = 0.f; im[i + LSEQ] = 0.f; }
    __syncthreads();
    fft_fwd(re, im, tw);
    const float2* kc = kf + (size_t)c * FFTN;
    for (int i = tid; i < FFTN; i += 512) {
      const float2 k = kc[i];
      const float xr = re[i], xi = im[i];
      re[i] = xr * k.x - xi * k.y;
      im[i] = xr * k.y + xi * k.x;
    }
    __syncthreads();
    fft_inv(re, im, tw);
    const float sk = skip[c];
    for (int i = tid; i < LSEQ; i += 512) {
      const float a = z1[i], b = z2[i];
      z1[i] = re[i] + a * sk;
      z2[i] = im[i] + b * sk;
    }
    __syncthreads();
  }
  if (l < 3) {
    const float* kcb = (const float*)(p.ws + OFF_KC);
    const float* partc = (const float*)(p.ws + OFF_PART) + 128 * 1024;
    float* zs = lds + w * 768;
    float* ks = zs + 256;
    for (int item = lbid(); item < 512; item += gridDim.x) {
      const int b = item >> 6, c = (item & 63) * 8 + w;
      float* z = zT + (size_t)ZC_OFF + ((size_t)b * 512 + c) * LCTX;
      float pv = (lane < 4) ? partc[lane * 1024 + c] + partc[lane * 1024 + 512 + c] : 0.f;
      pv = wave_sum(pv);
      const float sc = rsqrtf(pv + EPSV);
      for (int i = lane; i < 256; i += 64) zs[i] = z[i];
      for (int i = lane; i < 512; i += 64) ks[i] = kcb[c * 512 + i] * sc;
      __syncthreads();
      const float sk = skip[c];
      float acc[4] = {0.f, 0.f, 0.f, 0.f};
      for (int s = 0; s < 256; ++s) {
        const float zv = zs[s];
#pragma unroll
        for (int i = 0; i < 4; ++i) acc[i] += ks[(lane + 64 * i - s) & 511] * zv;
      }
#pragma unroll
      for (int i = 0; i < 4; ++i) z[lane + 64 * i] = acc[i] + zs[lane + 64 * i] * sk;
      __syncthreads();
    }
  }
}

DI void phase_h3(const Params& p, int l, float* lds) {
  const int tid = ltid();
  const u16* U0 = (const u16*)(p.ws + OFF_B);
  const float* zT = (const float*)(p.ws + OFF_A);
  u16* Y = (u16*)(p.ws + OFF_Y);
  const float* sw = p.hy_short_w + l * 3 * 1536;
  float* xs = lds;
  float* ys = lds + 66 * 65;
  const int nlat = 8 * 128 * 8, nctx = (l < 3) ? 8 * 4 * 8 : 0;
  for (int item = lbid(); item < nlat + nctx; item += gridDim.x) {
    int b, tt0, c0, Ls, rowbase; size_t zbase;
    if (item < nlat) { b = item >> 10; tt0 = ((item >> 3) & 127) * 64; c0 = (item & 7) * 64; Ls = LSEQ; rowbase = b * LSEQ; zbase = (size_t)b * 512 * LSEQ; }
    else { const int it = item - nlat; b = it >> 5; tt0 = ((it >> 3) & 3) * 64; c0 = (it & 7) * 64; Ls = LCTX; rowbase = ML + b * LCTX; zbase = (size_t)ZC_OFF + (size_t)b * 512 * LCTX; }
    for (int ch = tid; ch < 66 * 8; ch += 512) {
      const int rr = ch >> 3, cc8 = (ch & 7) * 8;
      const int t = tt0 - 1 + rr;
      float* dstp = xs + rr * 65 + cc8;
      if (t >= 0 && t < Ls) {
        const uint4 v = *(const uint4*)(U0 + (size_t)(rowbase + t) * 512 + c0 + cc8);
        const unsigned uu[4] = {v.x, v.y, v.z, v.w};
#pragma unroll
        for (int i = 0; i < 4; ++i) { dstp[2 * i] = __uint_as_float(uu[i] << 16); dstp[2 * i + 1] = __uint_as_float(uu[i] & 0xffff0000u); }
      } else {
#pragma unroll
        for (int i = 0; i < 8; ++i) dstp[i] = 0.f;
      }
    }
    {
      const int tt = tid & 63, cgp = tid >> 6;
#pragma unroll
      for (int i = 0; i < 8; ++i) {
        const int cc = cgp * 8 + i;
        ys[cc * 65 + tt] = zT[zbase + (size_t)(c0 + cc) * Ls + tt0 + tt];
      }
    }
    __syncthreads();
    {
      const int cc = tid & 63, tg = tid >> 6, c = c0 + cc;
      const float w0 = sw[c], w1 = sw[1536 + c], w2 = sw[2 * 1536 + c];
#pragma unroll
      for (int i = 0; i < 8; ++i) {
        const int tt = tg * 8 + i;
        const float x0 = w0 * xs[tt * 65 + cc] + w1 * xs[(tt + 1) * 65 + cc] + w2 * xs[(tt + 2) * 65 + cc];
        Y[(size_t)(rowbase + tt0 + tt) * 1536 + c] = f2bf(x0 * ys[cc * 65 + tt]);
      }
    }
    __syncthreads();
  }
}

DI void phase_p4(const Params& p, int l, u16* lds) {
  const u16* R = (const u16*)(p.ws + OFF_R);
  u16* QK = (u16*)(p.ws + OFF_A);
  const u16* wl = (const u16*)(p.ws + OFF_W) + (size_t)l * W_LAYER;
  const int NT = 14, nitems = (MALL / 256) * NT;
  for (int item = lbid(); item < nitems; item += gridDim.x) {
    const int mt = item / NT, nt = item % NT;
    const int m0 = mt * 256;
    f32x16 acc[2][2];
    ACC_ZERO(acc);
    int n0;
    if (nt < 6) { n0 = nt * 128; gemm_mainloop(R + (size_t)m0 * 1536 + 768, 1536, wl + WO_QB + (size_t)n0 * 384, 384, 384, acc, lds); }
    else { n0 = (nt - 6) * 128; gemm_mainloop(R + (size_t)m0 * 1536 + 1152, 1536, wl + WO_KVB + (size_t)n0 * 256, 256, 256, acc, lds); n0 += 768; }
    ACC_FOREACH(acc, m0, n0, { QK[(size_t)row * 1792 + col] = f2bf(val); });
  }
}

DI void phase_p5(const Params& p, int l, float* lds) {
  const int tid = ltid(), lane = tid & 63, w = tid >> 6;
  u16* QK = (u16*)(p.ws + OFF_A);
  u16* KM = (u16*)(p.ws + OFF_KM);
  const u16* R = (const u16*)(p.ws + OFF_R);
  float* rb = lds + w * 1856;
  float* hs = rb + 1824;
  const float* qn = p.mla_q_norm + l * 96;
  const float* kn = p.mla_k_norm + l * 96;
  const float* ropem = (const float*)(p.ws + OFF_ROPEM);
  const float qscale = 0.10206207261596575f * LOG2E;
  for (int r0 = lbid() * 8; r0 < MALL; r0 += gridDim.x * 8) {
    const int r = r0 + w;
    u16* rowp = QK + (size_t)r * 1792;
    for (int ch = lane; ch < 228; ch += 64) {
      const uint4 v = (ch < 224) ? *(const uint4*)(rowp + ch * 8) : *(const uint4*)(R + (size_t)r * 1536 + 1408 + (ch - 224) * 8);
      const unsigned uu[4] = {v.x, v.y, v.z, v.w};
#pragma unroll
      for (int i = 0; i < 4; ++i) { rb[ch * 8 + 2 * i] = __uint_as_float(uu[i] << 16); rb[ch * 8 + 2 * i + 1] = __uint_as_float(uu[i] & 0xffff0000u); }
    }
    __syncthreads();
    {
      const int hd = lane >> 3, j = lane & 7;
      float s = 0.f, s2 = 0.f;
#pragma unroll
      for (int i = 0; i < 12; ++i) {
        const int d = j * 12 + i;
        const float v = rb[hd * 96 + d];
        s += v * v;
        const float kv = (d < 64) ? rb[768 + hd * 128 + d] : rb[1792 + d - 64];
        s2 += kv * kv;
      }
      s += __shfl_xor(s, 1); s += __shfl_xor(s, 2); s += __shfl_xor(s, 4);
      s2 += __shfl_xor(s2, 1); s2 += __shfl_xor(s2, 2); s2 += __shfl_xor(s2, 4);
      if (j == 0) { hs[hd] = rsqrtf(s * (1.0f / 96.0f) + EPSV); hs[8 + hd] = rsqrtf(s2 * (1.0f / 96.0f) + EPSV); }
    }
    __syncthreads();
    {
      const bool lat = r < ML;
      const int t = r & (LSEQ - 1);
#pragma unroll
      for (int i = 0; i < 12; ++i) {
        const int e = lane + 64 * i;
        const int hd = e / 96, d = e - hd * 96;
        const float rq = hs[hd], rk = hs[8 + hd];
        float qv = rb[hd * 96 + d] * rq * qn[d];
        float kv = ((d < 64) ? rb[768 + hd * 128 + d] : rb[1792 + d - 64]) * rk * kn[d];
        if (d >= 64 && lat) {
          const int a = (d - 64) & 15;
          const float cs = ropem[(t * 16 + a) * 2], sn = ropem[(t * 16 + a) * 2 + 1];
          const int dp = (d < 80) ? d + 16 : d - 16;
          const float qp = rb[hd * 96 + dp] * rq * qn[dp];
          const float kp = rb[1792 + dp - 64] * rk * kn[dp];
          if (d < 80) { qv = qv * cs - qp * sn; kv = kv * cs - kp * sn; }
          else { qv = qp * sn + qv * cs; kv = kp * sn + kv * cs; }
        }
        rowp[e] = f2bf(qv * qscale);
        KM[(size_t)r * 768 + e] = f2bf(kv);
      }
    }
    __syncthreads();
  }
}

template <int DQK>
DI void attn_block(const u16* __restrict__ Qp, int q_ld, const u16* __restrict__ Kp, int k_ld, const u16* __restrict__ Vp,
                   int v_ld, u16* __restrict__ Op, int o_ld, int qrow0, int qt0, int s0_row0, int s0_n, int s0_t0,
                   int masked0, int s1_row0, int s1_n, float sink_l2, int has_sink, u16* lds) {
  constexpr int KS = DQK + 8, NS = DQK / 16, CPK = DQK / 8;
  const int tid = ltid(), lane = tid & 63, w = tid >> 6, l32 = lane & 31, hh = lane >> 5;
  u16* Ks = lds;
  u16* Vt = lds + 2 * 64 * KS;
  const int qrow = qrow0 + 32 * w + l32;
  bf16x8 qf[NS];
#pragma unroll
  for (int s = 0; s < NS; ++s) qf[s] = *(const bf16x8*)(Qp + (size_t)qrow * q_ld + 16 * s + 8 * hh);
  f32x16 ot[2];
#pragma unroll
  for (int i = 0; i < 16; ++i) { ot[0][i] = 0.f; ot[1][i] = 0.f; }
  float m = -1e30f, lsum = 0.f;
  const int nt0 = s0_n >> 6, nt = nt0 + (s1_n >> 6);
  const int kkey0 = tid / CPK, kch0 = tid - kkey0 * CPK;
  const int c1 = tid + 512;
  const bool has1 = c1 < 64 * CPK;
  const int kkey1 = has1 ? c1 / CPK : 0, kch1 = has1 ? c1 - kkey1 * CPK : 0;
  const int vkey = tid & 63, vch = tid >> 6;
  uint4 rk0, rk1, rv;
  rk1 = make_uint4(0, 0, 0, 0);
  {
    const int row0 = (0 < nt0) ? s0_row0 : s1_row0;
    rk0 = *(const uint4*)(Kp + (size_t)(row0 + kkey0) * k_ld + kch0 * 8);
    if (has1) rk1 = *(const uint4*)(Kp + (size_t)(row0 + kkey1) * k_ld + kch1 * 8);
    rv = *(const uint4*)(Vp + (size_t)(row0 + vkey) * v_ld + vch * 8);
  }
  {
    *(uint4*)(Ks + kkey0 * KS + kch0 * 8) = rk0;
    if (has1) *(uint4*)(Ks + kkey1 * KS + kch1 * 8) = rk1;
    const unsigned uu[4] = {rv.x, rv.y, rv.z, rv.w};
#pragma unroll
    for (int i = 0; i < 4; ++i) {
      Vt[(vch * 8 + 2 * i) * 68 + vkey] = (u16)(uu[i] & 0xffffu);
      Vt[(vch * 8 + 2 * i + 1) * 68 + vkey] = (u16)(uu[i] >> 16);
    }
  }
  __syncthreads();
  const int tq = qt0 + 32 * w + l32;
  for (int j = 0; j < nt; ++j) {
    const int cur = j & 1;
    const bool more = (j + 1 < nt);
    if (more) {
      const int jn = j + 1;
      const int row0 = (jn < nt0) ? s0_row0 + 64 * jn : s1_row0 + 64 * (jn - nt0);
      rk0 = *(const uint4*)(Kp + (size_t)(row0 + kkey0) * k_ld + kch0 * 8);
      if (has1) rk1 = *(const uint4*)(Kp + (size_t)(row0 + kkey1) * k_ld + kch1 * 8);
      rv = *(const uint4*)(Vp + (size_t)(row0 + vkey) * v_ld + vch * 8);
    }
    const bool mtile = masked0 && (j < nt0);
    const int tk0 = s0_t0 + 64 * j;
    bool active = true;
    if (mtile) {
      const int tql = qt0 + 32 * w;
      active = (tk0 + 63 >= tql - 128) && (tk0 <= tql + 31 + 128);
    }
    if (active) {
      const u16* kb = Ks + cur * 64 * KS + l32 * KS + hh * 8;
      f32x16 st[2];
#pragma unroll
      for (int i = 0; i < 16; ++i) { st[0][i] = 0.f; st[1][i] = 0.f; }
#pragma unroll
      for (int s = 0; s < NS; ++s) {
        const bf16x8 a0 = *(const bf16x8*)(kb + s * 16);
        const bf16x8 a1 = *(const bf16x8*)(kb + 32 * KS + s * 16);
        st[0] = MFMA(a0, qf[s], st[0]);
        st[1] = MFMA(a1, qf[s], st[1]);
      }
      if (mtile) {
#pragma unroll
        for (int kt = 0; kt < 2; ++kt)
#pragma unroll
          for (int rg = 0; rg < 16; ++rg) {
            const int tk = tk0 + 32 * kt + (rg & 3) + 8 * (rg >> 2) + 4 * hh;
            const int dlt = tk - tq;
            if (dlt > 128 || dlt < -128) st[kt][rg] = -1e30f;
          }
      }
      float mloc = st[0][0];
#pragma unroll
      for (int rg = 1; rg < 16; ++rg) mloc = fmaxf(mloc, st[0][rg]);
#pragma unroll
      for (int rg = 0; rg < 16; ++rg) mloc = fmaxf(mloc, st[1][rg]);
      mloc = fmaxf(mloc, __shfl_xor(mloc, 32));
      const float mnew = fmaxf(m, mloc);
      const float alpha = __builtin_amdgcn_exp2f(m - mnew);
      m = mnew;
      float ps = 0.f;
#pragma unroll
      for (int kt = 0; kt < 2; ++kt)
#pragma unroll
        for (int rg = 0; rg < 16; ++rg) {
          float pv = __builtin_amdgcn_exp2f(st[kt][rg] - mnew);
          if (mtile) pv = (st[kt][rg] < -1e29f) ? 0.f : pv;
          st[kt][rg] = pv;
          ps += pv;
        }
      lsum = lsum * alpha + ps;
#pragma unroll
      for (int i = 0; i < 16; ++i) { ot[0][i] *= alpha; ot[1][i] *= alpha; }
      const u16* vb = Vt + cur * 64 * 68 + l32 * 68 + 4 * hh;
#pragma unroll
      for (int kt = 0; kt < 2; ++kt)
#pragma unroll
        for (int s = 0; s < 2; ++s) {
          unsigned pw[4];
#pragma unroll
          for (int i = 0; i < 4; ++i) pw[i] = pk2(st[kt][8 * s + 2 * i], st[kt][8 * s + 2 * i + 1]);
          const uint4 pu = make_uint4(pw[0], pw[1], pw[2], pw[3]);
          const bf16x8 pf = __builtin_bit_cast(bf16x8, pu);
#pragma unroll
          for (int dt = 0; dt < 2; ++dt) {
            const u16* vp = vb + dt * 32 * 68 + 32 * kt + 16 * s;
            const uint2 lo = *(const uint2*)(vp);
            const uint2 hi = *(const uint2*)(vp + 8);
            const uint4 au = make_uint4(lo.x, lo.y, hi.x, hi.y);
            ot[dt] = MFMA(__builtin_bit_cast(bf16x8, au), pf, ot[dt]);
          }
        }
    }
    if (more) {
      u16* Kw = Ks + (cur ^ 1) * 64 * KS;
      u16* Vw = Vt + (cur ^ 1) * 64 * 68;
      *(uint4*)(Kw + kkey0 * KS + kch0 * 8) = rk0;
      if (has1) *(uint4*)(Kw + kkey1 * KS + kch1 * 8) = rk1;
      const unsigned uu[4] = {rv.x, rv.y, rv.z, rv.w};
#pragma unroll
      for (int i = 0; i < 4; ++i) {
        Vw[(vch * 8 + 2 * i) * 68 + vkey] = (u16)(uu[i] & 0xffffu);
        Vw[(vch * 8 + 2 * i + 1) * 68 + vkey] = (u16)(uu[i] >> 16);
      }
    }
    __syncthreads();
  }
  float ltot = lsum + __shfl_xor(lsum, 32);
  if (has_sink) ltot += __builtin_amdgcn_exp2f(sink_l2 - m);
  const float inv = 1.0f / ltot;
#pragma unroll
  for (int dt = 0; dt < 2; ++dt)
#pragma unroll
    for (int g = 0; g < 4; ++g) {
      uint2 pk;
      pk.x = pk2(ot[dt][4 * g] * inv, ot[dt][4 * g + 1] * inv);
      pk.y = pk2(ot[dt][4 * g + 2] * inv, ot[dt][4 * g + 3] * inv);
      *(uint2*)(Op + (size_t)qrow * o_ld + dt * 32 + 8 * g + 4 * hh) = pk;
    }
}

DI void phase_attn(const Params& p, int l, u16* lds) {
  const u16* R = (const u16*)(p.ws + OFF_R);
  const u16* QK = (const u16*)(p.ws + OFF_A);
  const u16* KM = (const u16*)(p.ws + OFF_KM);
  u16* Y = (u16*)(p.ws + OFF_Y);
  const float* sink = p.gqa_sink + l * 8;
  const int n_mla = 2048, n_gqa = 2048, n_ctx = (l < 3) ? 128 : 0;
  for (int item = lbid(); item < n_mla + n_gqa + n_ctx; item += gridDim.x) {
    int kind, qb, hd, b, isctx;
    if (item < n_mla) { kind = 0; isctx = 0; qb = item & 31; hd = (item >> 5) & 7; b = item >> 8; }
    else if (item < n_mla + n_gqa) { const int it = item - n_mla; kind = 1; isctx = 0; qb = it & 31; hd = (it >> 5) & 7; b = it >> 8; }
    else { const int it = item - n_mla - n_gqa; isctx = 1; qb = 0; hd = it & 7; b = (it >> 3) & 7; kind = it >> 6; }
    const int crow0 = ML + b * LCTX;
    if (kind == 0) {
      int qrow0, qt0, s0r, s0n, s1n;
      if (isctx) { qrow0 = crow0; qt0 = 0; s0r = crow0; s0n = LCTX; s1n = 0; }
      else { qrow0 = b * LSEQ + qb * 256; qt0 = qb * 256; s0r = b * LSEQ; s0n = LSEQ; s1n = LCTX; }
      attn_block<96>(QK + hd * 96, 1792, KM + hd * 96, 768, QK + 768 + hd * 128 + 64, 1792, Y + 1024 + hd * 64, 1536,
                     qrow0, qt0, s0r, s0n, 0, 0, crow0, s1n, 0.f, 0, lds);
    } else {
      const int kvh = hd >> 2;
      int qrow0, qt0, s0r, s0n, s0t, msk, s1n;
      if (isctx) { qrow0 = crow0; qt0 = 0; s0r = crow0; s0n = LCTX; s0t = 0; msk = 0; s1n = 0; }
      else {
        const int t0 = qb * 256;
        const int lo = (t0 - 128 < 0) ? 0 : t0 - 128;
        const int hi = (t0 + 384 > LSEQ) ? LSEQ : t0 + 384;
        qrow0 = b * LSEQ + t0; qt0 = t0; s0r = b * LSEQ + lo; s0n = hi - lo; s0t = lo; msk = 1; s1n = LCTX;
      }
      attn_block<64>(R + hd * 64, 1536, R + 512 + kvh * 64, 1536, R + 640 + kvh * 64, 1536, Y + 512 + hd * 64, 1536,
                     qrow0, qt0, s0r, s0n, s0t, msk, crow0, s1n, sink[hd] * LOG2E, 1, lds);
    }
  }
}

DI void phase_p7a(const Params& p, int l, int nrows, u16* lds) {
  const u16* hn = (const u16*)(p.ws + OFF_A);
  const u16* wt = (const u16*)(p.ws + OFF_W) + (size_t)l * W_LAYER + WO_TG;
  u16* Gt = (u16*)(p.ws + OFF_B);
  const int NT = 24, nitems = (nrows / 256) * NT;
  for (int item = lbid(); item < nitems; item += gridDim.x) {
    const int m0 = (item / NT) * 256, n0 = (item % NT) * 128;
    f32x16 acc[2][2];
    ACC_ZERO(acc);
    gemm_mainloop(hn + (size_t)m0 * 1024, 1024, wt + (size_t)n0 * 1024, 1024, 1024, acc, lds);
    ACC_FOREACH(acc, m0, n0, { Gt[(size_t)row * 3072 + col] = f2bf(sigmoidf_(val)); });
  }
}
DI void phase_p7b(const Params& p, int l, int nrows, u16* lds) {
  const u16* Y = (const u16*)(p.ws + OFF_Y);
  const u16* Gt = (const u16*)(p.ws + OFF_B);
  const u16* wb = (const u16*)(p.ws + OFF_W) + (size_t)l * W_LAYER + WO_BR;
  u16* mg = (u16*)(p.ws + OFF_A);
  const int NT = 8, nitems = (nrows / 256) * NT;
  for (int item = lbid(); item < nitems; item += gridDim.x) {
    const int m0 = (item / NT) * 256, n0 = (item % NT) * 128;
    f32x16 mrg[2][2];
    ACC_ZERO(mrg);
#pragma unroll 1
    for (int nb = 0; nb < 3; ++nb) {
      f32x16 acc[2][2];
      ACC_ZERO(acc);
      gemm_mainloop<true>(Y + (size_t)m0 * 1536 + nb * 512, 1536, wb + (size_t)nb * 1024 * 512 + (size_t)n0 * 512, 512, 512, acc, lds);
      {
        u16* gs = lds;
        const int tid = ltid();
#pragma unroll
        for (int i = 0; i < 8; ++i) {
          const int ch = tid + 512 * i, rr = ch >> 4, c16 = ch & 15;
          const uint4 v = *(const uint4*)(Gt + (size_t)(m0 + rr) * 3072 + nb * 1024 + n0 + c16 * 8);
          *(uint4*)(gs + rr * 136 + c16 * 8) = v;
        }
        __syncthreads();
        ACC_FOREACH(acc, 0, 0, { mrg[mi_][ni_][r_] += bf2f(gs[row * 136 + col]) * val; });
        __syncthreads();
      }
    }
    ACC_FOREACH(mrg, m0, n0, { mg[(size_t)row * 1024 + col] = f2bf(val); });
  }
}
DI void phase_p8(const Params& p, int l, int nrows, u16* lds) {
  const u16* mg = (const u16*)(p.ws + OFF_A);
  const u16* wt = (const u16*)(p.ws + OFF_W) + (size_t)l * W_LAYER + WO_OUT;
  const float* xs = (l == 0) ? p.x : p.out;
  const float* cs = (l == 0) ? p.ctx : (const float*)(p.ws + OFF_CTX);
  float* cd = (float*)(p.ws + OFF_CTX);
  const int NT = 8, nitems = (nrows / 256) * NT;
  for (int item = lbid(); item < nitems; item += gridDim.x) {
    const int m0 = (item / NT) * 256, n0 = (item % NT) * 128;
    f32x16 acc[2][2];
    ACC_ZERO(acc);
    gemm_mainloop(mg + (size_t)m0 * 1024, 1024, wt + (size_t)n0 * 1024, 1024, 1024, acc, lds);
    const int mrow = (m0 < ML) ? (m0 >> 13) : 8;
    const float* gate = mods_ptr(p, l, mrow, 2);
    ACC_FOREACH(acc, m0, n0, {
      const float g = gate[col];
      if (row < ML) p.out[(size_t)row * 1024 + col] = xs[(size_t)row * 1024 + col] + g * val;
      else cd[(size_t)(row - ML) * 1024 + col] = cs[(size_t)(row - ML) * 1024 + col] + g * val;
    });
  }
}
DI void phase_p10(const Params& p, int l, int nrows, u16* lds) {
  const u16* hn = (const u16*)(p.ws + OFF_A);
  const u16* wt = (const u16*)(p.ws + OFF_W) + (size_t)l * W_LAYER + WO_W1;
  u16* h1 = (u16*)(p.ws + OFF_B);
  const int NT = 32, nitems = (nrows / 256) * NT;
  for (int item = lbid(); item < nitems; item += gridDim.x) {
    const int m0 = (item / NT) * 256, n0 = (item % NT) * 128;
    f32x16 acc[2][2];
    ACC_ZERO(acc);
    gemm_mainloop(hn + (size_t)m0 * 1024, 1024, wt + (size_t)n0 * 1024, 1024, 1024, acc, lds);
    ACC_FOREACH(acc, m0, n0, { const float rl = fmaxf(val, 0.f); h1[(size_t)row * 4096 + col] = f2bf(rl * rl); });
  }
}
DI void phase_p11(const Params& p, int l, int nrows, u16* lds) {
  const u16* h1 = (const u16*)(p.ws + OFF_B);
  const u16* wt = (const u16*)(p.ws + OFF_W) + (size_t)l * W_LAYER + WO_W2;
  float* cd = (float*)(p.ws + OFF_CTX);
  const int NT = 8, nitems = (nrows / 256) * NT;
  for (int item = lbid(); item < nitems; item += gridDim.x) {
    const int m0 = (item / NT) * 256, n0 = (item % NT) * 128;
    f32x16 acc[2][2];
    ACC_ZERO(acc);
    gemm_mainloop(h1 + (size_t)m0 * 4096, 4096, wt + (size_t)n0 * 4096, 4096, 4096, acc, lds);
    const int mrow = (m0 < ML) ? (m0 >> 13) : 8;
    const float* gate = mods_ptr(p, l, mrow, 5);
    ACC_FOREACH(acc, m0, n0, {
      const float g = gate[col];
      float* dp = (row < ML) ? p.out + (size_t)row * 1024 + col : cd + (size_t)(row - ML) * 1024 + col;
      *dp = *dp + g * val;
    });
  }
}

DI void gsync(cg::grid_group& grid) {
  asm volatile("s_waitcnt vmcnt(0) lgkmcnt(0)" ::: "memory");
  __threadfence();
  grid.sync();
  __builtin_amdgcn_fence(__ATOMIC_ACQUIRE, "agent");
  asm volatile("s_waitcnt vmcnt(0)" ::: "memory");
  __syncthreads();
}

__global__ void __launch_bounds__(512) fwd_megakernel(Params p) {
  __shared__ __attribute__((aligned(16))) char lds[131072];
  cg::grid_group grid = cg::this_grid();
  phase0(p, lds);
  gsync(grid);
  for (int l = 0; l < 4; ++l) {
    const int nrows2 = (l < 3) ? MALL : ML;
    phase_rownorm(p, l, 0, MALL);
    filter_tiles(p, l, LSEQ, 2 * FFTN, (float*)(p.ws + OFF_KF), (float*)(p.ws + OFF_PART), (float*)lds);
    if (l < 3) filter_tiles(p, l, LCTX, 512, (float*)(p.ws + OFF_KC), (float*)(p.ws + OFF_PART) + 128 * 1024, (float*)lds);
    gsync(grid);
    phase_gemm1(p, l, (u16*)lds);
    phase_filter_fft(p, l, (float*)lds);
    gsync(grid);
    phase_h1(p, l, (float*)lds);
    phase_p3(p, l, (float*)lds);
    gsync(grid);
    phase_h2(p, l, (float*)lds);
    gsync(grid);
    phase_h3(p, l, (float*)lds);
    gsync(grid);
    phase_p4(p, l, (u16*)lds);
    gsync(grid);
    phase_p5(p, l, (float*)lds);
    gsync(grid);
    phase_attn(p, l, (u16*)lds);
    gsync(grid);
    phase_rownorm(p, l, 0, nrows2);
    gsync(grid);
    phase_p7a(p, l, nrows2, (u16*)lds);
    gsync(grid);
    phase_p7b(p, l, nrows2, (u16*)lds);
    gsync(grid);
    phase_p8(p, l, nrows2, (u16*)lds);
    gsync(grid);
    phase_rownorm(p, l, 1, nrows2);
    gsync(grid);
    phase_p10(p, l, nrows2, (u16*)lds);
    gsync(grid);
    phase_p11(p, l, nrows2, (u16*)lds);
    gsync(grid);
  }
}

extern "C" void kernel_launch(void* const* d_in, const int* in_sizes, int n_in, void* d_out, int out_size, void* d_ws,
                              size_t ws_size, hipStream_t stream) {
  static int grid_blocks = 0;
  if (!grid_blocks) {
    int dev = 0, cus = 0, per_cu = 0;
    hipGetDevice(&dev);
    hipDeviceGetAttribute(&cus, hipDeviceAttributeMultiprocessorCount, dev);
    hipOccupancyMaxActiveBlocksPerMultiprocessor(&per_cu, fwd_megakernel, 512, 0);
    if (per_cu < 1) per_cu = 1;
    if (per_cu > 1) per_cu = 1;
    grid_blocks = cus * per_cu;
  }
  Params p{};
  const float** pp = (const float**)&p;
  for (int i = 0; i < 30; ++i) pp[i] = (const float*)d_in[i];
  p.out = (float*)d_out;
  p.ws = (char*)d_ws;
  void* args[] = {&p};
  hipError_t e = hipLaunchCooperativeKernel((void*)fwd_megakernel, dim3(grid_blocks), dim3(512), args, 0, stream);
  if (e != hipSuccess) fprintf(stderr, "cooperative launch failed: %s (grid %d)\n", hipGetErrorString(e), grid_blocks);
}
```

```cpp
#include <hip/hip_runtime.h>
#include <hip/hip_cooperative_groups.h>
#include <cstdio>
namespace cg = cooperative_groups;

typedef unsigned short u16;
typedef short bf16x8 __attribute__((ext_vector_type(8)));
typedef float f32x16 __attribute__((ext_vector_type(16)));
typedef unsigned u32x4 __attribute__((ext_vector_type(4)));
#define VLOAD16(ptr) __builtin_bit_cast(uint4, *(const volatile u32x4*)(ptr))
typedef __bf16 bf16x2_t __attribute__((ext_vector_type(2)));
typedef float f32x2_t __attribute__((ext_vector_type(2)));
#define DI __device__ __forceinline__
#define MFMA(a, b, c) __builtin_amdgcn_mfma_f32_32x32x16_bf16((a), (b), (c), 0, 0, 0)

#define DM 1024
#define NBATCH 8
#define LSEQ 8192
#define LCTX 256
#define ML 65536
#define MC 2048
#define MALL 67584
#define NIN 6048
#define FFTN 16384
#define EPSV 1e-6f
#define LOG2E 1.4426950408889634f

#define W_LAYER 17858560ull
#define WO_T1 0ull
#define WO_TG 3145728ull
#define WO_QB 6291456ull
#define WO_KVB 6586368ull
#define WO_BR 6848512ull
#define WO_OUT 8421376ull
#define WO_W1 9469952ull
#define WO_W2 13664256ull
#define OFF_W 0ull
#define OFF_CTX 142868480ull
#define OFF_KF 151257088ull
#define OFF_KC 218365952ull
#define OFF_MODS 219414528ull
#define OFF_SUMSQ 220299264ull
#define OFF_ROPEG 220315648ull
#define OFF_ROPEM 222412800ull
#define OFF_TW 223461376ull
#define OFF_A 223592448ull
#define OFF_B 362004480ull
#define OFF_C 431210496ull
#define OFF_R 569622528ull
#define OFF_Y 777240576ull
#define OFF_KM (OFF_A + 242221056ull)
#define OFF_PART 984858624ull
#define ZC_OFF 33554432

struct Params {
  const float *x, *c, *ctx, *c_ctx, *w_mod, *b_mod, *norm_mix_g, *norm_mlp_g, *w_in, *hy_short_w, *hy_f1_w, *hy_f1_b,
      *hy_f2_w, *hy_f2_b, *hy_sin_freq, *hy_f3_w, *hy_skip, *gqa_q_norm, *gqa_k_norm, *gqa_sink, *mla_q_a_norm,
      *mla_kv_a_norm, *w_q_b, *w_kv_b, *mla_q_norm, *mla_k_norm, *w_branch, *w_out, *w_mlp1, *w_mlp2;
  float* out;
  char* ws;
};

DI int ltid() { int t = threadIdx.x; asm volatile("" : "+v"(t)); return t; }
DI int lbid() { int t = blockIdx.x; asm volatile("" : "+s"(t)); return t; }
DI u16 f2bf(float x) { return __builtin_bit_cast(u16, (__bf16)x); }
DI float bf2f(u16 v) { return __uint_as_float(((unsigned)v) << 16); }
DI unsigned pk2(float a, float b) {
  f32x2_t f = {a, b};
  return __builtin_bit_cast(unsigned, __builtin_convertvector(f, bf16x2_t));
}
DI float wave_sum(float v) {
#pragma unroll
  for (int o = 32; o > 0; o >>= 1) v += __shfl_xor(v, o);
  return v;
}
DI float sigmoidf_(float x) { return 1.0f / (1.0f + __expf(-x)); }
DI const float* mods_ptr(const Params& p, int l, int mrow, int j) {
  return (const float*)(p.ws + OFF_MODS) + ((size_t)(l * 9 + mrow) * 6144 + j * 1024);
}

template <bool LOWREG = false>
DI void gemm_mainloop(const u16* __restrict__ Ag, int lda, const u16* __restrict__ Bg, int ldb, int K,
                      f32x16 (&acc)[2][2], u16* lds) {
  const int tid = ltid(), lane = tid & 63, w = tid >> 6, l32 = lane & 31, hh = lane >> 5;
  const int wm = w >> 1, wn = w & 1;
  u16* As = lds;
  u16* Bs = lds + 2 * 256 * 72;
  const int arow = tid >> 3, ach = tid & 7;
  const u16* ap = Ag + (size_t)arow * lda + ach * 8;
  const u16* bp = Bg + (size_t)arow * ldb + ach * 8;
  uint4 ra[4], rb[2];
#pragma unroll
  for (int i = 0; i < 4; ++i) ra[i] = *(const uint4*)(ap + (size_t)(64 * i) * lda);
#pragma unroll
  for (int i = 0; i < 2; ++i) rb[i] = *(const uint4*)(bp + (size_t)(64 * i) * ldb);
#pragma unroll
  for (int i = 0; i < 4; ++i) *(uint4*)(As + (arow + 64 * i) * 72 + ach * 8) = ra[i];
#pragma unroll
  for (int i = 0; i < 2; ++i) *(uint4*)(Bs + (arow + 64 * i) * 72 + ach * 8) = rb[i];
  __syncthreads();
  const int nk = K >> 6;
  for (int kt = 0; kt < nk; ++kt) {
    const int cur = kt & 1;
    const int adv = (kt + 1 < nk) ? 64 : 0;
    ap += adv; bp += adv;
#pragma unroll
    for (int i = 0; i < 4; ++i) ra[i] = VLOAD16(ap + (size_t)(64 * i) * lda);
#pragma unroll
    for (int i = 0; i < 2; ++i) rb[i] = VLOAD16(bp + (size_t)(64 * i) * ldb);
    __builtin_amdgcn_sched_barrier(0);
    const u16* as = As + cur * 256 * 72 + (wm * 64 + l32) * 72 + hh * 8;
    const u16* bs = Bs + cur * 128 * 72 + (wn * 64 + l32) * 72 + hh * 8;
#pragma unroll
    for (int s = 0; s < 4; ++s) {
      bf16x8 a0 = *(const bf16x8*)(as + s * 16), a1 = *(const bf16x8*)(as + 32 * 72 + s * 16);
      bf16x8 b0 = *(const bf16x8*)(bs + s * 16), b1 = *(const bf16x8*)(bs + 32 * 72 + s * 16);
      acc[0][0] = MFMA(a0, b0, acc[0][0]);
      acc[0][1] = MFMA(a0, b1, acc[0][1]);
      acc[1][0] = MFMA(a1, b0, acc[1][0]);
      acc[1][1] = MFMA(a1, b1, acc[1][1]);
      if (LOWREG) __builtin_amdgcn_sched_barrier(0);
    }
    __builtin_amdgcn_sched_barrier(0);
    {
      u16* Aw = As + (cur ^ 1) * 256 * 72;
      u16* Bw = Bs + (cur ^ 1) * 128 * 72;
#pragma unroll
      for (int i = 0; i < 4; ++i) *(uint4*)(Aw + (arow + 64 * i) * 72 + ach * 8) = ra[i];
#pragma unroll
      for (int i = 0; i < 2; ++i) *(uint4*)(Bw + (arow + 64 * i) * 72 + ach * 8) = rb[i];
    }
    __syncthreads();
  }
}

#define ACC_ZERO(acc)                                                                      \
  _Pragma("unroll") for (int mi_ = 0; mi_ < 2; ++mi_) _Pragma("unroll") for (int ni_ = 0; ni_ < 2; ++ni_) \
      _Pragma("unroll") for (int r_ = 0; r_ < 16; ++r_) acc[mi_][ni_][r_] = 0.f;

#define ACC_FOREACH(acc, m0, n0, BODY)                                                     \
  {                                                                                        \
    const int lane_ = ltid() & 63, w_ = ltid() >> 6;                             \
    const int l32_ = lane_ & 31, hh_ = lane_ >> 5, wm_ = w_ >> 1, wn_ = w_ & 1;            \
    _Pragma("unroll") for (int mi_ = 0; mi_ < 2; ++mi_) _Pragma("unroll") for (int ni_ = 0; ni_ < 2; ++ni_) { \
        __builtin_amdgcn_sched_barrier(0);                                                 \
        _Pragma("unroll") for (int r_ = 0; r_ < 16; ++r_) {                                \
      const int row = (m0) + wm_ * 64 + mi_ * 32 + (r_ & 3) + 8 * (r_ >> 2) + 4 * hh_;     \
      const int col = (n0) + wn_ * 64 + ni_ * 32 + l32_;                                   \
      const float val = acc[mi_][ni_][r_];                                                    \
      BODY                                                                                 \
    } }                                                                                    \
  }

DI void stage_store_bf16(f32x16 (&acc)[2][2], u16* __restrict__ dst, int ld, int m0, int c0, u16* lds) {
  u16* cs = lds;
  ACC_FOREACH(acc, 0, 0, { cs[row * 136 + col] = f2bf(val); });
  __syncthreads();
  const int tid = ltid();
#pragma unroll
  for (int i = 0; i < 8; ++i) {
    const int ch = tid + 512 * i, rr = ch >> 4, c16 = ch & 15;
    const uint4 v = *(const uint4*)(cs + rr * 136 + c16 * 8);
    *(uint4*)(dst + (size_t)(m0 + rr) * ld + c0 + c16 * 8) = v;
  }
  __syncthreads();
}

DI void conv_job(const float* __restrict__ src, int ld, int K, int col0, int nvalid, int npad, u16* __restrict__ dst,
                 int& off, float* ts) {
  const int tid = ltid();
  const int tk = K >> 6, tn = npad >> 6, ntiles = tk * tn;
  const int G = gridDim.x;
  int first = ((int)lbid() - (off % G) + G) % G;
  for (int tile = first; tile < ntiles; tile += G) {
    const int k0 = (tile % tk) * 64, n0 = (tile / tk) * 64;
    {
      const int cc = tid & 63, rg = tid >> 6;
      const bool ok = (n0 + cc) < nvalid;
#pragma unroll
      for (int i = 0; i < 8; ++i) {
        const int rr = rg * 8 + i;
        ts[rr * 65 + cc] = ok ? src[(size_t)(k0 + rr) * ld + col0 + n0 + cc] : 0.f;
      }
    }
    __syncthreads();
    {
      const int kk = tid & 63, ng = tid >> 6;
#pragma unroll
      for (int i = 0; i < 8; ++i) {
        const int nn = ng * 8 + i;
        dst[(size_t)(n0 + nn) * K + k0 + kk] = f2bf(ts[kk * 65 + nn]);
      }
    }
    __syncthreads();
  }
  off += ntiles;
}

DI void phase0(const Params& p, char* ldsc) {
  float* ldsf = (float*)ldsc;
  const int tid = ltid();
  const int G = gridDim.x;
  int off = 0;
  for (int l = 0; l < 4; ++l) {
    u16* wl = (u16*)(p.ws + OFF_W) + (size_t)l * W_LAYER;
    conv_job(p.w_in + (size_t)l * 1024 * NIN, NIN, 1024, 0, 2976, 3072, wl + WO_T1, off, ldsf);
    conv_job(p.w_in + (size_t)l * 1024 * NIN, NIN, 1024, 2976, 3072, 3072, wl + WO_TG, off, ldsf);
    conv_job(p.w_q_b + (size_t)l * 384 * 768, 768, 384, 0, 768, 768, wl + WO_QB, off, ldsf);
    conv_job(p.w_kv_b + (size_t)l * 256 * 1024, 1024, 256, 0, 1024, 1024, wl + WO_KVB, off, ldsf);
    for (int nb = 0; nb < 3; ++nb)
      conv_job(p.w_branch + (size_t)(l * 3 + nb) * 512 * 1024, 1024, 512, 0, 1024, 1024, wl + WO_BR + (size_t)nb * 1024 * 512, off, ldsf);
    conv_job(p.w_out + (size_t)l * 1024 * 1024, 1024, 1024, 0, 1024, 1024, wl + WO_OUT, off, ldsf);
    conv_job(p.w_mlp1 + (size_t)l * 1024 * 4096, 4096, 1024, 0, 4096, 4096, wl + WO_W1, off, ldsf);
    conv_job(p.w_mlp2 + (size_t)l * 4096 * 1024, 1024, 4096, 0, 1024, 1024, wl + WO_W2, off, ldsf);
  }
  {
    float* sc = ldsf;
    float* red = ldsf + 9 * 1024;
    for (int i = tid; i < 9 * 1024; i += 512) {
      float v = (i < 8 * 1024) ? p.c[i] : p.c_ctx[i - 8 * 1024];
      sc[i] = v / (1.0f + expf(-v));
    }
    __syncthreads();
    float* mods = (float*)(p.ws + OFF_MODS);
    const int ol = tid & 63, kg = tid >> 6;
    for (int item = lbid(); item < 384; item += G) {
      const int l = item / 96, o = (item % 96) * 64 + ol;
      const float* wp = p.w_mod + (size_t)l * 1024 * 6144 + o;
      float acc[9];
#pragma unroll
      for (int b = 0; b < 9; ++b) acc[b] = 0.f;
#pragma unroll 4
      for (int k = kg * 128; k < kg * 128 + 128; ++k) {
        const float wv = wp[(size_t)k * 6144];
#pragma unroll
        for (int b = 0; b < 9; ++b) acc[b] += sc[b * 1024 + k] * wv;
      }
#pragma unroll
      for (int b = 0; b < 9; ++b) red[(kg * 9 + b) * 64 + ol] = acc[b];
      __syncthreads();
      for (int i = tid; i < 576; i += 512) {
        const int b = i >> 6, o2 = i & 63;
        float s = 0.f;
#pragma unroll
        for (int g = 0; g < 8; ++g) s += red[(g * 9 + b) * 64 + o2];
        const int oc = (item % 96) * 64 + o2;
        mods[(size_t)(l * 9 + b) * 6144 + oc] = s + p.b_mod[l * 6144 + oc];
      }
      __syncthreads();
    }
  }
  {
    const int gt = lbid() * 512 + tid, GT = G * 512;
    float* rg = (float*)(p.ws + OFF_ROPEG);
    float* rm = (float*)(p.ws + OFF_ROPEM);
    float* tw = (float*)(p.ws + OFF_TW);
    for (int i = gt; i < LSEQ * 32; i += GT) {
      const int t = i >> 5, a = i & 31;
      const float pos = (a < 16) ? (float)(t >> 6) : (float)(t & 63);
      const float inv = powf(10000.0f, -(float)(a & 15) / 16.0f);
      const float ang = pos * inv;
      rg[2 * i] = cosf(ang);
      rg[2 * i + 1] = sinf(ang);
    }
    for (int i = gt; i < LSEQ * 16; i += GT) {
      const int t = i >> 4, a = i & 15;
      const float pos = (a < 8) ? (float)(t >> 6) : (float)(t & 63);
      const float inv = powf(10000.0f, -(float)(a & 7) / 8.0f);
      const float ang = pos * inv;
      rm[2 * i] = cosf(ang);
      rm[2 * i + 1] = sinf(ang);
    }
    for (int i = gt; i < FFTN; i += GT) {
      float sn, cs;
      sincospif(2.0f * (float)i / (float)FFTN, &sn, &cs);
      tw[2 * i] = cs;
      tw[2 * i + 1] = -sn;
    }
  }
}

DI void phase_rownorm(const Params& p, int l, int which, int nrows) {
  const int tid = ltid(), lane = tid & 63, w = tid >> 6;
  u16* hn = (u16*)(p.ws + OFF_A);
  const float* g = (which ? p.norm_mlp_g : p.norm_mix_g) + l * 1024;
  const bool first = (which == 0 && l == 0);
  const float* xs = first ? p.x : p.out;
  const float* cs = first ? p.ctx : (const float*)(p.ws + OFF_CTX);
  for (int r = lbid() * 8 + w; r < nrows; r += gridDim.x * 8) {
    const float* src = (r < ML) ? xs + (size_t)r * 1024 : cs + (size_t)(r - ML) * 1024;
    const int mrow = (r < ML) ? (r >> 13) : 8;
    const float* shift = mods_ptr(p, l, mrow, which ? 3 : 0);
    const float* scale = mods_ptr(p, l, mrow, which ? 4 : 1);
    float4 v[4];
    float ss = 0.f;
#pragma unroll
    for (int i = 0; i < 4; ++i) {
      v[i] = *(const float4*)(src + 4 * (lane + 64 * i));
      ss += v[i].x * v[i].x + v[i].y * v[i].y + v[i].z * v[i].z + v[i].w * v[i].w;
    }
    ss = wave_sum(ss);
    const float rstd = rsqrtf(ss * (1.0f / 1024.0f) + EPSV);
#pragma unroll
    for (int i = 0; i < 4; ++i) {
      const int c0 = 4 * (lane + 64 * i);
      const float4 gg = *(const float4*)(g + c0), sh = *(const float4*)(shift + c0), sc = *(const float4*)(scale + c0);
      const float o0 = v[i].x * rstd * gg.x * (1.f + sc.x) + sh.x;
      const float o1 = v[i].y * rstd * gg.y * (1.f + sc.y) + sh.y;
      const float o2 = v[i].z * rstd * gg.z * (1.f + sc.z) + sh.z;
      const float o3 = v[i].w * rstd * gg.w * (1.f + sc.w) + sh.w;
      uint2 pk;
      pk.x = pk2(o0, o1);
      pk.y = pk2(o2, o3);
      *(uint2*)(hn + (size_t)r * 1024 + c0) = pk;
    }
  }
}

DI void filter_tiles(const Params& p, int l, int Lf, int cstride, float* __restrict__ kdst, float* __restrict__ part, float* lds) {
  const int tid = ltid(), lane = tid & 63, w = tid >> 6;
  float* zs = lds;
  float* h1s = lds + 64 * 33;
  float* h2s = h1s + 64 * 65;
  const float* f1w = p.hy_f1_w + l * 33 * 64;
  const float* f1b = p.hy_f1_b + l * 64;
  const float* f2w = p.hy_f2_w + l * 64 * 64;
  const float* f2b = p.hy_f2_b + l * 64;
  const float* sf = p.hy_sin_freq + l * 128;
  const float* f3w = p.hy_f3_w + (size_t)l * 64 * 1024;
  const int ntile = Lf >> 6;
  const float min_decay = logf(1e-2f) / 1.5f, max_decay = logf(1e-2f) / 0.3f;
  for (int tile = lbid(); tile < ntile; tile += gridDim.x) {
    const int t0 = tile * 64;
    for (int idx = tid; idx < 64 * 33; idx += 512) {
      const int tt = idx / 33, e = idx - tt * 33;
      const int t = t0 + tt;
      float val;
      if (e == 0) {
        val = (float)t / (float)(Lf - 1);
      } else {
        const float wt = 6.283185307179586f * (float)t / (float)Lf;
        const int bi = (e - 1) & 15;
        const float f = 1e-4f + (float)bi * ((15.0f - 1e-4f) / 15.0f);
        val = (e <= 16) ? cosf(f * wt) : -sinf(f * wt);
      }
      zs[idx] = val;
    }
    __syncthreads();
    {
      const int tt = tid & 63, jg = tid >> 6;
#pragma unroll 1
      for (int jj = 0; jj < 8; ++jj) {
        const int j = jg * 8 + jj;
        float a = f1b[j];
#pragma unroll 3
        for (int e = 0; e < 33; ++e) a += zs[tt * 33 + e] * f1w[e * 64 + j];
        h1s[tt * 65 + j] = sinf(sf[j] * a);
      }
    }
    __syncthreads();
    {
      const int tt = tid & 63, jg = tid >> 6;
#pragma unroll 1
      for (int jj = 0; jj < 8; ++jj) {
        const int j = jg * 8 + jj;
        float a = f2b[j];
#pragma unroll 4
        for (int e = 0; e < 64; ++e) a += h1s[tt * 65 + e] * f2w[e * 64 + j];
        h2s[tt * 65 + j] = sinf(sf[64 + j] * a);
      }
    }
    __syncthreads();
    {
      const int tt = lane, t = t0 + tt;
      const float tn = (float)t / (float)(Lf - 1);
#pragma unroll 1
      for (int ob = w * 128; ob < w * 128 + 128; ob += 16) {
        float acc[16];
#pragma unroll
        for (int q = 0; q < 16; ++q) acc[q] = 0.f;
#pragma unroll 2
        for (int i = 0; i < 64; ++i) {
          const float hv = h2s[tt * 65 + i];
          const float* wr = f3w + i * 1024 + ob;
#pragma unroll
          for (int q = 0; q < 16; ++q) acc[q] += hv * wr[q];
        }
#pragma unroll
        for (int q = 0; q < 16; ++q) {
          const int o = ob + q, dir = o >> 9, c = o & 511;
          const float delta = fabsf(min_decay + (float)c * ((max_decay - min_decay) / 511.0f));
          float val = acc[q] * expf(-tn * delta);
          int pos;
          if (dir == 0) pos = t;
          else if (t == 0) { pos = Lf; val = 0.f; }
          else pos = 2 * Lf - t;
          kdst[(size_t)c * cstride + pos] = val;
          const float s2 = wave_sum(val * val);
          if (lane == 0) part[tile * 1024 + o] = s2;
        }
      }
    }
    __syncthreads();
  }
}

DI void fft_fwd(float* re, float* im, const float2* __restrict__ tw) {
  const int tid = ltid();
  for (int s = 0; s < 7; ++s) {
    const int qs = 12 - 2 * s;
    const int q = 1 << qs;
    for (int bi = tid; bi < 4096; bi += 512) {
      const int j = bi & (q - 1), g = bi >> qs;
      const int i0 = (g << (qs + 2)) + j, i1 = i0 + q, i2 = i1 + q, i3 = i2 + q;
      const float ar = re[i0], ai = im[i0], br = re[i1], bi_ = im[i1], cr = re[i2], ci = im[i2], dr = re[i3], di = im[i3];
      const float t0r = ar + cr, t0i = ai + ci, t1r = ar - cr, t1i = ai - ci;
      const float t2r = br + dr, t2i = bi_ + di;
      const float er = br - dr, ei = bi_ - di;
      const float t3r = ei, t3i = -er;
      const float2 w1 = tw[j << (2 * s)];
      const float w2r = w1.x * w1.x - w1.y * w1.y, w2i = 2.f * w1.x * w1.y;
      const float w3r = w2r * w1.x - w2i * w1.y, w3i = w2r * w1.y + w2i * w1.x;
      const float y1r = t1r + t3r, y1i = t1i + t3i, y2r = t0r - t2r, y2i = t0i - t2i, y3r = t1r - t3r, y3i = t1i - t3i;
      re[i0] = t0r + t2r; im[i0] = t0i + t2i;
      re[i1] = y1r * w1.x - y1i * w1.y; im[i1] = y1r * w1.y + y1i * w1.x;
      re[i2] = y2r * w2r - y2i * w2i;   im[i2] = y2r * w2i + y2i * w2r;
      re[i3] = y3r * w3r - y3i * w3i;   im[i3] = y3r * w3i + y3i * w3r;
    }
    __syncthreads();
  }
}
DI void fft_inv(float* re, float* im, const float2* __restrict__ tw) {
  const int tid = ltid();
  for (int s = 6; s >= 0; --s) {
    const int qs = 12 - 2 * s;
    const int q = 1 << qs;
    for (int bi = tid; bi < 4096; bi += 512) {
      const int j = bi & (q - 1), g = bi >> qs;
      const int i0 = (g << (qs + 2)) + j, i1 = i0 + q, i2 = i1 + q, i3 = i2 + q;
      const float2 w1 = tw[j << (2 * s)];
      const float w1r = w1.x, w1i = -w1.y;
      const float w2r = w1r * w1r - w1i * w1i, w2i = 2.f * w1r * w1i;
      const float w3r = w2r * w1r - w2i * w1i, w3i = w2r * w1i + w2i * w1r;
      const float ar = re[i0], ai = im[i0];
      const float xr1 = re[i1], xi1 = im[i1], xr2 = re[i2], xi2 = im[i2], xr3 = re[i3], xi3 = im[i3];
      const float br = xr1 * w1r - xi1 * w1i, bi_ = xr1 * w1i + xi1 * w1r;
      const float cr = xr2 * w2r - xi2 * w2i, ci = xr2 * w2i + xi2 * w2r;
      const float dr = xr3 * w3r - xi3 * w3i, di = xr3 * w3i + xi3 * w3r;
      const float t0r = ar + cr, t0i = ai + ci, t1r = ar - cr, t1i = ai - ci;
      const float t2r = br + dr, t2i = bi_ + di;
      const float er = br - dr, ei = bi_ - di;
      const float t3r = -ei, t3i = er;
      re[i0] = t0r + t2r; im[i0] = t0i + t2i;
      re[i1] = t1r + t3r; im[i1] = t1i + t3i;
      re[i2] = t0r - t2r; im[i2] = t0i - t2i;
      re[i3] = t1r - t3r; im[i3] = t1i - t3i;
    }
    __syncthreads();
  }
}

DI void phase_filter_fft(const Params& p, int l, float* lds) {
  const int tid = ltid();
  float* re = lds;
  float* im = lds + FFTN;
  float* kf = (float*)(p.ws + OFF_KF);
  const float2* tw = (const float2*)(p.ws + OFF_TW);
  const float* part = (const float*)(p.ws + OFF_PART);
  for (int c = lbid(); c < 512; c += gridDim.x) {
    float* slot = kf + (size_t)c * (2 * FFTN);
    float pv = 0.f;
    if (tid < 128) pv = part[tid * 1024 + c] + part[tid * 1024 + 512 + c];
    pv = wave_sum(pv);
    if ((tid & 63) == 0) lds[tid >> 6] = pv;
    __syncthreads();
    const float ssq = lds[0] + lds[1];
    __syncthreads();
    const float sc = rsqrtf(ssq + EPSV) * (1.0f / (float)FFTN);
    for (int i = tid; i < FFTN; i += 512) { re[i] = slot[i] * sc; im[i] = 0.f; }
    __syncthreads();
    fft_fwd(re, im, tw);
    for (int i = tid; i < FFTN; i += 512) { float2 v; v.x = re[i]; v.y = im[i]; ((float2*)slot)[i] = v; }
    __syncthreads();
  }
}

DI void phase_gemm1(const Params& p, int l, u16* lds) {
  const u16* hn = (const u16*)(p.ws + OFF_A);
  const u16* wt = (const u16*)(p.ws + OFF_W) + (size_t)l * W_LAYER + WO_T1;
  const int NT = 24, nitems = (MALL / 256) * NT;
  for (int item = lbid(); item < nitems; item += gridDim.x) {
    const int mt = item / NT, nt = item % NT;
    const int m0 = mt * 256, n0 = nt * 128;
    f32x16 acc[2][2];
    ACC_ZERO(acc);
    gemm_mainloop(hn + (size_t)m0 * 1024, 1024, wt + (size_t)n0 * 1024, 1024, 1024, acc, lds);
    u16* dst; int ld, cofs;
    if (nt < 4) { dst = (u16*)(p.ws + OFF_B); ld = 512; cofs = 0; }
    else if (nt < 12) { dst = (u16*)(p.ws + OFF_C); ld = 1024; cofs = 512; }
    else { dst = (u16*)(p.ws + OFF_R); ld = 1536; cofs = 1536; }
    stage_store_bf16(acc, dst, ld, m0, n0 - cofs, lds);
  }
}

DI void phase_h1(const Params& p, int l, float* lds) {
  const int tid = ltid();
  const u16* U12 = (const u16*)(p.ws + OFF_C);
  float* zT = (float*)(p.ws + OFF_A);
  const float* sw = p.hy_short_w + l * 3 * 1536;
  float* xs = lds;
  float* vs = lds + 66 * 65;
  const int nlat = 8 * 128 * 8, nctx = (l < 3) ? 8 * 4 * 8 : 0;
  for (int item = lbid(); item < nlat + nctx; item += gridDim.x) {
    int b, tt0, c0, Ls, rowbase; size_t zbase;
    if (item < nlat) { b = item >> 10; tt0 = ((item >> 3) & 127) * 64; c0 = (item & 7) * 64; Ls = LSEQ; rowbase = b * LSEQ; zbase = (size_t)b * 512 * LSEQ; }
    else { const int it = item - nlat; b = it >> 5; tt0 = ((it >> 3) & 3) * 64; c0 = (it & 7) * 64; Ls = LCTX; rowbase = ML + b * LCTX; zbase = (size_t)ZC_OFF + (size_t)b * 512 * LCTX; }
    for (int ch = tid; ch < 66 * 16; ch += 512) {
      const int arr = ch / 528, rem = ch - arr * 528;
      const int rr = rem >> 3, cc8 = (rem & 7) * 8;
      const int t = tt0 - 1 + rr;
      float* dstp = (arr ? vs : xs) + rr * 65 + cc8;
      if (t >= 0 && t < Ls) {
        const uint4 v = *(const uint4*)(U12 + (size_t)(rowbase + t) * 1024 + arr * 512 + c0 + cc8);
        const unsigned uu[4] = {v.x, v.y, v.z, v.w};
#pragma unroll
        for (int i = 0; i < 4; ++i) { dstp[2 * i] = __uint_as_float(uu[i] << 16); dstp[2 * i + 1] = __uint_as_float(uu[i] & 0xffff0000u); }
      } else {
#pragma unroll
        for (int i = 0; i < 8; ++i) dstp[i] = 0.f;
      }
    }
    __syncthreads();
    {
      const int tt = tid & 63, cgp = tid >> 6;
#pragma unroll
      for (int i = 0; i < 8; ++i) {
        const int cc = cgp * 8 + i, c = c0 + cc;
        float x1 = 0.f, vv = 0.f;
#pragma unroll
        for (int j = 0; j < 3; ++j) {
          x1 += sw[j * 1536 + 512 + c] * xs[(tt + j) * 65 + cc];
          vv += sw[j * 1536 + 1024 + c] * vs[(tt + j) * 65 + cc];
        }
        zT[zbase + (size_t)c * Ls + tt0 + tt] = x1 * vv;
      }
    }
    __syncthreads();
  }
}

DI void phase_p3(const Params& p, int l, float* lds) {
  const int tid = ltid(), lane = tid & 63, w = tid >> 6;
  u16* R = (u16*)(p.ws + OFF_R);
  float* rb = lds + w * 1472;
  float* hs = rb + 1440;
  const float* qn = p.gqa_q_norm + l * 64;
  const float* kn = p.gqa_k_norm + l * 64;
  const float* qan = p.mla_q_a_norm + l * 384;
  const float* kvan = p.mla_kv_a_norm + l * 256;
  const float* ropeg = (const float*)(p.ws + OFF_ROPEG);
  const float qscale = 0.125f * LOG2E;
  for (int r0 = lbid() * 8; r0 < MALL; r0 += gridDim.x * 8) {
    const int r = r0 + w;
    u16* rowp = R + (size_t)r * 1536;
    for (int ch = lane; ch < 180; ch += 64) {
      const uint4 v = *(const uint4*)(rowp + ch * 8);
      const unsigned uu[4] = {v.x, v.y, v.z, v.w};
#pragma unroll
      for (int i = 0; i < 4; ++i) { rb[ch * 8 + 2 * i] = __uint_as_float(uu[i] << 16); rb[ch * 8 + 2 * i + 1] = __uint_as_float(uu[i] & 0xffff0000u); }
    }
    __syncthreads();
    {
      float s = 0.f;
#pragma unroll
      for (int i = 0; i < 8; ++i) { const float v = rb[lane * 8 + i]; s += v * v; }
      s += __shfl_xor(s, 1); s += __shfl_xor(s, 2); s += __shfl_xor(s, 4);
      if ((lane & 7) == 0) hs[lane >> 3] = rsqrtf(s * (1.0f / 64.0f) + EPSV);
      float s2 = 0.f;
      if (lane < 16) {
#pragma unroll
        for (int i = 0; i < 8; ++i) { const float v = rb[512 + lane * 8 + i]; s2 += v * v; }
      }
      s2 += __shfl_xor(s2, 1); s2 += __shfl_xor(s2, 2); s2 += __shfl_xor(s2, 4);
      if (lane < 16 && (lane & 7) == 0) hs[8 + (lane >> 3)] = rsqrtf(s2 * (1.0f / 64.0f) + EPSV);
      float s3 = 0.f, s4 = 0.f;
#pragma unroll
      for (int i = 0; i < 6; ++i) { const float v = rb[768 + lane * 6 + i]; s3 += v * v; }
#pragma unroll
      for (int i = 0; i < 4; ++i) { const float v = rb[1152 + lane * 4 + i]; s4 += v * v; }
      s3 = wave_sum(s3); s4 = wave_sum(s4);
      if (lane == 0) { hs[10] = rsqrtf(s3 * (1.0f / 384.0f) + EPSV); hs[11] = rsqrtf(s4 * (1.0f / 256.0f) + EPSV); }
    }
    __syncthreads();
    {
      const bool lat = r < ML;
      const int t = r & (LSEQ - 1);
      const int d = lane, a = d & 31;
      float cs = 1.f, sn = 0.f;
      if (lat) { cs = ropeg[(t * 32 + a) * 2]; sn = ropeg[(t * 32 + a) * 2 + 1]; }
#pragma unroll
      for (int hd = 0; hd < 10; ++hd) {
        const float* gq = (hd < 8) ? qn : kn;
        const float rs = hs[hd];
        const float v = rb[hd * 64 + d] * rs * gq[d];
        const int dp = d ^ 32;
        const float vp = rb[hd * 64 + dp] * rs * gq[dp];
        float o = (d < 32) ? (v * cs - vp * sn) : (vp * sn + v * cs);
        if (hd < 8) o *= qscale;
        rowp[hd * 64 + d] = f2bf(o);
      }
#pragma unroll
      for (int i = 0; i < 6; ++i) { const int e = lane + 64 * i; rowp[768 + e] = f2bf(rb[768 + e] * hs[10] * qan[e]); }
#pragma unroll
      for (int i = 0; i < 4; ++i) { const int e = lane + 64 * i; rowp[1152 + e] = f2bf(rb[1152 + e] * hs[11] * kvan[e]); }
    }
    __syncthreads();
  }
}

DI void phase_h2(const Params& p, int l, float* lds) {
  const int tid = ltid(), lane = tid & 63, w = tid >> 6;
  float* zT = (float*)(p.ws + OFF_A);
  const float2* kf = (const float2*)(p.ws + OFF_KF);
  const float2* tw = (const float2*)(p.ws + OFF_TW);
  const float* skip = p.hy_skip + l * 512;
  float* re = lds;
  float* im = lds + FFTN;
  for (int item = lbid(); item < 2048; item += gridDim.x) {
    const int c = item >> 2, bp = item & 3;
    float* z1 = zT + ((size_t)(2 * bp) * 512 + c) * LSEQ;
    float* z2 = zT + ((size_t)(2 * bp + 1) * 512 + c) * LSEQ;
    for (int i = tid; i < LSEQ; i += 512) { re[i] = z1[i]; im[i] = z2[i]; re[i + LSEQ] = 0.f; im[i + LSEQ] = 0.f; }
    __syncthreads();
    fft_fwd(re, im, tw);
    const float2* kc = kf + (size_t)c * FFTN;
    for (int i = tid; i < FFTN; i += 512) {
      const float2 k = kc[i];
      const float xr = re[i], xi = im[i];
      re[i] = xr * k.x - xi * k.y;
      im[i] = xr * k.y + xi * k.x;
    }
    __syncthreads();
    fft_inv(re, im, tw);
    const float sk = skip[c];
    for (int i = tid; i < LSEQ; i += 512) {
      const float a = z1[i], b = z2[i];
      z1[i] = re[i] + a * sk;
      z2[i] = im[i] + b * sk;
    }
    __syncthreads();
  }
  if (l < 3) {
    const float* kcb = (const float*)(p.ws + OFF_KC);
    const float* partc = (const float*)(p.ws + OFF_PART) + 128 * 1024;
    float* zs = lds + w * 768;
    float* ks = zs + 256;
    for (int item = lbid(); item < 512; item += gridDim.x) {
      const int b = item >> 6, c = (item & 63) * 8 + w;
      float* z = zT + (size_t)ZC_OFF + ((size_t)b * 512 + c) * LCTX;
      float pv = (lane < 4) ? partc[lane * 1024 + c] + partc[lane * 1024 + 512 + c] : 0.f;
      pv = wave_sum(pv);
      const float sc = rsqrtf(pv + EPSV);
      for (int i = lane; i < 256; i += 64) zs[i] = z[i];
      for (int i = lane; i < 512; i += 64) ks[i] = kcb[c * 512 + i] * sc;
      __syncthreads();
      const float sk = skip[c];
      float acc[4] = {0.f, 0.f, 0.f, 0.f};
      for (int s = 0; s < 256; ++s) {
        const float zv = zs[s];
#pragma unroll
        for (int i = 0; i < 4; ++i) acc[i] += ks[(lane + 64 * i - s) & 511] * zv;
      }
#pragma unroll
      for (int i = 0; i < 4; ++i) z[lane + 64 * i] = acc[i] + zs[lane + 64 * i] * sk;
      __syncthreads();
    }
  }
}

DI void phase_h3(const Params& p, int l, float* lds) {
  const int tid = ltid();
  const u16* U0 = (const u16*)(p.ws + OFF_B);
  const float* zT = (const float*)(p.ws + OFF_A);
  u16* Y = (u16*)(p.ws + OFF_Y);
  const float* sw = p.hy_short_w + l * 3 * 1536;
  float* xs = lds;
  float* ys = lds + 66 * 65;
  const int nlat = 8 * 128 * 8, nctx = (l < 3) ? 8 * 4 * 8 : 0;
  for (int item = lbid(); item < nlat + nctx; item += gridDim.x) {
    int b, tt0, c0, Ls, rowbase; size_t zbase;
    if (item < nlat) { b = item >> 10; tt0 = ((item >> 3) & 127) * 64; c0 = (item & 7) * 64; Ls = LSEQ; rowbase = b * LSEQ; zbase = (size_t)b * 512 * LSEQ; }
    else { const int it = item - nlat; b = it >> 5; tt0 = ((it >> 3) & 3) * 64; c0 = (it & 7) * 64; Ls = LCTX; rowbase = ML + b * LCTX; zbase = (size_t)ZC_OFF + (size_t)b * 512 * LCTX; }
    for (int ch = tid; ch < 66 * 8; ch += 512) {
      const int rr = ch >> 3, cc8 = (ch & 7) * 8;
      const int t = tt0 - 1 + rr;
      float* dstp = xs + rr * 65 + cc8;
      if (t >= 0 && t < Ls) {
        const uint4 v = *(const uint4*)(U0 + (size_t)(rowbase + t) * 512 + c0 + cc8);
        const unsigned uu[4] = {v.x, v.y, v.z, v.w};
#pragma unroll
        for (int i = 0; i < 4; ++i) { dstp[2 * i] = __uint_as_float(uu[i] << 16); dstp[2 * i + 1] = __uint_as_float(uu[i] & 0xffff0000u); }
      } else {
#pragma unroll
        for (int i = 0; i < 8; ++i) dstp[i] = 0.f;
      }
    }
    {
      const int tt = tid & 63, cgp = tid >> 6;
#pragma unroll
      for (int i = 0; i < 8; ++i) {
        const int cc = cgp * 8 + i;
        ys[cc * 65 + tt] = zT[zbase + (size_t)(c0 + cc) * Ls + tt0 + tt];
      }
    }
    __syncthreads();
    {
      const int cc = tid & 63, tg = tid >> 6, c = c0 + cc;
      const float w0 = sw[c], w1 = sw[1536 + c], w2 = sw[2 * 1536 + c];
#pragma unroll
      for (int i = 0; i < 8; ++i) {
        const int tt = tg * 8 + i;
        const float x0 = w0 * xs[tt * 65 + cc] + w1 * xs[(tt + 1) * 65 + cc] + w2 * xs[(tt + 2) * 65 + cc];
        Y[(size_t)(rowbase + tt0 + tt) * 1536 + c] = f2bf(x0 * ys[cc * 65 + tt]);
      }
    }
    __syncthreads();
  }
}

DI void phase_p4(const Params& p, int l, u16* lds) {
  const u16* R = (const u16*)(p.ws + OFF_R);
  u16* QK = (u16*)(p.ws + OFF_A);
  const u16* wl = (const u16*)(p.ws + OFF_W) + (size_t)l * W_LAYER;
  const int NT = 14, nitems = (MALL / 256) * NT;
  for (int item = lbid(); item < nitems; item += gridDim.x) {
    const int mt = item / NT, nt = item % NT;
    const int m0 = mt * 256;
    f32x16 acc[2][2];
    ACC_ZERO(acc);
    int n0;
    if (nt < 6) { n0 = nt * 128; gemm_mainloop(R + (size_t)m0 * 1536 + 768, 1536, wl + WO_QB + (size_t)n0 * 384, 384, 384, acc, lds); }
    else { n0 = (nt - 6) * 128; gemm_mainloop(R + (size_t)m0 * 1536 + 1152, 1536, wl + WO_KVB + (size_t)n0 * 256, 256, 256, acc, lds); n0 += 768; }
    stage_store_bf16(acc, QK, 1792, m0, n0, lds);
  }
}

DI void phase_p5(const Params& p, int l, float* lds) {
  const int tid = ltid(), lane = tid & 63, w = tid >> 6;
  u16* QK = (u16*)(p.ws + OFF_A);
  u16* KM = (u16*)(p.ws + OFF_KM);
  const u16* R = (const u16*)(p.ws + OFF_R);
  float* rb = lds + w * 1856;
  float* hs = rb + 1824;
  const float* qn = p.mla_q_norm + l * 96;
  const float* kn = p.mla_k_norm + l * 96;
  const float* ropem = (const float*)(p.ws + OFF_ROPEM);
  const float qscale = 0.10206207261596575f * LOG2E;
  for (int r0 = lbid() * 8; r0 < MALL; r0 += gridDim.x * 8) {
    const int r = r0 + w;
    u16* rowp = QK + (size_t)r * 1792;
    for (int ch = lane; ch < 228; ch += 64) {
      const uint4 v = (ch < 224) ? *(const uint4*)(rowp + ch * 8) : *(const uint4*)(R + (size_t)r * 1536 + 1408 + (ch - 224) * 8);
      const unsigned uu[4] = {v.x, v.y, v.z, v.w};
#pragma unroll
      for (int i = 0; i < 4; ++i) { rb[ch * 8 + 2 * i] = __uint_as_float(uu[i] << 16); rb[ch * 8 + 2 * i + 1] = __uint_as_float(uu[i] & 0xffff0000u); }
    }
    __syncthreads();
    {
      const int hd = lane >> 3, j = lane & 7;
      float s = 0.f, s2 = 0.f;
#pragma unroll
      for (int i = 0; i < 12; ++i) {
        const int d = j * 12 + i;
        const float v = rb[hd * 96 + d];
        s += v * v;
        const float kv = (d < 64) ? rb[768 + hd * 128 + d] : rb[1792 + d - 64];
        s2 += kv * kv;
      }
      s += __shfl_xor(s, 1); s += __shfl_xor(s, 2); s += __shfl_xor(s, 4);
      s2 += __shfl_xor(s2, 1); s2 += __shfl_xor(s2, 2); s2 += __shfl_xor(s2, 4);
      if (j == 0) { hs[hd] = rsqrtf(s * (1.0f / 96.0f) + EPSV); hs[8 + hd] = rsqrtf(s2 * (1.0f / 96.0f) + EPSV); }
    }
    __syncthreads();
    {
      const bool lat = r < ML;
      const int t = r & (LSEQ - 1);
#pragma unroll
      for (int i = 0; i < 12; ++i) {
        const int e = lane + 64 * i;
        const int hd = e / 96, d = e - hd * 96;
        const float rq = hs[hd], rk = hs[8 + hd];
        float qv = rb[hd * 96 + d] * rq * qn[d];
        float kv = ((d < 64) ? rb[768 + hd * 128 + d] : rb[1792 + d - 64]) * rk * kn[d];
        if (d >= 64 && lat) {
          const int a = (d - 64) & 15;
          const float cs = ropem[(t * 16 + a) * 2], sn = ropem[(t * 16 + a) * 2 + 1];
          const int dp = (d < 80) ? d + 16 : d - 16;
          const float qp = rb[hd * 96 + dp] * rq * qn[dp];
          const float kp = rb[1792 + dp - 64] * rk * kn[dp];
          if (d < 80) { qv = qv * cs - qp * sn; kv = kv * cs - kp * sn; }
          else { qv = qp * sn + qv * cs; kv = kp * sn + kv * cs; }
        }
        rowp[e] = f2bf(qv * qscale);
        KM[(size_t)r * 768 + e] = f2bf(kv);
      }
    }
    __syncthreads();
  }
}

template <int DQK>
DI void attn_block(const u16* __restrict__ Qp, int q_ld, const u16* __restrict__ Kp, int k_ld, const u16* __restrict__ Vp,
                   int v_ld, u16* __restrict__ Op, int o_ld, int qrow0, int qt0, int s0_row0, int s0_n, int s0_t0,
                   int masked0, int s1_row0, int s1_n, float sink_l2, int has_sink, u16* lds) {
  constexpr int KS = DQK + 8, NS = DQK / 16, CPK = DQK / 8;
  const int tid = ltid(), lane = tid & 63, w = tid >> 6, l32 = lane & 31, hh = lane >> 5;
  u16* Ks = lds;
  u16* Vt = lds + 2 * 64 * KS;
  const int qrow = qrow0 + 32 * w + l32;
  bf16x8 qf[NS];
#pragma unroll
  for (int s = 0; s < NS; ++s) qf[s] = *(const bf16x8*)(Qp + (size_t)qrow * q_ld + 16 * s + 8 * hh);
  f32x16 ot[2];
#pragma unroll
  for (int i = 0; i < 16; ++i) { ot[0][i] = 0.f; ot[1][i] = 0.f; }
  float m = -1e30f, lsum = 0.f;
  const int nt0 = s0_n >> 6, nt = nt0 + (s1_n >> 6);
  const int kkey0 = tid / CPK, kch0 = tid - kkey0 * CPK;
  const int c1 = tid + 512;
  const bool has1 = c1 < 64 * CPK;
  const int kkey1 = has1 ? c1 / CPK : 0, kch1 = has1 ? c1 - kkey1 * CPK : 0;
  const int vkey = tid & 63, vch = tid >> 6;
  uint4 rk0, rk1, rv;
  rk1 = make_uint4(0, 0, 0, 0);
  {
    const int row0 = (0 < nt0) ? s0_row0 : s1_row0;
    rk0 = *(const uint4*)(Kp + (size_t)(row0 + kkey0) * k_ld + kch0 * 8);
    if (has1) rk1 = *(const uint4*)(Kp + (size_t)(row0 + kkey1) * k_ld + kch1 * 8);
    rv = *(const uint4*)(Vp + (size_t)(row0 + vkey) * v_ld + vch * 8);
  }
  {
    *(uint4*)(Ks + kkey0 * KS + kch0 * 8) = rk0;
    if (has1) *(uint4*)(Ks + kkey1 * KS + kch1 * 8) = rk1;
    const unsigned uu[4] = {rv.x, rv.y, rv.z, rv.w};
#pragma unroll
    for (int i = 0; i < 4; ++i) {
      Vt[(vch * 8 + 2 * i) * 68 + vkey] = (u16)(uu[i] & 0xffffu);
      Vt[(vch * 8 + 2 * i + 1) * 68 + vkey] = (u16)(uu[i] >> 16);
    }
  }
  __syncthreads();
  const int tq = qt0 + 32 * w + l32;
  for (int j = 0; j < nt; ++j) {
    const int cur = j & 1;
    {
      const int jn = (j + 1 < nt) ? j + 1 : j;
      const int row0 = (jn < nt0) ? s0_row0 + 64 * jn : s1_row0 + 64 * (jn - nt0);
      rk0 = VLOAD16(Kp + (size_t)(row0 + kkey0) * k_ld + kch0 * 8);
      if (DQK == 96) rk1 = VLOAD16(Kp + (size_t)(row0 + kkey1) * k_ld + kch1 * 8);
      rv = VLOAD16(Vp + (size_t)(row0 + vkey) * v_ld + vch * 8);
    }
    __builtin_amdgcn_sched_barrier(0);
    const bool mtile = masked0 && (j < nt0);
    const int tk0 = s0_t0 + 64 * j;
    bool active = true;
    if (mtile) {
      const int tql = qt0 + 32 * w;
      active = (tk0 + 63 >= tql - 128) && (tk0 <= tql + 31 + 128);
    }
    if (active) {
      const u16* kb = Ks + cur * 64 * KS + l32 * KS + hh * 8;
      f32x16 st[2];
#pragma unroll
      for (int i = 0; i < 16; ++i) { st[0][i] = 0.f; st[1][i] = 0.f; }
#pragma unroll
      for (int s = 0; s < NS; ++s) {
        const bf16x8 a0 = *(const bf16x8*)(kb + s * 16);
        const bf16x8 a1 = *(const bf16x8*)(kb + 32 * KS + s * 16);
        st[0] = MFMA(a0, qf[s], st[0]);
        st[1] = MFMA(a1, qf[s], st[1]);
      }
      if (mtile) {
#pragma unroll
        for (int kt = 0; kt < 2; ++kt)
#pragma unroll
          for (int rg = 0; rg < 16; ++rg) {
            const int tk = tk0 + 32 * kt + (rg & 3) + 8 * (rg >> 2) + 4 * hh;
            const int dlt = tk - tq;
            if (dlt > 128 || dlt < -128) st[kt][rg] = -1e30f;
          }
      }
      float mloc = st[0][0];
#pragma unroll
      for (int rg = 1; rg < 16; ++rg) mloc = fmaxf(mloc, st[0][rg]);
#pragma unroll
      for (int rg = 0; rg < 16; ++rg) mloc = fmaxf(mloc, st[1][rg]);
      mloc = fmaxf(mloc, __shfl_xor(mloc, 32));
      const float mnew = fmaxf(m, mloc);
      const float alpha = __builtin_amdgcn_exp2f(m - mnew);
      m = mnew;
      float ps = 0.f;
#pragma unroll
      for (int kt = 0; kt < 2; ++kt)
#pragma unroll
        for (int rg = 0; rg < 16; ++rg) {
          float pv = __builtin_amdgcn_exp2f(st[kt][rg] - mnew);
          if (mtile) pv = (st[kt][rg] < -1e29f) ? 0.f : pv;
          st[kt][rg] = pv;
          ps += pv;
        }
      lsum = lsum * alpha + ps;
#pragma unroll
      for (int i = 0; i < 16; ++i) { ot[0][i] *= alpha; ot[1][i] *= alpha; }
      const u16* vb = Vt + cur * 64 * 68 + l32 * 68 + 4 * hh;
#pragma unroll
      for (int kt = 0; kt < 2; ++kt)
#pragma unroll
        for (int s = 0; s < 2; ++s) {
          unsigned pw[4];
#pragma unroll
          for (int i = 0; i < 4; ++i) pw[i] = pk2(st[kt][8 * s + 2 * i], st[kt][8 * s + 2 * i + 1]);
          const uint4 pu = make_uint4(pw[0], pw[1], pw[2], pw[3]);
          const bf16x8 pf = __builtin_bit_cast(bf16x8, pu);
#pragma unroll
          for (int dt = 0; dt < 2; ++dt) {
            const u16* vp = vb + dt * 32 * 68 + 32 * kt + 16 * s;
            const uint2 lo = *(const uint2*)(vp);
            const uint2 hi = *(const uint2*)(vp + 8);
            const uint4 au = make_uint4(lo.x, lo.y, hi.x, hi.y);
            ot[dt] = MFMA(__builtin_bit_cast(bf16x8, au), pf, ot[dt]);
          }
        }
    }
    __builtin_amdgcn_sched_barrier(0);
    {
      u16* Kw = Ks + (cur ^ 1) * 64 * KS;
      u16* Vw = Vt + (cur ^ 1) * 64 * 68;
      *(uint4*)(Kw + kkey0 * KS + kch0 * 8) = rk0;
      if (has1) *(uint4*)(Kw + kkey1 * KS + kch1 * 8) = rk1;
      const unsigned uu[4] = {rv.x, rv.y, rv.z, rv.w};
#pragma unroll
      for (int i = 0; i < 4; ++i) {
        Vw[(vch * 8 + 2 * i) * 68 + vkey] = (u16)(uu[i] & 0xffffu);
        Vw[(vch * 8 + 2 * i + 1) * 68 + vkey] = (u16)(uu[i] >> 16);
      }
    }
    __syncthreads();
  }
  float ltot = lsum + __shfl_xor(lsum, 32);
  if (has_sink) ltot += __builtin_amdgcn_exp2f(sink_l2 - m);
  const float inv = 1.0f / ltot;
#pragma unroll
  for (int dt = 0; dt < 2; ++dt)
#pragma unroll
    for (int g = 0; g < 4; ++g) {
      uint2 pk;
      pk.x = pk2(ot[dt][4 * g] * inv, ot[dt][4 * g + 1] * inv);
      pk.y = pk2(ot[dt][4 * g + 2] * inv, ot[dt][4 * g + 3] * inv);
      *(uint2*)(Op + (size_t)qrow * o_ld + dt * 32 + 8 * g + 4 * hh) = pk;
    }
}

DI void phase_attn(const Params& p, int l, u16* lds) {
  const u16* R = (const u16*)(p.ws + OFF_R);
  const u16* QK = (const u16*)(p.ws + OFF_A);
  const u16* KM = (const u16*)(p.ws + OFF_KM);
  u16* Y = (u16*)(p.ws + OFF_Y);
  const float* sink = p.gqa_sink + l * 8;
  const int n_mla = 2048, n_gqa = 2048, n_ctx = (l < 3) ? 128 : 0;
  for (int item = lbid(); item < n_mla + n_gqa + n_ctx; item += gridDim.x) {
    int kind, qb, hd, b, isctx;
    if (item < n_mla) { kind = 0; isctx = 0; qb = item & 31; hd = (item >> 5) & 7; b = item >> 8; }
    else if (item < n_mla + n_gqa) { const int it = item - n_mla; kind = 1; isctx = 0; qb = it & 31; hd = (it >> 5) & 7; b = it >> 8; }
    else { const int it = item - n_mla - n_gqa; isctx = 1; qb = 0; hd = it & 7; b = (it >> 3) & 7; kind = it >> 6; }
    const int crow0 = ML + b * LCTX;
    if (kind == 0) {
      int qrow0, qt0, s0r, s0n, s1n;
      if (isctx) { qrow0 = crow0; qt0 = 0; s0r = crow0; s0n = LCTX; s1n = 0; }
      else { qrow0 = b * LSEQ + qb * 256; qt0 = qb * 256; s0r = b * LSEQ; s0n = LSEQ; s1n = LCTX; }
      attn_block<96>(QK + hd * 96, 1792, KM + hd * 96, 768, QK + 768 + hd * 128 + 64, 1792, Y + 1024 + hd * 64, 1536,
                     qrow0, qt0, s0r, s0n, 0, 0, crow0, s1n, 0.f, 0, lds);
    } else {
      const int kvh = hd >> 2;
      int qrow0, qt0, s0r, s0n, s0t, msk, s1n;
      if (isctx) { qrow0 = crow0; qt0 = 0; s0r = crow0; s0n = LCTX; s0t = 0; msk = 0; s1n = 0; }
      else {
        const int t0 = qb * 256;
        const int lo = (t0 - 128 < 0) ? 0 : t0 - 128;
        const int hi = (t0 + 384 > LSEQ) ? LSEQ : t0 + 384;
        qrow0 = b * LSEQ + t0; qt0 = t0; s0r = b * LSEQ + lo; s0n = hi - lo; s0t = lo; msk = 1; s1n = LCTX;
      }
      attn_block<64>(R + hd * 64, 1536, R + 512 + kvh * 64, 1536, R + 640 + kvh * 64, 1536, Y + 512 + hd * 64, 1536,
                     qrow0, qt0, s0r, s0n, s0t, msk, crow0, s1n, sink[hd] * LOG2E, 1, lds);
    }
  }
}

DI void phase_p7a(const Params& p, int l, int nrows, u16* lds) {
  const u16* hn = (const u16*)(p.ws + OFF_A);
  const u16* wt = (const u16*)(p.ws + OFF_W) + (size_t)l * W_LAYER + WO_TG;
  u16* Gt = (u16*)(p.ws + OFF_B);
  const int NT = 24, nitems = (nrows / 256) * NT;
  for (int item = lbid(); item < nitems; item += gridDim.x) {
    const int m0 = (item / NT) * 256, n0 = (item % NT) * 128;
    f32x16 acc[2][2];
    ACC_ZERO(acc);
    gemm_mainloop(hn + (size_t)m0 * 1024, 1024, wt + (size_t)n0 * 1024, 1024, 1024, acc, lds);
    ACC_FOREACH(acc, m0, n0, { acc[mi_][ni_][r_] = sigmoidf_(val); });
    stage_store_bf16(acc, Gt, 3072, m0, n0, lds);
  }
}
DI void phase_p7b(const Params& p, int l, int nrows, u16* lds) {
  const u16* Y = (const u16*)(p.ws + OFF_Y);
  const u16* Gt = (const u16*)(p.ws + OFF_B);
  const u16* wb = (const u16*)(p.ws + OFF_W) + (size_t)l * W_LAYER + WO_BR;
  u16* mg = (u16*)(p.ws + OFF_A);
  const int NT = 8, nitems = (nrows / 256) * NT;
  for (int item = lbid(); item < nitems; item += gridDim.x) {
    const int m0 = (item / NT) * 256, n0 = (item % NT) * 128;
    f32x16 mrg[2][2];
    ACC_ZERO(mrg);
#pragma unroll 1
    for (int nb = 0; nb < 3; ++nb) {
      f32x16 acc[2][2];
      ACC_ZERO(acc);
      gemm_mainloop<true>(Y + (size_t)m0 * 1536 + nb * 512, 1536, wb + (size_t)nb * 1024 * 512 + (size_t)n0 * 512, 512, 512, acc, lds);
      {
        u16* gs = lds;
        const int tid = ltid();
#pragma unroll
        for (int i = 0; i < 8; ++i) {
          const int ch = tid + 512 * i, rr = ch >> 4, c16 = ch & 15;
          const uint4 v = *(const uint4*)(Gt + (size_t)(m0 + rr) * 3072 + nb * 1024 + n0 + c16 * 8);
          *(uint4*)(gs + rr * 136 + c16 * 8) = v;
        }
        __syncthreads();
        ACC_FOREACH(acc, 0, 0, { mrg[mi_][ni_][r_] += bf2f(gs[row * 136 + col]) * val; });
        __syncthreads();
      }
    }
    stage_store_bf16(mrg, mg, 1024, m0, n0, lds);
  }
}
DI void phase_p8(const Params& p, int l, int nrows, u16* lds) {
  const u16* mg = (const u16*)(p.ws + OFF_A);
  const u16* wt = (const u16*)(p.ws + OFF_W) + (size_t)l * W_LAYER + WO_OUT;
  const float* xs = (l == 0) ? p.x : p.out;
  const float* cs = (l == 0) ? p.ctx : (const float*)(p.ws + OFF_CTX);
  float* cd = (float*)(p.ws + OFF_CTX);
  const int NT = 8, nitems = (nrows / 256) * NT;
  for (int item = lbid(); item < nitems; item += gridDim.x) {
    const int m0 = (item / NT) * 256, n0 = (item % NT) * 128;
    f32x16 acc[2][2];
    ACC_ZERO(acc);
    gemm_mainloop(mg + (size_t)m0 * 1024, 1024, wt + (size_t)n0 * 1024, 1024, 1024, acc, lds);
    const int mrow = (m0 < ML) ? (m0 >> 13) : 8;
    const float* gate = mods_ptr(p, l, mrow, 2);
    ACC_FOREACH(acc, m0, n0, {
      const float g = gate[col];
      if (row < ML) p.out[(size_t)row * 1024 + col] = xs[(size_t)row * 1024 + col] + g * val;
      else cd[(size_t)(row - ML) * 1024 + col] = cs[(size_t)(row - ML) * 1024 + col] + g * val;
    });
  }
}
DI void phase_p10(const Params& p, int l, int nrows, u16* lds) {
  const u16* hn = (const u16*)(p.ws + OFF_A);
  const u16* wt = (const u16*)(p.ws + OFF_W) + (size_t)l * W_LAYER + WO_W1;
  u16* h1 = (u16*)(p.ws + OFF_B);
  const int NT = 32, nitems = (nrows / 256) * NT;
  for (int item = lbid(); item < nitems; item += gridDim.x) {
    const int m0 = (item / NT) * 256, n0 = (item % NT) * 128;
    f32x16 acc[2][2];
    ACC_ZERO(acc);
    gemm_mainloop(hn + (size_t)m0 * 1024, 1024, wt + (size_t)n0 * 1024, 1024, 1024, acc, lds);
    ACC_FOREACH(acc, m0, n0, { const float rl = fmaxf(val, 0.f); acc[mi_][ni_][r_] = rl * rl; });
    stage_store_bf16(acc, h1, 4096, m0, n0, lds);
  }
}
DI void phase_p11(const Params& p, int l, int nrows, u16* lds) {
  const u16* h1 = (const u16*)(p.ws + OFF_B);
  const u16* wt = (const u16*)(p.ws + OFF_W) + (size_t)l * W_LAYER + WO_W2;
  float* cd = (float*)(p.ws + OFF_CTX);
  const int NT = 8, nitems = (nrows / 256) * NT;
  for (int item = lbid(); item < nitems; item += gridDim.x) {
    const int m0 = (item / NT) * 256, n0 = (item % NT) * 128;
    f32x16 acc[2][2];
    ACC_ZERO(acc);
    gemm_mainloop(h1 + (size_t)m0 * 4096, 4096, wt + (size_t)n0 * 4096, 4096, 4096, acc, lds);
    const int mrow = (m0 < ML) ? (m0 >> 13) : 8;
    const float* gate = mods_ptr(p, l, mrow, 5);
    ACC_FOREACH(acc, m0, n0, {
      const float g = gate[col];
      float* dp = (row < ML) ? p.out + (size_t)row * 1024 + col : cd + (size_t)(row - ML) * 1024 + col;
      *dp = *dp + g * val;
    });
  }
}

DI void gsync(cg::grid_group& grid) {
  asm volatile("s_waitcnt vmcnt(0) lgkmcnt(0)" ::: "memory");
  __threadfence();
  grid.sync();
  __builtin_amdgcn_fence(__ATOMIC_ACQUIRE, "agent");
  asm volatile("s_waitcnt vmcnt(0)" ::: "memory");
  __syncthreads();
}

__global__ void __launch_bounds__(512) fwd_megakernel(Params p) {
  __shared__ __attribute__((aligned(16))) char lds[131072];
  cg::grid_group grid = cg::this_grid();
  phase0(p, lds);
  gsync(grid);
  for (int l = 0; l < 4; ++l) {
    const int nrows2 = (l < 3) ? MALL : ML;
    phase_rownorm(p, l, 0, MALL);
    filter_tiles(p, l, LSEQ, 2 * FFTN, (float*)(p.ws + OFF_KF), (float*)(p.ws + OFF_PART), (float*)lds);
    if (l < 3) filter_tiles(p, l, LCTX, 512, (float*)(p.ws + OFF_KC), (float*)(p.ws + OFF_PART) + 128 * 1024, (float*)lds);
    gsync(grid);
    phase_gemm1(p, l, (u16*)lds);
    phase_filter_fft(p, l, (float*)lds);
    gsync(grid);
    phase_h1(p, l, (float*)lds);
    phase_p3(p, l, (float*)lds);
    gsync(grid);
    phase_h2(p, l, (float*)lds);
    gsync(grid);
    phase_h3(p, l, (float*)lds);
    gsync(grid);
    phase_p4(p, l, (u16*)lds);
    gsync(grid);
    phase_p5(p, l, (float*)lds);
    gsync(grid);
    phase_attn(p, l, (u16*)lds);
#ifdef PROBE_ATTN2
    gsync(grid);
    phase_attn(p, l, (u16*)lds);
#endif
    gsync(grid);
    phase_rownorm(p, l, 0, nrows2);
    gsync(grid);
    phase_p7a(p, l, nrows2, (u16*)lds);
    gsync(grid);
    phase_p7b(p, l, nrows2, (u16*)lds);
    gsync(grid);
    phase_p8(p, l, nrows2, (u16*)lds);
    gsync(grid);
    phase_rownorm(p, l, 1, nrows2);
    gsync(grid);
    phase_p10(p, l, nrows2, (u16*)lds);
#ifdef PROBE_P10X2
    gsync(grid);
    phase_p10(p, l, nrows2, (u16*)lds);
#endif
    gsync(grid);
    phase_p11(p, l, nrows2, (u16*)lds);
    gsync(grid);
  }
}

extern "C" void kernel_launch(void* const* d_in, const int* in_sizes, int n_in, void* d_out, int out_size, void* d_ws,
                              size_t ws_size, hipStream_t stream) {
  static int grid_blocks = 0;
  if (!grid_blocks) {
    int dev = 0, cus = 0, per_cu = 0;
    hipGetDevice(&dev);
    hipDeviceGetAttribute(&cus, hipDeviceAttributeMultiprocessorCount, dev);
    hipOccupancyMaxActiveBlocksPerMultiprocessor(&per_cu, fwd_megakernel, 512, 0);
    if (per_cu < 1) per_cu = 1;
    if (per_cu > 1) per_cu = 1;
    grid_blocks = cus * per_cu;
  }
  Params p{};
  const float** pp = (const float**)&p;
  for (int i = 0; i < 30; ++i) pp[i] = (const float*)d_in[i];
  p.out = (float*)d_out;
  p.ws = (char*)d_ws;
  void* args[] = {&p};
  hipError_t e = hipLaunchCooperativeKernel((void*)fwd_megakernel, dim3(grid_blocks), dim3(512), args, 0, stream);
  if (e != hipSuccess) fprintf(stderr, "cooperative launch failed: %s (grid %d)\n", hipGetErrorString(e), grid_blocks);
}
```

```cpp
#include <hip/hip_runtime.h>
#include <hip/hip_cooperative_groups.h>
#include <cstdio>
namespace cg = cooperative_groups;

typedef unsigned short u16;
typedef short bf16x8 __attribute__((ext_vector_type(8)));
typedef float f32x16 __attribute__((ext_vector_type(16)));
typedef unsigned u32x4 __attribute__((ext_vector_type(4)));
#define VLOAD16(ptr) __builtin_bit_cast(uint4, *(const volatile u32x4*)(ptr))
typedef __bf16 bf16x2_t __attribute__((ext_vector_type(2)));
typedef float f32x2_t __attribute__((ext_vector_type(2)));
#define DI __device__ __forceinline__
#define MFMA(a, b, c) __builtin_amdgcn_mfma_f32_32x32x16_bf16((a), (b), (c), 0, 0, 0)

#define DM 1024
#define NBATCH 8
#define LSEQ 8192
#define LCTX 256
#define ML 65536
#define MC 2048
#define MALL 67584
#define NIN 6048
#define FFTN 16384
#define EPSV 1e-6f
#define LOG2E 1.4426950408889634f

#define W_LAYER 17858560ull
#define WO_T1 0ull
#define WO_TG 3145728ull
#define WO_QB 6291456ull
#define WO_KVB 6586368ull
#define WO_BR 6848512ull
#define WO_OUT 8421376ull
#define WO_W1 9469952ull
#define WO_W2 13664256ull
#define OFF_W 0ull
#define OFF_CTX 142868480ull
#define OFF_KF 151257088ull
#define OFF_KC 218365952ull
#define OFF_MODS 219414528ull
#define OFF_SUMSQ 220299264ull
#define OFF_ROPEG 220315648ull
#define OFF_ROPEM 222412800ull
#define OFF_TW 223461376ull
#define OFF_A 223592448ull
#define OFF_B 362004480ull
#define OFF_C 431210496ull
#define OFF_R 569622528ull
#define OFF_Y 777240576ull
#define OFF_KM (OFF_A + 242221056ull)
#define OFF_PART 984858624ull
#define ZC_OFF 33554432

struct Params {
  const float *x, *c, *ctx, *c_ctx, *w_mod, *b_mod, *norm_mix_g, *norm_mlp_g, *w_in, *hy_short_w, *hy_f1_w, *hy_f1_b,
      *hy_f2_w, *hy_f2_b, *hy_sin_freq, *hy_f3_w, *hy_skip, *gqa_q_norm, *gqa_k_norm, *gqa_sink, *mla_q_a_norm,
      *mla_kv_a_norm, *w_q_b, *w_kv_b, *mla_q_norm, *mla_k_norm, *w_branch, *w_out, *w_mlp1, *w_mlp2;
  float* out;
  char* ws;
};

DI int ltid() { int t = threadIdx.x; asm volatile("" : "+v"(t)); return t; }
DI int lbid() { int t = blockIdx.x; asm volatile("" : "+s"(t)); return t; }
DI u16 f2bf(float x) { return __builtin_bit_cast(u16, (__bf16)x); }
DI float bf2f(u16 v) { return __uint_as_float(((unsigned)v) << 16); }
DI unsigned pk2(float a, float b) {
  f32x2_t f = {a, b};
  return __builtin_bit_cast(unsigned, __builtin_convertvector(f, bf16x2_t));
}
DI float wave_sum(float v) {
#pragma unroll
  for (int o = 32; o > 0; o >>= 1) v += __shfl_xor(v, o);
  return v;
}
DI float sigmoidf_(float x) { return 1.0f / (1.0f + __expf(-x)); }
DI const float* mods_ptr(const Params& p, int l, int mrow, int j) {
  return (const float*)(p.ws + OFF_MODS) + ((size_t)(l * 9 + mrow) * 6144 + j * 1024);
}

template <bool LOWREG = false>
DI void gemm_mainloop(const u16* __restrict__ Ag, int lda, const u16* __restrict__ Bg, int ldb, int K,
                      f32x16 (&acc)[2][2], u16* lds) {
  const int tid = ltid(), lane = tid & 63, w = tid >> 6, l32 = lane & 31, hh = lane >> 5;
  const int wm = w >> 1, wn = w & 1;
  u16* As = lds;
  u16* Bs = lds + 2 * 256 * 72;
  const int arow = tid >> 3, ach = tid & 7;
  const u16* ap = Ag + (size_t)arow * lda + ach * 8;
  const u16* bp = Bg + (size_t)arow * ldb + ach * 8;
  const int nk = K >> 6;
  uint4 ra0[4], rb0[2], ra1[4], rb1[2];
#define G_LOAD(RA, RB, T)                                                                   \
  {                                                                                         \
    const int t_ = ((T) < nk) ? (T) : nk - 1;                                               \
    _Pragma("unroll") for (int i = 0; i < 4; ++i) RA[i] = VLOAD16(ap + (size_t)(64 * i) * lda + 64 * t_); \
    _Pragma("unroll") for (int i = 0; i < 2; ++i) RB[i] = VLOAD16(bp + (size_t)(64 * i) * ldb + 64 * t_); \
  }
#define G_STORE(RA, RB, BUF)                                                                \
  {                                                                                         \
    u16* Aw = As + (BUF) * 256 * 72;                                                        \
    u16* Bw = Bs + (BUF) * 128 * 72;                                                        \
    _Pragma("unroll") for (int i = 0; i < 4; ++i) *(uint4*)(Aw + (arow + 64 * i) * 72 + ach * 8) = RA[i]; \
    _Pragma("unroll") for (int i = 0; i < 2; ++i) *(uint4*)(Bw + (arow + 64 * i) * 72 + ach * 8) = RB[i]; \
  }
#define G_COMPUTE(BUF)                                                                      \
  {                                                                                         \
    const u16* as = As + (BUF) * 256 * 72 + (wm * 64 + l32) * 72 + hh * 8;                  \
    const u16* bs = Bs + (BUF) * 128 * 72 + (wn * 64 + l32) * 72 + hh * 8;                  \
    _Pragma("unroll") for (int s = 0; s < 4; ++s) {                                         \
      bf16x8 a0 = *(const bf16x8*)(as + s * 16), a1 = *(const bf16x8*)(as + 32 * 72 + s * 16); \
      bf16x8 b0 = *(const bf16x8*)(bs + s * 16), b1 = *(const bf16x8*)(bs + 32 * 72 + s * 16); \
      acc[0][0] = MFMA(a0, b0, acc[0][0]);                                                  \
      acc[0][1] = MFMA(a0, b1, acc[0][1]);                                                  \
      acc[1][0] = MFMA(a1, b0, acc[1][0]);                                                  \
      acc[1][1] = MFMA(a1, b1, acc[1][1]);                                                  \
      if (LOWREG) __builtin_amdgcn_sched_barrier(0);                                        \
    }                                                                                       \
  }
  G_LOAD(ra0, rb0, 0);
  G_LOAD(ra1, rb1, 1);
  __builtin_amdgcn_sched_barrier(0);
  G_STORE(ra0, rb0, 0);
  __syncthreads();
  for (int kt = 0; kt < nk; kt += 2) {
    G_LOAD(ra0, rb0, kt + 2);
    __builtin_amdgcn_sched_barrier(0);
    G_COMPUTE(0);
    __builtin_amdgcn_sched_barrier(0);
    G_STORE(ra1, rb1, 1);
    __syncthreads();
    G_LOAD(ra1, rb1, kt + 3);
    __builtin_amdgcn_sched_barrier(0);
    G_COMPUTE(1);
    __builtin_amdgcn_sched_barrier(0);
    G_STORE(ra0, rb0, 0);
    __syncthreads();
  }
#undef G_LOAD
#undef G_STORE
#undef G_COMPUTE
}

#define ACC_ZERO(acc)                                                                      \
  _Pragma("unroll") for (int mi_ = 0; mi_ < 2; ++mi_) _Pragma("unroll") for (int ni_ = 0; ni_ < 2; ++ni_) \
      _Pragma("unroll") for (int r_ = 0; r_ < 16; ++r_) acc[mi_][ni_][r_] = 0.f;

#define ACC_FOREACH(acc, m0, n0, BODY)                                                     \
  {                                                                                        \
    const int lane_ = ltid() & 63, w_ = ltid() >> 6;                             \
    const int l32_ = lane_ & 31, hh_ = lane_ >> 5, wm_ = w_ >> 1, wn_ = w_ & 1;            \
    _Pragma("unroll") for (int mi_ = 0; mi_ < 2; ++mi_) _Pragma("unroll") for (int ni_ = 0; ni_ < 2; ++ni_) { \
        __builtin_amdgcn_sched_barrier(0);                                                 \
        _Pragma("unroll") for (int r_ = 0; r_ < 16; ++r_) {                                \
      const int row = (m0) + wm_ * 64 + mi_ * 32 + (r_ & 3) + 8 * (r_ >> 2) + 4 * hh_;     \
      const int col = (n0) + wn_ * 64 + ni_ * 32 + l32_;                                   \
      const float val = acc[mi_][ni_][r_];                                                    \
      BODY                                                                                 \
    } }                                                                                    \
  }

DI void stage_store_bf16(f32x16 (&acc)[2][2], u16* __restrict__ dst, int ld, int m0, int c0, u16* lds) {
  u16* cs = lds;
  ACC_FOREACH(acc, 0, 0, { cs[row * 136 + col] = f2bf(val); });
  __syncthreads();
  const int tid = ltid();
#pragma unroll
  for (int i = 0; i < 8; ++i) {
    const int ch = tid + 512 * i, rr = ch >> 4, c16 = ch & 15;
    const uint4 v = *(const uint4*)(cs + rr * 136 + c16 * 8);
    *(uint4*)(dst + (size_t)(m0 + rr) * ld + c0 + c16 * 8) = v;
  }
  __syncthreads();
}

DI void conv_job(const float* __restrict__ src, int ld, int K, int col0, int nvalid, int npad, u16* __restrict__ dst,
                 int& off, float* ts) {
  const int tid = ltid();
  const int tk = K >> 6, tn = npad >> 6, ntiles = tk * tn;
  const int G = gridDim.x;
  int first = ((int)lbid() - (off % G) + G) % G;
  for (int tile = first; tile < ntiles; tile += G) {
    const int k0 = (tile % tk) * 64, n0 = (tile / tk) * 64;
    {
      const int cc = tid & 63, rg = tid >> 6;
      const bool ok = (n0 + cc) < nvalid;
#pragma unroll
      for (int i = 0; i < 8; ++i) {
        const int rr = rg * 8 + i;
        ts[rr * 65 + cc] = ok ? src[(size_t)(k0 + rr) * ld + col0 + n0 + cc] : 0.f;
      }
    }
    __syncthreads();
    {
      const int kk = tid & 63, ng = tid >> 6;
#pragma unroll
      for (int i = 0; i < 8; ++i) {
        const int nn = ng * 8 + i;
        dst[(size_t)(n0 + nn) * K + k0 + kk] = f2bf(ts[kk * 65 + nn]);
      }
    }
    __syncthreads();
  }
  off += ntiles;
}

DI void phase0(const Params& p, char* ldsc) {
  float* ldsf = (float*)ldsc;
  const int tid = ltid();
  const int G = gridDim.x;
  int off = 0;
  for (int l = 0; l < 4; ++l) {
    u16* wl = (u16*)(p.ws + OFF_W) + (size_t)l * W_LAYER;
    conv_job(p.w_in + (size_t)l * 1024 * NIN, NIN, 1024, 0, 2976, 3072, wl + WO_T1, off, ldsf);
    conv_job(p.w_in + (size_t)l * 1024 * NIN, NIN, 1024, 2976, 3072, 3072, wl + WO_TG, off, ldsf);
    conv_job(p.w_q_b + (size_t)l * 384 * 768, 768, 384, 0, 768, 768, wl + WO_QB, off, ldsf);
    conv_job(p.w_kv_b + (size_t)l * 256 * 1024, 1024, 256, 0, 1024, 1024, wl + WO_KVB, off, ldsf);
    for (int nb = 0; nb < 3; ++nb)
      conv_job(p.w_branch + (size_t)(l * 3 + nb) * 512 * 1024, 1024, 512, 0, 1024, 1024, wl + WO_BR + (size_t)nb * 1024 * 512, off, ldsf);
    conv_job(p.w_out + (size_t)l * 1024 * 1024, 1024, 1024, 0, 1024, 1024, wl + WO_OUT, off, ldsf);
    conv_job(p.w_mlp1 + (size_t)l * 1024 * 4096, 4096, 1024, 0, 4096, 4096, wl + WO_W1, off, ldsf);
    conv_job(p.w_mlp2 + (size_t)l * 4096 * 1024, 1024, 4096, 0, 1024, 1024, wl + WO_W2, off, ldsf);
  }
  {
    float* sc = ldsf;
    float* red = ldsf + 9 * 1024;
    for (int i = tid; i < 9 * 1024; i += 512) {
      float v = (i < 8 * 1024) ? p.c[i] : p.c_ctx[i - 8 * 1024];
      sc[i] = v / (1.0f + expf(-v));
    }
    __syncthreads();
    float* mods = (float*)(p.ws + OFF_MODS);
    const int ol = tid & 63, kg = tid >> 6;
    for (int item = lbid(); item < 384; item += G) {
      const int l = item / 96, o = (item % 96) * 64 + ol;
      const float* wp = p.w_mod + (size_t)l * 1024 * 6144 + o;
      float acc[9];
#pragma unroll
      for (int b = 0; b < 9; ++b) acc[b] = 0.f;
#pragma unroll 4
      for (int k = kg * 128; k < kg * 128 + 128; ++k) {
        const float wv = wp[(size_t)k * 6144];
#pragma unroll
        for (int b = 0; b < 9; ++b) acc[b] += sc[b * 1024 + k] * wv;
      }
#pragma unroll
      for (int b = 0; b < 9; ++b) red[(kg * 9 + b) * 64 + ol] = acc[b];
      __syncthreads();
      for (int i = tid; i < 576; i += 512) {
        const int b = i >> 6, o2 = i & 63;
        float s = 0.f;
#pragma unroll
        for (int g = 0; g < 8; ++g) s += red[(g * 9 + b) * 64 + o2];
        const int oc = (item % 96) * 64 + o2;
        mods[(size_t)(l * 9 + b) * 6144 + oc] = s + p.b_mod[l * 6144 + oc];
      }
      __syncthreads();
    }
  }
  {
    const int gt = lbid() * 512 + tid, GT = G * 512;
    float* rg = (float*)(p.ws + OFF_ROPEG);
    float* rm = (float*)(p.ws + OFF_ROPEM);
    float* tw = (float*)(p.ws + OFF_TW);
    for (int i = gt; i < LSEQ * 32; i += GT) {
      const int t = i >> 5, a = i & 31;
      const float pos = (a < 16) ? (float)(t >> 6) : (float)(t & 63);
      const float inv = powf(10000.0f, -(float)(a & 15) / 16.0f);
      const float ang = pos * inv;
      rg[2 * i] = cosf(ang);
      rg[2 * i + 1] = sinf(ang);
    }
    for (int i = gt; i < LSEQ * 16; i += GT) {
      const int t = i >> 4, a = i & 15;
      const float pos = (a < 8) ? (float)(t >> 6) : (float)(t & 63);
      const float inv = powf(10000.0f, -(float)(a & 7) / 8.0f);
      const float ang = pos * inv;
      rm[2 * i] = cosf(ang);
      rm[2 * i + 1] = sinf(ang);
    }
    for (int i = gt; i < FFTN; i += GT) {
      float sn, cs;
      sincospif(2.0f * (float)i / (float)FFTN, &sn, &cs);
      tw[2 * i] = cs;
      tw[2 * i + 1] = -sn;
    }
  }
}

DI void phase_rownorm(const Params& p, int l, int which, int nrows) {
  const int tid = ltid(), lane = tid & 63, w = tid >> 6;
  u16* hn = (u16*)(p.ws + OFF_A);
  const float* g = (which ? p.norm_mlp_g : p.norm_mix_g) + l * 1024;
  const bool first = (which == 0 && l == 0);
  const float* xs = first ? p.x : p.out;
  const float* cs = first ? p.ctx : (const float*)(p.ws + OFF_CTX);
  for (int r = lbid() * 8 + w; r < nrows; r += gridDim.x * 8) {
    const float* src = (r < ML) ? xs + (size_t)r * 1024 : cs + (size_t)(r - ML) * 1024;
    const int mrow = (r < ML) ? (r >> 13) : 8;
    const float* shift = mods_ptr(p, l, mrow, which ? 3 : 0);
    const float* scale = mods_ptr(p, l, mrow, which ? 4 : 1);
    float4 v[4];
    float ss = 0.f;
#pragma unroll
    for (int i = 0; i < 4; ++i) {
      v[i] = *(const float4*)(src + 4 * (lane + 64 * i));
      ss += v[i].x * v[i].x + v[i].y * v[i].y + v[i].z * v[i].z + v[i].w * v[i].w;
    }
    ss = wave_sum(ss);
    const float rstd = rsqrtf(ss * (1.0f / 1024.0f) + EPSV);
#pragma unroll
    for (int i = 0; i < 4; ++i) {
      const int c0 = 4 * (lane + 64 * i);
      const float4 gg = *(const float4*)(g + c0), sh = *(const float4*)(shift + c0), sc = *(const float4*)(scale + c0);
      const float o0 = v[i].x * rstd * gg.x * (1.f + sc.x) + sh.x;
      const float o1 = v[i].y * rstd * gg.y * (1.f + sc.y) + sh.y;
      const float o2 = v[i].z * rstd * gg.z * (1.f + sc.z) + sh.z;
      const float o3 = v[i].w * rstd * gg.w * (1.f + sc.w) + sh.w;
      uint2 pk;
      pk.x = pk2(o0, o1);
      pk.y = pk2(o2, o3);
      *(uint2*)(hn + (size_t)r * 1024 + c0) = pk;
    }
  }
}

DI void filter_tiles(const Params& p, int l, int Lf, int cstride, float* __restrict__ kdst, float* __restrict__ part, float* lds) {
  const int tid = ltid(), lane = tid & 63, w = tid >> 6;
  float* zs = lds;
  float* h1s = lds + 64 * 33;
  float* h2s = h1s + 64 * 65;
  const float* f1w = p.hy_f1_w + l * 33 * 64;
  const float* f1b = p.hy_f1_b + l * 64;
  const float* f2w = p.hy_f2_w + l * 64 * 64;
  const float* f2b = p.hy_f2_b + l * 64;
  const float* sf = p.hy_sin_freq + l * 128;
  const float* f3w = p.hy_f3_w + (size_t)l * 64 * 1024;
  const int ntile = Lf >> 6;
  const float min_decay = logf(1e-2f) / 1.5f, max_decay = logf(1e-2f) / 0.3f;
  for (int tile = lbid(); tile < ntile; tile += gridDim.x) {
    const int t0 = tile * 64;
    for (int idx = tid; idx < 64 * 33; idx += 512) {
      const int tt = idx / 33, e = idx - tt * 33;
      const int t = t0 + tt;
      float val;
      if (e == 0) {
        val = (float)t / (float)(Lf - 1);
      } else {
        const float wt = 6.283185307179586f * (float)t / (float)Lf;
        const int bi = (e - 1) & 15;
        const float f = 1e-4f + (float)bi * ((15.0f - 1e-4f) / 15.0f);
        val = (e <= 16) ? cosf(f * wt) : -sinf(f * wt);
      }
      zs[idx] = val;
    }
    __syncthreads();
    {
      const int tt = tid & 63, jg = tid >> 6;
#pragma unroll 1
      for (int jj = 0; jj < 8; ++jj) {
        const int j = jg * 8 + jj;
        float a = f1b[j];
#pragma unroll 3
        for (int e = 0; e < 33; ++e) a += zs[tt * 33 + e] * f1w[e * 64 + j];
        h1s[tt * 65 + j] = sinf(sf[j] * a);
      }
    }
    __syncthreads();
    {
      const int tt = tid & 63, jg = tid >> 6;
#pragma unroll 1
      for (int jj = 0; jj < 8; ++jj) {
        const int j = jg * 8 + jj;
        float a = f2b[j];
#pragma unroll 4
        for (int e = 0; e < 64; ++e) a += h1s[tt * 65 + e] * f2w[e * 64 + j];
        h2s[tt * 65 + j] = sinf(sf[64 + j] * a);
      }
    }
    __syncthreads();
    {
      const int tt = lane, t = t0 + tt;
      const float tn = (float)t / (float)(Lf - 1);
      const int wu = __builtin_amdgcn_readfirstlane(w);
#pragma unroll 1
      for (int ob = wu * 128; ob < wu * 128 + 128; ob += 16) {
        float acc[16];
#pragma unroll
        for (int q = 0; q < 16; ++q) acc[q] = 0.f;
#pragma unroll 2
        for (int i = 0; i < 64; ++i) {
          const float hv = h2s[tt * 65 + i];
          const float* wr = f3w + i * 1024 + ob;
#pragma unroll
          for (int q = 0; q < 16; ++q) acc[q] += hv * wr[q];
        }
#pragma unroll
        for (int q = 0; q < 16; ++q) {
          const int o = ob + q, dir = o >> 9, c = o & 511;
          const float delta = fabsf(min_decay + (float)c * ((max_decay - min_decay) / 511.0f));
          float val = acc[q] * expf(-tn * delta);
          int pos;
          if (dir == 0) pos = t;
          else if (t == 0) { pos = Lf; val = 0.f; }
          else pos = 2 * Lf - t;
          kdst[(size_t)c * cstride + pos] = val;
          const float s2 = wave_sum(val * val);
          if (lane == 0) part[tile * 1024 + o] = s2;
        }
      }
    }
    __syncthreads();
  }
}

DI void fft_fwd(float* re, float* im, const float2* __restrict__ tw) {
  const int tid = ltid();
  for (int s = 0; s < 7; ++s) {
    const int qs = 12 - 2 * s;
    const int q = 1 << qs;
    for (int bi = tid; bi < 4096; bi += 512) {
      const int j = bi & (q - 1), g = bi >> qs;
      const int i0 = (g << (qs + 2)) + j, i1 = i0 + q, i2 = i1 + q, i3 = i2 + q;
      const float ar = re[i0], ai = im[i0], br = re[i1], bi_ = im[i1], cr = re[i2], ci = im[i2], dr = re[i3], di = im[i3];
      const float t0r = ar + cr, t0i = ai + ci, t1r = ar - cr, t1i = ai - ci;
      const float t2r = br + dr, t2i = bi_ + di;
      const float er = br - dr, ei = bi_ - di;
      const float t3r = ei, t3i = -er;
      const float2 w1 = tw[j << (2 * s)];
      const float w2r = w1.x * w1.x - w1.y * w1.y, w2i = 2.f * w1.x * w1.y;
      const float w3r = w2r * w1.x - w2i * w1.y, w3i = w2r * w1.y + w2i * w1.x;
      const float y1r = t1r + t3r, y1i = t1i + t3i, y2r = t0r - t2r, y2i = t0i - t2i, y3r = t1r - t3r, y3i = t1i - t3i;
      re[i0] = t0r + t2r; im[i0] = t0i + t2i;
      re[i1] = y1r * w1.x - y1i * w1.y; im[i1] = y1r * w1.y + y1i * w1.x;
      re[i2] = y2r * w2r - y2i * w2i;   im[i2] = y2r * w2i + y2i * w2r;
      re[i3] = y3r * w3r - y3i * w3i;   im[i3] = y3r * w3i + y3i * w3r;
    }
    __syncthreads();
  }
}
DI void fft_inv(float* re, float* im, const float2* __restrict__ tw) {
  const int tid = ltid();
  for (int s = 6; s >= 0; --s) {
    const int qs = 12 - 2 * s;
    const int q = 1 << qs;
    for (int bi = tid; bi < 4096; bi += 512) {
      const int j = bi & (q - 1), g = bi >> qs;
      const int i0 = (g << (qs + 2)) + j, i1 = i0 + q, i2 = i1 + q, i3 = i2 + q;
      const float2 w1 = tw[j << (2 * s)];
      const float w1r = w1.x, w1i = -w1.y;
      const float w2r = w1r * w1r - w1i * w1i, w2i = 2.f * w1r * w1i;
      const float w3r = w2r * w1r - w2i * w1i, w3i = w2r * w1i + w2i * w1r;
      const float ar = re[i0], ai = im[i0];
      const float xr1 = re[i1], xi1 = im[i1], xr2 = re[i2], xi2 = im[i2], xr3 = re[i3], xi3 = im[i3];
      const float br = xr1 * w1r - xi1 * w1i, bi_ = xr1 * w1i + xi1 * w1r;
      const float cr = xr2 * w2r - xi2 * w2i, ci = xr2 * w2i + xi2 * w2r;
      const float dr = xr3 * w3r - xi3 * w3i, di = xr3 * w3i + xi3 * w3r;
      const float t0r = ar + cr, t0i = ai + ci, t1r = ar - cr, t1i = ai - ci;
      const float t2r = br + dr, t2i = bi_ + di;
      const float er = br - dr, ei = bi_ - di;
      const float t3r = -ei, t3i = er;
      re[i0] = t0r + t2r; im[i0] = t0i + t2i;
      re[i1] = t1r + t3r; im[i1] = t1i + t3i;
      re[i2] = t0r - t2r; im[i2] = t0i - t2i;
      re[i3] = t1r - t3r; im[i3] = t1i - t3i;
    }
    __syncthreads();
  }
}

DI void phase_filter_fft(const Params& p, int l, float* lds) {
  const int tid = ltid();
  float* re = lds;
  float* im = lds + FFTN;
  float* kf = (float*)(p.ws + OFF_KF);
  const float2* tw = (const float2*)(p.ws + OFF_TW);
  const float* part = (const float*)(p.ws + OFF_PART);
  for (int c = lbid(); c < 512; c += gridDim.x) {
    float* slot = kf + (size_t)c * (2 * FFTN);
    float pv = 0.f;
    if (tid < 128) pv = part[tid * 1024 + c] + part[tid * 1024 + 512 + c];
    pv = wave_sum(pv);
    if ((tid & 63) == 0) lds[tid >> 6] = pv;
    __syncthreads();
    const float ssq = lds[0] + lds[1];
    __syncthreads();
    const float sc = rsqrtf(ssq + EPSV) * (1.0f / (float)FFTN);
    for (int i = tid; i < FFTN; i += 512) { re[i] = slot[i] * sc; im[i] = 0.f; }
    __syncthreads();
    fft_fwd(re, im, tw);
    for (int i = tid; i < FFTN; i += 512) { float2 v; v.x = re[i]; v.y = im[i]; ((float2*)slot)[i] = v; }
    __syncthreads();
  }
}

DI void phase_gemm1(const Params& p, int l, u16* lds) {
  const u16* hn = (const u16*)(p.ws + OFF_A);
  const u16* wt = (const u16*)(p.ws + OFF_W) + (size_t)l * W_LAYER + WO_T1;
  const int NT = 24, nitems = (MALL / 256) * NT;
  for (int item = lbid(); item < nitems; item += gridDim.x) {
    const int mt = item / NT, nt = item % NT;
    const int m0 = mt * 256, n0 = nt * 128;
    f32x16 acc[2][2];
    ACC_ZERO(acc);
    gemm_mainloop(hn + (size_t)m0 * 1024, 1024, wt + (size_t)n0 * 1024, 1024, 1024, acc, lds);
    u16* dst; int ld, cofs;
    if (nt < 4) { dst = (u16*)(p.ws + OFF_B); ld = 512; cofs = 0; }
    else if (nt < 12) { dst = (u16*)(p.ws + OFF_C); ld = 1024; cofs = 512; }
    else { dst = (u16*)(p.ws + OFF_R); ld = 1536; cofs = 1536; }
    stage_store_bf16(acc, dst, ld, m0, n0 - cofs, lds);
  }
}

DI void phase_h1(const Params& p, int l, float* lds) {
  const int tid = ltid();
  const u16* U12 = (const u16*)(p.ws + OFF_C);
  float* zT = (float*)(p.ws + OFF_A);
  const float* sw = p.hy_short_w + l * 3 * 1536;
  float* xs = lds;
  float* vs = lds + 66 * 65;
  const int nlat = 8 * 128 * 8, nctx = (l < 3) ? 8 * 4 * 8 : 0;
  for (int item = lbid(); item < nlat + nctx; item += gridDim.x) {
    int b, tt0, c0, Ls, rowbase; size_t zbase;
    if (item < nlat) { b = item >> 10; tt0 = ((item >> 3) & 127) * 64; c0 = (item & 7) * 64; Ls = LSEQ; rowbase = b * LSEQ; zbase = (size_t)b * 512 * LSEQ; }
    else { const int it = item - nlat; b = it >> 5; tt0 = ((it >> 3) & 3) * 64; c0 = (it & 7) * 64; Ls = LCTX; rowbase = ML + b * LCTX; zbase = (size_t)ZC_OFF + (size_t)b * 512 * LCTX; }
    for (int ch = tid; ch < 66 * 16; ch += 512) {
      const int arr = ch / 528, rem = ch - arr * 528;
      const int rr = rem >> 3, cc8 = (rem & 7) * 8;
      const int t = tt0 - 1 + rr;
      float* dstp = (arr ? vs : xs) + rr * 65 + cc8;
      if (t >= 0 && t < Ls) {
        const uint4 v = *(const uint4*)(U12 + (size_t)(rowbase + t) * 1024 + arr * 512 + c0 + cc8);
        const unsigned uu[4] = {v.x, v.y, v.z, v.w};
#pragma unroll
        for (int i = 0; i < 4; ++i) { dstp[2 * i] = __uint_as_float(uu[i] << 16); dstp[2 * i + 1] = __uint_as_float(uu[i] & 0xffff0000u); }
      } else {
#pragma unroll
        for (int i = 0; i < 8; ++i) dstp[i] = 0.f;
      }
    }
    __syncthreads();
    {
      const int tt = tid & 63, cgp = tid >> 6;
#pragma unroll
      for (int i = 0; i < 8; ++i) {
        const int cc = cgp * 8 + i, c = c0 + cc;
        float x1 = 0.f, vv = 0.f;
#pragma unroll
        for (int j = 0; j < 3; ++j) {
          x1 += sw[j * 1536 + 512 + c] * xs[(tt + j) * 65 + cc];
          vv += sw[j * 1536 + 1024 + c] * vs[(tt + j) * 65 + cc];
        }
        zT[zbase + (size_t)c * Ls + tt0 + tt] = x1 * vv;
      }
    }
    __syncthreads();
  }
}

DI void phase_p3(const Params& p, int l, float* lds) {
  const int tid = ltid(), lane = tid & 63, w = tid >> 6;
  u16* R = (u16*)(p.ws + OFF_R);
  float* rb = lds + w * 1472;
  float* hs = rb + 1440;
  const float* qn = p.gqa_q_norm + l * 64;
  const float* kn = p.gqa_k_norm + l * 64;
  const float* qan = p.mla_q_a_norm + l * 384;
  const float* kvan = p.mla_kv_a_norm + l * 256;
  const float* ropeg = (const float*)(p.ws + OFF_ROPEG);
  const float qscale = 0.125f * LOG2E;
  for (int r0 = lbid() * 8; r0 < MALL; r0 += gridDim.x * 8) {
    const int r = r0 + w;
    u16* rowp = R + (size_t)r * 1536;
    for (int ch = lane; ch < 180; ch += 64) {
      const uint4 v = *(const uint4*)(rowp + ch * 8);
      const unsigned uu[4] = {v.x, v.y, v.z, v.w};
#pragma unroll
      for (int i = 0; i < 4; ++i) { rb[ch * 8 + 2 * i] = __uint_as_float(uu[i] << 16); rb[ch * 8 + 2 * i + 1] = __uint_as_float(uu[i] & 0xffff0000u); }
    }
    __syncthreads();
    {
      float s = 0.f;
#pragma unroll
      for (int i = 0; i < 8; ++i) { const float v = rb[lane * 8 + i]; s += v * v; }
      s += __shfl_xor(s, 1); s += __shfl_xor(s, 2); s += __shfl_xor(s, 4);
      if ((lane & 7) == 0) hs[lane >> 3] = rsqrtf(s * (1.0f / 64.0f) + EPSV);
      float s2 = 0.f;
      if (lane < 16) {
#pragma unroll
        for (int i = 0; i < 8; ++i) { const float v = rb[512 + lane * 8 + i]; s2 += v * v; }
      }
      s2 += __shfl_xor(s2, 1); s2 += __shfl_xor(s2, 2); s2 += __shfl_xor(s2, 4);
      if (lane < 16 && (lane & 7) == 0) hs[8 + (lane >> 3)] = rsqrtf(s2 * (1.0f / 64.0f) + EPSV);
      float s3 = 0.f, s4 = 0.f;
#pragma unroll
      for (int i = 0; i < 6; ++i) { const float v = rb[768 + lane * 6 + i]; s3 += v * v; }
#pragma unroll
      for (int i = 0; i < 4; ++i) { const float v = rb[1152 + lane * 4 + i]; s4 += v * v; }
      s3 = wave_sum(s3); s4 = wave_sum(s4);
      if (lane == 0) { hs[10] = rsqrtf(s3 * (1.0f / 384.0f) + EPSV); hs[11] = rsqrtf(s4 * (1.0f / 256.0f) + EPSV); }
    }
    __syncthreads();
    {
      const bool lat = r < ML;
      const int t = r & (LSEQ - 1);
      const int d = lane, a = d & 31;
      float cs = 1.f, sn = 0.f;
      if (lat) { cs = ropeg[(t * 32 + a) * 2]; sn = ropeg[(t * 32 + a) * 2 + 1]; }
#pragma unroll
      for (int hd = 0; hd < 10; ++hd) {
        const float* gq = (hd < 8) ? qn : kn;
        const float rs = hs[hd];
        const float v = rb[hd * 64 + d] * rs * gq[d];
        const int dp = d ^ 32;
        const float vp = rb[hd * 64 + dp] * rs * gq[dp];
        float o = (d < 32) ? (v * cs - vp * sn) : (vp * sn + v * cs);
        if (hd < 8) o *= qscale;
        rowp[hd * 64 + d] = f2bf(o);
      }
#pragma unroll
      for (int i = 0; i < 6; ++i) { const int e = lane + 64 * i; rowp[768 + e] = f2bf(rb[768 + e] * hs[10] * qan[e]); }
#pragma unroll
      for (int i = 0; i < 4; ++i) { const int e = lane + 64 * i; rowp[1152 + e] = f2bf(rb[1152 + e] * hs[11] * kvan[e]); }
    }
    __syncthreads();
  }
}

DI void phase_h2(const Params& p, int l, float* lds) {
  const int tid = ltid(), lane = tid & 63, w = tid >> 6;
  float* zT = (float*)(p.ws + OFF_A);
  const float2* kf = (const float2*)(p.ws + OFF_KF);
  const float2* tw = (const float2*)(p.ws + OFF_TW);
  const float* skip = p.hy_skip + l * 512;
  float* re = lds;
  float* im = lds + FFTN;
  for (int item = lbid(); item < 2048; item += gridDim.x) {
    const int c = item >> 2, bp = item & 3;
    float* z1 = zT + ((size_t)(2 * bp) * 512 + c) * LSEQ;
    float* z2 = zT + ((size_t)(2 * bp + 1) * 512 + c) * LSEQ;
    for (int i = tid; i < LSEQ; i += 512) { re[i] = z1[i]; im[i] = z2[i]; re[i + LSEQ] = 0.f; im[i + LSEQ] = 0.f; }
    __syncthreads();
    fft_fwd(re, im, tw);
    const float2* kc = kf + (size_t)c * FFTN;
    for (int i = tid; i < FFTN; i += 512) {
      const float2 k = kc[i];
      const float xr = re[i], xi = im[i];
      re[i] = xr * k.x - xi * k.y;
      im[i] = xr * k.y + xi * k.x;
    }
    __syncthreads();
    fft_inv(re, im, tw);
    const float sk = skip[c];
    for (int i = tid; i < LSEQ; i += 512) {
      const float a = z1[i], b = z2[i];
      z1[i] = re[i] + a * sk;
      z2[i] = im[i] + b * sk;
    }
    __syncthreads();
  }
  if (l < 3) {
    const float* kcb = (const float*)(p.ws + OFF_KC);
    const float* partc = (const float*)(p.ws + OFF_PART) + 128 * 1024;
    float* zs = lds + w * 768;
    float* ks = zs + 256;
    for (int item = lbid(); item < 512; item += gridDim.x) {
      const int b = item >> 6, c = (item & 63) * 8 + w;
      float* z = zT + (size_t)ZC_OFF + ((size_t)b * 512 + c) * LCTX;
      float pv = (lane < 4) ? partc[lane * 1024 + c] + partc[lane * 1024 + 512 + c] : 0.f;
      pv = wave_sum(pv);
      const float sc = rsqrtf(pv + EPSV);
      for (int i = lane; i < 256; i += 64) zs[i] = z[i];
      for (int i = lane; i < 512; i += 64) ks[i] = kcb[c * 512 + i] * sc;
      __syncthreads();
      const float sk = skip[c];
      float acc[4] = {0.f, 0.f, 0.f, 0.f};
      for (int s = 0; s < 256; ++s) {
        const float zv = zs[s];
#pragma unroll
        for (int i = 0; i < 4; ++i) acc[i] += ks[(lane + 64 * i - s) & 511] * zv;
      }
#pragma unroll
      for (int i = 0; i < 4; ++i) z[lane + 64 * i] = acc[i] + zs[lane + 64 * i] * sk;
      __syncthreads();
    }
  }
}

DI void phase_h3(const Params& p, int l, float* lds) {
  const int tid = ltid();
  const u16* U0 = (const u16*)(p.ws + OFF_B);
  const float* zT = (const float*)(p.ws + OFF_A);
  u16* Y = (u16*)(p.ws + OFF_Y);
  const float* sw = p.hy_short_w + l * 3 * 1536;
  float* xs = lds;
  float* ys = lds + 66 * 65;
  const int nlat = 8 * 128 * 8, nctx = (l < 3) ? 8 * 4 * 8 : 0;
  for (int item = lbid(); item < nlat + nctx; item += gridDim.x) {
    int b, tt0, c0, Ls, rowbase; size_t zbase;
    if (item < nlat) { b = item >> 10; tt0 = ((item >> 3) & 127) * 64; c0 = (item & 7) * 64; Ls = LSEQ; rowbase = b * LSEQ; zbase = (size_t)b * 512 * LSEQ; }
    else { const int it = item - nlat; b = it >> 5; tt0 = ((it >> 3) & 3) * 64; c0 = (it & 7) * 64; Ls = LCTX; rowbase = ML + b * LCTX; zbase = (size_t)ZC_OFF + (size_t)b * 512 * LCTX; }
    for (int ch = tid; ch < 66 * 8; ch += 512) {
      const int rr = ch >> 3, cc8 = (ch & 7) * 8;
      const int t = tt0 - 1 + rr;
      float* dstp = xs + rr * 65 + cc8;
      if (t >= 0 && t < Ls) {
        const uint4 v = *(const uint4*)(U0 + (size_t)(rowbase + t) * 512 + c0 + cc8);
        const unsigned uu[4] = {v.x, v.y, v.z, v.w};
#pragma unroll
        for (int i = 0; i < 4; ++i) { dstp[2 * i] = __uint_as_float(uu[i] << 16); dstp[2 * i + 1] = __uint_as_float(uu[i] & 0xffff0000u); }
      } else {
#pragma unroll
        for (int i = 0; i < 8; ++i) dstp[i] = 0.f;
      }
    }
    {
      const int tt = tid & 63, cgp = tid >> 6;
#pragma unroll
      for (int i = 0; i < 8; ++i) {
        const int cc = cgp * 8 + i;
        ys[cc * 65 + tt] = zT[zbase + (size_t)(c0 + cc) * Ls + tt0 + tt];
      }
    }
    __syncthreads();
    {
      const int cc = tid & 63, tg = tid >> 6, c = c0 + cc;
      const float w0 = sw[c], w1 = sw[1536 + c], w2 = sw[2 * 1536 + c];
#pragma unroll
      for (int i = 0; i < 8; ++i) {
        const int tt = tg * 8 + i;
        const float x0 = w0 * xs[tt * 65 + cc] + w1 * xs[(tt + 1) * 65 + cc] + w2 * xs[(tt + 2) * 65 + cc];
        Y[(size_t)(rowbase + tt0 + tt) * 1536 + c] = f2bf(x0 * ys[cc * 65 + tt]);
      }
    }
    __syncthreads();
  }
}

DI void phase_p4(const Params& p, int l, u16* lds) {
  const u16* R = (const u16*)(p.ws + OFF_R);
  u16* QK = (u16*)(p.ws + OFF_A);
  const u16* wl = (const u16*)(p.ws + OFF_W) + (size_t)l * W_LAYER;
  const int NT = 14, nitems = (MALL / 256) * NT;
  for (int item = lbid(); item < nitems; item += gridDim.x) {
    const int mt = item / NT, nt = item % NT;
    const int m0 = mt * 256;
    f32x16 acc[2][2];
    ACC_ZERO(acc);
    int n0;
    if (nt < 6) { n0 = nt * 128; gemm_mainloop(R + (size_t)m0 * 1536 + 768, 1536, wl + WO_QB + (size_t)n0 * 384, 384, 384, acc, lds); }
    else { n0 = (nt - 6) * 128; gemm_mainloop(R + (size_t)m0 * 1536 + 1152, 1536, wl + WO_KVB + (size_t)n0 * 256, 256, 256, acc, lds); n0 += 768; }
    stage_store_bf16(acc, QK, 1792, m0, n0, lds);
  }
}

DI void phase_p5(const Params& p, int l, float* lds) {
  const int tid = ltid(), lane = tid & 63, w = tid >> 6;
  u16* QK = (u16*)(p.ws + OFF_A);
  u16* KM = (u16*)(p.ws + OFF_KM);
  const u16* R = (const u16*)(p.ws + OFF_R);
  float* rb = lds + w * 1856;
  float* hs = rb + 1824;
  const float* qn = p.mla_q_norm + l * 96;
  const float* kn = p.mla_k_norm + l * 96;
  const float* ropem = (const float*)(p.ws + OFF_ROPEM);
  const float qscale = 0.10206207261596575f * LOG2E;
  for (int r0 = lbid() * 8; r0 < MALL; r0 += gridDim.x * 8) {
    const int r = r0 + w;
    u16* rowp = QK + (size_t)r * 1792;
    for (int ch = lane; ch < 228; ch += 64) {
      const uint4 v = (ch < 224) ? *(const uint4*)(rowp + ch * 8) : *(const uint4*)(R + (size_t)r * 1536 + 1408 + (ch - 224) * 8);
      const unsigned uu[4] = {v.x, v.y, v.z, v.w};
#pragma unroll
      for (int i = 0; i < 4; ++i) { rb[ch * 8 + 2 * i] = __uint_as_float(uu[i] << 16); rb[ch * 8 + 2 * i + 1] = __uint_as_float(uu[i] & 0xffff0000u); }
    }
    __syncthreads();
    {
      const int hd = lane >> 3, j = lane & 7;
      float s = 0.f, s2 = 0.f;
#pragma unroll
      for (int i = 0; i < 12; ++i) {
        const int d = j * 12 + i;
        const float v = rb[hd * 96 + d];
        s += v * v;
        const float kv = (d < 64) ? rb[768 + hd * 128 + d] : rb[1792 + d - 64];
        s2 += kv * kv;
      }
      s += __shfl_xor(s, 1); s += __shfl_xor(s, 2); s += __shfl_xor(s, 4);
      s2 += __shfl_xor(s2, 1); s2 += __shfl_xor(s2, 2); s2 += __shfl_xor(s2, 4);
      if (j == 0) { hs[hd] = rsqrtf(s * (1.0f / 96.0f) + EPSV); hs[8 + hd] = rsqrtf(s2 * (1.0f / 96.0f) + EPSV); }
    }
    __syncthreads();
    {
      const bool lat = r < ML;
      const int t = r & (LSEQ - 1);
#pragma unroll
      for (int i = 0; i < 12; ++i) {
        const int e = lane + 64 * i;
        const int hd = e / 96, d = e - hd * 96;
        const float rq = hs[hd], rk = hs[8 + hd];
        float qv = rb[hd * 96 + d] * rq * qn[d];
        float kv = ((d < 64) ? rb[768 + hd * 128 + d] : rb[1792 + d - 64]) * rk * kn[d];
        if (d >= 64 && lat) {
          const int a = (d - 64) & 15;
          const float cs = ropem[(t * 16 + a) * 2], sn = ropem[(t * 16 + a) * 2 + 1];
          const int dp = (d < 80) ? d + 16 : d - 16;
          const float qp = rb[hd * 96 + dp] * rq * qn[dp];
          const float kp = rb[1792 + dp - 64] * rk * kn[dp];
          if (d < 80) { qv = qv * cs - qp * sn; kv = kv * cs - kp * sn; }
          else { qv = qp * sn + qv * cs; kv = kp * sn + kv * cs; }
        }
        rowp[e] = f2bf(qv * qscale);
        KM[(size_t)r * 768 + e] = f2bf(kv);
      }
    }
    __syncthreads();
  }
}

template <int DQK>
DI void attn_block(const u16* __restrict__ Qp, int q_ld, const u16* __restrict__ Kp, int k_ld, const u16* __restrict__ Vp,
                   int v_ld, u16* __restrict__ Op, int o_ld, int qrow0, int qt0, int s0_row0, int s0_n, int s0_t0,
                   int masked0, int s1_row0, int s1_n, float sink_l2, int has_sink, u16* lds) {
  constexpr int KS = DQK + 8, NS = DQK / 16, CPK = DQK / 8;
  const int tid = ltid(), lane = tid & 63, w = tid >> 6, l32 = lane & 31, hh = lane >> 5;
  u16* Ks = lds;
  u16* Vt = lds + 2 * 64 * KS;
  const int qrow = qrow0 + 32 * w + l32;
  bf16x8 qf[NS];
#pragma unroll
  for (int s = 0; s < NS; ++s) qf[s] = *(const bf16x8*)(Qp + (size_t)qrow * q_ld + 16 * s + 8 * hh);
  f32x16 ot[2];
#pragma unroll
  for (int i = 0; i < 16; ++i) { ot[0][i] = 0.f; ot[1][i] = 0.f; }
  float m = -1e30f, lsum = 0.f;
  const int nt0 = s0_n >> 6, nt = nt0 + (s1_n >> 6);
  const int kkey0 = tid / CPK, kch0 = tid - kkey0 * CPK;
  const int c1 = tid + 512;
  const bool has1 = c1 < 64 * CPK;
  const int kkey1 = has1 ? c1 / CPK : 0, kch1 = has1 ? c1 - kkey1 * CPK : 0;
  const int vkey = tid & 63, vch = tid >> 6;
  uint4 rk0, rk1, rv;
  rk1 = make_uint4(0, 0, 0, 0);
  {
    const int row0 = (0 < nt0) ? s0_row0 : s1_row0;
    rk0 = *(const uint4*)(Kp + (size_t)(row0 + kkey0) * k_ld + kch0 * 8);
    if (has1) rk1 = *(const uint4*)(Kp + (size_t)(row0 + kkey1) * k_ld + kch1 * 8);
    rv = *(const uint4*)(Vp + (size_t)(row0 + vkey) * v_ld + vch * 8);
  }
  {
    *(uint4*)(Ks + kkey0 * KS + kch0 * 8) = rk0;
    if (has1) *(uint4*)(Ks + kkey1 * KS + kch1 * 8) = rk1;
    const unsigned uu[4] = {rv.x, rv.y, rv.z, rv.w};
#pragma unroll
    for (int i = 0; i < 4; ++i) {
      Vt[(vch * 8 + 2 * i) * 68 + vkey] = (u16)(uu[i] & 0xffffu);
      Vt[(vch * 8 + 2 * i + 1) * 68 + vkey] = (u16)(uu[i] >> 16);
    }
  }
  __syncthreads();
  const int tq = qt0 + 32 * w + l32;
  for (int j = 0; j < nt; ++j) {
    const int cur = j & 1;
    {
      const int jn = (j + 1 < nt) ? j + 1 : j;
      const int row0 = (jn < nt0) ? s0_row0 + 64 * jn : s1_row0 + 64 * (jn - nt0);
      rk0 = VLOAD16(Kp + (size_t)(row0 + kkey0) * k_ld + kch0 * 8);
      if (DQK == 96) rk1 = VLOAD16(Kp + (size_t)(row0 + kkey1) * k_ld + kch1 * 8);
      rv = VLOAD16(Vp + (size_t)(row0 + vkey) * v_ld + vch * 8);
    }
    __builtin_amdgcn_sched_barrier(0);
    const bool mtile = masked0 && (j < nt0);
    const int tk0 = s0_t0 + 64 * j;
    bool active = true;
    if (mtile) {
      const int tql = qt0 + 32 * w;
      active = (tk0 + 63 >= tql - 128) && (tk0 <= tql + 31 + 128);
    }
    if (active) {
      const u16* kb = Ks + cur * 64 * KS + l32 * KS + hh * 8;
      f32x16 st[2];
#pragma unroll
      for (int i = 0; i < 16; ++i) { st[0][i] = 0.f; st[1][i] = 0.f; }
#pragma unroll
      for (int s = 0; s < NS; ++s) {
        const bf16x8 a0 = *(const bf16x8*)(kb + s * 16);
        const bf16x8 a1 = *(const bf16x8*)(kb + 32 * KS + s * 16);
        st[0] = MFMA(a0, qf[s], st[0]);
        st[1] = MFMA(a1, qf[s], st[1]);
      }
      if (mtile) {
#pragma unroll
        for (int kt = 0; kt < 2; ++kt)
#pragma unroll
          for (int rg = 0; rg < 16; ++rg) {
            const int tk = tk0 + 32 * kt + (rg & 3) + 8 * (rg >> 2) + 4 * hh;
            const int dlt = tk - tq;
            if (dlt > 128 || dlt < -128) st[kt][rg] = -1e30f;
          }
      }
      float mloc = st[0][0];
#pragma unroll
      for (int rg = 1; rg < 16; ++rg) mloc = fmaxf(mloc, st[0][rg]);
#pragma unroll
      for (int rg = 0; rg < 16; ++rg) mloc = fmaxf(mloc, st[1][rg]);
      mloc = fmaxf(mloc, __shfl_xor(mloc, 32));
      const float mnew = fmaxf(m, mloc);
      const float alpha = __builtin_amdgcn_exp2f(m - mnew);
      m = mnew;
      float ps = 0.f;
#pragma unroll
      for (int kt = 0; kt < 2; ++kt)
#pragma unroll
        for (int rg = 0; rg < 16; ++rg) {
          float pv = __builtin_amdgcn_exp2f(st[kt][rg] - mnew);
          if (mtile) pv = (st[kt][rg] < -1e29f) ? 0.f : pv;
          st[kt][rg] = pv;
          ps += pv;
        }
      lsum = lsum * alpha + ps;
#pragma unroll
      for (int i = 0; i < 16; ++i) { ot[0][i] *= alpha; ot[1][i] *= alpha; }
      const u16* vb = Vt + cur * 64 * 68 + l32 * 68 + 4 * hh;
#pragma unroll
      for (int kt = 0; kt < 2; ++kt)
#pragma unroll
        for (int s = 0; s < 2; ++s) {
          unsigned pw[4];
#pragma unroll
          for (int i = 0; i < 4; ++i) pw[i] = pk2(st[kt][8 * s + 2 * i], st[kt][8 * s + 2 * i + 1]);
          const uint4 pu = make_uint4(pw[0], pw[1], pw[2], pw[3]);
          const bf16x8 pf = __builtin_bit_cast(bf16x8, pu);
#pragma unroll
          for (int dt = 0; dt < 2; ++dt) {
            const u16* vp = vb + dt * 32 * 68 + 32 * kt + 16 * s;
            const uint2 lo = *(const uint2*)(vp);
            const uint2 hi = *(const uint2*)(vp + 8);
            const uint4 au = make_uint4(lo.x, lo.y, hi.x, hi.y);
            ot[dt] = MFMA(__builtin_bit_cast(bf16x8, au), pf, ot[dt]);
          }
        }
    }
    __builtin_amdgcn_sched_barrier(0);
    {
      u16* Kw = Ks + (cur ^ 1) * 64 * KS;
      u16* Vw = Vt + (cur ^ 1) * 64 * 68;
      *(uint4*)(Kw + kkey0 * KS + kch0 * 8) = rk0;
      if (has1) *(uint4*)(Kw + kkey1 * KS + kch1 * 8) = rk1;
      const unsigned uu[4] = {rv.x, rv.y, rv.z, rv.w};
#pragma unroll
      for (int i = 0; i < 4; ++i) {
        Vw[(vch * 8 + 2 * i) * 68 + vkey] = (u16)(uu[i] & 0xffffu);
        Vw[(vch * 8 + 2 * i + 1) * 68 + vkey] = (u16)(uu[i] >> 16);
      }
    }
    __syncthreads();
  }
  float ltot = lsum + __shfl_xor(lsum, 32);
  if (has_sink) ltot += __builtin_amdgcn_exp2f(sink_l2 - m);
  const float inv = 1.0f / ltot;
#pragma unroll
  for (int dt = 0; dt < 2; ++dt)
#pragma unroll
    for (int g = 0; g < 4; ++g) {
      uint2 pk;
      pk.x = pk2(ot[dt][4 * g] * inv, ot[dt][4 * g + 1] * inv);
      pk.y = pk2(ot[dt][4 * g + 2] * inv, ot[dt][4 * g + 3] * inv);
      *(uint2*)(Op + (size_t)qrow * o_ld + dt * 32 + 8 * g + 4 * hh) = pk;
    }
}

DI void phase_attn(const Params& p, int l, u16* lds) {
  const u16* R = (const u16*)(p.ws + OFF_R);
  const u16* QK = (const u16*)(p.ws + OFF_A);
  const u16* KM = (const u16*)(p.ws + OFF_KM);
  u16* Y = (u16*)(p.ws + OFF_Y);
  const float* sink = p.gqa_sink + l * 8;
  const int n_mla = 2048, n_gqa = 2048, n_ctx = (l < 3) ? 128 : 0;
  for (int item = lbid(); item < n_mla + n_gqa + n_ctx; item += gridDim.x) {
    int kind, qb, hd, b, isctx;
    if (item < n_mla) { kind = 0; isctx = 0; qb = item & 31; hd = (item >> 5) & 7; b = item >> 8; }
    else if (item < n_mla + n_gqa) { const int it = item - n_mla; kind = 1; isctx = 0; qb = it & 31; hd = (it >> 5) & 7; b = it >> 8; }
    else { const int it = item - n_mla - n_gqa; isctx = 1; qb = 0; hd = it & 7; b = (it >> 3) & 7; kind = it >> 6; }
    const int crow0 = ML + b * LCTX;
    if (kind == 0) {
      int qrow0, qt0, s0r, s0n, s1n;
      if (isctx) { qrow0 = crow0; qt0 = 0; s0r = crow0; s0n = LCTX; s1n = 0; }
      else { qrow0 = b * LSEQ + qb * 256; qt0 = qb * 256; s0r = b * LSEQ; s0n = LSEQ; s1n = LCTX; }
      attn_block<96>(QK + hd * 96, 1792, KM + hd * 96, 768, QK + 768 + hd * 128 + 64, 1792, Y + 1024 + hd * 64, 1536,
                     qrow0, qt0, s0r, s0n, 0, 0, crow0, s1n, 0.f, 0, lds);
    } else {
      const int kvh = hd >> 2;
      int qrow0, qt0, s0r, s0n, s0t, msk, s1n;
      if (isctx) { qrow0 = crow0; qt0 = 0; s0r = crow0; s0n = LCTX; s0t = 0; msk = 0; s1n = 0; }
      else {
        const int t0 = qb * 256;
        const int lo = (t0 - 128 < 0) ? 0 : t0 - 128;
        const int hi = (t0 + 384 > LSEQ) ? LSEQ : t0 + 384;
        qrow0 = b * LSEQ + t0; qt0 = t0; s0r = b * LSEQ + lo; s0n = hi - lo; s0t = lo; msk = 1; s1n = LCTX;
      }
      attn_block<64>(R + hd * 64, 1536, R + 512 + kvh * 64, 1536, R + 640 + kvh * 64, 1536, Y + 512 + hd * 64, 1536,
                     qrow0, qt0, s0r, s0n, s0t, msk, crow0, s1n, sink[hd] * LOG2E, 1, lds);
    }
  }
}

DI void phase_p7a(const Params& p, int l, int nrows, u16* lds) {
  const u16* hn = (const u16*)(p.ws + OFF_A);
  const u16* wt = (const u16*)(p.ws + OFF_W) + (size_t)l * W_LAYER + WO_TG;
  u16* Gt = (u16*)(p.ws + OFF_B);
  const int NT = 24, nitems = (nrows / 256) * NT;
  for (int item = lbid(); item < nitems; item += gridDim.x) {
    const int m0 = (item / NT) * 256, n0 = (item % NT) * 128;
    f32x16 acc[2][2];
    ACC_ZERO(acc);
    gemm_mainloop(hn + (size_t)m0 * 1024, 1024, wt + (size_t)n0 * 1024, 1024, 1024, acc, lds);
    ACC_FOREACH(acc, m0, n0, { acc[mi_][ni_][r_] = sigmoidf_(val); });
    stage_store_bf16(acc, Gt, 3072, m0, n0, lds);
  }
}
DI void phase_p7b(const Params& p, int l, int nrows, u16* lds) {
  const u16* Y = (const u16*)(p.ws + OFF_Y);
  const u16* Gt = (const u16*)(p.ws + OFF_B);
  const u16* wb = (const u16*)(p.ws + OFF_W) + (size_t)l * W_LAYER + WO_BR;
  u16* mg = (u16*)(p.ws + OFF_A);
  const int NT = 8, nitems = (nrows / 256) * NT;
  for (int item = lbid(); item < nitems; item += gridDim.x) {
    const int m0 = (item / NT) * 256, n0 = (item % NT) * 128;
    f32x16 mrg[2][2];
    ACC_ZERO(mrg);
#pragma unroll 1
    for (int nb = 0; nb < 3; ++nb) {
      f32x16 acc[2][2];
      ACC_ZERO(acc);
      gemm_mainloop<true>(Y + (size_t)m0 * 1536 + nb * 512, 1536, wb + (size_t)nb * 1024 * 512 + (size_t)n0 * 512, 512, 512, acc, lds);
      {
        u16* gs = lds;
        const int tid = ltid();
#pragma unroll
        for (int i = 0; i < 8; ++i) {
          const int ch = tid + 512 * i, rr = ch >> 4, c16 = ch & 15;
          const uint4 v = *(const uint4*)(Gt + (size_t)(m0 + rr) * 3072 + nb * 1024 + n0 + c16 * 8);
          *(uint4*)(gs + rr * 136 + c16 * 8) = v;
        }
        __syncthreads();
        ACC_FOREACH(acc, 0, 0, { mrg[mi_][ni_][r_] += bf2f(gs[row * 136 + col]) * val; });
        __syncthreads();
      }
    }
    stage_store_bf16(mrg, mg, 1024, m0, n0, lds);
  }
}
DI void phase_p8(const Params& p, int l, int nrows, u16* lds) {
  const u16* mg = (const u16*)(p.ws + OFF_A);
  const u16* wt = (const u16*)(p.ws + OFF_W) + (size_t)l * W_LAYER + WO_OUT;
  const float* xs = (l == 0) ? p.x : p.out;
  const float* cs = (l == 0) ? p.ctx : (const float*)(p.ws + OFF_CTX);
  float* cd = (float*)(p.ws + OFF_CTX);
  const int NT = 8, nitems = (nrows / 256) * NT;
  for (int item = lbid(); item < nitems; item += gridDim.x) {
    const int m0 = (item / NT) * 256, n0 = (item % NT) * 128;
    f32x16 acc[2][2];
    ACC_ZERO(acc);
    gemm_mainloop(mg + (size_t)m0 * 1024, 1024, wt + (size_t)n0 * 1024, 1024, 1024, acc, lds);
    const int mrow = (m0 < ML) ? (m0 >> 13) : 8;
    const float* gate = mods_ptr(p, l, mrow, 2);
    ACC_FOREACH(acc, m0, n0, {
      const float g = gate[col];
      if (row < ML) p.out[(size_t)row * 1024 + col] = xs[(size_t)row * 1024 + col] + g * val;
      else cd[(size_t)(row - ML) * 1024 + col] = cs[(size_t)(row - ML) * 1024 + col] + g * val;
    });
  }
}
DI void phase_p10(const Params& p, int l, int nrows, u16* lds) {
  const u16* hn = (const u16*)(p.ws + OFF_A);
  const u16* wt = (const u16*)(p.ws + OFF_W) + (size_t)l * W_LAYER + WO_W1;
  u16* h1 = (u16*)(p.ws + OFF_B);
  const int NT = 32, nitems = (nrows / 256) * NT;
  for (int item = lbid(); item < nitems; item += gridDim.x) {
    const int m0 = (item / NT) * 256, n0 = (item % NT) * 128;
    f32x16 acc[2][2];
    ACC_ZERO(acc);
    gemm_mainloop(hn + (size_t)m0 * 1024, 1024, wt + (size_t)n0 * 1024, 1024, 1024, acc, lds);
    ACC_FOREACH(acc, m0, n0, { const float rl = fmaxf(val, 0.f); acc[mi_][ni_][r_] = rl * rl; });
    stage_store_bf16(acc, h1, 4096, m0, n0, lds);
  }
}
DI void phase_p11(const Params& p, int l, int nrows, u16* lds) {
  const u16* h1 = (const u16*)(p.ws + OFF_B);
  const u16* wt = (const u16*)(p.ws + OFF_W) + (size_t)l * W_LAYER + WO_W2;
  float* cd = (float*)(p.ws + OFF_CTX);
  const int NT = 8, nitems = (nrows / 256) * NT;
  for (int item = lbid(); item < nitems; item += gridDim.x) {
    const int m0 = (item / NT) * 256, n0 = (item % NT) * 128;
    f32x16 acc[2][2];
    ACC_ZERO(acc);
    gemm_mainloop(h1 + (size_t)m0 * 4096, 4096, wt + (size_t)n0 * 4096, 4096, 4096, acc, lds);
    const int mrow = (m0 < ML) ? (m0 >> 13) : 8;
    const float* gate = mods_ptr(p, l, mrow, 5);
    ACC_FOREACH(acc, m0, n0, {
      const float g = gate[col];
      float* dp = (row < ML) ? p.out + (size_t)row * 1024 + col : cd + (size_t)(row - ML) * 1024 + col;
      *dp = *dp + g * val;
    });
  }
}

DI void gsync(cg::grid_group& grid) {
  asm volatile("s_waitcnt vmcnt(0) lgkmcnt(0)" ::: "memory");
  grid.sync();
  if (ltid() < 64) {
    __builtin_amdgcn_fence(__ATOMIC_ACQUIRE, "agent");
    asm volatile("s_waitcnt vmcnt(0)" ::: "memory");
  }
  __syncthreads();
}

__global__ void __launch_bounds__(512) fwd_megakernel(Params p) {
  __shared__ __attribute__((aligned(16))) char lds[131072];
  cg::grid_group grid = cg::this_grid();
  phase0(p, lds);
  gsync(grid);
  for (int l = 0; l < 4; ++l) {
    const int nrows2 = (l < 3) ? MALL : ML;
#ifdef PROBE_SYNC10
    for (int q = 0; q < 10; ++q) gsync(grid);
#endif
#ifdef PROBE_FILT
    filter_tiles(p, l, LSEQ, 2 * FFTN, (float*)(p.ws + OFF_KF), (float*)(p.ws + OFF_PART), (float*)lds);
    gsync(grid);
    phase_filter_fft(p, l, (float*)lds);
    gsync(grid);
#endif
    phase_rownorm(p, l, 0, MALL);
#ifdef PROBE_ELEM
    phase_rownorm(p, l, 0, MALL);
    phase_rownorm(p, l, 0, MALL);
    phase_rownorm(p, l, 0, MALL);
#endif
    filter_tiles(p, l, LSEQ, 2 * FFTN, (float*)(p.ws + OFF_KF), (float*)(p.ws + OFF_PART), (float*)lds);
    if (l < 3) filter_tiles(p, l, LCTX, 512, (float*)(p.ws + OFF_KC), (float*)(p.ws + OFF_PART) + 128 * 1024, (float*)lds);
    gsync(grid);
    phase_gemm1(p, l, (u16*)lds);
#ifdef PROBE_GEMMS
    phase_gemm1(p, l, (u16*)lds);
#endif
    phase_filter_fft(p, l, (float*)lds);
    gsync(grid);
    phase_h1(p, l, (float*)lds);
#ifdef PROBE_ELEM
    phase_h1(p, l, (float*)lds);
#endif
    phase_p3(p, l, (float*)lds);
    gsync(grid);
    phase_h2(p, l, (float*)lds);
    gsync(grid);
#ifdef PROBE_H2
    phase_h1(p, l, (float*)lds);
    gsync(grid);
    phase_h2(p, l, (float*)lds);
    gsync(grid);
#endif
    phase_h3(p, l, (float*)lds);
#ifdef PROBE_ELEM
    phase_h3(p, l, (float*)lds);
#endif
    gsync(grid);
    phase_p4(p, l, (u16*)lds);
#ifdef PROBE_GEMMS
    phase_p4(p, l, (u16*)lds);
#endif
    gsync(grid);
    phase_p5(p, l, (float*)lds);
    gsync(grid);
    phase_attn(p, l, (u16*)lds);
#ifdef PROBE_ATTN2
    gsync(grid);
    phase_attn(p, l, (u16*)lds);
#endif
    gsync(grid);
    phase_rownorm(p, l, 0, nrows2);
    gsync(grid);
    phase_p7a(p, l, nrows2, (u16*)lds);
#ifdef PROBE_GEMMS
    phase_p7a(p, l, nrows2, (u16*)lds);
#endif
    gsync(grid);
    phase_p7b(p, l, nrows2, (u16*)lds);
#ifdef PROBE_GEMMS
    phase_p7b(p, l, nrows2, (u16*)lds);
#endif
    gsync(grid);
    phase_p8(p, l, nrows2, (u16*)lds);
    gsync(grid);
    phase_rownorm(p, l, 1, nrows2);
    gsync(grid);
    phase_p10(p, l, nrows2, (u16*)lds);
#if defined(PROBE_P10X2) || defined(PROBE_GEMMS)
    gsync(grid);
    phase_p10(p, l, nrows2, (u16*)lds);
#endif
    gsync(grid);
    phase_p11(p, l, nrows2, (u16*)lds);
    gsync(grid);
  }
}

extern "C" void kernel_launch(void* const* d_in, const int* in_sizes, int n_in, void* d_out, int out_size, void* d_ws,
                              size_t ws_size, hipStream_t stream) {
  static int grid_blocks = 0;
  if (!grid_blocks) {
    int dev = 0, cus = 0, per_cu = 0;
    hipGetDevice(&dev);
    hipDeviceGetAttribute(&cus, hipDeviceAttributeMultiprocessorCount, dev);
    hipOccupancyMaxActiveBlocksPerMultiprocessor(&per_cu, fwd_megakernel, 512, 0);
    if (per_cu < 1) per_cu = 1;
    if (per_cu > 1) per_cu = 1;
    grid_blocks = cus * per_cu;
  }
  Params p{};
  const float** pp = (const float**)&p;
  for (int i = 0; i < 30; ++i) pp[i] = (const float*)d_in[i];
  p.out = (float*)d_out;
  p.ws = (char*)d_ws;
  void* args[] = {&p};
  hipError_t e = hipLaunchCooperativeKernel((void*)fwd_megakernel, dim3(grid_blocks), dim3(512), args, 0, stream);
  if (e != hipSuccess) fprintf(stderr, "cooperative launch failed: %s (grid %d)\n", hipGetErrorString(e), grid_blocks);
}
```

```cpp
#include <hip/hip_runtime.h>
#include <hip/hip_cooperative_groups.h>
#include <cstdio>
namespace cg = cooperative_groups;

typedef unsigned short u16;
typedef short bf16x8 __attribute__((ext_vector_type(8)));
typedef float f32x16 __attribute__((ext_vector_type(16)));
typedef unsigned u32x4 __attribute__((ext_vector_type(4)));
#define VLOAD16(ptr) __builtin_bit_cast(uint4, *(const volatile u32x4*)(ptr))
typedef __bf16 bf16x2_t __attribute__((ext_vector_type(2)));
typedef float f32x2_t __attribute__((ext_vector_type(2)));
#define DI __device__ __forceinline__
#define MFMA(a, b, c) __builtin_amdgcn_mfma_f32_32x32x16_bf16((a), (b), (c), 0, 0, 0)

#define DM 1024
#define NBATCH 8
#define LSEQ 8192
#define LCTX 256
#define ML 65536
#define MC 2048
#define MALL 67584
#define NIN 6048
#define FFTN 16384
#define EPSV 1e-6f
#define LOG2E 1.4426950408889634f

#define W_LAYER 17858560ull
#define WO_T1 0ull
#define WO_TG 3145728ull
#define WO_QB 6291456ull
#define WO_KVB 6586368ull
#define WO_BR 6848512ull
#define WO_OUT 8421376ull
#define WO_W1 9469952ull
#define WO_W2 13664256ull
#define OFF_W 0ull
#define OFF_CTX 142868480ull
#define OFF_KF 151257088ull
#define OFF_KC 218365952ull
#define OFF_MODS 219414528ull
#define OFF_SUMSQ 220299264ull
#define OFF_ROPEG 220315648ull
#define OFF_ROPEM 222412800ull
#define OFF_TW 223461376ull
#define OFF_A 223592448ull
#define OFF_B 362004480ull
#define OFF_C 431210496ull
#define OFF_R 569622528ull
#define OFF_Y 777240576ull
#define OFF_KM (OFF_A + 242221056ull)
#define OFF_PART 984858624ull
#define ZC_OFF 33554432

struct Params {
  const float *x, *c, *ctx, *c_ctx, *w_mod, *b_mod, *norm_mix_g, *norm_mlp_g, *w_in, *hy_short_w, *hy_f1_w, *hy_f1_b,
      *hy_f2_w, *hy_f2_b, *hy_sin_freq, *hy_f3_w, *hy_skip, *gqa_q_norm, *gqa_k_norm, *gqa_sink, *mla_q_a_norm,
      *mla_kv_a_norm, *w_q_b, *w_kv_b, *mla_q_norm, *mla_k_norm, *w_branch, *w_out, *w_mlp1, *w_mlp2;
  float* out;
  char* ws;
};

DI int ltid() { int t = threadIdx.x; asm volatile("" : "+v"(t)); return t; }
DI int lbid() { int t = blockIdx.x; asm volatile("" : "+s"(t)); return t; }
DI u16 f2bf(float x) { return __builtin_bit_cast(u16, (__bf16)x); }
DI float bf2f(u16 v) { return __uint_as_float(((unsigned)v) << 16); }
DI unsigned pk2(float a, float b) {
  f32x2_t f = {a, b};
  return __builtin_bit_cast(unsigned, __builtin_convertvector(f, bf16x2_t));
}
DI float wave_sum(float v) {
#pragma unroll
  for (int o = 32; o > 0; o >>= 1) v += __shfl_xor(v, o);
  return v;
}
DI float sigmoidf_(float x) { return 1.0f / (1.0f + __expf(-x)); }
DI const float* mods_ptr(const Params& p, int l, int mrow, int j) {
  return (const float*)(p.ws + OFF_MODS) + ((size_t)(l * 9 + mrow) * 6144 + j * 1024);
}

template <bool LOWREG = false>
DI void gemm_mainloop(const u16* __restrict__ Ag, int lda, const u16* __restrict__ Bg, int ldb, int K,
                      f32x16 (&acc)[2][2], u16* lds) {
  const int tid = ltid(), lane = tid & 63, w = tid >> 6, l32 = lane & 31, hh = lane >> 5;
  const int wm = w >> 1, wn = w & 1;
  u16* As = lds;
  u16* Bs = lds + 2 * 256 * 72;
  const int arow = tid >> 3, ach = tid & 7;
  const u16* ap = Ag + (size_t)arow * lda + ach * 8;
  const u16* bp = Bg + (size_t)arow * ldb + ach * 8;
  const int nk = K >> 6;
  uint4 ra0[4], rb0[2], ra1[4], rb1[2];
#define G_LOAD(RA, RB, T)                                                                   \
  {                                                                                         \
    const int t_ = ((T) < nk) ? (T) : nk - 1;                                               \
    _Pragma("unroll") for (int i = 0; i < 4; ++i) RA[i] = VLOAD16(ap + (size_t)(64 * i) * lda + 64 * t_); \
    _Pragma("unroll") for (int i = 0; i < 2; ++i) RB[i] = VLOAD16(bp + (size_t)(64 * i) * ldb + 64 * t_); \
  }
#define G_STORE(RA, RB, BUF)                                                                \
  {                                                                                         \
    u16* Aw = As + (BUF) * 256 * 72;                                                        \
    u16* Bw = Bs + (BUF) * 128 * 72;                                                        \
    _Pragma("unroll") for (int i = 0; i < 4; ++i) *(uint4*)(Aw + (arow + 64 * i) * 72 + ach * 8) = RA[i]; \
    _Pragma("unroll") for (int i = 0; i < 2; ++i) *(uint4*)(Bw + (arow + 64 * i) * 72 + ach * 8) = RB[i]; \
  }
#define G_COMPUTE(BUF, RA, RB, WBUF)                                                        \
  {                                                                                         \
    const u16* as = As + (BUF) * 256 * 72 + (wm * 64 + l32) * 72 + hh * 8;                  \
    const u16* bs = Bs + (BUF) * 128 * 72 + (wn * 64 + l32) * 72 + hh * 8;                  \
    u16* Aw = As + (WBUF) * 256 * 72 + arow * 72 + ach * 8;                                 \
    u16* Bw = Bs + (WBUF) * 128 * 72 + arow * 72 + ach * 8;                                 \
    _Pragma("unroll") for (int s = 0; s < 4; ++s) {                                         \
      bf16x8 a0 = *(const bf16x8*)(as + s * 16), a1 = *(const bf16x8*)(as + 32 * 72 + s * 16); \
      bf16x8 b0 = *(const bf16x8*)(bs + s * 16), b1 = *(const bf16x8*)(bs + 32 * 72 + s * 16); \
      acc[0][0] = MFMA(a0, b0, acc[0][0]);                                                  \
      acc[0][1] = MFMA(a0, b1, acc[0][1]);                                                  \
      acc[1][0] = MFMA(a1, b0, acc[1][0]);                                                  \
      acc[1][1] = MFMA(a1, b1, acc[1][1]);                                                  \
      if (s == 0) { *(uint4*)(Aw) = RA[0]; *(uint4*)(Aw + 64 * 72) = RA[1]; }               \
      if (s == 1) { *(uint4*)(Aw + 128 * 72) = RA[2]; *(uint4*)(Aw + 192 * 72) = RA[3]; }   \
      if (s == 2) { *(uint4*)(Bw) = RB[0]; *(uint4*)(Bw + 64 * 72) = RB[1]; }               \
      if (LOWREG) __builtin_amdgcn_sched_barrier(0);                                        \
    }                                                                                       \
  }
  G_LOAD(ra0, rb0, 0);
  G_LOAD(ra1, rb1, 1);
  __builtin_amdgcn_sched_barrier(0);
  G_STORE(ra0, rb0, 0);
  __syncthreads();
  for (int kt = 0; kt < nk; kt += 2) {
    G_LOAD(ra0, rb0, kt + 2);
    __builtin_amdgcn_sched_barrier(0);
    G_COMPUTE(0, ra1, rb1, 1);
    __syncthreads();
    G_LOAD(ra1, rb1, kt + 3);
    __builtin_amdgcn_sched_barrier(0);
    G_COMPUTE(1, ra0, rb0, 0);
    __syncthreads();
  }
#undef G_LOAD
#undef G_STORE
#undef G_COMPUTE
}

DI int xcd_remap(int it) { const int r = it & 255; return (it & ~255) + ((r & 7) << 5) + (r >> 3); }

#define ACC_ZERO(acc)                                                                      \
  _Pragma("unroll") for (int mi_ = 0; mi_ < 2; ++mi_) _Pragma("unroll") for (int ni_ = 0; ni_ < 2; ++ni_) \
      _Pragma("unroll") for (int r_ = 0; r_ < 16; ++r_) acc[mi_][ni_][r_] = 0.f;

#define ACC_FOREACH(acc, m0, n0, BODY)                                                     \
  {                                                                                        \
    const int lane_ = ltid() & 63, w_ = ltid() >> 6;                             \
    const int l32_ = lane_ & 31, hh_ = lane_ >> 5, wm_ = w_ >> 1, wn_ = w_ & 1;            \
    _Pragma("unroll") for (int mi_ = 0; mi_ < 2; ++mi_) _Pragma("unroll") for (int ni_ = 0; ni_ < 2; ++ni_) { \
        __builtin_amdgcn_sched_barrier(0);                                                 \
        _Pragma("unroll") for (int r_ = 0; r_ < 16; ++r_) {                                \
      const int row = (m0) + wm_ * 64 + mi_ * 32 + (r_ & 3) + 8 * (r_ >> 2) + 4 * hh_;     \
      const int col = (n0) + wn_ * 64 + ni_ * 32 + l32_;                                   \
      const float val = acc[mi_][ni_][r_];                                                    \
      BODY                                                                                 \
    } }                                                                                    \
  }

DI void stage_store_bf16(f32x16 (&acc)[2][2], u16* __restrict__ dst, int ld, int m0, int c0, u16* lds) {
  u16* cs = lds;
  ACC_FOREACH(acc, 0, 0, { cs[row * 136 + col] = f2bf(val); });
  __syncthreads();
  const int tid = ltid();
#pragma unroll
  for (int i = 0; i < 8; ++i) {
    const int ch = tid + 512 * i, rr = ch >> 4, c16 = ch & 15;
    const uint4 v = *(const uint4*)(cs + rr * 136 + c16 * 8);
    *(uint4*)(dst + (size_t)(m0 + rr) * ld + c0 + c16 * 8) = v;
  }
  __syncthreads();
}

DI void conv_job(const float* __restrict__ src, int ld, int K, int col0, int nvalid, int npad, u16* __restrict__ dst,
                 int& off, float* ts) {
  const int tid = ltid();
  const int tk = K >> 6, tn = npad >> 6, ntiles = tk * tn;
  const int G = gridDim.x;
  int first = ((int)lbid() - (off % G) + G) % G;
  for (int tile = first; tile < ntiles; tile += G) {
    const int k0 = (tile % tk) * 64, n0 = (tile / tk) * 64;
    {
      const int cc = tid & 63, rg = tid >> 6;
      const bool ok = (n0 + cc) < nvalid;
#pragma unroll
      for (int i = 0; i < 8; ++i) {
        const int rr = rg * 8 + i;
        ts[rr * 65 + cc] = ok ? src[(size_t)(k0 + rr) * ld + col0 + n0 + cc] : 0.f;
      }
    }
    __syncthreads();
    {
      const int kk = tid & 63, ng = tid >> 6;
#pragma unroll
      for (int i = 0; i < 8; ++i) {
        const int nn = ng * 8 + i;
        dst[(size_t)(n0 + nn) * K + k0 + kk] = f2bf(ts[kk * 65 + nn]);
      }
    }
    __syncthreads();
  }
  off += ntiles;
}

DI void phase0(const Params& p, char* ldsc) {
  float* ldsf = (float*)ldsc;
  const int tid = ltid();
  const int G = gridDim.x;
  int off = 0;
  for (int l = 0; l < 4; ++l) {
    u16* wl = (u16*)(p.ws + OFF_W) + (size_t)l * W_LAYER;
    conv_job(p.w_in + (size_t)l * 1024 * NIN, NIN, 1024, 0, 2976, 3072, wl + WO_T1, off, ldsf);
    conv_job(p.w_in + (size_t)l * 1024 * NIN, NIN, 1024, 2976, 3072, 3072, wl + WO_TG, off, ldsf);
    conv_job(p.w_q_b + (size_t)l * 384 * 768, 768, 384, 0, 768, 768, wl + WO_QB, off, ldsf);
    conv_job(p.w_kv_b + (size_t)l * 256 * 1024, 1024, 256, 0, 1024, 1024, wl + WO_KVB, off, ldsf);
    for (int nb = 0; nb < 3; ++nb)
      conv_job(p.w_branch + (size_t)(l * 3 + nb) * 512 * 1024, 1024, 512, 0, 1024, 1024, wl + WO_BR + (size_t)nb * 1024 * 512, off, ldsf);
    conv_job(p.w_out + (size_t)l * 1024 * 1024, 1024, 1024, 0, 1024, 1024, wl + WO_OUT, off, ldsf);
    conv_job(p.w_mlp1 + (size_t)l * 1024 * 4096, 4096, 1024, 0, 4096, 4096, wl + WO_W1, off, ldsf);
    conv_job(p.w_mlp2 + (size_t)l * 4096 * 1024, 1024, 4096, 0, 1024, 1024, wl + WO_W2, off, ldsf);
  }
  {
    float* sc = ldsf;
    float* red = ldsf + 9 * 1024;
    for (int i = tid; i < 9 * 1024; i += 512) {
      float v = (i < 8 * 1024) ? p.c[i] : p.c_ctx[i - 8 * 1024];
      sc[i] = v / (1.0f + expf(-v));
    }
    __syncthreads();
    float* mods = (float*)(p.ws + OFF_MODS);
    const int ol = tid & 63, kg = tid >> 6;
    for (int item = lbid(); item < 384; item += G) {
      const int l = item / 96, o = (item % 96) * 64 + ol;
      const float* wp = p.w_mod + (size_t)l * 1024 * 6144 + o;
      float acc[9];
#pragma unroll
      for (int b = 0; b < 9; ++b) acc[b] = 0.f;
#pragma unroll 4
      for (int k = kg * 128; k < kg * 128 + 128; ++k) {
        const float wv = wp[(size_t)k * 6144];
#pragma unroll
        for (int b = 0; b < 9; ++b) acc[b] += sc[b * 1024 + k] * wv;
      }
#pragma unroll
      for (int b = 0; b < 9; ++b) red[(kg * 9 + b) * 64 + ol] = acc[b];
      __syncthreads();
      for (int i = tid; i < 576; i += 512) {
        const int b = i >> 6, o2 = i & 63;
        float s = 0.f;
#pragma unroll
        for (int g = 0; g < 8; ++g) s += red[(g * 9 + b) * 64 + o2];
        const int oc = (item % 96) * 64 + o2;
        mods[(size_t)(l * 9 + b) * 6144 + oc] = s + p.b_mod[l * 6144 + oc];
      }
      __syncthreads();
    }
  }
  {
    const int gt = lbid() * 512 + tid, GT = G * 512;
    float* rg = (float*)(p.ws + OFF_ROPEG);
    float* rm = (float*)(p.ws + OFF_ROPEM);
    float* tw = (float*)(p.ws + OFF_TW);
    for (int i = gt; i < LSEQ * 32; i += GT) {
      const int t = i >> 5, a = i & 31;
      const float pos = (a < 16) ? (float)(t >> 6) : (float)(t & 63);
      const float inv = powf(10000.0f, -(float)(a & 15) / 16.0f);
      const float ang = pos * inv;
      rg[2 * i] = cosf(ang);
      rg[2 * i + 1] = sinf(ang);
    }
    for (int i = gt; i < LSEQ * 16; i += GT) {
      const int t = i >> 4, a = i & 15;
      const float pos = (a < 8) ? (float)(t >> 6) : (float)(t & 63);
      const float inv = powf(10000.0f, -(float)(a & 7) / 8.0f);
      const float ang = pos * inv;
      rm[2 * i] = cosf(ang);
      rm[2 * i + 1] = sinf(ang);
    }
    for (int i = gt; i < FFTN; i += GT) {
      float sn, cs;
      sincospif(2.0f * (float)i / (float)FFTN, &sn, &cs);
      tw[2 * i] = cs;
      tw[2 * i + 1] = -sn;
    }
  }
}

DI void phase_rownorm(const Params& p, int l, int which, int nrows) {
  const int tid = ltid(), lane = tid & 63, w = tid >> 6;
  u16* hn = (u16*)(p.ws + OFF_A);
  const float* g = (which ? p.norm_mlp_g : p.norm_mix_g) + l * 1024;
  const bool first = (which == 0 && l == 0);
  const float* xs = first ? p.x : p.out;
  const float* cs = first ? p.ctx : (const float*)(p.ws + OFF_CTX);
  for (int r = lbid() * 8 + w; r < nrows; r += gridDim.x * 8) {
    const float* src = (r < ML) ? xs + (size_t)r * 1024 : cs + (size_t)(r - ML) * 1024;
    const int mrow = (r < ML) ? (r >> 13) : 8;
    const float* shift = mods_ptr(p, l, mrow, which ? 3 : 0);
    const float* scale = mods_ptr(p, l, mrow, which ? 4 : 1);
    float4 v[4];
    float ss = 0.f;
#pragma unroll
    for (int i = 0; i < 4; ++i) {
      v[i] = *(const float4*)(src + 4 * (lane + 64 * i));
      ss += v[i].x * v[i].x + v[i].y * v[i].y + v[i].z * v[i].z + v[i].w * v[i].w;
    }
    ss = wave_sum(ss);
    const float rstd = rsqrtf(ss * (1.0f / 1024.0f) + EPSV);
#pragma unroll
    for (int i = 0; i < 4; ++i) {
      const int c0 = 4 * (lane + 64 * i);
      const float4 gg = *(const float4*)(g + c0), sh = *(const float4*)(shift + c0), sc = *(const float4*)(scale + c0);
      const float o0 = v[i].x * rstd * gg.x * (1.f + sc.x) + sh.x;
      const float o1 = v[i].y * rstd * gg.y * (1.f + sc.y) + sh.y;
      const float o2 = v[i].z * rstd * gg.z * (1.f + sc.z) + sh.z;
      const float o3 = v[i].w * rstd * gg.w * (1.f + sc.w) + sh.w;
      uint2 pk;
      pk.x = pk2(o0, o1);
      pk.y = pk2(o2, o3);
      *(uint2*)(hn + (size_t)r * 1024 + c0) = pk;
    }
  }
}

DI void filter_tiles(const Params& p, int l, int Lf, int cstride, float* __restrict__ kdst, float* __restrict__ part, float* lds) {
  const int tid = ltid(), lane = tid & 63, w = tid >> 6;
  float* zs = lds;
  float* h1s = lds + 64 * 33;
  float* h2s = h1s + 64 * 65;
  const float* f1w = p.hy_f1_w + l * 33 * 64;
  const float* f1b = p.hy_f1_b + l * 64;
  const float* f2w = p.hy_f2_w + l * 64 * 64;
  const float* f2b = p.hy_f2_b + l * 64;
  const float* sf = p.hy_sin_freq + l * 128;
  const float* f3w = p.hy_f3_w + (size_t)l * 64 * 1024;
  const int ntile = Lf >> 6;
  const float min_decay = logf(1e-2f) / 1.5f, max_decay = logf(1e-2f) / 0.3f;
  for (int tile = lbid(); tile < ntile; tile += gridDim.x) {
    const int t0 = tile * 64;
    for (int idx = tid; idx < 64 * 33; idx += 512) {
      const int tt = idx / 33, e = idx - tt * 33;
      const int t = t0 + tt;
      float val;
      if (e == 0) {
        val = (float)t / (float)(Lf - 1);
      } else {
        const float wt = 6.283185307179586f * (float)t / (float)Lf;
        const int bi = (e - 1) & 15;
        const float f = 1e-4f + (float)bi * ((15.0f - 1e-4f) / 15.0f);
        val = (e <= 16) ? cosf(f * wt) : -sinf(f * wt);
      }
      zs[idx] = val;
    }
    __syncthreads();
    {
      const int tt = tid & 63, jg = tid >> 6;
#pragma unroll 1
      for (int jj = 0; jj < 8; ++jj) {
        const int j = jg * 8 + jj;
        float a = f1b[j];
#pragma unroll 3
        for (int e = 0; e < 33; ++e) a += zs[tt * 33 + e] * f1w[e * 64 + j];
        h1s[tt * 65 + j] = sinf(sf[j] * a);
      }
    }
    __syncthreads();
    {
      const int tt = tid & 63, jg = tid >> 6;
#pragma unroll 1
      for (int jj = 0; jj < 8; ++jj) {
        const int j = jg * 8 + jj;
        float a = f2b[j];
#pragma unroll 4
        for (int e = 0; e < 64; ++e) a += h1s[tt * 65 + e] * f2w[e * 64 + j];
        h2s[tt * 65 + j] = sinf(sf[64 + j] * a);
      }
    }
    __syncthreads();
    {
      const int tt = lane, t = t0 + tt;
      const float tn = (float)t / (float)(Lf - 1);
      const int wu = __builtin_amdgcn_readfirstlane(w);
#pragma unroll 1
      for (int ob = wu * 128; ob < wu * 128 + 128; ob += 16) {
        float acc[16];
#pragma unroll
        for (int q = 0; q < 16; ++q) acc[q] = 0.f;
#pragma unroll 2
        for (int i = 0; i < 64; ++i) {
          const float hv = h2s[tt * 65 + i];
          const float* wr = f3w + i * 1024 + ob;
#pragma unroll
          for (int q = 0; q < 16; ++q) acc[q] += hv * wr[q];
        }
#pragma unroll
        for (int q = 0; q < 16; ++q) {
          const int o = ob + q, dir = o >> 9, c = o & 511;
          const float delta = fabsf(min_decay + (float)c * ((max_decay - min_decay) / 511.0f));
          float val = acc[q] * expf(-tn * delta);
          int pos;
          if (dir == 0) pos = t;
          else if (t == 0) { pos = Lf; val = 0.f; }
          else pos = 2 * Lf - t;
          kdst[(size_t)c * cstride + pos] = val;
          const float s2 = wave_sum(val * val);
          if (lane == 0) part[tile * 1024 + o] = s2;
        }
      }
    }
    __syncthreads();
  }
}

DI int fsw(int i) { return (i & ~15) | ((((i >> 2) + (i >> 6)) & 3) << 2) | (i & 3); }

DI void r16_fwd(float (&xr)[16], float (&xi)[16]) {
#pragma unroll
  for (int st = 0; st < 2; ++st) {
    const int q = (st == 0) ? 4 : 1;
#pragma unroll
    for (int bi = 0; bi < 4; ++bi) {
      const int j = bi & (q - 1), g = bi / q;
      const int i0 = g * 4 * q + j, i1 = i0 + q, i2 = i1 + q, i3 = i2 + q;
      const float ar = xr[i0], ai = xi[i0], br = xr[i1], bi_ = xi[i1], cr = xr[i2], ci = xi[i2], dr = xr[i3], di = xi[i3];
      const float t0r = ar + cr, t0i = ai + ci, t1r = ar - cr, t1i = ai - ci;
      const float t2r = br + dr, t2i = bi_ + di;
      const float er = br - dr, ei = bi_ - di;
      const float t3r = ei, t3i = -er;
      const float y1r = t1r + t3r, y1i = t1i + t3i, y2r = t0r - t2r, y2i = t0i - t2i, y3r = t1r - t3r, y3i = t1i - t3i;
      xr[i0] = t0r + t2r; xi[i0] = t0i + t2i;
      if (q == 1 || j == 0) {
        xr[i1] = y1r; xi[i1] = y1i; xr[i2] = y2r; xi[i2] = y2i; xr[i3] = y3r; xi[i3] = y3i;
      } else {
        const float ang = -6.283185307179586f * (float)j / (float)(4 * q);
        const float w1r = __builtin_cosf(ang), w1i = __builtin_sinf(ang);
        const float w2r = __builtin_cosf(2.f * ang), w2i = __builtin_sinf(2.f * ang);
        const float w3r = __builtin_cosf(3.f * ang), w3i = __builtin_sinf(3.f * ang);
        xr[i1] = y1r * w1r - y1i * w1i; xi[i1] = y1r * w1i + y1i * w1r;
        xr[i2] = y2r * w2r - y2i * w2i; xi[i2] = y2r * w2i + y2i * w2r;
        xr[i3] = y3r * w3r - y3i * w3i; xi[i3] = y3r * w3i + y3i * w3r;
      }
    }
  }
}
DI void r16_inv(float (&xr)[16], float (&xi)[16]) {
#pragma unroll
  for (int st = 0; st < 2; ++st) {
    const int q = (st == 0) ? 1 : 4;
#pragma unroll
    for (int bi = 0; bi < 4; ++bi) {
      const int j = bi & (q - 1), g = bi / q;
      const int i0 = g * 4 * q + j, i1 = i0 + q, i2 = i1 + q, i3 = i2 + q;
      const float ar = xr[i0], ai = xi[i0];
      float br = xr[i1], bi_ = xi[i1], cr = xr[i2], ci = xi[i2], dr = xr[i3], di = xi[i3];
      if (!(q == 1 || j == 0)) {
        const float ang = 6.283185307179586f * (float)j / (float)(4 * q);
        const float w1r = __builtin_cosf(ang), w1i = __builtin_sinf(ang);
        const float w2r = __builtin_cosf(2.f * ang), w2i = __builtin_sinf(2.f * ang);
        const float w3r = __builtin_cosf(3.f * ang), w3i = __builtin_sinf(3.f * ang);
        const float b0 = br, c0 = cr, d0 = dr;
        br = b0 * w1r - bi_ * w1i; bi_ = b0 * w1i + bi_ * w1r;
        cr = c0 * w2r - ci * w2i;  ci = c0 * w2i + ci * w2r;
        dr = d0 * w3r - di * w3i;  di = d0 * w3i + di * w3r;
      }
      const float t0r = ar + cr, t0i = ai + ci, t1r = ar - cr, t1i = ai - ci;
      const float t2r = br + dr, t2i = bi_ + di;
      const float er = br - dr, ei = bi_ - di;
      const float t3r = -ei, t3i = er;
      xr[i0] = t0r + t2r; xi[i0] = t0i + t2i;
      xr[i1] = t1r + t3r; xi[i1] = t1i + t3i;
      xr[i2] = t0r - t2r; xi[i2] = t0i - t2i;
      xr[i3] = t1r - t3r; xi[i3] = t1i - t3i;
    }
  }
}

template <bool INV>
DI void fft_lds_stage(float* re, float* im, const float2* __restrict__ tw, const int s) {
  const int tid = ltid();
  const int qs = 12 - 2 * s;
  const int q = 1 << qs;
  float2 wb = tw[(tid & (q - 1)) << (2 * s)];
  if (INV) wb.y = -wb.y;
  float vr[8][4], vi[8][4];
  int idx[8][4];
#pragma unroll
  for (int k = 0; k < 8; ++k) {
    const int bi = tid + 512 * k;
    const int j = bi & (q - 1), g = bi >> qs;
    const int l0 = (g << (qs + 2)) + j;
#pragma unroll
    for (int m = 0; m < 4; ++m) { idx[k][m] = fsw(l0 + m * q); vr[k][m] = re[idx[k][m]]; vi[k][m] = im[idx[k][m]]; }
  }
#pragma unroll
  for (int k = 0; k < 8; ++k) {
    const int delta = (512 * k) & (q - 1);
    const float ang = (INV ? 6.283185307179586f : -6.283185307179586f) * (float)(delta << (2 * s)) / 16384.0f;
    const float cr_ = __builtin_cosf(ang), ci_ = __builtin_sinf(ang);
    const float w1r = (delta == 0) ? wb.x : wb.x * cr_ - wb.y * ci_;
    const float w1i = (delta == 0) ? wb.y : wb.x * ci_ + wb.y * cr_;
    const float w2r = w1r * w1r - w1i * w1i, w2i = 2.f * w1r * w1i;
    const float w3r = w2r * w1r - w2i * w1i, w3i = w2r * w1i + w2i * w1r;
    if (!INV) {
      const float ar = vr[k][0], ai = vi[k][0], br = vr[k][1], bi_ = vi[k][1], cr = vr[k][2], ci = vi[k][2], dr = vr[k][3], di = vi[k][3];
      const float t0r = ar + cr, t0i = ai + ci, t1r = ar - cr, t1i = ai - ci;
      const float t2r = br + dr, t2i = bi_ + di;
      const float er = br - dr, ei = bi_ - di;
      const float t3r = ei, t3i = -er;
      const float y1r = t1r + t3r, y1i = t1i + t3i, y2r = t0r - t2r, y2i = t0i - t2i, y3r = t1r - t3r, y3i = t1i - t3i;
      re[idx[k][0]] = t0r + t2r; im[idx[k][0]] = t0i + t2i;
      re[idx[k][1]] = y1r * w1r - y1i * w1i; im[idx[k][1]] = y1r * w1i + y1i * w1r;
      re[idx[k][2]] = y2r * w2r - y2i * w2i; im[idx[k][2]] = y2r * w2i + y2i * w2r;
      re[idx[k][3]] = y3r * w3r - y3i * w3i; im[idx[k][3]] = y3r * w3i + y3i * w3r;
    } else {
      const float ar = vr[k][0], ai = vi[k][0];
      const float br = vr[k][1] * w1r - vi[k][1] * w1i, bi_ = vr[k][1] * w1i + vi[k][1] * w1r;
      const float cr = vr[k][2] * w2r - vi[k][2] * w2i, ci = vr[k][2] * w2i + vi[k][2] * w2r;
      const float dr = vr[k][3] * w3r - vi[k][3] * w3i, di = vr[k][3] * w3i + vi[k][3] * w3r;
      const float t0r = ar + cr, t0i = ai + ci, t1r = ar - cr, t1i = ai - ci;
      const float t2r = br + dr, t2i = bi_ + di;
      const float er = br - dr, ei = bi_ - di;
      const float t3r = -ei, t3i = er;
      re[idx[k][0]] = t0r + t2r; im[idx[k][0]] = t0i + t2i;
      re[idx[k][1]] = t1r + t3r; im[idx[k][1]] = t1i + t3i;
      re[idx[k][2]] = t0r - t2r; im[idx[k][2]] = t0i - t2i;
      re[idx[k][3]] = t1r - t3r; im[idx[k][3]] = t1i - t3i;
    }
  }
  __syncthreads();
}
DI void fft_fwd4(float* re, float* im, const float2* __restrict__ tw) {
  fft_lds_stage<false>(re, im, tw, 0);
  fft_lds_stage<false>(re, im, tw, 1);
  fft_lds_stage<false>(re, im, tw, 2);
  fft_lds_stage<false>(re, im, tw, 3);
  fft_lds_stage<false>(re, im, tw, 4);
}
DI void fft_inv4(float* re, float* im, const float2* __restrict__ tw) {
  fft_lds_stage<true>(re, im, tw, 4);
  fft_lds_stage<true>(re, im, tw, 3);
  fft_lds_stage<true>(re, im, tw, 2);
  fft_lds_stage<true>(re, im, tw, 1);
  fft_lds_stage<true>(re, im, tw, 0);
}
DI void r16_load(const float* re, const float* im, int b, float (&xr)[16], float (&xi)[16]) {
#pragma unroll
  for (int c = 0; c < 4; ++c) {
    const int ph = 16 * b + 4 * ((c + (b >> 2)) & 3);
    const float4 vr = *(const float4*)(re + ph), vi = *(const float4*)(im + ph);
    xr[4 * c] = vr.x; xr[4 * c + 1] = vr.y; xr[4 * c + 2] = vr.z; xr[4 * c + 3] = vr.w;
    xi[4 * c] = vi.x; xi[4 * c + 1] = vi.y; xi[4 * c + 2] = vi.z; xi[4 * c + 3] = vi.w;
  }
}
DI void r16_store(float* re, float* im, int b, const float (&xr)[16], const float (&xi)[16]) {
#pragma unroll
  for (int c = 0; c < 4; ++c) {
    const int ph = 16 * b + 4 * ((c + (b >> 2)) & 3);
    *(float4*)(re + ph) = make_float4(xr[4 * c], xr[4 * c + 1], xr[4 * c + 2], xr[4 * c + 3]);
    *(float4*)(im + ph) = make_float4(xi[4 * c], xi[4 * c + 1], xi[4 * c + 2], xi[4 * c + 3]);
  }
}

DI void phase_filter_fft(const Params& p, int l, float* lds) {
  const int tid = ltid();
  float* re = lds;
  float* im = lds + FFTN;
  float* kf = (float*)(p.ws + OFF_KF);
  const float2* tw = (const float2*)(p.ws + OFF_TW);
  const float* part = (const float*)(p.ws + OFF_PART);
  for (int c = lbid(); c < 512; c += gridDim.x) {
    float* slot = kf + (size_t)c * (2 * FFTN);
    float pv = 0.f;
    if (tid < 128) pv = part[tid * 1024 + c] + part[tid * 1024 + 512 + c];
    pv = wave_sum(pv);
    if ((tid & 63) == 0) lds[tid >> 6] = pv;
    __syncthreads();
    const float ssq = lds[0] + lds[1];
    __syncthreads();
    const float sc = rsqrtf(ssq + EPSV) * (1.0f / (float)FFTN);
    for (int i = tid; i < FFTN; i += 512) { const int ph = fsw(i); re[ph] = slot[i] * sc; im[ph] = 0.f; }
    __syncthreads();
    fft_fwd4(re, im, tw);
    {
      float2* so = (float2*)slot;
#pragma unroll 1
      for (int b = tid; b < 1024; b += 512) {
        float xr[16], xi[16];
        r16_load(re, im, b, xr, xi);
        r16_fwd(xr, xi);
#pragma unroll
        for (int e = 0; e < 16; ++e) { float2 v; v.x = xr[e]; v.y = xi[e]; so[e * 1024 + b] = v; }
      }
    }
    __syncthreads();
  }
}

DI void phase_gemm1(const Params& p, int l, u16* lds) {
  const u16* hn = (const u16*)(p.ws + OFF_A);
  const u16* wt = (const u16*)(p.ws + OFF_W) + (size_t)l * W_LAYER + WO_T1;
  const int NT = 24, nitems = (MALL / 256) * NT;
  for (int it_ = lbid(); it_ < ((nitems + 255) & ~255); it_ += gridDim.x) {
    const int item = xcd_remap(it_);
    if (item >= nitems) continue;
    const int mt = item / NT, nt = item % NT;
    const int m0 = mt * 256, n0 = nt * 128;
    f32x16 acc[2][2];
    ACC_ZERO(acc);
    gemm_mainloop(hn + (size_t)m0 * 1024, 1024, wt + (size_t)n0 * 1024, 1024, 1024, acc, lds);
    u16* dst; int ld, cofs;
    if (nt < 4) { dst = (u16*)(p.ws + OFF_B); ld = 512; cofs = 0; }
    else if (nt < 12) { dst = (u16*)(p.ws + OFF_C); ld = 1024; cofs = 512; }
    else { dst = (u16*)(p.ws + OFF_R); ld = 1536; cofs = 1536; }
    stage_store_bf16(acc, dst, ld, m0, n0 - cofs, lds);
  }
}

DI void phase_h1(const Params& p, int l, float* lds) {
  const int tid = ltid();
  const u16* U12 = (const u16*)(p.ws + OFF_C);
  float* zT = (float*)(p.ws + OFF_A);
  const float* sw = p.hy_short_w + l * 3 * 1536;
  float* xs = lds;
  float* vs = lds + 66 * 65;
  const int nlat = 8 * 128 * 8, nctx = (l < 3) ? 8 * 4 * 8 : 0;
  for (int item = lbid(); item < nlat + nctx; item += gridDim.x) {
    int b, tt0, c0, Ls, rowbase; size_t zbase;
    if (item < nlat) { b = item >> 10; tt0 = ((item >> 3) & 127) * 64; c0 = (item & 7) * 64; Ls = LSEQ; rowbase = b * LSEQ; zbase = (size_t)b * 512 * LSEQ; }
    else { const int it = item - nlat; b = it >> 5; tt0 = ((it >> 3) & 3) * 64; c0 = (it & 7) * 64; Ls = LCTX; rowbase = ML + b * LCTX; zbase = (size_t)ZC_OFF + (size_t)b * 512 * LCTX; }
    for (int ch = tid; ch < 66 * 16; ch += 512) {
      const int arr = ch / 528, rem = ch - arr * 528;
      const int rr = rem >> 3, cc8 = (rem & 7) * 8;
      const int t = tt0 - 1 + rr;
      float* dstp = (arr ? vs : xs) + rr * 65 + cc8;
      if (t >= 0 && t < Ls) {
        const uint4 v = *(const uint4*)(U12 + (size_t)(rowbase + t) * 1024 + arr * 512 + c0 + cc8);
        const unsigned uu[4] = {v.x, v.y, v.z, v.w};
#pragma unroll
        for (int i = 0; i < 4; ++i) { dstp[2 * i] = __uint_as_float(uu[i] << 16); dstp[2 * i + 1] = __uint_as_float(uu[i] & 0xffff0000u); }
      } else {
#pragma unroll
        for (int i = 0; i < 8; ++i) dstp[i] = 0.f;
      }
    }
    __syncthreads();
    {
      const int tt = tid & 63, cgp = tid >> 6;
#pragma unroll
      for (int i = 0; i < 8; ++i) {
        const int cc = cgp * 8 + i, c = c0 + cc;
        float x1 = 0.f, vv = 0.f;
#pragma unroll
        for (int j = 0; j < 3; ++j) {
          x1 += sw[j * 1536 + 512 + c] * xs[(tt + j) * 65 + cc];
          vv += sw[j * 1536 + 1024 + c] * vs[(tt + j) * 65 + cc];
        }
        zT[zbase + (size_t)c * Ls + tt0 + tt] = x1 * vv;
      }
    }
    __syncthreads();
  }
}

DI void phase_p3(const Params& p, int l, float* lds) {
  const int tid = ltid(), lane = tid & 63, w = tid >> 6;
  u16* R = (u16*)(p.ws + OFF_R);
  float* rb = lds + w * 1472;
  float* hs = rb + 1440;
  const float* qn = p.gqa_q_norm + l * 64;
  const float* kn = p.gqa_k_norm + l * 64;
  const float* qan = p.mla_q_a_norm + l * 384;
  const float* kvan = p.mla_kv_a_norm + l * 256;
  const float* ropeg = (const float*)(p.ws + OFF_ROPEG);
  const float qscale = 0.125f * LOG2E;
  for (int r0 = lbid() * 8; r0 < MALL; r0 += gridDim.x * 8) {
    const int r = r0 + w;
    u16* rowp = R + (size_t)r * 1536;
    for (int ch = lane; ch < 180; ch += 64) {
      const uint4 v = *(const uint4*)(rowp + ch * 8);
      const unsigned uu[4] = {v.x, v.y, v.z, v.w};
#pragma unroll
      for (int i = 0; i < 4; ++i) { rb[ch * 8 + 2 * i] = __uint_as_float(uu[i] << 16); rb[ch * 8 + 2 * i + 1] = __uint_as_float(uu[i] & 0xffff0000u); }
    }
    __syncthreads();
    {
      float s = 0.f;
#pragma unroll
      for (int i = 0; i < 8; ++i) { const float v = rb[lane * 8 + i]; s += v * v; }
      s += __shfl_xor(s, 1); s += __shfl_xor(s, 2); s += __shfl_xor(s, 4);
      if ((lane & 7) == 0) hs[lane >> 3] = rsqrtf(s * (1.0f / 64.0f) + EPSV);
      float s2 = 0.f;
      if (lane < 16) {
#pragma unroll
        for (int i = 0; i < 8; ++i) { const float v = rb[512 + lane * 8 + i]; s2 += v * v; }
      }
      s2 += __shfl_xor(s2, 1); s2 += __shfl_xor(s2, 2); s2 += __shfl_xor(s2, 4);
      if (lane < 16 && (lane & 7) == 0) hs[8 + (lane >> 3)] = rsqrtf(s2 * (1.0f / 64.0f) + EPSV);
      float s3 = 0.f, s4 = 0.f;
#pragma unroll
      for (int i = 0; i < 6; ++i) { const float v = rb[768 + lane * 6 + i]; s3 += v * v; }
#pragma unroll
      for (int i = 0; i < 4; ++i) { const float v = rb[1152 + lane * 4 + i]; s4 += v * v; }
      s3 = wave_sum(s3); s4 = wave_sum(s4);
      if (lane == 0) { hs[10] = rsqrtf(s3 * (1.0f / 384.0f) + EPSV); hs[11] = rsqrtf(s4 * (1.0f / 256.0f) + EPSV); }
    }
    __syncthreads();
    {
      const bool lat = r < ML;
      const int t = r & (LSEQ - 1);
      const int d = lane, a = d & 31;
      float cs = 1.f, sn = 0.f;
      if (lat) { cs = ropeg[(t * 32 + a) * 2]; sn = ropeg[(t * 32 + a) * 2 + 1]; }
#pragma unroll
      for (int hd = 0; hd < 10; ++hd) {
        const float* gq = (hd < 8) ? qn : kn;
        const float rs = hs[hd];
        const float v = rb[hd * 64 + d] * rs * gq[d];
        const int dp = d ^ 32;
        const float vp = rb[hd * 64 + dp] * rs * gq[dp];
        float o = (d < 32) ? (v * cs - vp * sn) : (vp * sn + v * cs);
        if (hd < 8) o *= qscale;
        rowp[hd * 64 + d] = f2bf(o);
      }
#pragma unroll
      for (int i = 0; i < 6; ++i) { const int e = lane + 64 * i; rowp[768 + e] = f2bf(rb[768 + e] * hs[10] * qan[e]); }
#pragma unroll
      for (int i = 0; i < 4; ++i) { const int e = lane + 64 * i; rowp[1152 + e] = f2bf(rb[1152 + e] * hs[11] * kvan[e]); }
    }
    __syncthreads();
  }
}

DI void phase_h2(const Params& p, int l, float* lds) {
  const int tid = ltid(), lane = tid & 63, w = tid >> 6;
  float* zT = (float*)(p.ws + OFF_A);
  const float2* kf = (const float2*)(p.ws + OFF_KF);
  const float2* tw = (const float2*)(p.ws + OFF_TW);
  const float* skip = p.hy_skip + l * 512;
  float* re = lds;
  float* im = lds + FFTN;
  for (int item = lbid(); item < 2048; item += gridDim.x) {
    const int c = item >> 2, bp = item & 3;
    float* z1 = zT + ((size_t)(2 * bp) * 512 + c) * LSEQ;
    float* z2 = zT + ((size_t)(2 * bp + 1) * 512 + c) * LSEQ;
    for (int i = tid; i < LSEQ; i += 512) {
      const int p0 = fsw(i), p1 = fsw(i + LSEQ);
      re[p0] = z1[i]; im[p0] = z2[i]; re[p1] = 0.f; im[p1] = 0.f;
    }
    __syncthreads();
    fft_fwd4(re, im, tw);
    {
      const float2* kc = kf + (size_t)c * FFTN;
#pragma unroll 1
      for (int b = tid; b < 1024; b += 512) {
        float xr[16], xi[16];
        r16_load(re, im, b, xr, xi);
        r16_fwd(xr, xi);
#pragma unroll
        for (int e = 0; e < 16; ++e) {
          const float2 k = kc[e * 1024 + b];
          const float a = xr[e], b2 = xi[e];
          xr[e] = a * k.x - b2 * k.y;
          xi[e] = a * k.y + b2 * k.x;
        }
        r16_inv(xr, xi);
        r16_store(re, im, b, xr, xi);
      }
    }
    __syncthreads();
    fft_inv4(re, im, tw);
    const float sk = skip[c];
    for (int i = tid; i < LSEQ; i += 512) {
      const int p0 = fsw(i);
      const float a = z1[i], b = z2[i];
      z1[i] = re[p0] + a * sk;
      z2[i] = im[p0] + b * sk;
    }
    __syncthreads();
  }
  if (l < 3) {
    const float* kcb = (const float*)(p.ws + OFF_KC);
    const float* partc = (const float*)(p.ws + OFF_PART) + 128 * 1024;
    float* zs = lds + w * 768;
    float* ks = zs + 256;
    for (int item = lbid(); item < 512; item += gridDim.x) {
      const int b = item >> 6, c = (item & 63) * 8 + w;
      float* z = zT + (size_t)ZC_OFF + ((size_t)b * 512 + c) * LCTX;
      float pv = (lane < 4) ? partc[lane * 1024 + c] + partc[lane * 1024 + 512 + c] : 0.f;
      pv = wave_sum(pv);
      const float sc = rsqrtf(pv + EPSV);
      for (int i = lane; i < 256; i += 64) zs[i] = z[i];
      for (int i = lane; i < 512; i += 64) ks[i] = kcb[c * 512 + i] * sc;
      __syncthreads();
      const float sk = skip[c];
      float acc[4] = {0.f, 0.f, 0.f, 0.f};
      for (int s = 0; s < 256; ++s) {
        const float zv = zs[s];
#pragma unroll
        for (int i = 0; i < 4; ++i) acc[i] += ks[(lane + 64 * i - s) & 511] * zv;
      }
#pragma unroll
      for (int i = 0; i < 4; ++i) z[lane + 64 * i] = acc[i] + zs[lane + 64 * i] * sk;
      __syncthreads();
    }
  }
}

DI void phase_h3(const Params& p, int l, float* lds) {
  const int tid = ltid();
  const u16* U0 = (const u16*)(p.ws + OFF_B);
  const float* zT = (const float*)(p.ws + OFF_A);
  u16* Y = (u16*)(p.ws + OFF_Y);
  const float* sw = p.hy_short_w + l * 3 * 1536;
  float* xs = lds;
  float* ys = lds + 66 * 65;
  const int nlat = 8 * 128 * 8, nctx = (l < 3) ? 8 * 4 * 8 : 0;
  for (int item = lbid(); item < nlat + nctx; item += gridDim.x) {
    int b, tt0, c0, Ls, rowbase; size_t zbase;
    if (item < nlat) { b = item >> 10; tt0 = ((item >> 3) & 127) * 64; c0 = (item & 7) * 64; Ls = LSEQ; rowbase = b * LSEQ; zbase = (size_t)b * 512 * LSEQ; }
    else { const int it = item - nlat; b = it >> 5; tt0 = ((it >> 3) & 3) * 64; c0 = (it & 7) * 64; Ls = LCTX; rowbase = ML + b * LCTX; zbase = (size_t)ZC_OFF + (size_t)b * 512 * LCTX; }
    for (int ch = tid; ch < 66 * 8; ch += 512) {
      const int rr = ch >> 3, cc8 = (ch & 7) * 8;
      const int t = tt0 - 1 + rr;
      float* dstp = xs + rr * 65 + cc8;
      if (t >= 0 && t < Ls) {
        const uint4 v = *(const uint4*)(U0 + (size_t)(rowbase + t) * 512 + c0 + cc8);
        const unsigned uu[4] = {v.x, v.y, v.z, v.w};
#pragma unroll
        for (int i = 0; i < 4; ++i) { dstp[2 * i] = __uint_as_float(uu[i] << 16); dstp[2 * i + 1] = __uint_as_float(uu[i] & 0xffff0000u); }
      } else {
#pragma unroll
        for (int i = 0; i < 8; ++i) dstp[i] = 0.f;
      }
    }
    {
      const int tt = tid & 63, cgp = tid >> 6;
#pragma unroll
      for (int i = 0; i < 8; ++i) {
        const int cc = cgp * 8 + i;
        ys[cc * 65 + tt] = zT[zbase + (size_t)(c0 + cc) * Ls + tt0 + tt];
      }
    }
    __syncthreads();
    {
      const int cc = tid & 63, tg = tid >> 6, c = c0 + cc;
      const float w0 = sw[c], w1 = sw[1536 + c], w2 = sw[2 * 1536 + c];
#pragma unroll
      for (int i = 0; i < 8; ++i) {
        const int tt = tg * 8 + i;
        const float x0 = w0 * xs[tt * 65 + cc] + w1 * xs[(tt + 1) * 65 + cc] + w2 * xs[(tt + 2) * 65 + cc];
        Y[(size_t)(rowbase + tt0 + tt) * 1536 + c] = f2bf(x0 * ys[cc * 65 + tt]);
      }
    }
    __syncthreads();
  }
}

DI void phase_p4(const Params& p, int l, u16* lds) {
  const u16* R = (const u16*)(p.ws + OFF_R);
  u16* QK = (u16*)(p.ws + OFF_A);
  const u16* wl = (const u16*)(p.ws + OFF_W) + (size_t)l * W_LAYER;
  const int NT = 14, nitems = (MALL / 256) * NT;
  for (int it_ = lbid(); it_ < ((nitems + 255) & ~255); it_ += gridDim.x) {
    const int item = xcd_remap(it_);
    if (item >= nitems) continue;
    const int mt = item / NT, nt = item % NT;
    const int m0 = mt * 256;
    f32x16 acc[2][2];
    ACC_ZERO(acc);
    int n0;
    if (nt < 6) { n0 = nt * 128; gemm_mainloop(R + (size_t)m0 * 1536 + 768, 1536, wl + WO_QB + (size_t)n0 * 384, 384, 384, acc, lds); }
    else { n0 = (nt - 6) * 128; gemm_mainloop(R + (size_t)m0 * 1536 + 1152, 1536, wl + WO_KVB + (size_t)n0 * 256, 256, 256, acc, lds); n0 += 768; }
    stage_store_bf16(acc, QK, 1792, m0, n0, lds);
  }
}

DI void phase_p5(const Params& p, int l, float* lds) {
  const int tid = ltid(), lane = tid & 63, w = tid >> 6;
  u16* QK = (u16*)(p.ws + OFF_A);
  u16* KM = (u16*)(p.ws + OFF_KM);
  const u16* R = (const u16*)(p.ws + OFF_R);
  float* rb = lds + w * 1856;
  float* hs = rb + 1824;
  const float* qn = p.mla_q_norm + l * 96;
  const float* kn = p.mla_k_norm + l * 96;
  const float* ropem = (const float*)(p.ws + OFF_ROPEM);
  const float qscale = 0.10206207261596575f * LOG2E;
  for (int r0 = lbid() * 8; r0 < MALL; r0 += gridDim.x * 8) {
    const int r = r0 + w;
    u16* rowp = QK + (size_t)r * 1792;
    for (int ch = lane; ch < 228; ch += 64) {
      const uint4 v = (ch < 224) ? *(const uint4*)(rowp + ch * 8) : *(const uint4*)(R + (size_t)r * 1536 + 1408 + (ch - 224) * 8);
      const unsigned uu[4] = {v.x, v.y, v.z, v.w};
#pragma unroll
      for (int i = 0; i < 4; ++i) { rb[ch * 8 + 2 * i] = __uint_as_float(uu[i] << 16); rb[ch * 8 + 2 * i + 1] = __uint_as_float(uu[i] & 0xffff0000u); }
    }
    __syncthreads();
    {
      const int hd = lane >> 3, j = lane & 7;
      float s = 0.f, s2 = 0.f;
#pragma unroll
      for (int i = 0; i < 12; ++i) {
        const int d = j * 12 + i;
        const float v = rb[hd * 96 + d];
        s += v * v;
        const float kv = (d < 64) ? rb[768 + hd * 128 + d] : rb[1792 + d - 64];
        s2 += kv * kv;
      }
      s += __shfl_xor(s, 1); s += __shfl_xor(s, 2); s += __shfl_xor(s, 4);
      s2 += __shfl_xor(s2, 1); s2 += __shfl_xor(s2, 2); s2 += __shfl_xor(s2, 4);
      if (j == 0) { hs[hd] = rsqrtf(s * (1.0f / 96.0f) + EPSV); hs[8 + hd] = rsqrtf(s2 * (1.0f / 96.0f) + EPSV); }
    }
    __syncthreads();
    {
      const bool lat = r < ML;
      const int t = r & (LSEQ - 1);
#pragma unroll
      for (int i = 0; i < 12; ++i) {
        const int e = lane + 64 * i;
        const int hd = e / 96, d = e - hd * 96;
        const float rq = hs[hd], rk = hs[8 + hd];
        float qv = rb[hd * 96 + d] * rq * qn[d];
        float kv = ((d < 64) ? rb[768 + hd * 128 + d] : rb[1792 + d - 64]) * rk * kn[d];
        if (d >= 64 && lat) {
          const int a = (d - 64) & 15;
          const float cs = ropem[(t * 16 + a) * 2], sn = ropem[(t * 16 + a) * 2 + 1];
          const int dp = (d < 80) ? d + 16 : d - 16;
          const float qp = rb[hd * 96 + dp] * rq * qn[dp];
          const float kp = rb[1792 + dp - 64] * rk * kn[dp];
          if (d < 80) { qv = qv * cs - qp * sn; kv = kv * cs - kp * sn; }
          else { qv = qp * sn + qv * cs; kv = kp * sn + kv * cs; }
        }
        rowp[e] = f2bf(qv * qscale);
        KM[(size_t)r * 768 + e] = f2bf(kv);
      }
    }
    __syncthreads();
  }
}

template <int DQK>
DI void attn_block(const u16* __restrict__ Qp, int q_ld, const u16* __restrict__ Kp, int k_ld, const u16* __restrict__ Vp,
                   int v_ld, u16* __restrict__ Op, int o_ld, int qrow0, int qt0, int s0_row0, int s0_n, int s0_t0,
                   int masked0, int s1_row0, int s1_n, float sink_l2, int has_sink, u16* lds) {
  constexpr int KS = DQK + 8, NS = DQK / 16, CPK = DQK / 8;
  const int tid = ltid(), lane = tid & 63, w = tid >> 6, l32 = lane & 31, hh = lane >> 5;
  u16* Ks = lds;
  u16* Vt = lds + 2 * 64 * KS;
  const int qrow = qrow0 + 32 * w + l32;
  bf16x8 qf[NS];
#pragma unroll
  for (int s = 0; s < NS; ++s) qf[s] = *(const bf16x8*)(Qp + (size_t)qrow * q_ld + 16 * s + 8 * hh);
  f32x16 ot[2];
#pragma unroll
  for (int i = 0; i < 16; ++i) { ot[0][i] = 0.f; ot[1][i] = 0.f; }
  float m = -1e30f, lsum = 0.f;
  const int nt0 = s0_n >> 6, nt = nt0 + (s1_n >> 6);
  const int kkey0 = tid / CPK, kch0 = tid - kkey0 * CPK;
  const int c1 = tid + 512;
  const bool has1 = c1 < 64 * CPK;
  const int kkey1 = has1 ? c1 / CPK : 0, kch1 = has1 ? c1 - kkey1 * CPK : 0;
  const int vkey = tid & 63, vch = tid >> 6;
  uint4 rk0, rk1, rv;
  rk1 = make_uint4(0, 0, 0, 0);
  {
    const int row0 = (0 < nt0) ? s0_row0 : s1_row0;
    rk0 = *(const uint4*)(Kp + (size_t)(row0 + kkey0) * k_ld + kch0 * 8);
    if (has1) rk1 = *(const uint4*)(Kp + (size_t)(row0 + kkey1) * k_ld + kch1 * 8);
    rv = *(const uint4*)(Vp + (size_t)(row0 + vkey) * v_ld + vch * 8);
  }
  {
    *(uint4*)(Ks + kkey0 * KS + kch0 * 8) = rk0;
    if (has1) *(uint4*)(Ks + kkey1 * KS + kch1 * 8) = rk1;
    const unsigned uu[4] = {rv.x, rv.y, rv.z, rv.w};
#pragma unroll
    for (int i = 0; i < 4; ++i) {
      Vt[(vch * 8 + 2 * i) * 68 + vkey] = (u16)(uu[i] & 0xffffu);
      Vt[(vch * 8 + 2 * i + 1) * 68 + vkey] = (u16)(uu[i] >> 16);
    }
  }
  __syncthreads();
  const int tq = qt0 + 32 * w + l32;
  for (int j = 0; j < nt; ++j) {
    const int cur = j & 1;
    {
      const int jn = (j + 1 < nt) ? j + 1 : j;
      const int row0 = (jn < nt0) ? s0_row0 + 64 * jn : s1_row0 + 64 * (jn - nt0);
      rk0 = VLOAD16(Kp + (size_t)(row0 + kkey0) * k_ld + kch0 * 8);
      if (DQK == 96) rk1 = VLOAD16(Kp + (size_t)(row0 + kkey1) * k_ld + kch1 * 8);
      rv = VLOAD16(Vp + (size_t)(row0 + vkey) * v_ld + vch * 8);
    }
    __builtin_amdgcn_sched_barrier(0);
    const bool mtile = masked0 && (j < nt0);
    const int tk0 = s0_t0 + 64 * j;
    bool active = true;
    if (mtile) {
      const int tql = qt0 + 32 * w;
      active = (tk0 + 63 >= tql - 128) && (tk0 <= tql + 31 + 128);
    }
    if (active) {
      const u16* kb = Ks + cur * 64 * KS + l32 * KS + hh * 8;
      f32x16 st[2];
#pragma unroll
      for (int i = 0; i < 16; ++i) { st[0][i] = 0.f; st[1][i] = 0.f; }
#pragma unroll
      for (int s = 0; s < NS; ++s) {
        const bf16x8 a0 = *(const bf16x8*)(kb + s * 16);
        const bf16x8 a1 = *(const bf16x8*)(kb + 32 * KS + s * 16);
        st[0] = MFMA(a0, qf[s], st[0]);
        st[1] = MFMA(a1, qf[s], st[1]);
      }
      if (mtile) {
#pragma unroll
        for (int kt = 0; kt < 2; ++kt)
#pragma unroll
          for (int rg = 0; rg < 16; ++rg) {
            const int tk = tk0 + 32 * kt + (rg & 3) + 8 * (rg >> 2) + 4 * hh;
            const int dlt = tk - tq;
            if (dlt > 128 || dlt < -128) st[kt][rg] = -1e30f;
          }
      }
      float mloc = st[0][0];
#pragma unroll
      for (int rg = 1; rg < 16; ++rg) mloc = fmaxf(mloc, st[0][rg]);
#pragma unroll
      for (int rg = 0; rg < 16; ++rg) mloc = fmaxf(mloc, st[1][rg]);
      mloc = fmaxf(mloc, __shfl_xor(mloc, 32));
      const bool grow = mloc > m + 8.0f;
      if (__builtin_amdgcn_ballot_w64(grow) != 0ull) {
        const float mnew = fmaxf(m, mloc);
        const float alpha = __builtin_amdgcn_exp2f(m - mnew);
        m = mnew;
        lsum *= alpha;
        const f32x2_t a2 = {alpha, alpha};
#pragma unroll
        for (int i = 0; i < 8; ++i) {
          f32x2_t o0 = {ot[0][2 * i], ot[0][2 * i + 1]}, o1 = {ot[1][2 * i], ot[1][2 * i + 1]};
          o0 *= a2; o1 *= a2;
          ot[0][2 * i] = o0.x; ot[0][2 * i + 1] = o0.y; ot[1][2 * i] = o1.x; ot[1][2 * i + 1] = o1.y;
        }
      }
      const f32x2_t nm2 = {-m, -m};
      f32x2_t ps2 = {0.f, 0.f};
#pragma unroll
      for (int kt = 0; kt < 2; ++kt)
#pragma unroll
        for (int rg = 0; rg < 16; rg += 2) {
          f32x2_t sv = {st[kt][rg], st[kt][rg + 1]};
          sv += nm2;
          float p0 = __builtin_amdgcn_exp2f(sv.x), p1 = __builtin_amdgcn_exp2f(sv.y);
          if (mtile) { p0 = (st[kt][rg] < -1e29f) ? 0.f : p0; p1 = (st[kt][rg + 1] < -1e29f) ? 0.f : p1; }
          st[kt][rg] = p0; st[kt][rg + 1] = p1;
          const f32x2_t pv = {p0, p1};
          ps2 += pv;
        }
      lsum += ps2.x + ps2.y;
      const u16* vb = Vt + cur * 64 * 68 + l32 * 68 + 4 * hh;
#pragma unroll
      for (int kt = 0; kt < 2; ++kt)
#pragma unroll
        for (int s = 0; s < 2; ++s) {
          unsigned pw[4];
#pragma unroll
          for (int i = 0; i < 4; ++i) pw[i] = pk2(st[kt][8 * s + 2 * i], st[kt][8 * s + 2 * i + 1]);
          const uint4 pu = make_uint4(pw[0], pw[1], pw[2], pw[3]);
          const bf16x8 pf = __builtin_bit_cast(bf16x8, pu);
#pragma unroll
          for (int dt = 0; dt < 2; ++dt) {
            const u16* vp = vb + dt * 32 * 68 + 32 * kt + 16 * s;
            const uint2 lo = *(const uint2*)(vp);
            const uint2 hi = *(const uint2*)(vp + 8);
            const uint4 au = make_uint4(lo.x, lo.y, hi.x, hi.y);
            ot[dt] = MFMA(__builtin_bit_cast(bf16x8, au), pf, ot[dt]);
          }
        }
    }
    __builtin_amdgcn_sched_barrier(0);
    {
      u16* Kw = Ks + (cur ^ 1) * 64 * KS;
      u16* Vw = Vt + (cur ^ 1) * 64 * 68;
      *(uint4*)(Kw + kkey0 * KS + kch0 * 8) = rk0;
      if (has1) *(uint4*)(Kw + kkey1 * KS + kch1 * 8) = rk1;
      const unsigned uu[4] = {rv.x, rv.y, rv.z, rv.w};
#pragma unroll
      for (int i = 0; i < 4; ++i) {
        Vw[(vch * 8 + 2 * i) * 68 + vkey] = (u16)(uu[i] & 0xffffu);
        Vw[(vch * 8 + 2 * i + 1) * 68 + vkey] = (u16)(uu[i] >> 16);
      }
    }
    __syncthreads();
  }
  float ltot = lsum + __shfl_xor(lsum, 32);
  if (has_sink) ltot += __builtin_amdgcn_exp2f(sink_l2 - m);
  const float inv = 1.0f / ltot;
#pragma unroll
  for (int dt = 0; dt < 2; ++dt)
#pragma unroll
    for (int g = 0; g < 4; ++g) {
      uint2 pk;
      pk.x = pk2(ot[dt][4 * g] * inv, ot[dt][4 * g + 1] * inv);
      pk.y = pk2(ot[dt][4 * g + 2] * inv, ot[dt][4 * g + 3] * inv);
      *(uint2*)(Op + (size_t)qrow * o_ld + dt * 32 + 8 * g + 4 * hh) = pk;
    }
}

DI void phase_attn(const Params& p, int l, u16* lds) {
  const u16* R = (const u16*)(p.ws + OFF_R);
  const u16* QK = (const u16*)(p.ws + OFF_A);
  const u16* KM = (const u16*)(p.ws + OFF_KM);
  u16* Y = (u16*)(p.ws + OFF_Y);
  const float* sink = p.gqa_sink + l * 8;
  const int n_mla = 2048, n_gqa = 2048, n_ctx = (l < 3) ? 128 : 0;
  for (int item = lbid(); item < n_mla + n_gqa + n_ctx; item += gridDim.x) {
    int kind, qb, hd, b, isctx;
    if (item < n_mla) { kind = 0; isctx = 0; qb = item & 31; hd = (item >> 5) & 7; b = item >> 8; }
    else if (item < n_mla + n_gqa) { const int it = item - n_mla; kind = 1; isctx = 0; qb = it & 31; hd = (it >> 5) & 7; b = it >> 8; }
    else { const int it = item - n_mla - n_gqa; isctx = 1; qb = 0; hd = it & 7; b = (it >> 3) & 7; kind = it >> 6; }
    const int crow0 = ML + b * LCTX;
    if (kind == 0) {
      int qrow0, qt0, s0r, s0n, s1n;
      if (isctx) { qrow0 = crow0; qt0 = 0; s0r = crow0; s0n = LCTX; s1n = 0; }
      else { qrow0 = b * LSEQ + qb * 256; qt0 = qb * 256; s0r = b * LSEQ; s0n = LSEQ; s1n = LCTX; }
      attn_block<96>(QK + hd * 96, 1792, KM + hd * 96, 768, QK + 768 + hd * 128 + 64, 1792, Y + 1024 + hd * 64, 1536,
                     qrow0, qt0, s0r, s0n, 0, 0, crow0, s1n, 0.f, 0, lds);
    } else {
      const int kvh = hd >> 2;
      int qrow0, qt0, s0r, s0n, s0t, msk, s1n;
      if (isctx) { qrow0 = crow0; qt0 = 0; s0r = crow0; s0n = LCTX; s0t = 0; msk = 0; s1n = 0; }
      else {
        const int t0 = qb * 256;
        const int lo = (t0 - 128 < 0) ? 0 : t0 - 128;
        const int hi = (t0 + 384 > LSEQ) ? LSEQ : t0 + 384;
        qrow0 = b * LSEQ + t0; qt0 = t0; s0r = b * LSEQ + lo; s0n = hi - lo; s0t = lo; msk = 1; s1n = LCTX;
      }
      attn_block<64>(R + hd * 64, 1536, R + 512 + kvh * 64, 1536, R + 640 + kvh * 64, 1536, Y + 512 + hd * 64, 1536,
                     qrow0, qt0, s0r, s0n, s0t, msk, crow0, s1n, sink[hd] * LOG2E, 1, lds);
    }
  }
}

DI void phase_p7a(const Params& p, int l, int nrows, u16* lds) {
  const u16* hn = (const u16*)(p.ws + OFF_A);
  const u16* wt = (const u16*)(p.ws + OFF_W) + (size_t)l * W_LAYER + WO_TG;
  u16* Gt = (u16*)(p.ws + OFF_B);
  const int NT = 24, nitems = (nrows / 256) * NT;
  for (int it_ = lbid(); it_ < ((nitems + 255) & ~255); it_ += gridDim.x) {
    const int item = xcd_remap(it_);
    if (item >= nitems) continue;
    const int m0 = (item / NT) * 256, n0 = (item % NT) * 128;
    f32x16 acc[2][2];
    ACC_ZERO(acc);
    gemm_mainloop(hn + (size_t)m0 * 1024, 1024, wt + (size_t)n0 * 1024, 1024, 1024, acc, lds);
    ACC_FOREACH(acc, m0, n0, { acc[mi_][ni_][r_] = sigmoidf_(val); });
    stage_store_bf16(acc, Gt, 3072, m0, n0, lds);
  }
}
DI void phase_p7b(const Params& p, int l, int nrows, u16* lds) {
  const u16* Y = (const u16*)(p.ws + OFF_Y);
  const u16* Gt = (const u16*)(p.ws + OFF_B);
  const u16* wb = (const u16*)(p.ws + OFF_W) + (size_t)l * W_LAYER + WO_BR;
  u16* mg = (u16*)(p.ws + OFF_A);
  const int NT = 8, nitems = (nrows / 256) * NT;
  for (int it_ = lbid(); it_ < ((nitems + 255) & ~255); it_ += gridDim.x) {
    const int item = xcd_remap(it_);
    if (item >= nitems) continue;
    const int m0 = (item / NT) * 256, n0 = (item % NT) * 128;
    f32x16 mrg[2][2];
    ACC_ZERO(mrg);
#pragma unroll 1
    for (int nb = 0; nb < 3; ++nb) {
      f32x16 acc[2][2];
      ACC_ZERO(acc);
      gemm_mainloop<true>(Y + (size_t)m0 * 1536 + nb * 512, 1536, wb + (size_t)nb * 1024 * 512 + (size_t)n0 * 512, 512, 512, acc, lds);
      {
        u16* gs = lds;
        const int tid = ltid();
#pragma unroll
        for (int i = 0; i < 8; ++i) {
          const int ch = tid + 512 * i, rr = ch >> 4, c16 = ch & 15;
          const uint4 v = *(const uint4*)(Gt + (size_t)(m0 + rr) * 3072 + nb * 1024 + n0 + c16 * 8);
          *(uint4*)(gs + rr * 136 + c16 * 8) = v;
        }
        __syncthreads();
        ACC_FOREACH(acc, 0, 0, { mrg[mi_][ni_][r_] += bf2f(gs[row * 136 + col]) * val; });
        __syncthreads();
      }
    }
    stage_store_bf16(mrg, mg, 1024, m0, n0, lds);
  }
}
DI void phase_p8(const Params& p, int l, int nrows, u16* lds) {
  const u16* mg = (const u16*)(p.ws + OFF_A);
  const u16* wt = (const u16*)(p.ws + OFF_W) + (size_t)l * W_LAYER + WO_OUT;
  const float* xs = (l == 0) ? p.x : p.out;
  const float* cs = (l == 0) ? p.ctx : (const float*)(p.ws + OFF_CTX);
  float* cd = (float*)(p.ws + OFF_CTX);
  const int NT = 8, nitems = (nrows / 256) * NT;
  for (int it_ = lbid(); it_ < ((nitems + 255) & ~255); it_ += gridDim.x) {
    const int item = xcd_remap(it_);
    if (item >= nitems) continue;
    const int m0 = (item / NT) * 256, n0 = (item % NT) * 128;
    f32x16 acc[2][2];
    ACC_ZERO(acc);
    gemm_mainloop(mg + (size_t)m0 * 1024, 1024, wt + (size_t)n0 * 1024, 1024, 1024, acc, lds);
    const int mrow = (m0 < ML) ? (m0 >> 13) : 8;
    const float* gate = mods_ptr(p, l, mrow, 2);
    ACC_FOREACH(acc, m0, n0, {
      const float g = gate[col];
      if (row < ML) p.out[(size_t)row * 1024 + col] = xs[(size_t)row * 1024 + col] + g * val;
      else cd[(size_t)(row - ML) * 1024 + col] = cs[(size_t)(row - ML) * 1024 + col] + g * val;
    });
  }
}
DI void phase_p10(const Params& p, int l, int nrows, u16* lds) {
  const u16* hn = (const u16*)(p.ws + OFF_A);
  const u16* wt = (const u16*)(p.ws + OFF_W) + (size_t)l * W_LAYER + WO_W1;
  u16* h1 = (u16*)(p.ws + OFF_B);
  const int NT = 32, nitems = (nrows / 256) * NT;
  for (int it_ = lbid(); it_ < ((nitems + 255) & ~255); it_ += gridDim.x) {
    const int item = xcd_remap(it_);
    if (item >= nitems) continue;
    const int m0 = (item / NT) * 256, n0 = (item % NT) * 128;
    f32x16 acc[2][2];
    ACC_ZERO(acc);
    gemm_mainloop(hn + (size_t)m0 * 1024, 1024, wt + (size_t)n0 * 1024, 1024, 1024, acc, lds);
    ACC_FOREACH(acc, m0, n0, { const float rl = fmaxf(val, 0.f); acc[mi_][ni_][r_] = rl * rl; });
    stage_store_bf16(acc, h1, 4096, m0, n0, lds);
  }
}
DI void phase_p11(const Params& p, int l, int nrows, u16* lds) {
  const u16* h1 = (const u16*)(p.ws + OFF_B);
  const u16* wt = (const u16*)(p.ws + OFF_W) + (size_t)l * W_LAYER + WO_W2;
  float* cd = (float*)(p.ws + OFF_CTX);
  const int NT = 8, nitems = (nrows / 256) * NT;
  for (int it_ = lbid(); it_ < ((nitems + 255) & ~255); it_ += gridDim.x) {
    const int item = xcd_remap(it_);
    if (item >= nitems) continue;
    const int m0 = (item / NT) * 256, n0 = (item % NT) * 128;
    f32x16 acc[2][2];
    ACC_ZERO(acc);
    gemm_mainloop(h1 + (size_t)m0 * 4096, 4096, wt + (size_t)n0 * 4096, 4096, 4096, acc, lds);
    const int mrow = (m0 < ML) ? (m0 >> 13) : 8;
    const float* gate = mods_ptr(p, l, mrow, 5);
    ACC_FOREACH(acc, m0, n0, {
      const float g = gate[col];
      float* dp = (row < ML) ? p.out + (size_t)row * 1024 + col : cd + (size_t)(row - ML) * 1024 + col;
      *dp = *dp + g * val;
    });
  }
}

DI void gsync(cg::grid_group& grid) {
  asm volatile("s_waitcnt vmcnt(0) lgkmcnt(0)" ::: "memory");
  grid.sync();
  if (ltid() < 64) {
    __builtin_amdgcn_fence(__ATOMIC_ACQUIRE, "agent");
    asm volatile("s_waitcnt vmcnt(0)" ::: "memory");
  }
  __syncthreads();
}

__global__ void __launch_bounds__(512) fwd_megakernel(Params p) {
  __shared__ __attribute__((aligned(16))) char lds[131072];
  cg::grid_group grid = cg::this_grid();
  phase0(p, lds);
  gsync(grid);
  for (int l = 0; l < 4; ++l) {
    const int nrows2 = (l < 3) ? MALL : ML;
#ifdef PROBE_SYNC10
    for (int q = 0; q < 10; ++q) gsync(grid);
#endif
#ifdef PROBE_FILT
    filter_tiles(p, l, LSEQ, 2 * FFTN, (float*)(p.ws + OFF_KF), (float*)(p.ws + OFF_PART), (float*)lds);
    gsync(grid);
    phase_filter_fft(p, l, (float*)lds);
    gsync(grid);
#endif
    phase_rownorm(p, l, 0, MALL);
#ifdef PROBE_ELEM
    phase_rownorm(p, l, 0, MALL);
    phase_rownorm(p, l, 0, MALL);
    phase_rownorm(p, l, 0, MALL);
#endif
    filter_tiles(p, l, LSEQ, 2 * FFTN, (float*)(p.ws + OFF_KF), (float*)(p.ws + OFF_PART), (float*)lds);
    if (l < 3) filter_tiles(p, l, LCTX, 512, (float*)(p.ws + OFF_KC), (float*)(p.ws + OFF_PART) + 128 * 1024, (float*)lds);
    gsync(grid);
    phase_gemm1(p, l, (u16*)lds);
#ifdef PROBE_GEMMS
    phase_gemm1(p, l, (u16*)lds);
#endif
    phase_filter_fft(p, l, (float*)lds);
    gsync(grid);
    phase_h1(p, l, (float*)lds);
#ifdef PROBE_ELEM
    phase_h1(p, l, (float*)lds);
#endif
    phase_p3(p, l, (float*)lds);
    gsync(grid);
    phase_h2(p, l, (float*)lds);
    gsync(grid);
#ifdef PROBE_H2
    phase_h1(p, l, (float*)lds);
    gsync(grid);
    phase_h2(p, l, (float*)lds);
    gsync(grid);
#endif
    phase_h3(p, l, (float*)lds);
#ifdef PROBE_ELEM
    phase_h3(p, l, (float*)lds);
#endif
    gsync(grid);
    phase_p4(p, l, (u16*)lds);
#ifdef PROBE_GEMMS
    phase_p4(p, l, (u16*)lds);
#endif
    gsync(grid);
    phase_p5(p, l, (float*)lds);
    gsync(grid);
    phase_attn(p, l, (u16*)lds);
#ifdef PROBE_ATTN2
    gsync(grid);
    phase_attn(p, l, (u16*)lds);
#endif
    gsync(grid);
    phase_rownorm(p, l, 0, nrows2);
    gsync(grid);
    phase_p7a(p, l, nrows2, (u16*)lds);
#ifdef PROBE_GEMMS
    phase_p7a(p, l, nrows2, (u16*)lds);
#endif
    gsync(grid);
    phase_p7b(p, l, nrows2, (u16*)lds);
#ifdef PROBE_GEMMS
    phase_p7b(p, l, nrows2, (u16*)lds);
#endif
    gsync(grid);
    phase_p8(p, l, nrows2, (u16*)lds);
    gsync(grid);
    phase_rownorm(p, l, 1, nrows2);
    gsync(grid);
    phase_p10(p, l, nrows2, (u16*)lds);
#if defined(PROBE_P10X2) || defined(PROBE_GEMMS)
    gsync(grid);
    phase_p10(p, l, nrows2, (u16*)lds);
#endif
    gsync(grid);
    phase_p11(p, l, nrows2, (u16*)lds);
    gsync(grid);
  }
}

extern "C" void kernel_launch(void* const* d_in, const int* in_sizes, int n_in, void* d_out, int out_size, void* d_ws,
                              size_t ws_size, hipStream_t stream) {
  static int grid_blocks = 0;
  if (!grid_blocks) {
    int dev = 0, cus = 0, per_cu = 0;
    hipGetDevice(&dev);
    hipDeviceGetAttribute(&cus, hipDeviceAttributeMultiprocessorCount, dev);
    hipOccupancyMaxActiveBlocksPerMultiprocessor(&per_cu, fwd_megakernel, 512, 0);
    if (per_cu < 1) per_cu = 1;
    if (per_cu > 1) per_cu = 1;
    grid_blocks = cus * per_cu;
  }
  Params p{};
  const float** pp = (const float**)&p;
  for (int i = 0; i < 30; ++i) pp[i] = (const float*)d_in[i];
  p.out = (float*)d_out;
  p.ws = (char*)d_ws;
  void* args[] = {&p};
  hipError_t e = hipLaunchCooperativeKernel((void*)fwd_megakernel, dim3(grid_blocks), dim3(512), args, 0, stream);
  if (e != hipSuccess) fprintf(stderr, "cooperative launch failed: %s (grid %d)\n", hipGetErrorString(e), grid_blocks);
}
```

```cpp
#include <hip/hip_runtime.h>
#include <hip/hip_cooperative_groups.h>
#include <cstdio>
namespace cg = cooperative_groups;

typedef unsigned short u16;
typedef short bf16x8 __attribute__((ext_vector_type(8)));
typedef float f32x16 __attribute__((ext_vector_type(16)));
typedef unsigned u32x4 __attribute__((ext_vector_type(4)));
#define VLOAD16(ptr) __builtin_bit_cast(uint4, *(const volatile u32x4*)(ptr))
typedef __bf16 bf16x2_t __attribute__((ext_vector_type(2)));
typedef float f32x2_t __attribute__((ext_vector_type(2)));
#define DI __device__ __forceinline__
#define MFMA(a, b, c) __builtin_amdgcn_mfma_f32_32x32x16_bf16((a), (b), (c), 0, 0, 0)

#define DM 1024
#define NBATCH 8
#define LSEQ 8192
#define LCTX 256
#define ML 65536
#define MC 2048
#define MALL 67584
#define NIN 6048
#define FFTN 16384
#define EPSV 1e-6f
#define LOG2E 1.4426950408889634f

#define W_LAYER 17858560ull
#define WO_T1 0ull
#define WO_TG 3145728ull
#define WO_QB 6291456ull
#define WO_KVB 6586368ull
#define WO_BR 6848512ull
#define WO_OUT 8421376ull
#define WO_W1 9469952ull
#define WO_W2 13664256ull
#define OFF_W 0ull
#define OFF_CTX 142868480ull
#define OFF_KF 151257088ull
#define OFF_KC 218365952ull
#define OFF_MODS 219414528ull
#define OFF_SUMSQ 220299264ull
#define OFF_ROPEG 220315648ull
#define OFF_ROPEM 222412800ull
#define OFF_TW 223461376ull
#define OFF_A 223592448ull
#define OFF_B 362004480ull
#define OFF_C 431210496ull
#define OFF_R 569622528ull
#define OFF_Y 777240576ull
#define OFF_KM (OFF_A + 242221056ull)
#define OFF_PART 984858624ull
#define ZC_OFF 33554432

struct Params {
  const float *x, *c, *ctx, *c_ctx, *w_mod, *b_mod, *norm_mix_g, *norm_mlp_g, *w_in, *hy_short_w, *hy_f1_w, *hy_f1_b,
      *hy_f2_w, *hy_f2_b, *hy_sin_freq, *hy_f3_w, *hy_skip, *gqa_q_norm, *gqa_k_norm, *gqa_sink, *mla_q_a_norm,
      *mla_kv_a_norm, *w_q_b, *w_kv_b, *mla_q_norm, *mla_k_norm, *w_branch, *w_out, *w_mlp1, *w_mlp2;
  float* out;
  char* ws;
};

DI int ltid() { int t = threadIdx.x; asm volatile("" : "+v"(t)); return t; }
DI int lbid() { int t = blockIdx.x; asm volatile("" : "+s"(t)); return t; }
DI u16 f2bf(float x) { return __builtin_bit_cast(u16, (__bf16)x); }
DI float bf2f(u16 v) { return __uint_as_float(((unsigned)v) << 16); }
DI unsigned pk2(float a, float b) {
  f32x2_t f = {a, b};
  return __builtin_bit_cast(unsigned, __builtin_convertvector(f, bf16x2_t));
}
DI float wave_sum(float v) {
#pragma unroll
  for (int o = 32; o > 0; o >>= 1) v += __shfl_xor(v, o);
  return v;
}
DI float sigmoidf_(float x) { return 1.0f / (1.0f + __expf(-x)); }
DI const float* mods_ptr(const Params& p, int l, int mrow, int j) {
  return (const float*)(p.ws + OFF_MODS) + ((size_t)(l * 9 + mrow) * 6144 + j * 1024);
}

template <bool LOWREG = false>
DI void gemm_mainloop(const u16* __restrict__ Ag, int lda, const u16* __restrict__ Bg, int ldb, int K,
                      f32x16 (&acc)[2][2], u16* lds) {
  const int tid = ltid(), lane = tid & 63, w = tid >> 6, l32 = lane & 31, hh = lane >> 5;
  const int wm = w >> 1, wn = w & 1;
  u16* As = lds;
  u16* Bs = lds + 2 * 256 * 72;
  const int arow = tid >> 3, ach = tid & 7;
  const u16* ap = Ag + (size_t)arow * lda + ach * 8;
  const u16* bp = Bg + (size_t)arow * ldb + ach * 8;
  const int nk = K >> 6;
  uint4 ra0[4], rb0[2], ra1[4], rb1[2];
#define G_LOAD(RA, RB, T)                                                                   \
  {                                                                                         \
    const int t_ = ((T) < nk) ? (T) : nk - 1;                                               \
    _Pragma("unroll") for (int i = 0; i < 4; ++i) RA[i] = VLOAD16(ap + (size_t)(64 * i) * lda + 64 * t_); \
    _Pragma("unroll") for (int i = 0; i < 2; ++i) RB[i] = VLOAD16(bp + (size_t)(64 * i) * ldb + 64 * t_); \
  }
#define G_STORE(RA, RB, BUF)                                                                \
  {                                                                                         \
    u16* Aw = As + (BUF) * 256 * 72;                                                        \
    u16* Bw = Bs + (BUF) * 128 * 72;                                                        \
    _Pragma("unroll") for (int i = 0; i < 4; ++i) *(uint4*)(Aw + (arow + 64 * i) * 72 + ach * 8) = RA[i]; \
    _Pragma("unroll") for (int i = 0; i < 2; ++i) *(uint4*)(Bw + (arow + 64 * i) * 72 + ach * 8) = RB[i]; \
  }
#define G_COMPUTE(BUF, RA, RB, WBUF)                                                        \
  {                                                                                         \
    const u16* as = As + (BUF) * 256 * 72 + (wm * 64 + l32) * 72 + hh * 8;                  \
    const u16* bs = Bs + (BUF) * 128 * 72 + (wn * 64 + l32) * 72 + hh * 8;                  \
    u16* Aw = As + (WBUF) * 256 * 72 + arow * 72 + ach * 8;                                 \
    u16* Bw = Bs + (WBUF) * 128 * 72 + arow * 72 + ach * 8;                                 \
    _Pragma("unroll") for (int s = 0; s < 4; ++s) {                                         \
      bf16x8 a0 = *(const bf16x8*)(as + s * 16), a1 = *(const bf16x8*)(as + 32 * 72 + s * 16); \
      bf16x8 b0 = *(const bf16x8*)(bs + s * 16), b1 = *(const bf16x8*)(bs + 32 * 72 + s * 16); \
      acc[0][0] = MFMA(a0, b0, acc[0][0]);                                                  \
      acc[0][1] = MFMA(a0, b1, acc[0][1]);                                                  \
      acc[1][0] = MFMA(a1, b0, acc[1][0]);                                                  \
      acc[1][1] = MFMA(a1, b1, acc[1][1]);                                                  \
      if (s == 0) { *(uint4*)(Aw) = RA[0]; *(uint4*)(Aw + 64 * 72) = RA[1]; }               \
      if (s == 1) { *(uint4*)(Aw + 128 * 72) = RA[2]; *(uint4*)(Aw + 192 * 72) = RA[3]; }   \
      if (s == 2) { *(uint4*)(Bw) = RB[0]; *(uint4*)(Bw + 64 * 72) = RB[1]; }               \
      if (LOWREG) __builtin_amdgcn_sched_barrier(0);                                        \
    }                                                                                       \
  }
  G_LOAD(ra0, rb0, 0);
  G_LOAD(ra1, rb1, 1);
  __builtin_amdgcn_sched_barrier(0);
  G_STORE(ra0, rb0, 0);
  __syncthreads();
  for (int kt = 0; kt < nk; kt += 2) {
    G_LOAD(ra0, rb0, kt + 2);
    __builtin_amdgcn_sched_barrier(0);
    G_COMPUTE(0, ra1, rb1, 1);
    __syncthreads();
    G_LOAD(ra1, rb1, kt + 3);
    __builtin_amdgcn_sched_barrier(0);
    G_COMPUTE(1, ra0, rb0, 0);
    __syncthreads();
  }
#undef G_LOAD
#undef G_STORE
#undef G_COMPUTE
}

DI int xcd_remap(int it) { const int r = it & 255; return (it & ~255) + ((r & 7) << 5) + (r >> 3); }

#define ACC_ZERO(acc)                                                                      \
  _Pragma("unroll") for (int mi_ = 0; mi_ < 2; ++mi_) _Pragma("unroll") for (int ni_ = 0; ni_ < 2; ++ni_) \
      _Pragma("unroll") for (int r_ = 0; r_ < 16; ++r_) acc[mi_][ni_][r_] = 0.f;

#define ACC_FOREACH(acc, m0, n0, BODY)                                                     \
  {                                                                                        \
    const int lane_ = ltid() & 63, w_ = ltid() >> 6;                             \
    const int l32_ = lane_ & 31, hh_ = lane_ >> 5, wm_ = w_ >> 1, wn_ = w_ & 1;            \
    _Pragma("unroll") for (int mi_ = 0; mi_ < 2; ++mi_) _Pragma("unroll") for (int ni_ = 0; ni_ < 2; ++ni_) { \
        __builtin_amdgcn_sched_barrier(0);                                                 \
        _Pragma("unroll") for (int r_ = 0; r_ < 16; ++r_) {                                \
      const int row = (m0) + wm_ * 64 + mi_ * 32 + (r_ & 3) + 8 * (r_ >> 2) + 4 * hh_;     \
      const int col = (n0) + wn_ * 64 + ni_ * 32 + l32_;                                   \
      const float val = acc[mi_][ni_][r_];                                                    \
      BODY                                                                                 \
    } }                                                                                    \
  }

DI void stage_store_bf16(f32x16 (&acc)[2][2], u16* __restrict__ dst, int ld, int m0, int c0, u16* lds) {
  u16* cs = lds;
  ACC_FOREACH(acc, 0, 0, { cs[row * 136 + col] = f2bf(val); });
  __syncthreads();
  const int tid = ltid();
#pragma unroll
  for (int i = 0; i < 8; ++i) {
    const int ch = tid + 512 * i, rr = ch >> 4, c16 = ch & 15;
    const uint4 v = *(const uint4*)(cs + rr * 136 + c16 * 8);
    *(uint4*)(dst + (size_t)(m0 + rr) * ld + c0 + c16 * 8) = v;
  }
  __syncthreads();
}

DI void conv_job(const float* __restrict__ src, int ld, int K, int col0, int nvalid, int npad, u16* __restrict__ dst,
                 int& off, float* ts) {
  const int tid = ltid();
  const int tk = K >> 6, tn = npad >> 6, ntiles = tk * tn;
  const int G = gridDim.x;
  int first = ((int)lbid() - (off % G) + G) % G;
  for (int tile = first; tile < ntiles; tile += G) {
    const int k0 = (tile % tk) * 64, n0 = (tile / tk) * 64;
    {
      const int cc = tid & 63, rg = tid >> 6;
      const bool ok = (n0 + cc) < nvalid;
#pragma unroll
      for (int i = 0; i < 8; ++i) {
        const int rr = rg * 8 + i;
        ts[rr * 65 + cc] = ok ? src[(size_t)(k0 + rr) * ld + col0 + n0 + cc] : 0.f;
      }
    }
    __syncthreads();
    {
      const int kk = tid & 63, ng = tid >> 6;
#pragma unroll
      for (int i = 0; i < 8; ++i) {
        const int nn = ng * 8 + i;
        dst[(size_t)(n0 + nn) * K + k0 + kk] = f2bf(ts[kk * 65 + nn]);
      }
    }
    __syncthreads();
  }
  off += ntiles;
}

DI void phase0(const Params& p, char* ldsc) {
  float* ldsf = (float*)ldsc;
  const int tid = ltid();
  const int G = gridDim.x;
  int off = 0;
  for (int l = 0; l < 4; ++l) {
    u16* wl = (u16*)(p.ws + OFF_W) + (size_t)l * W_LAYER;
    conv_job(p.w_in + (size_t)l * 1024 * NIN, NIN, 1024, 0, 2976, 3072, wl + WO_T1, off, ldsf);
    conv_job(p.w_in + (size_t)l * 1024 * NIN, NIN, 1024, 2976, 3072, 3072, wl + WO_TG, off, ldsf);
    conv_job(p.w_q_b + (size_t)l * 384 * 768, 768, 384, 0, 768, 768, wl + WO_QB, off, ldsf);
    conv_job(p.w_kv_b + (size_t)l * 256 * 1024, 1024, 256, 0, 1024, 1024, wl + WO_KVB, off, ldsf);
    for (int nb = 0; nb < 3; ++nb)
      conv_job(p.w_branch + (size_t)(l * 3 + nb) * 512 * 1024, 1024, 512, 0, 1024, 1024, wl + WO_BR + (size_t)nb * 1024 * 512, off, ldsf);
    conv_job(p.w_out + (size_t)l * 1024 * 1024, 1024, 1024, 0, 1024, 1024, wl + WO_OUT, off, ldsf);
    conv_job(p.w_mlp1 + (size_t)l * 1024 * 4096, 4096, 1024, 0, 4096, 4096, wl + WO_W1, off, ldsf);
    conv_job(p.w_mlp2 + (size_t)l * 4096 * 1024, 1024, 4096, 0, 1024, 1024, wl + WO_W2, off, ldsf);
  }
  {
    float* sc = ldsf;
    float* red = ldsf + 9 * 1024;
    for (int i = tid; i < 9 * 1024; i += 512) {
      float v = (i < 8 * 1024) ? p.c[i] : p.c_ctx[i - 8 * 1024];
      sc[i] = v / (1.0f + expf(-v));
    }
    __syncthreads();
    float* mods = (float*)(p.ws + OFF_MODS);
    const int ol = tid & 63, kg = tid >> 6;
    for (int item = lbid(); item < 384; item += G) {
      const int l = item / 96, o = (item % 96) * 64 + ol;
      const float* wp = p.w_mod + (size_t)l * 1024 * 6144 + o;
      float acc[9];
#pragma unroll
      for (int b = 0; b < 9; ++b) acc[b] = 0.f;
#pragma unroll 4
      for (int k = kg * 128; k < kg * 128 + 128; ++k) {
        const float wv = wp[(size_t)k * 6144];
#pragma unroll
        for (int b = 0; b < 9; ++b) acc[b] += sc[b * 1024 + k] * wv;
      }
#pragma unroll
      for (int b = 0; b < 9; ++b) red[(kg * 9 + b) * 64 + ol] = acc[b];
      __syncthreads();
      for (int i = tid; i < 576; i += 512) {
        const int b = i >> 6, o2 = i & 63;
        float s = 0.f;
#pragma unroll
        for (int g = 0; g < 8; ++g) s += red[(g * 9 + b) * 64 + o2];
        const int oc = (item % 96) * 64 + o2;
        mods[(size_t)(l * 9 + b) * 6144 + oc] = s + p.b_mod[l * 6144 + oc];
      }
      __syncthreads();
    }
  }
  {
    const int gt = lbid() * 512 + tid, GT = G * 512;
    float* rg = (float*)(p.ws + OFF_ROPEG);
    float* rm = (float*)(p.ws + OFF_ROPEM);
    float* tw = (float*)(p.ws + OFF_TW);
    for (int i = gt; i < LSEQ * 32; i += GT) {
      const int t = i >> 5, a = i & 31;
      const float pos = (a < 16) ? (float)(t >> 6) : (float)(t & 63);
      const float inv = powf(10000.0f, -(float)(a & 15) / 16.0f);
      const float ang = pos * inv;
      rg[2 * i] = cosf(ang);
      rg[2 * i + 1] = sinf(ang);
    }
    for (int i = gt; i < LSEQ * 16; i += GT) {
      const int t = i >> 4, a = i & 15;
      const float pos = (a < 8) ? (float)(t >> 6) : (float)(t & 63);
      const float inv = powf(10000.0f, -(float)(a & 7) / 8.0f);
      const float ang = pos * inv;
      rm[2 * i] = cosf(ang);
      rm[2 * i + 1] = sinf(ang);
    }
    for (int i = gt; i < FFTN; i += GT) {
      float sn, cs;
      sincospif(2.0f * (float)i / (float)FFTN, &sn, &cs);
      tw[2 * i] = cs;
      tw[2 * i + 1] = -sn;
    }
  }
}

DI void phase_rownorm(const Params& p, int l, int which, int nrows) {
  const int tid = ltid(), lane = tid & 63, w = tid >> 6;
  u16* hn = (u16*)(p.ws + OFF_A);
  const float* g = (which ? p.norm_mlp_g : p.norm_mix_g) + l * 1024;
  const bool first = (which == 0 && l == 0);
  const float* xs = first ? p.x : p.out;
  const float* cs = first ? p.ctx : (const float*)(p.ws + OFF_CTX);
  for (int r = lbid() * 8 + w; r < nrows; r += gridDim.x * 8) {
    const float* src = (r < ML) ? xs + (size_t)r * 1024 : cs + (size_t)(r - ML) * 1024;
    const int mrow = (r < ML) ? (r >> 13) : 8;
    const float* shift = mods_ptr(p, l, mrow, which ? 3 : 0);
    const float* scale = mods_ptr(p, l, mrow, which ? 4 : 1);
    float4 v[4];
    float ss = 0.f;
#pragma unroll
    for (int i = 0; i < 4; ++i) {
      v[i] = *(const float4*)(src + 4 * (lane + 64 * i));
      ss += v[i].x * v[i].x + v[i].y * v[i].y + v[i].z * v[i].z + v[i].w * v[i].w;
    }
    ss = wave_sum(ss);
    const float rstd = rsqrtf(ss * (1.0f / 1024.0f) + EPSV);
#pragma unroll
    for (int i = 0; i < 4; ++i) {
      const int c0 = 4 * (lane + 64 * i);
      const float4 gg = *(const float4*)(g + c0), sh = *(const float4*)(shift + c0), sc = *(const float4*)(scale + c0);
      const float o0 = v[i].x * rstd * gg.x * (1.f + sc.x) + sh.x;
      const float o1 = v[i].y * rstd * gg.y * (1.f + sc.y) + sh.y;
      const float o2 = v[i].z * rstd * gg.z * (1.f + sc.z) + sh.z;
      const float o3 = v[i].w * rstd * gg.w * (1.f + sc.w) + sh.w;
      uint2 pk;
      pk.x = pk2(o0, o1);
      pk.y = pk2(o2, o3);
      *(uint2*)(hn + (size_t)r * 1024 + c0) = pk;
    }
  }
}

DI void filter_tiles(const Params& p, int l, int Lf, int cstride, float* __restrict__ kdst, float* __restrict__ part, float* lds) {
  const int tid = ltid(), lane = tid & 63, w = tid >> 6;
  float* zs = lds;
  float* h1s = lds + 64 * 33;
  float* h2s = h1s + 64 * 65;
  const float* f1w = p.hy_f1_w + l * 33 * 64;
  const float* f1b = p.hy_f1_b + l * 64;
  const float* f2w = p.hy_f2_w + l * 64 * 64;
  const float* f2b = p.hy_f2_b + l * 64;
  const float* sf = p.hy_sin_freq + l * 128;
  const float* f3w = p.hy_f3_w + (size_t)l * 64 * 1024;
  const int ntile = Lf >> 6;
  const float min_decay = logf(1e-2f) / 1.5f, max_decay = logf(1e-2f) / 0.3f;
  for (int tile = lbid(); tile < ntile; tile += gridDim.x) {
    const int t0 = tile * 64;
    for (int idx = tid; idx < 64 * 33; idx += 512) {
      const int tt = idx / 33, e = idx - tt * 33;
      const int t = t0 + tt;
      float val;
      if (e == 0) {
        val = (float)t / (float)(Lf - 1);
      } else {
        const float wt = 6.283185307179586f * (float)t / (float)Lf;
        const int bi = (e - 1) & 15;
        const float f = 1e-4f + (float)bi * ((15.0f - 1e-4f) / 15.0f);
        val = (e <= 16) ? cosf(f * wt) : -sinf(f * wt);
      }
      zs[idx] = val;
    }
    __syncthreads();
    {
      const int tt = tid & 63, jg = tid >> 6;
#pragma unroll 1
      for (int jj = 0; jj < 8; ++jj) {
        const int j = jg * 8 + jj;
        float a = f1b[j];
#pragma unroll 3
        for (int e = 0; e < 33; ++e) a += zs[tt * 33 + e] * f1w[e * 64 + j];
        h1s[tt * 65 + j] = sinf(sf[j] * a);
      }
    }
    __syncthreads();
    {
      const int tt = tid & 63, jg = tid >> 6;
#pragma unroll 1
      for (int jj = 0; jj < 8; ++jj) {
        const int j = jg * 8 + jj;
        float a = f2b[j];
#pragma unroll 4
        for (int e = 0; e < 64; ++e) a += h1s[tt * 65 + e] * f2w[e * 64 + j];
        h2s[tt * 65 + j] = sinf(sf[64 + j] * a);
      }
    }
    __syncthreads();
    {
      const int tt = lane, t = t0 + tt;
      const float tn = (float)t / (float)(Lf - 1);
      const int wu = __builtin_amdgcn_readfirstlane(w);
#pragma unroll 1
      for (int ob = wu * 128; ob < wu * 128 + 128; ob += 16) {
        float acc[16];
#pragma unroll
        for (int q = 0; q < 16; ++q) acc[q] = 0.f;
#pragma unroll 2
        for (int i = 0; i < 64; ++i) {
          const float hv = h2s[tt * 65 + i];
          const float* wr = f3w + i * 1024 + ob;
#pragma unroll
          for (int q = 0; q < 16; ++q) acc[q] += hv * wr[q];
        }
#pragma unroll
        for (int q = 0; q < 16; ++q) {
          const int o = ob + q, dir = o >> 9, c = o & 511;
          const float delta = fabsf(min_decay + (float)c * ((max_decay - min_decay) / 511.0f));
          float val = acc[q] * expf(-tn * delta);
          int pos;
          if (dir == 0) pos = t;
          else if (t == 0) { pos = Lf; val = 0.f; }
          else pos = 2 * Lf - t;
          kdst[(size_t)c * cstride + pos] = val;
          const float s2 = wave_sum(val * val);
          if (lane == 0) part[tile * 1024 + o] = s2;
        }
      }
    }
    __syncthreads();
  }
}

DI int fsw(int i) { return (i & ~15) | ((((i >> 2) + (i >> 6)) & 3) << 2) | (i & 3); }

DI void r16_fwd(float (&xr)[16], float (&xi)[16]) {
#pragma unroll
  for (int st = 0; st < 2; ++st) {
    const int q = (st == 0) ? 4 : 1;
#pragma unroll
    for (int bi = 0; bi < 4; ++bi) {
      const int j = bi & (q - 1), g = bi / q;
      const int i0 = g * 4 * q + j, i1 = i0 + q, i2 = i1 + q, i3 = i2 + q;
      const float ar = xr[i0], ai = xi[i0], br = xr[i1], bi_ = xi[i1], cr = xr[i2], ci = xi[i2], dr = xr[i3], di = xi[i3];
      const float t0r = ar + cr, t0i = ai + ci, t1r = ar - cr, t1i = ai - ci;
      const float t2r = br + dr, t2i = bi_ + di;
      const float er = br - dr, ei = bi_ - di;
      const float t3r = ei, t3i = -er;
      const float y1r = t1r + t3r, y1i = t1i + t3i, y2r = t0r - t2r, y2i = t0i - t2i, y3r = t1r - t3r, y3i = t1i - t3i;
      xr[i0] = t0r + t2r; xi[i0] = t0i + t2i;
      if (q == 1 || j == 0) {
        xr[i1] = y1r; xi[i1] = y1i; xr[i2] = y2r; xi[i2] = y2i; xr[i3] = y3r; xi[i3] = y3i;
      } else {
        const float ang = -6.283185307179586f * (float)j / (float)(4 * q);
        const float w1r = __builtin_cosf(ang), w1i = __builtin_sinf(ang);
        const float w2r = __builtin_cosf(2.f * ang), w2i = __builtin_sinf(2.f * ang);
        const float w3r = __builtin_cosf(3.f * ang), w3i = __builtin_sinf(3.f * ang);
        xr[i1] = y1r * w1r - y1i * w1i; xi[i1] = y1r * w1i + y1i * w1r;
        xr[i2] = y2r * w2r - y2i * w2i; xi[i2] = y2r * w2i + y2i * w2r;
        xr[i3] = y3r * w3r - y3i * w3i; xi[i3] = y3r * w3i + y3i * w3r;
      }
    }
  }
}
DI void r16_inv(float (&xr)[16], float (&xi)[16]) {
#pragma unroll
  for (int st = 0; st < 2; ++st) {
    const int q = (st == 0) ? 1 : 4;
#pragma unroll
    for (int bi = 0; bi < 4; ++bi) {
      const int j = bi & (q - 1), g = bi / q;
      const int i0 = g * 4 * q + j, i1 = i0 + q, i2 = i1 + q, i3 = i2 + q;
      const float ar = xr[i0], ai = xi[i0];
      float br = xr[i1], bi_ = xi[i1], cr = xr[i2], ci = xi[i2], dr = xr[i3], di = xi[i3];
      if (!(q == 1 || j == 0)) {
        const float ang = 6.283185307179586f * (float)j / (float)(4 * q);
        const float w1r = __builtin_cosf(ang), w1i = __builtin_sinf(ang);
        const float w2r = __builtin_cosf(2.f * ang), w2i = __builtin_sinf(2.f * ang);
        const float w3r = __builtin_cosf(3.f * ang), w3i = __builtin_sinf(3.f * ang);
        const float b0 = br, c0 = cr, d0 = dr;
        br = b0 * w1r - bi_ * w1i; bi_ = b0 * w1i + bi_ * w1r;
        cr = c0 * w2r - ci * w2i;  ci = c0 * w2i + ci * w2r;
        dr = d0 * w3r - di * w3i;  di = d0 * w3i + di * w3r;
      }
      const float t0r = ar + cr, t0i = ai + ci, t1r = ar - cr, t1i = ai - ci;
      const float t2r = br + dr, t2i = bi_ + di;
      const float er = br - dr, ei = bi_ - di;
      const float t3r = -ei, t3i = er;
      xr[i0] = t0r + t2r; xi[i0] = t0i + t2i;
      xr[i1] = t1r + t3r; xi[i1] = t1i + t3i;
      xr[i2] = t0r - t2r; xi[i2] = t0i - t2i;
      xr[i3] = t1r - t3r; xi[i3] = t1i - t3i;
    }
  }
}

template <bool INV>
DI void fft_lds_stage(float* re, float* im, const float2* __restrict__ tw, const int s) {
  const int tid = ltid();
  const int qs = 12 - 2 * s;
  const int q = 1 << qs;
  float2 wb = tw[(tid & (q - 1)) << (2 * s)];
  if (INV) wb.y = -wb.y;
  float vr[8][4], vi[8][4];
  int idx[8][4];
#pragma unroll
  for (int k = 0; k < 8; ++k) {
    const int bi = tid + 512 * k;
    const int j = bi & (q - 1), g = bi >> qs;
    const int l0 = (g << (qs + 2)) + j;
#pragma unroll
    for (int m = 0; m < 4; ++m) { idx[k][m] = fsw(l0 + m * q); vr[k][m] = re[idx[k][m]]; vi[k][m] = im[idx[k][m]]; }
  }
#pragma unroll
  for (int k = 0; k < 8; ++k) {
    const int delta = (512 * k) & (q - 1);
    const float ang = (INV ? 6.283185307179586f : -6.283185307179586f) * (float)(delta << (2 * s)) / 16384.0f;
    const float cr_ = __builtin_cosf(ang), ci_ = __builtin_sinf(ang);
    const float w1r = (delta == 0) ? wb.x : wb.x * cr_ - wb.y * ci_;
    const float w1i = (delta == 0) ? wb.y : wb.x * ci_ + wb.y * cr_;
    const float w2r = w1r * w1r - w1i * w1i, w2i = 2.f * w1r * w1i;
    const float w3r = w2r * w1r - w2i * w1i, w3i = w2r * w1i + w2i * w1r;
    if (!INV) {
      const float ar = vr[k][0], ai = vi[k][0], br = vr[k][1], bi_ = vi[k][1], cr = vr[k][2], ci = vi[k][2], dr = vr[k][3], di = vi[k][3];
      const float t0r = ar + cr, t0i = ai + ci, t1r = ar - cr, t1i = ai - ci;
      const float t2r = br + dr, t2i = bi_ + di;
      const float er = br - dr, ei = bi_ - di;
      const float t3r = ei, t3i = -er;
      const float y1r = t1r + t3r, y1i = t1i + t3i, y2r = t0r - t2r, y2i = t0i - t2i, y3r = t1r - t3r, y3i = t1i - t3i;
      re[idx[k][0]] = t0r + t2r; im[idx[k][0]] = t0i + t2i;
      re[idx[k][1]] = y1r * w1r - y1i * w1i; im[idx[k][1]] = y1r * w1i + y1i * w1r;
      re[idx[k][2]] = y2r * w2r - y2i * w2i; im[idx[k][2]] = y2r * w2i + y2i * w2r;
      re[idx[k][3]] = y3r * w3r - y3i * w3i; im[idx[k][3]] = y3r * w3i + y3i * w3r;
    } else {
      const float ar = vr[k][0], ai = vi[k][0];
      const float br = vr[k][1] * w1r - vi[k][1] * w1i, bi_ = vr[k][1] * w1i + vi[k][1] * w1r;
      const float cr = vr[k][2] * w2r - vi[k][2] * w2i, ci = vr[k][2] * w2i + vi[k][2] * w2r;
      const float dr = vr[k][3] * w3r - vi[k][3] * w3i, di = vr[k][3] * w3i + vi[k][3] * w3r;
      const float t0r = ar + cr, t0i = ai + ci, t1r = ar - cr, t1i = ai - ci;
      const float t2r = br + dr, t2i = bi_ + di;
      const float er = br - dr, ei = bi_ - di;
      const float t3r = -ei, t3i = er;
      re[idx[k][0]] = t0r + t2r; im[idx[k][0]] = t0i + t2i;
      re[idx[k][1]] = t1r + t3r; im[idx[k][1]] = t1i + t3i;
      re[idx[k][2]] = t0r - t2r; im[idx[k][2]] = t0i - t2i;
      re[idx[k][3]] = t1r - t3r; im[idx[k][3]] = t1i - t3i;
    }
  }
  __syncthreads();
}
DI void fft_fwd4(float* re, float* im, const float2* __restrict__ tw) {
  fft_lds_stage<false>(re, im, tw, 0);
  fft_lds_stage<false>(re, im, tw, 1);
  fft_lds_stage<false>(re, im, tw, 2);
  fft_lds_stage<false>(re, im, tw, 3);
  fft_lds_stage<false>(re, im, tw, 4);
}
DI void fft_inv4(float* re, float* im, const float2* __restrict__ tw) {
  fft_lds_stage<true>(re, im, tw, 4);
  fft_lds_stage<true>(re, im, tw, 3);
  fft_lds_stage<true>(re, im, tw, 2);
  fft_lds_stage<true>(re, im, tw, 1);
  fft_lds_stage<true>(re, im, tw, 0);
}
DI void r16_load(const float* re, const float* im, int b, float (&xr)[16], float (&xi)[16]) {
#pragma unroll
  for (int c = 0; c < 4; ++c) {
    const int ph = 16 * b + 4 * ((c + (b >> 2)) & 3);
    const float4 vr = *(const float4*)(re + ph), vi = *(const float4*)(im + ph);
    xr[4 * c] = vr.x; xr[4 * c + 1] = vr.y; xr[4 * c + 2] = vr.z; xr[4 * c + 3] = vr.w;
    xi[4 * c] = vi.x; xi[4 * c + 1] = vi.y; xi[4 * c + 2] = vi.z; xi[4 * c + 3] = vi.w;
  }
}
DI void r16_store(float* re, float* im, int b, const float (&xr)[16], const float (&xi)[16]) {
#pragma unroll
  for (int c = 0; c < 4; ++c) {
    const int ph = 16 * b + 4 * ((c + (b >> 2)) & 3);
    *(float4*)(re + ph) = make_float4(xr[4 * c], xr[4 * c + 1], xr[4 * c + 2], xr[4 * c + 3]);
    *(float4*)(im + ph) = make_float4(xi[4 * c], xi[4 * c + 1], xi[4 * c + 2], xi[4 * c + 3]);
  }
}

DI void phase_filter_fft(const Params& p, int l, float* lds) {
  const int tid = ltid();
  float* re = lds;
  float* im = lds + FFTN;
  float* kf = (float*)(p.ws + OFF_KF);
  const float2* tw = (const float2*)(p.ws + OFF_TW);
  const float* part = (const float*)(p.ws + OFF_PART);
  for (int c = lbid(); c < 512; c += gridDim.x) {
    float* slot = kf + (size_t)c * (2 * FFTN);
    float pv = 0.f;
    if (tid < 128) pv = part[tid * 1024 + c] + part[tid * 1024 + 512 + c];
    pv = wave_sum(pv);
    if ((tid & 63) == 0) lds[tid >> 6] = pv;
    __syncthreads();
    const float ssq = lds[0] + lds[1];
    __syncthreads();
    const float sc = rsqrtf(ssq + EPSV) * (1.0f / (float)FFTN);
    for (int i = tid; i < FFTN; i += 512) { const int ph = fsw(i); re[ph] = slot[i] * sc; im[ph] = 0.f; }
    __syncthreads();
    fft_fwd4(re, im, tw);
    {
      float2* so = (float2*)slot;
#pragma unroll 1
      for (int b = tid; b < 1024; b += 512) {
        float xr[16], xi[16];
        r16_load(re, im, b, xr, xi);
        r16_fwd(xr, xi);
#pragma unroll
        for (int e = 0; e < 16; ++e) { float2 v; v.x = xr[e]; v.y = xi[e]; so[e * 1024 + b] = v; }
      }
    }
    __syncthreads();
  }
}

DI void phase_gemm1(const Params& p, int l, u16* lds) {
  const u16* hn = (const u16*)(p.ws + OFF_A);
  const u16* wt = (const u16*)(p.ws + OFF_W) + (size_t)l * W_LAYER + WO_T1;
  const int NT = 24, nitems = (MALL / 256) * NT;
  for (int it_ = lbid(); it_ < ((nitems + 255) & ~255); it_ += gridDim.x) {
    const int item = xcd_remap(it_);
    if (item >= nitems) continue;
    const int mt = item / NT, nt = item % NT;
    const int m0 = mt * 256, n0 = nt * 128;
    f32x16 acc[2][2];
    ACC_ZERO(acc);
    gemm_mainloop(hn + (size_t)m0 * 1024, 1024, wt + (size_t)n0 * 1024, 1024, 1024, acc, lds);
    u16* dst; int ld, cofs;
    if (nt < 4) { dst = (u16*)(p.ws + OFF_B); ld = 512; cofs = 0; }
    else if (nt < 12) { dst = (u16*)(p.ws + OFF_C); ld = 1024; cofs = 512; }
    else { dst = (u16*)(p.ws + OFF_R); ld = 1536; cofs = 1536; }
    stage_store_bf16(acc, dst, ld, m0, n0 - cofs, lds);
  }
}

DI void phase_h1(const Params& p, int l, float* lds) {
  const int tid = ltid();
  const u16* U12 = (const u16*)(p.ws + OFF_C);
  float* zT = (float*)(p.ws + OFF_A);
  const float* sw = p.hy_short_w + l * 3 * 1536;
  float* xs = lds;
  float* vs = lds + 66 * 65;
  const int nlat = 8 * 128 * 8, nctx = (l < 3) ? 8 * 4 * 8 : 0;
  for (int item = lbid(); item < nlat + nctx; item += gridDim.x) {
    int b, tt0, c0, Ls, rowbase; size_t zbase;
    if (item < nlat) { b = item >> 10; tt0 = ((item >> 3) & 127) * 64; c0 = (item & 7) * 64; Ls = LSEQ; rowbase = b * LSEQ; zbase = (size_t)b * 512 * LSEQ; }
    else { const int it = item - nlat; b = it >> 5; tt0 = ((it >> 3) & 3) * 64; c0 = (it & 7) * 64; Ls = LCTX; rowbase = ML + b * LCTX; zbase = (size_t)ZC_OFF + (size_t)b * 512 * LCTX; }
    for (int ch = tid; ch < 66 * 16; ch += 512) {
      const int arr = ch / 528, rem = ch - arr * 528;
      const int rr = rem >> 3, cc8 = (rem & 7) * 8;
      const int t = tt0 - 1 + rr;
      float* dstp = (arr ? vs : xs) + rr * 65 + cc8;
      if (t >= 0 && t < Ls) {
        const uint4 v = *(const uint4*)(U12 + (size_t)(rowbase + t) * 1024 + arr * 512 + c0 + cc8);
        const unsigned uu[4] = {v.x, v.y, v.z, v.w};
#pragma unroll
        for (int i = 0; i < 4; ++i) { dstp[2 * i] = __uint_as_float(uu[i] << 16); dstp[2 * i + 1] = __uint_as_float(uu[i] & 0xffff0000u); }
      } else {
#pragma unroll
        for (int i = 0; i < 8; ++i) dstp[i] = 0.f;
      }
    }
    __syncthreads();
    {
      const int tt = tid & 63, cgp = tid >> 6;
#pragma unroll
      for (int i = 0; i < 8; ++i) {
        const int cc = cgp * 8 + i, c = c0 + cc;
        float x1 = 0.f, vv = 0.f;
#pragma unroll
        for (int j = 0; j < 3; ++j) {
          x1 += sw[j * 1536 + 512 + c] * xs[(tt + j) * 65 + cc];
          vv += sw[j * 1536 + 1024 + c] * vs[(tt + j) * 65 + cc];
        }
        zT[zbase + (size_t)c * Ls + tt0 + tt] = x1 * vv;
      }
    }
    __syncthreads();
  }
}

DI void phase_p3(const Params& p, int l, float* lds) {
  const int tid = ltid(), lane = tid & 63, w = tid >> 6;
  u16* R = (u16*)(p.ws + OFF_R);
  float* rb = lds + w * 1472;
  float* hs = rb + 1440;
  const float* qn = p.gqa_q_norm + l * 64;
  const float* kn = p.gqa_k_norm + l * 64;
  const float* qan = p.mla_q_a_norm + l * 384;
  const float* kvan = p.mla_kv_a_norm + l * 256;
  const float* ropeg = (const float*)(p.ws + OFF_ROPEG);
  const float qscale = 0.125f * LOG2E;
  for (int r0 = lbid() * 8; r0 < MALL; r0 += gridDim.x * 8) {
    const int r = r0 + w;
    u16* rowp = R + (size_t)r * 1536;
    for (int ch = lane; ch < 180; ch += 64) {
      const uint4 v = *(const uint4*)(rowp + ch * 8);
      const unsigned uu[4] = {v.x, v.y, v.z, v.w};
#pragma unroll
      for (int i = 0; i < 4; ++i) { rb[ch * 8 + 2 * i] = __uint_as_float(uu[i] << 16); rb[ch * 8 + 2 * i + 1] = __uint_as_float(uu[i] & 0xffff0000u); }
    }
    __syncthreads();
    {
      float s = 0.f;
#pragma unroll
      for (int i = 0; i < 8; ++i) { const float v = rb[lane * 8 + i]; s += v * v; }
      s += __shfl_xor(s, 1); s += __shfl_xor(s, 2); s += __shfl_xor(s, 4);
      if ((lane & 7) == 0) hs[lane >> 3] = rsqrtf(s * (1.0f / 64.0f) + EPSV);
      float s2 = 0.f;
      if (lane < 16) {
#pragma unroll
        for (int i = 0; i < 8; ++i) { const float v = rb[512 + lane * 8 + i]; s2 += v * v; }
      }
      s2 += __shfl_xor(s2, 1); s2 += __shfl_xor(s2, 2); s2 += __shfl_xor(s2, 4);
      if (lane < 16 && (lane & 7) == 0) hs[8 + (lane >> 3)] = rsqrtf(s2 * (1.0f / 64.0f) + EPSV);
      float s3 = 0.f, s4 = 0.f;
#pragma unroll
      for (int i = 0; i < 6; ++i) { const float v = rb[768 + lane * 6 + i]; s3 += v * v; }
#pragma unroll
      for (int i = 0; i < 4; ++i) { const float v = rb[1152 + lane * 4 + i]; s4 += v * v; }
      s3 = wave_sum(s3); s4 = wave_sum(s4);
      if (lane == 0) { hs[10] = rsqrtf(s3 * (1.0f / 384.0f) + EPSV); hs[11] = rsqrtf(s4 * (1.0f / 256.0f) + EPSV); }
    }
    __syncthreads();
    {
      const bool lat = r < ML;
      const int t = r & (LSEQ - 1);
      const int d = lane, a = d & 31;
      float cs = 1.f, sn = 0.f;
      if (lat) { cs = ropeg[(t * 32 + a) * 2]; sn = ropeg[(t * 32 + a) * 2 + 1]; }
#pragma unroll
      for (int hd = 0; hd < 10; ++hd) {
        const float* gq = (hd < 8) ? qn : kn;
        const float rs = hs[hd];
        const float v = rb[hd * 64 + d] * rs * gq[d];
        const int dp = d ^ 32;
        const float vp = rb[hd * 64 + dp] * rs * gq[dp];
        float o = (d < 32) ? (v * cs - vp * sn) : (vp * sn + v * cs);
        if (hd < 8) o *= qscale;
        rowp[hd * 64 + d] = f2bf(o);
      }
#pragma unroll
      for (int i = 0; i < 6; ++i) { const int e = lane + 64 * i; rowp[768 + e] = f2bf(rb[768 + e] * hs[10] * qan[e]); }
#pragma unroll
      for (int i = 0; i < 4; ++i) { const int e = lane + 64 * i; rowp[1152 + e] = f2bf(rb[1152 + e] * hs[11] * kvan[e]); }
    }
    __syncthreads();
  }
}

DI void phase_h2(const Params& p, int l, float* lds) {
  const int tid = ltid(), lane = tid & 63, w = tid >> 6;
  float* zT = (float*)(p.ws + OFF_A);
  const float2* kf = (const float2*)(p.ws + OFF_KF);
  const float2* tw = (const float2*)(p.ws + OFF_TW);
  const float* skip = p.hy_skip + l * 512;
  float* re = lds;
  float* im = lds + FFTN;
  for (int item = lbid(); item < 2048; item += gridDim.x) {
    const int c = item >> 2, bp = item & 3;
    float* z1 = zT + ((size_t)(2 * bp) * 512 + c) * LSEQ;
    float* z2 = zT + ((size_t)(2 * bp + 1) * 512 + c) * LSEQ;
    for (int i = tid; i < LSEQ; i += 512) {
      const int p0 = fsw(i), p1 = fsw(i + LSEQ);
      re[p0] = z1[i]; im[p0] = z2[i]; re[p1] = 0.f; im[p1] = 0.f;
    }
    __syncthreads();
    fft_fwd4(re, im, tw);
    {
      const float2* kc = kf + (size_t)c * FFTN;
#pragma unroll 1
      for (int b = tid; b < 1024; b += 512) {
        float xr[16], xi[16];
        r16_load(re, im, b, xr, xi);
        r16_fwd(xr, xi);
#pragma unroll
        for (int e = 0; e < 16; ++e) {
          const float2 k = kc[e * 1024 + b];
          const float a = xr[e], b2 = xi[e];
          xr[e] = a * k.x - b2 * k.y;
          xi[e] = a * k.y + b2 * k.x;
        }
        r16_inv(xr, xi);
        r16_store(re, im, b, xr, xi);
      }
    }
    __syncthreads();
    fft_inv4(re, im, tw);
    const float sk = skip[c];
    for (int i = tid; i < LSEQ; i += 512) {
      const int p0 = fsw(i);
      const float a = z1[i], b = z2[i];
      z1[i] = re[p0] + a * sk;
      z2[i] = im[p0] + b * sk;
    }
    __syncthreads();
  }
  if (l < 3) {
    const float* kcb = (const float*)(p.ws + OFF_KC);
    const float* partc = (const float*)(p.ws + OFF_PART) + 128 * 1024;
    float* zs = lds + w * 768;
    float* ks = zs + 256;
    for (int item = lbid(); item < 512; item += gridDim.x) {
      const int b = item >> 6, c = (item & 63) * 8 + w;
      float* z = zT + (size_t)ZC_OFF + ((size_t)b * 512 + c) * LCTX;
      float pv = (lane < 4) ? partc[lane * 1024 + c] + partc[lane * 1024 + 512 + c] : 0.f;
      pv = wave_sum(pv);
      const float sc = rsqrtf(pv + EPSV);
      for (int i = lane; i < 256; i += 64) zs[i] = z[i];
      for (int i = lane; i < 512; i += 64) ks[i] = kcb[c * 512 + i] * sc;
      __syncthreads();
      const float sk = skip[c];
      float acc[4] = {0.f, 0.f, 0.f, 0.f};
      for (int s = 0; s < 256; ++s) {
        const float zv = zs[s];
#pragma unroll
        for (int i = 0; i < 4; ++i) acc[i] += ks[(lane + 64 * i - s) & 511] * zv;
      }
#pragma unroll
      for (int i = 0; i < 4; ++i) z[lane + 64 * i] = acc[i] + zs[lane + 64 * i] * sk;
      __syncthreads();
    }
  }
}

DI void phase_h3(const Params& p, int l, float* lds) {
  const int tid = ltid();
  const u16* U0 = (const u16*)(p.ws + OFF_B);
  const float* zT = (const float*)(p.ws + OFF_A);
  u16* Y = (u16*)(p.ws + OFF_Y);
  const float* sw = p.hy_short_w + l * 3 * 1536;
  float* xs = lds;
  float* ys = lds + 66 * 65;
  const int nlat = 8 * 128 * 8, nctx = (l < 3) ? 8 * 4 * 8 : 0;
  for (int item = lbid(); item < nlat + nctx; item += gridDim.x) {
    int b, tt0, c0, Ls, rowbase; size_t zbase;
    if (item < nlat) { b = item >> 10; tt0 = ((item >> 3) & 127) * 64; c0 = (item & 7) * 64; Ls = LSEQ; rowbase = b * LSEQ; zbase = (size_t)b * 512 * LSEQ; }
    else { const int it = item - nlat; b = it >> 5; tt0 = ((it >> 3) & 3) * 64; c0 = (it & 7) * 64; Ls = LCTX; rowbase = ML + b * LCTX; zbase = (size_t)ZC_OFF + (size_t)b * 512 * LCTX; }
    for (int ch = tid; ch < 66 * 8; ch += 512) {
      const int rr = ch >> 3, cc8 = (ch & 7) * 8;
      const int t = tt0 - 1 + rr;
      float* dstp = xs + rr * 65 + cc8;
      if (t >= 0 && t < Ls) {
        const uint4 v = *(const uint4*)(U0 + (size_t)(rowbase + t) * 512 + c0 + cc8);
        const unsigned uu[4] = {v.x, v.y, v.z, v.w};
#pragma unroll
        for (int i = 0; i < 4; ++i) { dstp[2 * i] = __uint_as_float(uu[i] << 16); dstp[2 * i + 1] = __uint_as_float(uu[i] & 0xffff0000u); }
      } else {
#pragma unroll
        for (int i = 0; i < 8; ++i) dstp[i] = 0.f;
      }
    }
    {
      const int tt = tid & 63, cgp = tid >> 6;
#pragma unroll
      for (int i = 0; i < 8; ++i) {
        const int cc = cgp * 8 + i;
        ys[cc * 65 + tt] = zT[zbase + (size_t)(c0 + cc) * Ls + tt0 + tt];
      }
    }
    __syncthreads();
    {
      const int cc = tid & 63, tg = tid >> 6, c = c0 + cc;
      const float w0 = sw[c], w1 = sw[1536 + c], w2 = sw[2 * 1536 + c];
#pragma unroll
      for (int i = 0; i < 8; ++i) {
        const int tt = tg * 8 + i;
        const float x0 = w0 * xs[tt * 65 + cc] + w1 * xs[(tt + 1) * 65 + cc] + w2 * xs[(tt + 2) * 65 + cc];
        Y[(size_t)(rowbase + tt0 + tt) * 1536 + c] = f2bf(x0 * ys[cc * 65 + tt]);
      }
    }
    __syncthreads();
  }
}

DI void phase_p4(const Params& p, int l, u16* lds) {
  const u16* R = (const u16*)(p.ws + OFF_R);
  u16* QK = (u16*)(p.ws + OFF_A);
  const u16* wl = (const u16*)(p.ws + OFF_W) + (size_t)l * W_LAYER;
  const int NT = 14, nitems = (MALL / 256) * NT;
  for (int it_ = lbid(); it_ < ((nitems + 255) & ~255); it_ += gridDim.x) {
    const int item = xcd_remap(it_);
    if (item >= nitems) continue;
    const int mt = item / NT, nt = item % NT;
    const int m0 = mt * 256;
    f32x16 acc[2][2];
    ACC_ZERO(acc);
    int n0;
    if (nt < 6) { n0 = nt * 128; gemm_mainloop(R + (size_t)m0 * 1536 + 768, 1536, wl + WO_QB + (size_t)n0 * 384, 384, 384, acc, lds); }
    else { n0 = (nt - 6) * 128; gemm_mainloop(R + (size_t)m0 * 1536 + 1152, 1536, wl + WO_KVB + (size_t)n0 * 256, 256, 256, acc, lds); n0 += 768; }
    stage_store_bf16(acc, QK, 1792, m0, n0, lds);
  }
}

DI void phase_p5(const Params& p, int l, float* lds) {
  const int tid = ltid(), lane = tid & 63, w = tid >> 6;
  u16* QK = (u16*)(p.ws + OFF_A);
  u16* KM = (u16*)(p.ws + OFF_KM);
  const u16* R = (const u16*)(p.ws + OFF_R);
  float* rb = lds + w * 1856;
  float* hs = rb + 1824;
  const float* qn = p.mla_q_norm + l * 96;
  const float* kn = p.mla_k_norm + l * 96;
  const float* ropem = (const float*)(p.ws + OFF_ROPEM);
  const float qscale = 0.10206207261596575f * LOG2E;
  for (int r0 = lbid() * 8; r0 < MALL; r0 += gridDim.x * 8) {
    const int r = r0 + w;
    u16* rowp = QK + (size_t)r * 1792;
    for (int ch = lane; ch < 228; ch += 64) {
      const uint4 v = (ch < 224) ? *(const uint4*)(rowp + ch * 8) : *(const uint4*)(R + (size_t)r * 1536 + 1408 + (ch - 224) * 8);
      const unsigned uu[4] = {v.x, v.y, v.z, v.w};
#pragma unroll
      for (int i = 0; i < 4; ++i) { rb[ch * 8 + 2 * i] = __uint_as_float(uu[i] << 16); rb[ch * 8 + 2 * i + 1] = __uint_as_float(uu[i] & 0xffff0000u); }
    }
    __syncthreads();
    {
      const int hd = lane >> 3, j = lane & 7;
      float s = 0.f, s2 = 0.f;
#pragma unroll
      for (int i = 0; i < 12; ++i) {
        const int d = j * 12 + i;
        const float v = rb[hd * 96 + d];
        s += v * v;
        const float kv = (d < 64) ? rb[768 + hd * 128 + d] : rb[1792 + d - 64];
        s2 += kv * kv;
      }
      s += __shfl_xor(s, 1); s += __shfl_xor(s, 2); s += __shfl_xor(s, 4);
      s2 += __shfl_xor(s2, 1); s2 += __shfl_xor(s2, 2); s2 += __shfl_xor(s2, 4);
      if (j == 0) { hs[hd] = rsqrtf(s * (1.0f / 96.0f) + EPSV); hs[8 + hd] = rsqrtf(s2 * (1.0f / 96.0f) + EPSV); }
    }
    __syncthreads();
    {
      const bool lat = r < ML;
      const int t = r & (LSEQ - 1);
#pragma unroll
      for (int i = 0; i < 12; ++i) {
        const int e = lane + 64 * i;
        const int hd = e / 96, d = e - hd * 96;
        const float rq = hs[hd], rk = hs[8 + hd];
        float qv = rb[hd * 96 + d] * rq * qn[d];
        float kv = ((d < 64) ? rb[768 + hd * 128 + d] : rb[1792 + d - 64]) * rk * kn[d];
        if (d >= 64 && lat) {
          const int a = (d - 64) & 15;
          const float cs = ropem[(t * 16 + a) * 2], sn = ropem[(t * 16 + a) * 2 + 1];
          const int dp = (d < 80) ? d + 16 : d - 16;
          const float qp = rb[hd * 96 + dp] * rq * qn[dp];
          const float kp = rb[1792 + dp - 64] * rk * kn[dp];
          if (d < 80) { qv = qv * cs - qp * sn; kv = kv * cs - kp * sn; }
          else { qv = qp * sn + qv * cs; kv = kp * sn + kv * cs; }
        }
        rowp[e] = f2bf(qv * qscale);
        KM[(size_t)r * 768 + e] = f2bf(kv);
      }
    }
    __syncthreads();
  }
}

template <int DQK>
DI void attn_block(const u16* __restrict__ Qp, int q_ld, const u16* __restrict__ Kp, int k_ld, const u16* __restrict__ Vp,
                   int v_ld, u16* __restrict__ Op, int o_ld, int qrow0, int qt0, int s0_row0, int s0_n, int s0_t0,
                   int masked0, int s1_row0, int s1_n, float sink_l2, int has_sink, u16* lds) {
  constexpr int KS = DQK + 8, NS = DQK / 16, CPK = DQK / 8;
  const int tid = ltid(), lane = tid & 63, w = tid >> 6, l32 = lane & 31, hh = lane >> 5;
  u16* Ks = lds;
  u16* Vt = lds + 2 * 64 * KS;
  const int qrow = qrow0 + 32 * w + l32;
  bf16x8 qf[NS];
#pragma unroll
  for (int s = 0; s < NS; ++s) qf[s] = *(const bf16x8*)(Qp + (size_t)qrow * q_ld + 16 * s + 8 * hh);
  f32x16 ot[2];
#pragma unroll
  for (int i = 0; i < 16; ++i) { ot[0][i] = 0.f; ot[1][i] = 0.f; }
  float m = -1e30f, lsum = 0.f;
  const int nt0 = s0_n >> 6, nt = nt0 + (s1_n >> 6);
  const int kkey0 = tid / CPK, kch0 = tid - kkey0 * CPK;
  const int c1 = tid + 512;
  const bool has1 = c1 < 64 * CPK;
  const int kkey1 = has1 ? c1 / CPK : 0, kch1 = has1 ? c1 - kkey1 * CPK : 0;
  const int vkey = tid & 63, vch = tid >> 6;
  uint4 rk0, rk1, rv;
  rk1 = make_uint4(0, 0, 0, 0);
  {
    const int row0 = (0 < nt0) ? s0_row0 : s1_row0;
    rk0 = *(const uint4*)(Kp + (size_t)(row0 + kkey0) * k_ld + kch0 * 8);
    if (has1) rk1 = *(const uint4*)(Kp + (size_t)(row0 + kkey1) * k_ld + kch1 * 8);
    rv = *(const uint4*)(Vp + (size_t)(row0 + vkey) * v_ld + vch * 8);
  }
  {
    *(uint4*)(Ks + kkey0 * KS + kch0 * 8) = rk0;
    if (has1) *(uint4*)(Ks + kkey1 * KS + kch1 * 8) = rk1;
    const unsigned uu[4] = {rv.x, rv.y, rv.z, rv.w};
#pragma unroll
    for (int i = 0; i < 4; ++i) {
      Vt[(vch * 8 + 2 * i) * 68 + vkey] = (u16)(uu[i] & 0xffffu);
      Vt[(vch * 8 + 2 * i + 1) * 68 + vkey] = (u16)(uu[i] >> 16);
    }
  }
  __syncthreads();
  const int tq = qt0 + 32 * w + l32;
  for (int j = 0; j < nt; ++j) {
    const int cur = j & 1;
    {
      const int jn = (j + 1 < nt) ? j + 1 : j;
      const int row0 = (jn < nt0) ? s0_row0 + 64 * jn : s1_row0 + 64 * (jn - nt0);
      rk0 = VLOAD16(Kp + (size_t)(row0 + kkey0) * k_ld + kch0 * 8);
      if (DQK == 96) rk1 = VLOAD16(Kp + (size_t)(row0 + kkey1) * k_ld + kch1 * 8);
      rv = VLOAD16(Vp + (size_t)(row0 + vkey) * v_ld + vch * 8);
    }
    __builtin_amdgcn_sched_barrier(0);
    const bool mtile = masked0 && (j < nt0);
    const int tk0 = s0_t0 + 64 * j;
    bool active = true;
    if (mtile) {
      const int tql = qt0 + 32 * w;
      active = (tk0 + 63 >= tql - 128) && (tk0 <= tql + 31 + 128);
    }
    if (active) {
      const u16* kb = Ks + cur * 64 * KS + l32 * KS + hh * 8;
      f32x16 st[2];
#pragma unroll
      for (int i = 0; i < 16; ++i) { st[0][i] = 0.f; st[1][i] = 0.f; }
#pragma unroll
      for (int s = 0; s < NS; ++s) {
        const bf16x8 a0 = *(const bf16x8*)(kb + s * 16);
        const bf16x8 a1 = *(const bf16x8*)(kb + 32 * KS + s * 16);
        st[0] = MFMA(a0, qf[s], st[0]);
        st[1] = MFMA(a1, qf[s], st[1]);
      }
      if (mtile) {
#pragma unroll
        for (int kt = 0; kt < 2; ++kt)
#pragma unroll
          for (int rg = 0; rg < 16; ++rg) {
            const int tk = tk0 + 32 * kt + (rg & 3) + 8 * (rg >> 2) + 4 * hh;
            const int dlt = tk - tq;
            if (dlt > 128 || dlt < -128) st[kt][rg] = -1e30f;
          }
      }
      float mloc = st[0][0];
#pragma unroll
      for (int rg = 1; rg < 16; ++rg) mloc = fmaxf(mloc, st[0][rg]);
#pragma unroll
      for (int rg = 0; rg < 16; ++rg) mloc = fmaxf(mloc, st[1][rg]);
      mloc = fmaxf(mloc, __shfl_xor(mloc, 32));
      const bool grow = mloc > m + 8.0f;
      if (__builtin_amdgcn_ballot_w64(grow) != 0ull) {
        const float mnew = fmaxf(m, mloc);
        const float alpha = __builtin_amdgcn_exp2f(m - mnew);
        m = mnew;
        lsum *= alpha;
        const f32x2_t a2 = {alpha, alpha};
#pragma unroll
        for (int i = 0; i < 8; ++i) {
          f32x2_t o0 = {ot[0][2 * i], ot[0][2 * i + 1]}, o1 = {ot[1][2 * i], ot[1][2 * i + 1]};
          o0 *= a2; o1 *= a2;
          ot[0][2 * i] = o0.x; ot[0][2 * i + 1] = o0.y; ot[1][2 * i] = o1.x; ot[1][2 * i + 1] = o1.y;
        }
      }
      const f32x2_t nm2 = {-m, -m};
      f32x2_t ps2 = {0.f, 0.f};
#pragma unroll
      for (int kt = 0; kt < 2; ++kt)
#pragma unroll
        for (int rg = 0; rg < 16; rg += 2) {
          f32x2_t sv = {st[kt][rg], st[kt][rg + 1]};
          sv += nm2;
          float p0 = __builtin_amdgcn_exp2f(sv.x), p1 = __builtin_amdgcn_exp2f(sv.y);
          if (mtile) { p0 = (st[kt][rg] < -1e29f) ? 0.f : p0; p1 = (st[kt][rg + 1] < -1e29f) ? 0.f : p1; }
          st[kt][rg] = p0; st[kt][rg + 1] = p1;
          const f32x2_t pv = {p0, p1};
          ps2 += pv;
        }
      lsum += ps2.x + ps2.y;
      const u16* vb = Vt + cur * 64 * 68 + l32 * 68 + 4 * hh;
#pragma unroll
      for (int kt = 0; kt < 2; ++kt)
#pragma unroll
        for (int s = 0; s < 2; ++s) {
          unsigned pw[4];
#pragma unroll
          for (int i = 0; i < 4; ++i) pw[i] = pk2(st[kt][8 * s + 2 * i], st[kt][8 * s + 2 * i + 1]);
          const uint4 pu = make_uint4(pw[0], pw[1], pw[2], pw[3]);
          const bf16x8 pf = __builtin_bit_cast(bf16x8, pu);
#pragma unroll
          for (int dt = 0; dt < 2; ++dt) {
            const u16* vp = vb + dt * 32 * 68 + 32 * kt + 16 * s;
            const uint2 lo = *(const uint2*)(vp);
            const uint2 hi = *(const uint2*)(vp + 8);
            const uint4 au = make_uint4(lo.x, lo.y, hi.x, hi.y);
            ot[dt] = MFMA(__builtin_bit_cast(bf16x8, au), pf, ot[dt]);
          }
        }
    }
    __builtin_amdgcn_sched_barrier(0);
    {
      u16* Kw = Ks + (cur ^ 1) * 64 * KS;
      u16* Vw = Vt + (cur ^ 1) * 64 * 68;
      *(uint4*)(Kw + kkey0 * KS + kch0 * 8) = rk0;
      if (has1) *(uint4*)(Kw + kkey1 * KS + kch1 * 8) = rk1;
      const unsigned uu[4] = {rv.x, rv.y, rv.z, rv.w};
#pragma unroll
      for (int i = 0; i < 4; ++i) {
        Vw[(vch * 8 + 2 * i) * 68 + vkey] = (u16)(uu[i] & 0xffffu);
        Vw[(vch * 8 + 2 * i + 1) * 68 + vkey] = (u16)(uu[i] >> 16);
      }
    }
    __syncthreads();
  }
  float ltot = lsum + __shfl_xor(lsum, 32);
  if (has_sink) ltot += __builtin_amdgcn_exp2f(sink_l2 - m);
  const float inv = 1.0f / ltot;
#pragma unroll
  for (int dt = 0; dt < 2; ++dt)
#pragma unroll
    for (int g = 0; g < 4; ++g) {
      uint2 pk;
      pk.x = pk2(ot[dt][4 * g] * inv, ot[dt][4 * g + 1] * inv);
      pk.y = pk2(ot[dt][4 * g + 2] * inv, ot[dt][4 * g + 3] * inv);
      *(uint2*)(Op + (size_t)qrow * o_ld + dt * 32 + 8 * g + 4 * hh) = pk;
    }
}

DI void phase_attn(const Params& p, int l, u16* lds) {
  const u16* R = (const u16*)(p.ws + OFF_R);
  const u16* QK = (const u16*)(p.ws + OFF_A);
  const u16* KM = (const u16*)(p.ws + OFF_KM);
  u16* Y = (u16*)(p.ws + OFF_Y);
  const float* sink = p.gqa_sink + l * 8;
  const int n_mla = 2048, n_gqa = 2048, n_ctx = (l < 3) ? 128 : 0;
  for (int item = lbid(); item < n_mla + n_gqa + n_ctx; item += gridDim.x) {
    int kind, qb, hd, b, isctx;
    if (item < n_mla) { kind = 0; isctx = 0; qb = item & 31; hd = (item >> 5) & 7; b = item >> 8; }
    else if (item < n_mla + n_gqa) { const int it = item - n_mla; kind = 1; isctx = 0; qb = it & 31; hd = (it >> 5) & 7; b = it >> 8; }
    else { const int it = item - n_mla - n_gqa; isctx = 1; qb = 0; hd = it & 7; b = (it >> 3) & 7; kind = it >> 6; }
    const int crow0 = ML + b * LCTX;
    if (kind == 0) {
      int qrow0, qt0, s0r, s0n, s1n;
      if (isctx) { qrow0 = crow0; qt0 = 0; s0r = crow0; s0n = LCTX; s1n = 0; }
      else { qrow0 = b * LSEQ + qb * 256; qt0 = qb * 256; s0r = b * LSEQ; s0n = LSEQ; s1n = LCTX; }
      attn_block<96>(QK + hd * 96, 1792, KM + hd * 96, 768, QK + 768 + hd * 128 + 64, 1792, Y + 1024 + hd * 64, 1536,
                     qrow0, qt0, s0r, s0n, 0, 0, crow0, s1n, 0.f, 0, lds);
    } else {
      const int kvh = hd >> 2;
      int qrow0, qt0, s0r, s0n, s0t, msk, s1n;
      if (isctx) { qrow0 = crow0; qt0 = 0; s0r = crow0; s0n = LCTX; s0t = 0; msk = 0; s1n = 0; }
      else {
        const int t0 = qb * 256;
        const int lo = (t0 - 128 < 0) ? 0 : t0 - 128;
        const int hi = (t0 + 384 > LSEQ) ? LSEQ : t0 + 384;
        qrow0 = b * LSEQ + t0; qt0 = t0; s0r = b * LSEQ + lo; s0n = hi - lo; s0t = lo; msk = 1; s1n = LCTX;
      }
      attn_block<64>(R + hd * 64, 1536, R + 512 + kvh * 64, 1536, R + 640 + kvh * 64, 1536, Y + 512 + hd * 64, 1536,
                     qrow0, qt0, s0r, s0n, s0t, msk, crow0, s1n, sink[hd] * LOG2E, 1, lds);
    }
  }
}

DI void phase_p7a(const Params& p, int l, int nrows, u16* lds) {
  const u16* hn = (const u16*)(p.ws + OFF_A);
  const u16* wt = (const u16*)(p.ws + OFF_W) + (size_t)l * W_LAYER + WO_TG;
  u16* Gt = (u16*)(p.ws + OFF_B);
  const int NT = 24, nitems = (nrows / 256) * NT;
  for (int it_ = lbid(); it_ < ((nitems + 255) & ~255); it_ += gridDim.x) {
    const int item = xcd_remap(it_);
    if (item >= nitems) continue;
    const int m0 = (item / NT) * 256, n0 = (item % NT) * 128;
    f32x16 acc[2][2];
    ACC_ZERO(acc);
    gemm_mainloop(hn + (size_t)m0 * 1024, 1024, wt + (size_t)n0 * 1024, 1024, 1024, acc, lds);
    ACC_FOREACH(acc, m0, n0, { acc[mi_][ni_][r_] = sigmoidf_(val); });
    stage_store_bf16(acc, Gt, 3072, m0, n0, lds);
  }
}
DI void phase_p7b(const Params& p, int l, int nrows, u16* lds) {
  const u16* Y = (const u16*)(p.ws + OFF_Y);
  const u16* Gt = (const u16*)(p.ws + OFF_B);
  const u16* wb = (const u16*)(p.ws + OFF_W) + (size_t)l * W_LAYER + WO_BR;
  u16* mg = (u16*)(p.ws + OFF_A);
  const int NT = 8, nitems = (nrows / 256) * NT;
  for (int it_ = lbid(); it_ < ((nitems + 255) & ~255); it_ += gridDim.x) {
    const int item = xcd_remap(it_);
    if (item >= nitems) continue;
    const int m0 = (item / NT) * 256, n0 = (item % NT) * 128;
    f32x16 mrg[2][2];
    ACC_ZERO(mrg);
#pragma unroll 1
    for (int nb = 0; nb < 3; ++nb) {
      f32x16 acc[2][2];
      ACC_ZERO(acc);
      gemm_mainloop<true>(Y + (size_t)m0 * 1536 + nb * 512, 1536, wb + (size_t)nb * 1024 * 512 + (size_t)n0 * 512, 512, 512, acc, lds);
      {
        u16* gs = lds;
        const int tid = ltid();
#pragma unroll
        for (int i = 0; i < 8; ++i) {
          const int ch = tid + 512 * i, rr = ch >> 4, c16 = ch & 15;
          const uint4 v = *(const uint4*)(Gt + (size_t)(m0 + rr) * 3072 + nb * 1024 + n0 + c16 * 8);
          *(uint4*)(gs + rr * 136 + c16 * 8) = v;
        }
        __syncthreads();
        ACC_FOREACH(acc, 0, 0, { mrg[mi_][ni_][r_] += bf2f(gs[row * 136 + col]) * val; });
        __syncthreads();
      }
    }
    stage_store_bf16(mrg, mg, 1024, m0, n0, lds);
  }
}
DI void phase_p8(const Params& p, int l, int nrows, u16* lds) {
  const u16* mg = (const u16*)(p.ws + OFF_A);
  const u16* wt = (const u16*)(p.ws + OFF_W) + (size_t)l * W_LAYER + WO_OUT;
  const float* xs = (l == 0) ? p.x : p.out;
  const float* cs = (l == 0) ? p.ctx : (const float*)(p.ws + OFF_CTX);
  float* cd = (float*)(p.ws + OFF_CTX);
  const int NT = 8, nitems = (nrows / 256) * NT;
  for (int it_ = lbid(); it_ < ((nitems + 255) & ~255); it_ += gridDim.x) {
    const int item = xcd_remap(it_);
    if (item >= nitems) continue;
    const int m0 = (item / NT) * 256, n0 = (item % NT) * 128;
    f32x16 acc[2][2];
    ACC_ZERO(acc);
    gemm_mainloop(mg + (size_t)m0 * 1024, 1024, wt + (size_t)n0 * 1024, 1024, 1024, acc, lds);
    const int mrow = (m0 < ML) ? (m0 >> 13) : 8;
    const float* gate = mods_ptr(p, l, mrow, 2);
    ACC_FOREACH(acc, m0, n0, {
      const float g = gate[col];
      if (row < ML) p.out[(size_t)row * 1024 + col] = xs[(size_t)row * 1024 + col] + g * val;
      else cd[(size_t)(row - ML) * 1024 + col] = cs[(size_t)(row - ML) * 1024 + col] + g * val;
    });
  }
}
DI void phase_p10(const Params& p, int l, int nrows, u16* lds) {
  const u16* hn = (const u16*)(p.ws + OFF_A);
  const u16* wt = (const u16*)(p.ws + OFF_W) + (size_t)l * W_LAYER + WO_W1;
  u16* h1 = (u16*)(p.ws + OFF_B);
  const int NT = 32, nitems = (nrows / 256) * NT;
  for (int it_ = lbid(); it_ < ((nitems + 255) & ~255); it_ += gridDim.x) {
    const int item = xcd_remap(it_);
    if (item >= nitems) continue;
    const int m0 = (item / NT) * 256, n0 = (item % NT) * 128;
    f32x16 acc[2][2];
    ACC_ZERO(acc);
    gemm_mainloop(hn + (size_t)m0 * 1024, 1024, wt + (size_t)n0 * 1024, 1024, 1024, acc, lds);
    ACC_FOREACH(acc, m0, n0, { const float rl = fmaxf(val, 0.f); acc[mi_][ni_][r_] = rl * rl; });
    stage_store_bf16(acc, h1, 4096, m0, n0, lds);
  }
}
DI void phase_p11(const Params& p, int l, int nrows, u16* lds) {
  const u16* h1 = (const u16*)(p.ws + OFF_B);
  const u16* wt = (const u16*)(p.ws + OFF_W) + (size_t)l * W_LAYER + WO_W2;
  float* cd = (float*)(p.ws + OFF_CTX);
  const int NT = 8, nitems = (nrows / 256) * NT;
  for (int it_ = lbid(); it_ < ((nitems + 255) & ~255); it_ += gridDim.x) {
    const int item = xcd_remap(it_);
    if (item >= nitems) continue;
    const int m0 = (item / NT) * 256, n0 = (item % NT) * 128;
    f32x16 acc[2][2];
    ACC_ZERO(acc);
    gemm_mainloop(h1 + (size_t)m0 * 4096, 4096, wt + (size_t)n0 * 4096, 4096, 4096, acc, lds);
    const int mrow = (m0 < ML) ? (m0 >> 13) : 8;
    const float* gate = mods_ptr(p, l, mrow, 5);
    ACC_FOREACH(acc, m0, n0, {
      const float g = gate[col];
      float* dp = (row < ML) ? p.out + (size_t)row * 1024 + col : cd + (size_t)(row - ML) * 1024 + col;
      *dp = *dp + g * val;
    });
  }
}

#define OFF_BAR 985907200ull
#define XB_TMO      128
#define XB_XCNT(j)  (256  + 64 * (j))
#define XB_XSUB(j)  (1280 + 64 * (j))
#define XB_XGEN(j)  (2304 + 64 * (j))
#define XB_TOP      3328
#define XB_TOPGEN   3392
#define XCD_BAR_WORDS 3456
#define XB_SPIN_CAP (1u << 18)
#define LAS __attribute__((address_space(3)))
DI unsigned xb_ld(unsigned* p) { return __hip_atomic_load(p, __ATOMIC_RELAXED, __HIP_MEMORY_SCOPE_AGENT); }
DI unsigned xb_add(unsigned* p, unsigned v) { return __hip_atomic_fetch_add(p, v, __ATOMIC_RELAXED, __HIP_MEMORY_SCOPE_AGENT); }
DI unsigned xb_xcc_id() { return (unsigned)__builtin_amdgcn_s_getreg((3 << 11) | 20) & 0xFu; }
#define XB_SPIN(cond, bar) do { unsigned _sp = 0; while (cond) { __builtin_amdgcn_s_sleep(1); \
    if ((++_sp & 255u) == 0u) { if (xb_ld(&(bar)[XB_TMO])) break; if (_sp > XB_SPIN_CAP) { atomicAdd(&(bar)[XB_TMO], 1u); break; } } } } while (0)
struct XcdBarrier { unsigned* bar; unsigned x; volatile LAS unsigned* st; };
DI XcdBarrier xcd_barrier_post(unsigned* bar, volatile LAS unsigned* st) {
  XcdBarrier b; b.bar = bar; b.x = xb_xcc_id(); b.st = st;
  if (threadIdx.x == 0) (void)xb_add(&bar[XB_XCNT(b.x)], 1u);
  return b;
}
DI void xcd_barrier_complete(unsigned* bar, unsigned x, unsigned& nloc, unsigned& nx) {
  const unsigned G = gridDim.x * gridDim.y * gridDim.z;
  unsigned sum, cnt, mine, sp = 0u;
  for (;;) {
    sum = 0u; cnt = 0u; mine = 0u;
#pragma unroll
    for (unsigned j = 0; j < 16; ++j) { const unsigned c = xb_ld(&bar[XB_XCNT(j)]); sum += c; cnt += (c > 0u) ? 1u : 0u; mine = (j == x) ? c : mine; }
    if (sum == G) break;
    __builtin_amdgcn_s_sleep(1);
    if ((++sp & 255u) == 0u) { if (xb_ld(&bar[XB_TMO])) break; if (sp > XB_SPIN_CAP) { atomicAdd(&bar[XB_TMO], 1u); break; } }
  }
  nloc = mine > 0u ? mine : 1u; nx = cnt > 0u ? cnt : 1u;
}
DI void xcd_barrier(const XcdBarrier& b) {
  asm volatile("s_waitcnt vmcnt(0) lgkmcnt(0)" ::: "memory");
  __syncthreads();
  if (threadIdx.x == 0) {
    unsigned* bar = b.bar;
    __builtin_amdgcn_s_waitcnt(0);
    unsigned nloc = b.st[0], nx = b.st[1];
    if (nloc == 0u) { xcd_barrier_complete(bar, b.x, nloc, nx); b.st[0] = nloc; b.st[1] = nx; }
    const unsigned old = xb_add(&bar[XB_XSUB(b.x)], 1u);
    const unsigned gen = old / nloc;
    if (old + 1u == (gen + 1u) * nloc) {
      __builtin_amdgcn_fence(__ATOMIC_RELEASE, "agent");
      asm volatile("s_waitcnt vmcnt(0)" ::: "memory");
      const unsigned og = xb_add(&bar[XB_TOP], 1u);
      const unsigned tg = og / nx;
      if (og + 1u == (tg + 1u) * nx) xb_add(&bar[XB_TOPGEN], 1u);
      else XB_SPIN(xb_ld(&bar[XB_TOPGEN]) == tg, bar);
      __builtin_amdgcn_fence(__ATOMIC_ACQUIRE, "agent");
      xb_add(&bar[XB_XGEN(b.x)], 1u);
      asm volatile("s_waitcnt vmcnt(0)" ::: "memory");
    } else {
      XB_SPIN(xb_ld(&bar[XB_XGEN(b.x)]) == gen, bar);
      __builtin_amdgcn_fence(__ATOMIC_ACQUIRE, "agent");
      asm volatile("s_waitcnt vmcnt(0)" ::: "memory");
    }
  }
  __syncthreads();
}

DI void gsync(cg::grid_group& grid) {
  asm volatile("s_waitcnt vmcnt(0) lgkmcnt(0)" ::: "memory");
  grid.sync();
  if (ltid() < 64) {
    __builtin_amdgcn_fence(__ATOMIC_ACQUIRE, "agent");
    asm volatile("s_waitcnt vmcnt(0)" ::: "memory");
  }
  __syncthreads();
}

__global__ void __launch_bounds__(512) fwd_megakernel(Params p) {
  __shared__ __attribute__((aligned(16))) char lds[131072];
  __shared__ uint4 xb_words;
  cg::grid_group grid = cg::this_grid();
  if (threadIdx.x == 0) xb_words = make_uint4(0u, 0u, 0u, 0u);
  __syncthreads();
  const XcdBarrier xb = xcd_barrier_post((unsigned*)(p.ws + OFF_BAR), (volatile LAS unsigned*)&xb_words);
  phase0(p, lds);
  gsync(grid);
  for (int l = 0; l < 4; ++l) {
    const int nrows2 = (l < 3) ? MALL : ML;
#ifdef PROBE_SYNC10
    for (int q = 0; q < 10; ++q) xcd_barrier(xb);
#endif
#ifdef PROBE_FILT
    filter_tiles(p, l, LSEQ, 2 * FFTN, (float*)(p.ws + OFF_KF), (float*)(p.ws + OFF_PART), (float*)lds);
    xcd_barrier(xb);
    phase_filter_fft(p, l, (float*)lds);
    xcd_barrier(xb);
#endif
    phase_rownorm(p, l, 0, MALL);
#ifdef PROBE_ELEM
    phase_rownorm(p, l, 0, MALL);
    phase_rownorm(p, l, 0, MALL);
    phase_rownorm(p, l, 0, MALL);
#endif
    filter_tiles(p, l, LSEQ, 2 * FFTN, (float*)(p.ws + OFF_KF), (float*)(p.ws + OFF_PART), (float*)lds);
    if (l < 3) filter_tiles(p, l, LCTX, 512, (float*)(p.ws + OFF_KC), (float*)(p.ws + OFF_PART) + 128 * 1024, (float*)lds);
    xcd_barrier(xb);
    phase_gemm1(p, l, (u16*)lds);
#ifdef PROBE_GEMMS
    phase_gemm1(p, l, (u16*)lds);
#endif
    phase_filter_fft(p, l, (float*)lds);
    xcd_barrier(xb);
    phase_h1(p, l, (float*)lds);
#ifdef PROBE_ELEM
    phase_h1(p, l, (float*)lds);
#endif
    phase_p3(p, l, (float*)lds);
    xcd_barrier(xb);
    phase_h2(p, l, (float*)lds);
    xcd_barrier(xb);
#ifdef PROBE_H2
    phase_h1(p, l, (float*)lds);
    xcd_barrier(xb);
    phase_h2(p, l, (float*)lds);
    xcd_barrier(xb);
#endif
    phase_h3(p, l, (float*)lds);
#ifdef PROBE_ELEM
    phase_h3(p, l, (float*)lds);
#endif
    xcd_barrier(xb);
    phase_p4(p, l, (u16*)lds);
#ifdef PROBE_GEMMS
    phase_p4(p, l, (u16*)lds);
#endif
    xcd_barrier(xb);
    phase_p5(p, l, (float*)lds);
    xcd_barrier(xb);
    phase_attn(p, l, (u16*)lds);
#ifdef PROBE_ATTN2
    xcd_barrier(xb);
    phase_attn(p, l, (u16*)lds);
#endif
    xcd_barrier(xb);
    phase_rownorm(p, l, 0, nrows2);
    xcd_barrier(xb);
    phase_p7a(p, l, nrows2, (u16*)lds);
#ifdef PROBE_GEMMS
    phase_p7a(p, l, nrows2, (u16*)lds);
#endif
    xcd_barrier(xb);
    phase_p7b(p, l, nrows2, (u16*)lds);
#ifdef PROBE_GEMMS
    phase_p7b(p, l, nrows2, (u16*)lds);
#endif
    xcd_barrier(xb);
    phase_p8(p, l, nrows2, (u16*)lds);
    xcd_barrier(xb);
    phase_rownorm(p, l, 1, nrows2);
    xcd_barrier(xb);
    phase_p10(p, l, nrows2, (u16*)lds);
#if defined(PROBE_P10X2) || defined(PROBE_GEMMS)
    xcd_barrier(xb);
    phase_p10(p, l, nrows2, (u16*)lds);
#endif
    xcd_barrier(xb);
    phase_p11(p, l, nrows2, (u16*)lds);
    xcd_barrier(xb);
  }
}

extern "C" void kernel_launch(void* const* d_in, const int* in_sizes, int n_in, void* d_out, int out_size, void* d_ws,
                              size_t ws_size, hipStream_t stream) {
  static int grid_blocks = 0;
  if (!grid_blocks) {
    int dev = 0, cus = 0, per_cu = 0;
    hipGetDevice(&dev);
    hipDeviceGetAttribute(&cus, hipDeviceAttributeMultiprocessorCount, dev);
    hipOccupancyMaxActiveBlocksPerMultiprocessor(&per_cu, fwd_megakernel, 512, 0);
    if (per_cu < 1) per_cu = 1;
    if (per_cu > 1) per_cu = 1;
    grid_blocks = cus * per_cu;
  }
  Params p{};
  const float** pp = (const float**)&p;
  for (int i = 0; i < 30; ++i) pp[i] = (const float*)d_in[i];
  p.out = (float*)d_out;
  p.ws = (char*)d_ws;
  hipMemsetAsync((char*)d_ws + OFF_BAR, 0, XCD_BAR_WORDS * sizeof(unsigned), stream);
  void* args[] = {&p};
  hipError_t e = hipLaunchCooperativeKernel((void*)fwd_megakernel, dim3(grid_blocks), dim3(512), args, 0, stream);
  if (e != hipSuccess) fprintf(stderr, "cooperative launch failed: %s (grid %d)\n", hipGetErrorString(e), grid_blocks);
}
```

```cpp
#include <hip/hip_runtime.h>
#include <hip/hip_cooperative_groups.h>
#include <cstdio>
namespace cg = cooperative_groups;

typedef unsigned short u16;
typedef short bf16x8 __attribute__((ext_vector_type(8)));
typedef float f32x16 __attribute__((ext_vector_type(16)));
typedef unsigned u32x4 __attribute__((ext_vector_type(4)));
#define VLOAD16(ptr) __builtin_bit_cast(uint4, *(const volatile u32x4*)(ptr))
typedef __bf16 bf16x2_t __attribute__((ext_vector_type(2)));
typedef float f32x2_t __attribute__((ext_vector_type(2)));
#define DI __device__ __forceinline__
#define MFMA(a, b, c) __builtin_amdgcn_mfma_f32_32x32x16_bf16((a), (b), (c), 0, 0, 0)

#define DM 1024
#define NBATCH 8
#define LSEQ 8192
#define LCTX 256
#define ML 65536
#define MC 2048
#define MALL 67584
#define NIN 6048
#define FFTN 16384
#define EPSV 1e-6f
#define LOG2E 1.4426950408889634f

#define W_LAYER 17858560ull
#define WO_T1 0ull
#define WO_TG 3145728ull
#define WO_QB 6291456ull
#define WO_KVB 6586368ull
#define WO_BR 6848512ull
#define WO_OUT 8421376ull
#define WO_W1 9469952ull
#define WO_W2 13664256ull
#define OFF_W 0ull
#define OFF_CTX 142868480ull
#define OFF_KF 151257088ull
#define OFF_KC 218365952ull
#define OFF_MODS 219414528ull
#define OFF_SUMSQ 220299264ull
#define OFF_ROPEG 220315648ull
#define OFF_ROPEM 222412800ull
#define OFF_TW 223461376ull
#define OFF_A 223592448ull
#define OFF_B 362004480ull
#define OFF_C 431210496ull
#define OFF_R 569622528ull
#define OFF_Y 777240576ull
#define OFF_KM (OFF_A + 242221056ull)
#define OFF_PART 984858624ull
#define ZC_OFF 33554432

struct Params {
  const float *x, *c, *ctx, *c_ctx, *w_mod, *b_mod, *norm_mix_g, *norm_mlp_g, *w_in, *hy_short_w, *hy_f1_w, *hy_f1_b,
      *hy_f2_w, *hy_f2_b, *hy_sin_freq, *hy_f3_w, *hy_skip, *gqa_q_norm, *gqa_k_norm, *gqa_sink, *mla_q_a_norm,
      *mla_kv_a_norm, *w_q_b, *w_kv_b, *mla_q_norm, *mla_k_norm, *w_branch, *w_out, *w_mlp1, *w_mlp2;
  float* out;
  char* ws;
};

DI int ltid() { int t = threadIdx.x; asm volatile("" : "+v"(t)); return t; }
DI int lbid() { int t = blockIdx.x; asm volatile("" : "+s"(t)); return t; }
DI u16 f2bf(float x) { return __builtin_bit_cast(u16, (__bf16)x); }
DI float bf2f(u16 v) { return __uint_as_float(((unsigned)v) << 16); }
DI unsigned pk2(float a, float b) {
  f32x2_t f = {a, b};
  return __builtin_bit_cast(unsigned, __builtin_convertvector(f, bf16x2_t));
}
DI float wave_sum(float v) {
#pragma unroll
  for (int o = 32; o > 0; o >>= 1) v += __shfl_xor(v, o);
  return v;
}
DI float sigmoidf_(float x) { return 1.0f / (1.0f + __expf(-x)); }
DI const float* mods_ptr(const Params& p, int l, int mrow, int j) {
  return (const float*)(p.ws + OFF_MODS) + ((size_t)(l * 9 + mrow) * 6144 + j * 1024);
}

template <bool LOWREG = false>
DI void gemm_mainloop(const u16* __restrict__ Ag, int lda, const u16* __restrict__ Bg, int ldb, int K,
                      f32x16 (&acc)[2][2], u16* lds) {
  const int tid = ltid(), lane = tid & 63, w = tid >> 6, l32 = lane & 31, hh = lane >> 5;
  const int wm = w >> 1, wn = w & 1;
  u16* As = lds;
  u16* Bs = lds + 2 * 256 * 72;
  const int arow = tid >> 3, ach = tid & 7;
  const u16* ap = Ag + (size_t)arow * lda + ach * 8;
  const u16* bp = Bg + (size_t)arow * ldb + ach * 8;
  const int nk = K >> 6;
  uint4 ra0[4], rb0[2], ra1[4], rb1[2];
#define G_LOAD(RA, RB, T)                                                                   \
  {                                                                                         \
    const int t_ = ((T) < nk) ? (T) : nk - 1;                                               \
    _Pragma("unroll") for (int i = 0; i < 4; ++i) RA[i] = VLOAD16(ap + (size_t)(64 * i) * lda + 64 * t_); \
    _Pragma("unroll") for (int i = 0; i < 2; ++i) RB[i] = VLOAD16(bp + (size_t)(64 * i) * ldb + 64 * t_); \
  }
#define G_STORE(RA, RB, BUF)                                                                \
  {                                                                                         \
    u16* Aw = As + (BUF) * 256 * 72;                                                        \
    u16* Bw = Bs + (BUF) * 128 * 72;                                                        \
    _Pragma("unroll") for (int i = 0; i < 4; ++i) *(uint4*)(Aw + (arow + 64 * i) * 72 + ach * 8) = RA[i]; \
    _Pragma("unroll") for (int i = 0; i < 2; ++i) *(uint4*)(Bw + (arow + 64 * i) * 72 + ach * 8) = RB[i]; \
  }
#define G_COMPUTE(BUF, RA, RB, WBUF)                                                        \
  {                                                                                         \
    const u16* as = As + (BUF) * 256 * 72 + (wm * 64 + l32) * 72 + hh * 8;                  \
    const u16* bs = Bs + (BUF) * 128 * 72 + (wn * 64 + l32) * 72 + hh * 8;                  \
    u16* Aw = As + (WBUF) * 256 * 72 + arow * 72 + ach * 8;                                 \
    u16* Bw = Bs + (WBUF) * 128 * 72 + arow * 72 + ach * 8;                                 \
    _Pragma("unroll") for (int s = 0; s < 4; ++s) {                                         \
      bf16x8 a0 = *(const bf16x8*)(as + s * 16), a1 = *(const bf16x8*)(as + 32 * 72 + s * 16); \
      bf16x8 b0 = *(const bf16x8*)(bs + s * 16), b1 = *(const bf16x8*)(bs + 32 * 72 + s * 16); \
      acc[0][0] = MFMA(a0, b0, acc[0][0]);                                                  \
      acc[0][1] = MFMA(a0, b1, acc[0][1]);                                                  \
      acc[1][0] = MFMA(a1, b0, acc[1][0]);                                                  \
      acc[1][1] = MFMA(a1, b1, acc[1][1]);                                                  \
      if (s == 0) { *(uint4*)(Aw) = RA[0]; *(uint4*)(Aw + 64 * 72) = RA[1]; }               \
      if (s == 1) { *(uint4*)(Aw + 128 * 72) = RA[2]; *(uint4*)(Aw + 192 * 72) = RA[3]; }   \
      if (s == 2) { *(uint4*)(Bw) = RB[0]; *(uint4*)(Bw + 64 * 72) = RB[1]; }               \
      if (LOWREG) __builtin_amdgcn_sched_barrier(0);                                        \
    }                                                                                       \
  }
  G_LOAD(ra0, rb0, 0);
  G_LOAD(ra1, rb1, 1);
  __builtin_amdgcn_sched_barrier(0);
  G_STORE(ra0, rb0, 0);
  __syncthreads();
  for (int kt = 0; kt < nk; kt += 2) {
    G_LOAD(ra0, rb0, kt + 2);
    __builtin_amdgcn_sched_barrier(0);
    G_COMPUTE(0, ra1, rb1, 1);
    __syncthreads();
    G_LOAD(ra1, rb1, kt + 3);
    __builtin_amdgcn_sched_barrier(0);
    G_COMPUTE(1, ra0, rb0, 0);
    __syncthreads();
  }
#undef G_LOAD
#undef G_STORE
#undef G_COMPUTE
}

DI int xcd_remap(int it) { const int r = it & 255; return (it & ~255) + ((r & 7) << 5) + (r >> 3); }

#define ACC_ZERO(acc)                                                                      \
  _Pragma("unroll") for (int mi_ = 0; mi_ < 2; ++mi_) _Pragma("unroll") for (int ni_ = 0; ni_ < 2; ++ni_) \
      _Pragma("unroll") for (int r_ = 0; r_ < 16; ++r_) acc[mi_][ni_][r_] = 0.f;

#define ACC_FOREACH(acc, m0, n0, BODY)                                                     \
  {                                                                                        \
    const int lane_ = ltid() & 63, w_ = ltid() >> 6;                             \
    const int l32_ = lane_ & 31, hh_ = lane_ >> 5, wm_ = w_ >> 1, wn_ = w_ & 1;            \
    _Pragma("unroll") for (int mi_ = 0; mi_ < 2; ++mi_) _Pragma("unroll") for (int ni_ = 0; ni_ < 2; ++ni_) { \
        __builtin_amdgcn_sched_barrier(0);                                                 \
        _Pragma("unroll") for (int r_ = 0; r_ < 16; ++r_) {                                \
      const int row = (m0) + wm_ * 64 + mi_ * 32 + (r_ & 3) + 8 * (r_ >> 2) + 4 * hh_;     \
      const int col = (n0) + wn_ * 64 + ni_ * 32 + l32_;                                   \
      const float val = acc[mi_][ni_][r_];                                                    \
      BODY                                                                                 \
    } }                                                                                    \
  }

DI void stage_store_bf16(f32x16 (&acc)[2][2], u16* __restrict__ dst, int ld, int m0, int c0, u16* lds) {
  u16* cs = lds;
  ACC_FOREACH(acc, 0, 0, { cs[row * 136 + col] = f2bf(val); });
  __syncthreads();
  const int tid = ltid();
#pragma unroll
  for (int i = 0; i < 8; ++i) {
    const int ch = tid + 512 * i, rr = ch >> 4, c16 = ch & 15;
    const uint4 v = *(const uint4*)(cs + rr * 136 + c16 * 8);
    *(uint4*)(dst + (size_t)(m0 + rr) * ld + c0 + c16 * 8) = v;
  }
  __syncthreads();
}

namespace pg8 {
#define PG8_LAS __attribute__((address_space(3)))
typedef unsigned short bf16_t;
typedef short bf16x8 __attribute__((ext_vector_type(8)));
typedef float f32x4 __attribute__((ext_vector_type(4)));
typedef unsigned u32x4 __attribute__((ext_vector_type(4)));
constexpr int BM = 256, BK = 64, HALF = 128, HTB = HALF * BK * 2  , STAGE_BYTES = 8 * HTB, NXCD = 8, WGM = 8;

__host__ __device__ __forceinline__ int lds_byte(int r, int c) { const int st = (r >> 4) * 2 + (c >> 5), rr = r & 15, cc = c & 31, ob = rr * 64 + cc * 2; return st * 1024 + (ob ^ (((ob >> 9) & 1) << 5)); }
__host__ __device__ __forceinline__ void stage_rc(int b, int& R, int& C) { const int st = b / 1024, sb = b % 1024, swz = sb ^ (((sb >> 9) & 1) << 5); R = (st >> 1) * 16 + swz / 64; C = (st & 1) * 32 + (swz % 64) / 2; }
__host__ __device__ __forceinline__ int perm32(int rho) { const int n = rho >> 4, i = rho & 15; return 8 * (i >> 2) + 4 * n + (i & 3); }

struct Unit { int pm, pn; };
struct Gemm { const bf16_t* A; const bf16_t* Bt; int M, N, K, lda; };

struct StaticOrder {
    int nM, nN, nwg, G, c;
    __host__ __device__ void init(int M, int N, int G_, int c_) { nM = M / BM; nN = N / BM; nwg = nM * nN; G = G_; c = c_; }
    __host__ __device__ bool next(int i, Unit& u) const {
        const long L = (long)i * G + c; if (L >= nwg) return false;
        int wgid = (int)L; { const int q = nwg / NXCD, r = nwg % NXCD, xcd = wgid % NXCD, off = wgid / NXCD; wgid = (xcd < r ? xcd * (q + 1) : r * (q + 1) + (xcd - r) * q) + off; }
        const int nig = WGM * nN, gid = wgid / nig, fm = gid * WGM, gsz = (nM - fm) < WGM ? (nM - fm) : WGM;
        u.pm = fm + ((wgid % nig) % gsz); u.pn = (wgid % nig) / gsz; return true;
    }
    __device__ __forceinline__ void a_ready(const Unit&) const {}
    __device__ __forceinline__ void done(const Unit&) const {}
};
template <class Epi, class Sched, bool STAMP = false>
__device__ __forceinline__ void gemm_phase(PG8_LAS unsigned char* lds, const Gemm g, const Sched& S, const Epi& E, unsigned long long* stamps) {
    const int tid = ltid(), wid = __builtin_amdgcn_readfirstlane(tid >> 6), lane = tid & 63, wr = wid >> 2, wc = wid & 3, fr = lane & 15, fq = lane >> 4;
    const int K = g.K, nt = K / BK;
    int ts_lo = 0, ts_hi = 0, nts = 0; const unsigned long long rt_entry = STAMP ? (unsigned long long)wall_clock64() : 0ull;
#define PG8_STAMP() do { if (STAMP && wid == 0 && nts < 64) { const unsigned long long _c = (unsigned long long)clock64(); \
        ts_lo = (lane == nts) ? (int)(unsigned)_c : ts_lo; ts_hi = (lane == nts) ? (int)(unsigned)(_c >> 32) : ts_hi; ++nts; } } while (0)
    PG8_STAMP();
    unsigned voffA[2], voffB[2];
#pragma unroll
    for (int i = 0; i < 2; ++i) { int R, C; stage_rc(tid * 16 + i * 8192, R, C); const int Rb = Epi::PERM ? ((R & ~31) + perm32(R & 31)) : R;
        voffA[i] = (unsigned)(R * g.lda + C) * 2u; voffB[i] = (unsigned)(Rb * K + C) * 2u; }
    const size_t kstep = (size_t)(BK * 2);
    const size_t hstep = (size_t)HALF * K * 2;
    const size_t tstep = 2 * hstep;
    const size_t hstepA = (size_t)HALF * g.lda * 2, tstepA = 2 * hstepA;
    const unsigned ldsw = (unsigned)wid * 1024u;
    const int aoff = lds_byte(wr * 64 + fr, fq * 8), boff = lds_byte(wc * 32 + fr, fq * 8);
#define PG8_SA(b, h) (((b) * 2 + (h)) * HTB)
#define PG8_SB(b, h) ((4 + (b) * 2 + (h)) * HTB)
#define PG8_STAGE(bufoff, gbase, voff) do { _Pragma("unroll") for (int _i = 0; _i < 2; ++_i) \
        __builtin_amdgcn_global_load_lds((const unsigned*)((const char*)(gbase) + (voff)[_i]), (PG8_LAS unsigned*)(lds + (bufoff) + ldsw + _i * 8192), 16, 0, 0); } while (0)
#define PG8_LDA(dst, b, h) do { _Pragma("unroll") for (int m = 0; m < 4; ++m) _Pragma("unroll") for (int k = 0; k < 2; ++k) dst[m][k] = *(const PG8_LAS bf16x8*)(lds + PG8_SA(b, h) + aoff + m * 2048 + k * 1024); } while (0)
#define PG8_LDB(dst, b, h) do { _Pragma("unroll") for (int n = 0; n < 2; ++n) _Pragma("unroll") for (int k = 0; k < 2; ++k) dst[n][k] = *(const PG8_LAS bf16x8*)(lds + PG8_SB(b, h) + boff + n * 2048 + k * 1024); } while (0)
#define PG8_MMA(ai, bj, At, Bt) do { __builtin_amdgcn_s_setprio(1); _Pragma("unroll") for (int m = 0; m < 4; ++m) _Pragma("unroll") for (int n = 0; n < 2; ++n) _Pragma("unroll") for (int k = 0; k < 2; ++k) \
        acc[ai][bj][m][n] = __builtin_amdgcn_mfma_f32_16x16x32_bf16(Bt[n][k], At[m][k], acc[ai][bj][m][n], 0, 0, 0); __builtin_amdgcn_s_setprio(0); } while (0)
#define PG8_WAIT_V(n) asm volatile("s_waitcnt vmcnt(" #n ")" ::: "memory")
#define PG8_WAIT_L(n) asm volatile("s_waitcnt lgkmcnt(" #n ")" ::: "memory")
#define PG8_BAR __builtin_amdgcn_s_barrier()
#define PG8_SCHED __builtin_amdgcn_sched_barrier(0)
    Unit cur, nxt; int ui = 0;
    if (!S.next(0, cur)) return;
    f32x4 acc[2][2][4][2];
#pragma unroll
    for (int a = 0; a < 2; ++a)
#pragma unroll
        for (int b = 0; b < 2; ++b)
#pragma unroll
            for (int m = 0; m < 4; ++m)
#pragma unroll
                for (int n = 0; n < 2; ++n) acc[a][b][m][n] = (f32x4){0.f, 0.f, 0.f, 0.f};
    bf16x8 At[4][2], B0[2][2], B1[2][2];
    const char* cA = (const char*)g.A + (size_t)cur.pm * tstepA; const char* cB = (const char*)g.Bt + (size_t)cur.pn * tstep;
    S.a_ready(cur);
    PG8_STAGE(PG8_SB(0, 0), cB, voffB); PG8_STAGE(PG8_SA(0, 0), cA, voffA); PG8_STAGE(PG8_SB(0, 1), cB + hstep, voffB); PG8_STAGE(PG8_SA(0, 1), cA + hstepA, voffA);
    if (wr == 1) PG8_BAR;
    PG8_WAIT_V(4); PG8_BAR;
    PG8_STAGE(PG8_SB(1, 0), cB + kstep, voffB); PG8_STAGE(PG8_SA(1, 0), cA + kstep, voffA); PG8_STAGE(PG8_SB(1, 1), cB + hstep + kstep, voffB);
    PG8_WAIT_V(6); PG8_BAR;
    PG8_STAMP();
    for (;;) {
        const bool has_next = S.next(ui + 1, nxt);
        const char* nA = has_next ? (const char*)g.A + (size_t)nxt.pm * tstepA : cA; const char* nB = has_next ? (const char*)g.Bt + (size_t)nxt.pn * tstep : cB;
        for (int t = 0; t < nt; t += 2) {
            const bool last = (t == nt - 2);
            const char* a1 = cA + (size_t)(t + 1) * kstep;
            const char* a2 = last ? nA : cA + (size_t)(t + 2) * kstep; const char* b2 = last ? nB : cB + (size_t)(t + 2) * kstep;
            const char* a3 = a2 + kstep; const char* b3 = b2 + kstep;
            if (last && has_next) S.a_ready(nxt);
            PG8_LDB(B0, 0, 0); PG8_SCHED; PG8_LDA(At, 0, 0); PG8_STAGE(PG8_SA(1, 1), a1 + hstepA, voffA);
            PG8_WAIT_L(8); PG8_BAR; PG8_WAIT_L(0); PG8_MMA(0, 0, At, B0); PG8_BAR; PG8_SCHED;
            PG8_LDB(B1, 0, 1); PG8_STAGE(PG8_SB(0, 0), b2, voffB);
            PG8_BAR; PG8_WAIT_L(0); PG8_MMA(0, 1, At, B1); PG8_BAR;
            PG8_LDA(At, 0, 1); PG8_STAGE(PG8_SA(0, 0), a2, voffA);
            PG8_BAR; PG8_WAIT_L(0); PG8_MMA(1, 0, At, B0); PG8_BAR; PG8_SCHED;
            PG8_STAGE(PG8_SB(0, 1), b2 + hstep, voffB);
            PG8_WAIT_V(6); PG8_BAR; PG8_MMA(1, 1, At, B1); PG8_BAR;
            PG8_LDB(B0, 1, 0); PG8_SCHED; PG8_LDA(At, 1, 0); PG8_STAGE(PG8_SA(0, 1), a2 + hstepA, voffA);
            PG8_WAIT_L(8); PG8_BAR; PG8_WAIT_L(0); PG8_MMA(0, 0, At, B0); PG8_BAR; PG8_SCHED;
            PG8_LDB(B1, 1, 1); PG8_STAGE(PG8_SB(1, 0), b3, voffB);
            PG8_BAR; PG8_WAIT_L(0); PG8_MMA(0, 1, At, B1); PG8_BAR;
            PG8_LDA(At, 1, 1); PG8_STAGE(PG8_SA(1, 0), a3, voffA);
            PG8_BAR; PG8_WAIT_L(0); PG8_MMA(1, 0, At, B0); PG8_BAR; PG8_SCHED;
            PG8_STAGE(PG8_SB(1, 1), b3 + hstep, voffB);
            PG8_WAIT_V(6); PG8_BAR; PG8_MMA(1, 1, At, B1); PG8_BAR;
        }
        PG8_STAMP();
        if constexpr (!Epi::AFTER_DRAIN) { E(acc, cur, wr, wc, fr, fq); S.done(cur); }
        PG8_STAMP();
        if (!has_next) break;
#pragma unroll
        for (int a = 0; a < 2; ++a)
#pragma unroll
            for (int b = 0; b < 2; ++b)
#pragma unroll
                for (int m = 0; m < 4; ++m)
#pragma unroll
                    for (int n = 0; n < 2; ++n) acc[a][b][m][n] = (f32x4){0.f, 0.f, 0.f, 0.f};
        cur = nxt; cA = nA; cB = nB; ++ui;
    }
    PG8_WAIT_V(0);
    if (wr == 0) PG8_BAR;
    PG8_BAR;
    if constexpr (Epi::AFTER_DRAIN) { E.fused(acc, cur, wr, wc, fr, fq, lds, wid, lane); S.done(cur); }
    PG8_STAMP();
    if (STAMP && wid == 0) { stamps[lane] = lane < nts ? (((unsigned long long)(unsigned)ts_hi << 32) | (unsigned)ts_lo) : 0ull;
        if (lane == 62) stamps[62] = rt_entry; if (lane == 63) stamps[63] = (unsigned long long)wall_clock64(); }
#undef PG8_STAMP
#undef PG8_SA
#undef PG8_SB
#undef PG8_STAGE
#undef PG8_LDA
#undef PG8_LDB
#undef PG8_MMA
#undef PG8_WAIT_V
#undef PG8_WAIT_L
#undef PG8_BAR
#undef PG8_SCHED
}
}

DI uint4 pack8_bf16(const pg8::f32x4& v0, const pg8::f32x4& v1) {
  uint4 w; w.x = pk2(v0[0], v0[1]); w.y = pk2(v0[2], v0[3]); w.z = pk2(v1[0], v1[1]); w.w = pk2(v1[2], v1[3]); return w;
}
struct EpiRouteBf16 {
  static constexpr bool PERM = true, AFTER_DRAIN = false;
  char* ws;
  DI void operator()(const pg8::f32x4 (&acc)[2][2][4][2], const pg8::Unit& u, int wr, int wc, int fr, int fq) const {
    const int row0 = u.pm * 256 + wr * 64 + fr;
    u16* base; int ld, colt;
    if (u.pn < 2) { base = (u16*)(ws + OFF_B); ld = 512; colt = u.pn * 256; }
    else if (u.pn < 6) { base = (u16*)(ws + OFF_C); ld = 1024; colt = u.pn * 256 - 512; }
    else { base = (u16*)(ws + OFF_R); ld = 1536; colt = u.pn * 256 - 1536; }
    const int col0 = colt + wc * 32 + 8 * fq;
#pragma unroll
    for (int ai = 0; ai < 2; ++ai)
#pragma unroll
      for (int m = 0; m < 4; ++m) {
        u16* rowp = base + (size_t)(row0 + ai * 128 + m * 16) * ld + col0;
#pragma unroll
        for (int bj = 0; bj < 2; ++bj) *(uint4*)(rowp + bj * 128) = pack8_bf16(acc[ai][bj][m][0], acc[ai][bj][m][1]);
      }
  }
};
template <int ACT  > struct EpiActBf16 {
  static constexpr bool PERM = true, AFTER_DRAIN = false;
  u16* O; int ldc;
  DI void operator()(const pg8::f32x4 (&acc)[2][2][4][2], const pg8::Unit& u, int wr, int wc, int fr, int fq) const {
    const int row0 = u.pm * 256 + wr * 64 + fr, col0 = u.pn * 256 + wc * 32 + 8 * fq;
#pragma unroll
    for (int ai = 0; ai < 2; ++ai)
#pragma unroll
      for (int m = 0; m < 4; ++m) {
        u16* rowp = O + (size_t)(row0 + ai * 128 + m * 16) * ldc + col0;
#pragma unroll
        for (int bj = 0; bj < 2; ++bj) {
          pg8::f32x4 v0 = acc[ai][bj][m][0], v1 = acc[ai][bj][m][1];
#pragma unroll
          for (int j = 0; j < 4; ++j) {
            if (ACT == 1) { v0[j] = sigmoidf_(v0[j]); v1[j] = sigmoidf_(v1[j]); }
            else if (ACT == 2) { const float a = fmaxf(v0[j], 0.f), b = fmaxf(v1[j], 0.f); v0[j] = a * a; v1[j] = b * b; }
          }
          *(uint4*)(rowp + bj * 128) = pack8_bf16(v0, v1);
        }
      }
  }
};
struct EpiResid {
  static constexpr bool PERM = false, AFTER_DRAIN = false;
  const float* xs; const float* cs; float* xo; float* co; const float* gbase;
  DI void operator()(const pg8::f32x4 (&acc)[2][2][4][2], const pg8::Unit& u, int wr, int wc, int fr, int fq) const {
    const int rowt = u.pm * 256;
    const int row0 = rowt + wr * 64 + fr, col0 = u.pn * 256 + wc * 32 + 4 * fq;
    const bool lat = rowt < ML;
    const int mrow = lat ? (rowt >> 13) : 8;
    const float* gate = gbase + (size_t)mrow * 6144;
    const float* src = lat ? xs : cs - (size_t)ML * 1024;
    float* dst = lat ? xo : co - (size_t)ML * 1024;
    pg8::f32x4 gv[2][2];
#pragma unroll
    for (int bj = 0; bj < 2; ++bj)
#pragma unroll
      for (int n = 0; n < 2; ++n) gv[bj][n] = *(const pg8::f32x4*)(gate + col0 + bj * 128 + n * 16);
#pragma unroll
    for (int ai = 0; ai < 2; ++ai)
#pragma unroll
      for (int m = 0; m < 4; ++m) {
        const size_t off = (size_t)(row0 + ai * 128 + m * 16) * 1024 + col0;
#pragma unroll
        for (int bj = 0; bj < 2; ++bj)
#pragma unroll
          for (int n = 0; n < 2; ++n) {
            const pg8::f32x4 xv = *(const pg8::f32x4*)(src + off + bj * 128 + n * 16);
            *(pg8::f32x4*)(dst + off + bj * 128 + n * 16) = xv + gv[bj][n] * acc[ai][bj][m][n];
          }
      }
  }
};
template <class Epi>
DI void run_gemm256(const u16* A, const u16* Bt, int M, int N, int K, const Epi& E, char* lds, int lda = 0) {
  pg8::Gemm g; g.A = A; g.Bt = Bt; g.M = M; g.N = N; g.K = K; g.lda = lda ? lda : K;
  pg8::StaticOrder S; S.init(M, N, (int)gridDim.x, lbid());
  pg8::gemm_phase<Epi, pg8::StaticOrder, false>((PG8_LAS unsigned char*)lds, g, S, E, nullptr);
  __syncthreads();
}

DI void conv_job(const float* __restrict__ src, int ld, int K, int col0, int nvalid, int npad, u16* __restrict__ dst,
                 int& off, float* ts) {
  const int tid = ltid();
  const int tk = K >> 6, tn = npad >> 6, ntiles = tk * tn;
  const int G = gridDim.x;
  int first = ((int)lbid() - (off % G) + G) % G;
  for (int tile = first; tile < ntiles; tile += G) {
    const int k0 = (tile % tk) * 64, n0 = (tile / tk) * 64;
    {
      const int cc = tid & 63, rg = tid >> 6;
      const bool ok = (n0 + cc) < nvalid;
#pragma unroll
      for (int i = 0; i < 8; ++i) {
        const int rr = rg * 8 + i;
        ts[rr * 65 + cc] = ok ? src[(size_t)(k0 + rr) * ld + col0 + n0 + cc] : 0.f;
      }
    }
    __syncthreads();
    {
      const int kk = tid & 63, ng = tid >> 6;
#pragma unroll
      for (int i = 0; i < 8; ++i) {
        const int nn = ng * 8 + i;
        dst[(size_t)(n0 + nn) * K + k0 + kk] = f2bf(ts[kk * 65 + nn]);
      }
    }
    __syncthreads();
  }
  off += ntiles;
}

DI void phase0(const Params& p, char* ldsc) {
  float* ldsf = (float*)ldsc;
  const int tid = ltid();
  const int G = gridDim.x;
  int off = 0;
  for (int l = 0; l < 4; ++l) {
    u16* wl = (u16*)(p.ws + OFF_W) + (size_t)l * W_LAYER;
    conv_job(p.w_in + (size_t)l * 1024 * NIN, NIN, 1024, 0, 2976, 3072, wl + WO_T1, off, ldsf);
    conv_job(p.w_in + (size_t)l * 1024 * NIN, NIN, 1024, 2976, 3072, 3072, wl + WO_TG, off, ldsf);
    conv_job(p.w_q_b + (size_t)l * 384 * 768, 768, 384, 0, 768, 768, wl + WO_QB, off, ldsf);
    conv_job(p.w_kv_b + (size_t)l * 256 * 1024, 1024, 256, 0, 1024, 1024, wl + WO_KVB, off, ldsf);
    for (int nb = 0; nb < 3; ++nb)
      conv_job(p.w_branch + (size_t)(l * 3 + nb) * 512 * 1024, 1024, 512, 0, 1024, 1024, wl + WO_BR + (size_t)nb * 1024 * 512, off, ldsf);
    conv_job(p.w_out + (size_t)l * 1024 * 1024, 1024, 1024, 0, 1024, 1024, wl + WO_OUT, off, ldsf);
    conv_job(p.w_mlp1 + (size_t)l * 1024 * 4096, 4096, 1024, 0, 4096, 4096, wl + WO_W1, off, ldsf);
    conv_job(p.w_mlp2 + (size_t)l * 4096 * 1024, 1024, 4096, 0, 1024, 1024, wl + WO_W2, off, ldsf);
  }
  {
    float* sc = ldsf;
    float* red = ldsf + 9 * 1024;
    for (int i = tid; i < 9 * 1024; i += 512) {
      float v = (i < 8 * 1024) ? p.c[i] : p.c_ctx[i - 8 * 1024];
      sc[i] = v / (1.0f + expf(-v));
    }
    __syncthreads();
    float* mods = (float*)(p.ws + OFF_MODS);
    const int ol = tid & 63, kg = tid >> 6;
    for (int item = lbid(); item < 384; item += G) {
      const int l = item / 96, o = (item % 96) * 64 + ol;
      const float* wp = p.w_mod + (size_t)l * 1024 * 6144 + o;
      float acc[9];
#pragma unroll
      for (int b = 0; b < 9; ++b) acc[b] = 0.f;
#pragma unroll 4
      for (int k = kg * 128; k < kg * 128 + 128; ++k) {
        const float wv = wp[(size_t)k * 6144];
#pragma unroll
        for (int b = 0; b < 9; ++b) acc[b] += sc[b * 1024 + k] * wv;
      }
#pragma unroll
      for (int b = 0; b < 9; ++b) red[(kg * 9 + b) * 64 + ol] = acc[b];
      __syncthreads();
      for (int i = tid; i < 576; i += 512) {
        const int b = i >> 6, o2 = i & 63;
        float s = 0.f;
#pragma unroll
        for (int g = 0; g < 8; ++g) s += red[(g * 9 + b) * 64 + o2];
        const int oc = (item % 96) * 64 + o2;
        mods[(size_t)(l * 9 + b) * 6144 + oc] = s + p.b_mod[l * 6144 + oc];
      }
      __syncthreads();
    }
  }
  {
    const int gt = lbid() * 512 + tid, GT = G * 512;
    float* rg = (float*)(p.ws + OFF_ROPEG);
    float* rm = (float*)(p.ws + OFF_ROPEM);
    float* tw = (float*)(p.ws + OFF_TW);
    for (int i = gt; i < LSEQ * 32; i += GT) {
      const int t = i >> 5, a = i & 31;
      const float pos = (a < 16) ? (float)(t >> 6) : (float)(t & 63);
      const float inv = powf(10000.0f, -(float)(a & 15) / 16.0f);
      const float ang = pos * inv;
      rg[2 * i] = cosf(ang);
      rg[2 * i + 1] = sinf(ang);
    }
    for (int i = gt; i < LSEQ * 16; i += GT) {
      const int t = i >> 4, a = i & 15;
      const float pos = (a < 8) ? (float)(t >> 6) : (float)(t & 63);
      const float inv = powf(10000.0f, -(float)(a & 7) / 8.0f);
      const float ang = pos * inv;
      rm[2 * i] = cosf(ang);
      rm[2 * i + 1] = sinf(ang);
    }
    for (int i = gt; i < FFTN; i += GT) {
      float sn, cs;
      sincospif(2.0f * (float)i / (float)FFTN, &sn, &cs);
      tw[2 * i] = cs;
      tw[2 * i + 1] = -sn;
    }
  }
}

DI void phase_rownorm(const Params& p, int l, int which, int nrows) {
  const int tid = ltid(), lane = tid & 63, w = tid >> 6;
  u16* hn = (u16*)(p.ws + OFF_A);
  const float* g = (which ? p.norm_mlp_g : p.norm_mix_g) + l * 1024;
  const bool first = (which == 0 && l == 0);
  const float* xs = first ? p.x : p.out;
  const float* cs = first ? p.ctx : (const float*)(p.ws + OFF_CTX);
  const int stride = gridDim.x * 8;
  for (int r = lbid() * 8 + w; r < nrows; r += 2 * stride) {
    int rr[2]; rr[0] = r; rr[1] = r + stride;
    const bool has2 = rr[1] < nrows;
    if (!has2) rr[1] = r;
    rr[0] = __builtin_amdgcn_readfirstlane(rr[0]);
    rr[1] = __builtin_amdgcn_readfirstlane(rr[1]);
    float4 v[2][4];
    float ss[2] = {0.f, 0.f};
#pragma unroll
    for (int q = 0; q < 2; ++q) {
      const float* src = (rr[q] < ML) ? xs + (size_t)rr[q] * 1024 : cs + (size_t)(rr[q] - ML) * 1024;
#pragma unroll
      for (int i = 0; i < 4; ++i) v[q][i] = *(const float4*)(src + 4 * (lane + 64 * i));
    }
#pragma unroll
    for (int q = 0; q < 2; ++q) {
#pragma unroll
      for (int i = 0; i < 4; ++i) ss[q] += v[q][i].x * v[q][i].x + v[q][i].y * v[q][i].y + v[q][i].z * v[q][i].z + v[q][i].w * v[q][i].w;
      ss[q] = wave_sum(ss[q]);
    }
#pragma unroll
    for (int q = 0; q < 2; ++q) {
      if (q == 1 && !has2) break;
      const int mrow = (rr[q] < ML) ? (rr[q] >> 13) : 8;
      const float* shift = mods_ptr(p, l, mrow, which ? 3 : 0);
      const float* scale = mods_ptr(p, l, mrow, which ? 4 : 1);
      const float rstd = rsqrtf(ss[q] * (1.0f / 1024.0f) + EPSV);
#pragma unroll
      for (int i = 0; i < 4; ++i) {
        const int c0 = 4 * (lane + 64 * i);
        const float4 gg = *(const float4*)(g + c0), sh = *(const float4*)(shift + c0), sc = *(const float4*)(scale + c0);
        const float o0 = v[q][i].x * rstd * gg.x * (1.f + sc.x) + sh.x;
        const float o1 = v[q][i].y * rstd * gg.y * (1.f + sc.y) + sh.y;
        const float o2 = v[q][i].z * rstd * gg.z * (1.f + sc.z) + sh.z;
        const float o3 = v[q][i].w * rstd * gg.w * (1.f + sc.w) + sh.w;
        uint2 pk;
        pk.x = pk2(o0, o1);
        pk.y = pk2(o2, o3);
        *(uint2*)(hn + (size_t)rr[q] * 1024 + c0) = pk;
      }
    }
  }
}

DI void filter_tiles(const Params& p, int l, int Lf, int cstride, float* __restrict__ kdst, float* __restrict__ part, float* lds) {
  const int tid = ltid(), lane = tid & 63, w = tid >> 6;
  float* zs = lds;
  float* h1s = lds + 64 * 33;
  float* h2s = h1s + 64 * 65;
  float* w3s = h2s + 64 * 65;
  const float* f1w = p.hy_f1_w + l * 33 * 64;
  const float* f1b = p.hy_f1_b + l * 64;
  const float* f2w = p.hy_f2_w + l * 64 * 64;
  const float* f2b = p.hy_f2_b + l * 64;
  const float* sf = p.hy_sin_freq + l * 128;
  const float* f3w = p.hy_f3_w + (size_t)l * 64 * 1024;
  const int nitem = (Lf >> 6) * 4;
  const float min_decay = logf(1e-2f) / 1.5f, max_decay = logf(1e-2f) / 0.3f;
  for (int item = lbid(); item < nitem; item += gridDim.x) {
    const int tile = item >> 2, quarter = item & 3;
    const int t0 = tile * 64;
    for (int idx = tid; idx < 64 * 33; idx += 512) {
      const int tt = idx / 33, e = idx - tt * 33;
      const int t = t0 + tt;
      float val;
      if (e == 0) {
        val = (float)t / (float)(Lf - 1);
      } else {
        const float wt = 6.283185307179586f * (float)t / (float)Lf;
        const int bi = (e - 1) & 15;
        const float f = 1e-4f + (float)bi * ((15.0f - 1e-4f) / 15.0f);
        val = (e <= 16) ? cosf(f * wt) : -sinf(f * wt);
      }
      zs[idx] = val;
    }
    for (int idx = tid; idx < 64 * 64; idx += 512) {
      const int i = idx >> 6, c4 = (idx & 63) * 4;
      *(float4*)(w3s + i * 256 + c4) = *(const float4*)(f3w + i * 1024 + quarter * 256 + c4);
    }
    __syncthreads();
    {
      const int tt = tid & 63, jg = tid >> 6;
#pragma unroll 1
      for (int jj = 0; jj < 8; ++jj) {
        const int j = jg * 8 + jj;
        float a = f1b[j];
#pragma unroll 3
        for (int e = 0; e < 33; ++e) a += zs[tt * 33 + e] * f1w[e * 64 + j];
        h1s[tt * 65 + j] = sinf(sf[j] * a);
      }
    }
    __syncthreads();
    {
      const int tt = tid & 63, jg = tid >> 6;
#pragma unroll 1
      for (int jj = 0; jj < 8; ++jj) {
        const int j = jg * 8 + jj;
        float a = f2b[j];
#pragma unroll 4
        for (int e = 0; e < 64; ++e) a += h1s[tt * 65 + e] * f2w[e * 64 + j];
        h2s[tt * 65 + j] = sinf(sf[64 + j] * a);
      }
    }
    __syncthreads();
    {
      const int tt = lane, t = t0 + tt;
      const float tn = (float)t / (float)(Lf - 1);
#pragma unroll 1
      for (int ob = w * 32; ob < w * 32 + 32; ob += 16) {
        float acc[16];
#pragma unroll
        for (int q = 0; q < 16; ++q) acc[q] = 0.f;
#pragma unroll 4
        for (int i = 0; i < 64; ++i) {
          const float hv = h2s[tt * 65 + i];
          const float* wr = w3s + i * 256 + ob;
#pragma unroll
          for (int q4 = 0; q4 < 4; ++q4) {
            const float4 wv = *(const float4*)(wr + 4 * q4);
            acc[4 * q4] += hv * wv.x; acc[4 * q4 + 1] += hv * wv.y; acc[4 * q4 + 2] += hv * wv.z; acc[4 * q4 + 3] += hv * wv.w;
          }
        }
#pragma unroll
        for (int q = 0; q < 16; ++q) {
          const int o = quarter * 256 + ob + q, dir = o >> 9, c = o & 511;
          const float delta = fabsf(min_decay + (float)c * ((max_decay - min_decay) / 511.0f));
          float val = acc[q] * expf(-tn * delta);
          int pos;
          if (dir == 0) pos = t;
          else if (t == 0) { pos = Lf; val = 0.f; }
          else pos = 2 * Lf - t;
          kdst[(size_t)c * cstride + pos] = val;
          const float s2 = wave_sum(val * val);
          if (lane == 0) part[tile * 1024 + o] = s2;
        }
      }
    }
    __syncthreads();
  }
}

DI int fsw(int i) { return (i & ~15) | ((((i >> 2) + (i >> 6)) & 3) << 2) | (i & 3); }

DI void r16_fwd(float (&xr)[16], float (&xi)[16]) {
#pragma unroll
  for (int st = 0; st < 2; ++st) {
    const int q = (st == 0) ? 4 : 1;
#pragma unroll
    for (int bi = 0; bi < 4; ++bi) {
      const int j = bi & (q - 1), g = bi / q;
      const int i0 = g * 4 * q + j, i1 = i0 + q, i2 = i1 + q, i3 = i2 + q;
      const float ar = xr[i0], ai = xi[i0], br = xr[i1], bi_ = xi[i1], cr = xr[i2], ci = xi[i2], dr = xr[i3], di = xi[i3];
      const float t0r = ar + cr, t0i = ai + ci, t1r = ar - cr, t1i = ai - ci;
      const float t2r = br + dr, t2i = bi_ + di;
      const float er = br - dr, ei = bi_ - di;
      const float t3r = ei, t3i = -er;
      const float y1r = t1r + t3r, y1i = t1i + t3i, y2r = t0r - t2r, y2i = t0i - t2i, y3r = t1r - t3r, y3i = t1i - t3i;
      xr[i0] = t0r + t2r; xi[i0] = t0i + t2i;
      if (q == 1 || j == 0) {
        xr[i1] = y1r; xi[i1] = y1i; xr[i2] = y2r; xi[i2] = y2i; xr[i3] = y3r; xi[i3] = y3i;
      } else {
        const float ang = -6.283185307179586f * (float)j / (float)(4 * q);
        const float w1r = __builtin_cosf(ang), w1i = __builtin_sinf(ang);
        const float w2r = __builtin_cosf(2.f * ang), w2i = __builtin_sinf(2.f * ang);
        const float w3r = __builtin_cosf(3.f * ang), w3i = __builtin_sinf(3.f * ang);
        xr[i1] = y1r * w1r - y1i * w1i; xi[i1] = y1r * w1i + y1i * w1r;
        xr[i2] = y2r * w2r - y2i * w2i; xi[i2] = y2r * w2i + y2i * w2r;
        xr[i3] = y3r * w3r - y3i * w3i; xi[i3] = y3r * w3i + y3i * w3r;
      }
    }
  }
}
DI void r16_inv(float (&xr)[16], float (&xi)[16]) {
#pragma unroll
  for (int st = 0; st < 2; ++st) {
    const int q = (st == 0) ? 1 : 4;
#pragma unroll
    for (int bi = 0; bi < 4; ++bi) {
      const int j = bi & (q - 1), g = bi / q;
      const int i0 = g * 4 * q + j, i1 = i0 + q, i2 = i1 + q, i3 = i2 + q;
      const float ar = xr[i0], ai = xi[i0];
      float br = xr[i1], bi_ = xi[i1], cr = xr[i2], ci = xi[i2], dr = xr[i3], di = xi[i3];
      if (!(q == 1 || j == 0)) {
        const float ang = 6.283185307179586f * (float)j / (float)(4 * q);
        const float w1r = __builtin_cosf(ang), w1i = __builtin_sinf(ang);
        const float w2r = __builtin_cosf(2.f * ang), w2i = __builtin_sinf(2.f * ang);
        const float w3r = __builtin_cosf(3.f * ang), w3i = __builtin_sinf(3.f * ang);
        const float b0 = br, c0 = cr, d0 = dr;
        br = b0 * w1r - bi_ * w1i; bi_ = b0 * w1i + bi_ * w1r;
        cr = c0 * w2r - ci * w2i;  ci = c0 * w2i + ci * w2r;
        dr = d0 * w3r - di * w3i;  di = d0 * w3i + di * w3r;
      }
      const float t0r = ar + cr, t0i = ai + ci, t1r = ar - cr, t1i = ai - ci;
      const float t2r = br + dr, t2i = bi_ + di;
      const float er = br - dr, ei = bi_ - di;
      const float t3r = -ei, t3i = er;
      xr[i0] = t0r + t2r; xi[i0] = t0i + t2i;
      xr[i1] = t1r + t3r; xi[i1] = t1i + t3i;
      xr[i2] = t0r - t2r; xi[i2] = t0i - t2i;
      xr[i3] = t1r - t3r; xi[i3] = t1i - t3i;
    }
  }
}

template <bool INV>
DI void fft_lds_stage(float* re, float* im, const float2* __restrict__ tw, const int s) {
  const int tid = ltid();
  const int qs = 12 - 2 * s;
  const int q = 1 << qs;
  float2 wb = tw[(tid & (q - 1)) << (2 * s)];
  if (INV) wb.y = -wb.y;
  float vr[8][4], vi[8][4];
  int idx[8][4];
#pragma unroll
  for (int k = 0; k < 8; ++k) {
    const int bi = tid + 512 * k;
    const int j = bi & (q - 1), g = bi >> qs;
    const int l0 = (g << (qs + 2)) + j;
#pragma unroll
    for (int m = 0; m < 4; ++m) { idx[k][m] = fsw(l0 + m * q); vr[k][m] = re[idx[k][m]]; vi[k][m] = im[idx[k][m]]; }
  }
#pragma unroll
  for (int k = 0; k < 8; ++k) {
    const int delta = (512 * k) & (q - 1);
    const float ang = (INV ? 6.283185307179586f : -6.283185307179586f) * (float)(delta << (2 * s)) / 16384.0f;
    const float cr_ = __builtin_cosf(ang), ci_ = __builtin_sinf(ang);
    const float w1r = (delta == 0) ? wb.x : wb.x * cr_ - wb.y * ci_;
    const float w1i = (delta == 0) ? wb.y : wb.x * ci_ + wb.y * cr_;
    const float w2r = w1r * w1r - w1i * w1i, w2i = 2.f * w1r * w1i;
    const float w3r = w2r * w1r - w2i * w1i, w3i = w2r * w1i + w2i * w1r;
    if (!INV) {
      const float ar = vr[k][0], ai = vi[k][0], br = vr[k][1], bi_ = vi[k][1], cr = vr[k][2], ci = vi[k][2], dr = vr[k][3], di = vi[k][3];
      const float t0r = ar + cr, t0i = ai + ci, t1r = ar - cr, t1i = ai - ci;
      const float t2r = br + dr, t2i = bi_ + di;
      const float er = br - dr, ei = bi_ - di;
      const float t3r = ei, t3i = -er;
      const float y1r = t1r + t3r, y1i = t1i + t3i, y2r = t0r - t2r, y2i = t0i - t2i, y3r = t1r - t3r, y3i = t1i - t3i;
      re[idx[k][0]] = t0r + t2r; im[idx[k][0]] = t0i + t2i;
      re[idx[k][1]] = y1r * w1r - y1i * w1i; im[idx[k][1]] = y1r * w1i + y1i * w1r;
      re[idx[k][2]] = y2r * w2r - y2i * w2i; im[idx[k][2]] = y2r * w2i + y2i * w2r;
      re[idx[k][3]] = y3r * w3r - y3i * w3i; im[idx[k][3]] = y3r * w3i + y3i * w3r;
    } else {
      const float ar = vr[k][0], ai = vi[k][0];
      const float br = vr[k][1] * w1r - vi[k][1] * w1i, bi_ = vr[k][1] * w1i + vi[k][1] * w1r;
      const float cr = vr[k][2] * w2r - vi[k][2] * w2i, ci = vr[k][2] * w2i + vi[k][2] * w2r;
      const float dr = vr[k][3] * w3r - vi[k][3] * w3i, di = vr[k][3] * w3i + vi[k][3] * w3r;
      const float t0r = ar + cr, t0i = ai + ci, t1r = ar - cr, t1i = ai - ci;
      const float t2r = br + dr, t2i = bi_ + di;
      const float er = br - dr, ei = bi_ - di;
      const float t3r = -ei, t3i = er;
      re[idx[k][0]] = t0r + t2r; im[idx[k][0]] = t0i + t2i;
      re[idx[k][1]] = t1r + t3r; im[idx[k][1]] = t1i + t3i;
      re[idx[k][2]] = t0r - t2r; im[idx[k][2]] = t0i - t2i;
      re[idx[k][3]] = t1r - t3r; im[idx[k][3]] = t1i - t3i;
    }
  }
  __syncthreads();
}
DI void fft_fwd4(float* re, float* im, const float2* __restrict__ tw) {
  fft_lds_stage<false>(re, im, tw, 0);
  fft_lds_stage<false>(re, im, tw, 1);
  fft_lds_stage<false>(re, im, tw, 2);
  fft_lds_stage<false>(re, im, tw, 3);
  fft_lds_stage<false>(re, im, tw, 4);
}
DI void fft_inv4(float* re, float* im, const float2* __restrict__ tw) {
  fft_lds_stage<true>(re, im, tw, 4);
  fft_lds_stage<true>(re, im, tw, 3);
  fft_lds_stage<true>(re, im, tw, 2);
  fft_lds_stage<true>(re, im, tw, 1);
  fft_lds_stage<true>(re, im, tw, 0);
}
DI void r16_load(const float* re, const float* im, int b, float (&xr)[16], float (&xi)[16]) {
#pragma unroll
  for (int c = 0; c < 4; ++c) {
    const int ph = 16 * b + 4 * ((c + (b >> 2)) & 3);
    const float4 vr = *(const float4*)(re + ph), vi = *(const float4*)(im + ph);
    xr[4 * c] = vr.x; xr[4 * c + 1] = vr.y; xr[4 * c + 2] = vr.z; xr[4 * c + 3] = vr.w;
    xi[4 * c] = vi.x; xi[4 * c + 1] = vi.y; xi[4 * c + 2] = vi.z; xi[4 * c + 3] = vi.w;
  }
}
DI void r16_store(float* re, float* im, int b, const float (&xr)[16], const float (&xi)[16]) {
#pragma unroll
  for (int c = 0; c < 4; ++c) {
    const int ph = 16 * b + 4 * ((c + (b >> 2)) & 3);
    *(float4*)(re + ph) = make_float4(xr[4 * c], xr[4 * c + 1], xr[4 * c + 2], xr[4 * c + 3]);
    *(float4*)(im + ph) = make_float4(xi[4 * c], xi[4 * c + 1], xi[4 * c + 2], xi[4 * c + 3]);
  }
}

DI void phase_filter_fft(const Params& p, int l, float* lds) {
  const int tid = ltid();
  float* re = lds;
  float* im = lds + FFTN;
  float* kf = (float*)(p.ws + OFF_KF);
  const float2* tw = (const float2*)(p.ws + OFF_TW);
  const float* part = (const float*)(p.ws + OFF_PART);
  for (int c = lbid(); c < 512; c += gridDim.x) {
    float* slot = kf + (size_t)c * (2 * FFTN);
    float pv = 0.f;
    if (tid < 128) pv = part[tid * 1024 + c] + part[tid * 1024 + 512 + c];
    pv = wave_sum(pv);
    if ((tid & 63) == 0) lds[tid >> 6] = pv;
    __syncthreads();
    const float ssq = lds[0] + lds[1];
    __syncthreads();
    const float sc = rsqrtf(ssq + EPSV) * (1.0f / (float)FFTN);
    for (int i = tid; i < FFTN; i += 512) { const int ph = fsw(i); re[ph] = slot[i] * sc; im[ph] = 0.f; }
    __syncthreads();
    fft_fwd4(re, im, tw);
    {
      float2* so = (float2*)slot;
#pragma unroll 1
      for (int b = tid; b < 1024; b += 512) {
        float xr[16], xi[16];
        r16_load(re, im, b, xr, xi);
        r16_fwd(xr, xi);
#pragma unroll
        for (int e = 0; e < 16; ++e) { float2 v; v.x = xr[e]; v.y = xi[e]; so[e * 1024 + b] = v; }
      }
    }
    __syncthreads();
  }
}

DI void phase_gemm1(const Params& p, int l, u16* lds) {
  const u16* hn = (const u16*)(p.ws + OFF_A);
  const u16* wt = (const u16*)(p.ws + OFF_W) + (size_t)l * W_LAYER + WO_T1;
  const int NT = 24, nitems = (MALL / 256) * NT;
  for (int it_ = lbid(); it_ < ((nitems + 255) & ~255); it_ += gridDim.x) {
    const int item = xcd_remap(it_);
    if (item >= nitems) continue;
    const int mt = item / NT, nt = item % NT;
    const int m0 = mt * 256, n0 = nt * 128;
    f32x16 acc[2][2];
    ACC_ZERO(acc);
    gemm_mainloop(hn + (size_t)m0 * 1024, 1024, wt + (size_t)n0 * 1024, 1024, 1024, acc, lds);
    u16* dst; int ld, cofs;
    if (nt < 4) { dst = (u16*)(p.ws + OFF_B); ld = 512; cofs = 0; }
    else if (nt < 12) { dst = (u16*)(p.ws + OFF_C); ld = 1024; cofs = 512; }
    else { dst = (u16*)(p.ws + OFF_R); ld = 1536; cofs = 1536; }
    stage_store_bf16(acc, dst, ld, m0, n0 - cofs, lds);
  }
}

DI void phase_h1(const Params& p, int l, float* lds) {
  const int tid = ltid();
  const u16* U12 = (const u16*)(p.ws + OFF_C);
  float* zT = (float*)(p.ws + OFF_A);
  const float* sw = p.hy_short_w + l * 3 * 1536;
  const int nlat = 8 * 128 * 8, nctx = (l < 3) ? 8 * 4 * 8 : 0;
  int par = 0;
  for (int item = lbid(); item < nlat + nctx; item += gridDim.x) {
    float* xs = lds + par * (2 * 66 * 65);
    float* vs = xs + 66 * 65;
    par ^= 1;
    int b, tt0, c0, Ls, rowbase; size_t zbase;
    if (item < nlat) { b = item >> 10; tt0 = ((item >> 3) & 127) * 64; c0 = (item & 7) * 64; Ls = LSEQ; rowbase = b * LSEQ; zbase = (size_t)b * 512 * LSEQ; }
    else { const int it = item - nlat; b = it >> 5; tt0 = ((it >> 3) & 3) * 64; c0 = (it & 7) * 64; Ls = LCTX; rowbase = ML + b * LCTX; zbase = (size_t)ZC_OFF + (size_t)b * 512 * LCTX; }
    for (int ch = tid; ch < 66 * 16; ch += 512) {
      const int arr = ch / 528, rem = ch - arr * 528;
      const int rr = rem >> 3, cc8 = (rem & 7) * 8;
      const int t = tt0 - 1 + rr;
      float* dstp = (arr ? vs : xs) + rr * 65 + cc8;
      if (t >= 0 && t < Ls) {
        const uint4 v = *(const uint4*)(U12 + (size_t)(rowbase + t) * 1024 + arr * 512 + c0 + cc8);
        const unsigned uu[4] = {v.x, v.y, v.z, v.w};
#pragma unroll
        for (int i = 0; i < 4; ++i) { dstp[2 * i] = __uint_as_float(uu[i] << 16); dstp[2 * i + 1] = __uint_as_float(uu[i] & 0xffff0000u); }
      } else {
#pragma unroll
        for (int i = 0; i < 8; ++i) dstp[i] = 0.f;
      }
    }
    __syncthreads();
    {
      const int tt = tid & 63, cgp = tid >> 6;
#pragma unroll
      for (int i = 0; i < 8; ++i) {
        const int cc = cgp * 8 + i, c = c0 + cc;
        float x1 = 0.f, vv = 0.f;
#pragma unroll
        for (int j = 0; j < 3; ++j) {
          x1 += sw[j * 1536 + 512 + c] * xs[(tt + j) * 65 + cc];
          vv += sw[j * 1536 + 1024 + c] * vs[(tt + j) * 65 + cc];
        }
        zT[zbase + (size_t)c * Ls + tt0 + tt] = x1 * vv;
      }
    }
  }
  __syncthreads();
}

DI void phase_p3(const Params& p, int l, float* lds) {
  const int tid = ltid(), lane = tid & 63, w = tid >> 6;
  u16* R = (u16*)(p.ws + OFF_R);
  float* rb = lds + w * 1472;
  float* hs = rb + 1440;
  const float* qn = p.gqa_q_norm + l * 64;
  const float* kn = p.gqa_k_norm + l * 64;
  const float* qan = p.mla_q_a_norm + l * 384;
  const float* kvan = p.mla_kv_a_norm + l * 256;
  const float* ropeg = (const float*)(p.ws + OFF_ROPEG);
  const float qscale = 0.125f * LOG2E;
  const int rstride = gridDim.x * 8;
  uint4 nv[3];
  {
    const u16* np_ = R + (size_t)(lbid() * 8 + w) * 1536;
#pragma unroll
    for (int i = 0; i < 3; ++i) { const int ch = lane + 64 * i; nv[i] = (ch < 180) ? *(const uint4*)(np_ + ch * 8) : make_uint4(0u, 0u, 0u, 0u); }
  }
  for (int r0 = lbid() * 8; r0 < MALL; r0 += rstride) {
    const int r = r0 + w;
    u16* rowp = R + (size_t)r * 1536;
#pragma unroll
    for (int i = 0; i < 3; ++i) {
      const int ch = lane + 64 * i;
      if (ch < 180) {
        const unsigned uu[4] = {nv[i].x, nv[i].y, nv[i].z, nv[i].w};
#pragma unroll
        for (int k = 0; k < 4; ++k) { rb[ch * 8 + 2 * k] = __uint_as_float(uu[k] << 16); rb[ch * 8 + 2 * k + 1] = __uint_as_float(uu[k] & 0xffff0000u); }
      }
    }
    if (r + rstride < MALL) {
      const u16* np_ = R + (size_t)(r + rstride) * 1536;
#pragma unroll
      for (int i = 0; i < 3; ++i) { const int ch = lane + 64 * i; if (ch < 180) nv[i] = VLOAD16(np_ + ch * 8); }
    }
    __builtin_amdgcn_wave_barrier();
    {
      float s = 0.f;
#pragma unroll
      for (int i = 0; i < 8; ++i) { const float v = rb[lane * 8 + i]; s += v * v; }
      s += __shfl_xor(s, 1); s += __shfl_xor(s, 2); s += __shfl_xor(s, 4);
      if ((lane & 7) == 0) hs[lane >> 3] = rsqrtf(s * (1.0f / 64.0f) + EPSV);
      float s2 = 0.f;
      if (lane < 16) {
#pragma unroll
        for (int i = 0; i < 8; ++i) { const float v = rb[512 + lane * 8 + i]; s2 += v * v; }
      }
      s2 += __shfl_xor(s2, 1); s2 += __shfl_xor(s2, 2); s2 += __shfl_xor(s2, 4);
      if (lane < 16 && (lane & 7) == 0) hs[8 + (lane >> 3)] = rsqrtf(s2 * (1.0f / 64.0f) + EPSV);
      float s3 = 0.f, s4 = 0.f;
#pragma unroll
      for (int i = 0; i < 6; ++i) { const float v = rb[768 + lane * 6 + i]; s3 += v * v; }
#pragma unroll
      for (int i = 0; i < 4; ++i) { const float v = rb[1152 + lane * 4 + i]; s4 += v * v; }
      s3 = wave_sum(s3); s4 = wave_sum(s4);
      if (lane == 0) { hs[10] = rsqrtf(s3 * (1.0f / 384.0f) + EPSV); hs[11] = rsqrtf(s4 * (1.0f / 256.0f) + EPSV); }
    }
    __builtin_amdgcn_wave_barrier();
    {
      const bool lat = r < ML;
      const int t = r & (LSEQ - 1);
      const int d = lane, a = d & 31;
      float cs = 1.f, sn = 0.f;
      if (lat) { cs = ropeg[(t * 32 + a) * 2]; sn = ropeg[(t * 32 + a) * 2 + 1]; }
#pragma unroll
      for (int hd = 0; hd < 10; ++hd) {
        const float* gq = (hd < 8) ? qn : kn;
        const float rs = hs[hd];
        const float v = rb[hd * 64 + d] * rs * gq[d];
        const int dp = d ^ 32;
        const float vp = rb[hd * 64 + dp] * rs * gq[dp];
        float o = (d < 32) ? (v * cs - vp * sn) : (vp * sn + v * cs);
        if (hd < 8) o *= qscale;
        rowp[hd * 64 + d] = f2bf(o);
      }
#pragma unroll
      for (int i = 0; i < 6; ++i) { const int e = lane + 64 * i; rowp[768 + e] = f2bf(rb[768 + e] * hs[10] * qan[e]); }
#pragma unroll
      for (int i = 0; i < 4; ++i) { const int e = lane + 64 * i; rowp[1152 + e] = f2bf(rb[1152 + e] * hs[11] * kvan[e]); }
    }
    __builtin_amdgcn_wave_barrier();
  }
}

DI void phase_h2(const Params& p, int l, float* lds) {
  const int tid = ltid(), lane = tid & 63, w = tid >> 6;
  float* zT = (float*)(p.ws + OFF_A);
  const float2* kf = (const float2*)(p.ws + OFF_KF);
  const float2* tw = (const float2*)(p.ws + OFF_TW);
  const float* skip = p.hy_skip + l * 512;
  float* re = lds;
  float* im = lds + FFTN;
  float za[16], zb[16], na[16], nb_[16];
  {
    const int it0 = lbid();
    if (it0 < 2048) {
      const int c0 = it0 >> 2, bp0 = it0 & 3;
      const float* s1 = zT + ((size_t)(2 * bp0) * 512 + c0) * LSEQ;
      const float* s2 = zT + ((size_t)(2 * bp0 + 1) * 512 + c0) * LSEQ;
#pragma unroll
      for (int k = 0; k < 16; ++k) { na[k] = s1[tid + 512 * k]; nb_[k] = s2[tid + 512 * k]; }
    }
  }
  for (int item = lbid(); item < 2048; item += gridDim.x) {
    const int c = item >> 2, bp = item & 3;
    float* z1 = zT + ((size_t)(2 * bp) * 512 + c) * LSEQ;
    float* z2 = zT + ((size_t)(2 * bp + 1) * 512 + c) * LSEQ;
#pragma unroll
    for (int k = 0; k < 16; ++k) {
      const int i = tid + 512 * k;
      za[k] = na[k]; zb[k] = nb_[k];
      const int p0 = fsw(i), p1 = fsw(i + LSEQ);
      re[p0] = za[k]; im[p0] = zb[k]; re[p1] = 0.f; im[p1] = 0.f;
    }
    __syncthreads();
    fft_fwd4(re, im, tw);
    {
      const float2* kc = kf + (size_t)c * FFTN;
#pragma unroll 1
      for (int b = tid; b < 1024; b += 512) {
        float xr[16], xi[16];
        r16_load(re, im, b, xr, xi);
        r16_fwd(xr, xi);
#pragma unroll
        for (int e = 0; e < 16; ++e) {
          const float2 k = kc[e * 1024 + b];
          const float a = xr[e], b2 = xi[e];
          xr[e] = a * k.x - b2 * k.y;
          xi[e] = a * k.y + b2 * k.x;
        }
        r16_inv(xr, xi);
        r16_store(re, im, b, xr, xi);
      }
    }
    {
      const int nit = item + gridDim.x;
      if (nit < 2048) {
        const int cn = nit >> 2, bpn = nit & 3;
        const float* s1 = zT + ((size_t)(2 * bpn) * 512 + cn) * LSEQ;
        const float* s2 = zT + ((size_t)(2 * bpn + 1) * 512 + cn) * LSEQ;
#pragma unroll
        for (int k = 0; k < 16; ++k) {
          na[k] = __builtin_bit_cast(float, *(const volatile unsigned*)(s1 + tid + 512 * k));
          nb_[k] = __builtin_bit_cast(float, *(const volatile unsigned*)(s2 + tid + 512 * k));
        }
      }
    }
    __syncthreads();
    fft_inv4(re, im, tw);
    const float sk = skip[c];
#pragma unroll
    for (int k = 0; k < 16; ++k) {
      const int i = tid + 512 * k;
      const int p0 = fsw(i);
      z1[i] = re[p0] + za[k] * sk;
      z2[i] = im[p0] + zb[k] * sk;
    }
    __syncthreads();
  }
  if (l < 3) {
    const float* kcb = (const float*)(p.ws + OFF_KC);
    const float* partc = (const float*)(p.ws + OFF_PART) + 128 * 1024;
    float* zs = lds + w * 768;
    float* ks = zs + 256;
    for (int item = lbid(); item < 512; item += gridDim.x) {
      const int b = item >> 6, c = (item & 63) * 8 + w;
      float* z = zT + (size_t)ZC_OFF + ((size_t)b * 512 + c) * LCTX;
      float pv = (lane < 4) ? partc[lane * 1024 + c] + partc[lane * 1024 + 512 + c] : 0.f;
      pv = wave_sum(pv);
      const float sc = rsqrtf(pv + EPSV);
      for (int i = lane; i < 256; i += 64) zs[i] = z[i];
      for (int i = lane; i < 512; i += 64) ks[i] = kcb[c * 512 + i] * sc;
      __syncthreads();
      const float sk = skip[c];
      float acc[4] = {0.f, 0.f, 0.f, 0.f};
      for (int s = 0; s < 256; ++s) {
        const float zv = zs[s];
#pragma unroll
        for (int i = 0; i < 4; ++i) acc[i] += ks[(lane + 64 * i - s) & 511] * zv;
      }
#pragma unroll
      for (int i = 0; i < 4; ++i) z[lane + 64 * i] = acc[i] + zs[lane + 64 * i] * sk;
      __syncthreads();
    }
  }
}

DI void phase_h3(const Params& p, int l, float* lds) {
  const int tid = ltid();
  const u16* U0 = (const u16*)(p.ws + OFF_B);
  const float* zT = (const float*)(p.ws + OFF_A);
  u16* Y = (u16*)(p.ws + OFF_Y);
  const float* sw = p.hy_short_w + l * 3 * 1536;
  const int nlat = 8 * 128 * 8, nctx = (l < 3) ? 8 * 4 * 8 : 0;
  int par = 0;
  for (int item = lbid(); item < nlat + nctx; item += gridDim.x) {
    float* xs = lds + par * (66 * 65 + 64 * 65);
    float* ys = xs + 66 * 65;
    par ^= 1;
    int b, tt0, c0, Ls, rowbase; size_t zbase;
    if (item < nlat) { b = item >> 10; tt0 = ((item >> 3) & 127) * 64; c0 = (item & 7) * 64; Ls = LSEQ; rowbase = b * LSEQ; zbase = (size_t)b * 512 * LSEQ; }
    else { const int it = item - nlat; b = it >> 5; tt0 = ((it >> 3) & 3) * 64; c0 = (it & 7) * 64; Ls = LCTX; rowbase = ML + b * LCTX; zbase = (size_t)ZC_OFF + (size_t)b * 512 * LCTX; }
    for (int ch = tid; ch < 66 * 8; ch += 512) {
      const int rr = ch >> 3, cc8 = (ch & 7) * 8;
      const int t = tt0 - 1 + rr;
      float* dstp = xs + rr * 65 + cc8;
      if (t >= 0 && t < Ls) {
        const uint4 v = *(const uint4*)(U0 + (size_t)(rowbase + t) * 512 + c0 + cc8);
        const unsigned uu[4] = {v.x, v.y, v.z, v.w};
#pragma unroll
        for (int i = 0; i < 4; ++i) { dstp[2 * i] = __uint_as_float(uu[i] << 16); dstp[2 * i + 1] = __uint_as_float(uu[i] & 0xffff0000u); }
      } else {
#pragma unroll
        for (int i = 0; i < 8; ++i) dstp[i] = 0.f;
      }
    }
    {
      const int tt = tid & 63, cgp = tid >> 6;
#pragma unroll
      for (int i = 0; i < 8; ++i) {
        const int cc = cgp * 8 + i;
        ys[cc * 65 + tt] = zT[zbase + (size_t)(c0 + cc) * Ls + tt0 + tt];
      }
    }
    __syncthreads();
    {
      const int cc = tid & 63, tg = tid >> 6, c = c0 + cc;
      const float w0 = sw[c], w1 = sw[1536 + c], w2 = sw[2 * 1536 + c];
#pragma unroll
      for (int i = 0; i < 8; ++i) {
        const int tt = tg * 8 + i;
        const float x0 = w0 * xs[tt * 65 + cc] + w1 * xs[(tt + 1) * 65 + cc] + w2 * xs[(tt + 2) * 65 + cc];
        Y[(size_t)(rowbase + tt0 + tt) * 1536 + c] = f2bf(x0 * ys[cc * 65 + tt]);
      }
    }
  }
  __syncthreads();
}

DI void phase_p4(const Params& p, int l, u16* lds) {
  const u16* R = (const u16*)(p.ws + OFF_R);
  u16* QK = (u16*)(p.ws + OFF_A);
  const u16* wl = (const u16*)(p.ws + OFF_W) + (size_t)l * W_LAYER;
  const int NT = 14, nitems = (MALL / 256) * NT;
  for (int it_ = lbid(); it_ < ((nitems + 255) & ~255); it_ += gridDim.x) {
    const int item = xcd_remap(it_);
    if (item >= nitems) continue;
    const int mt = item / NT, nt = item % NT;
    const int m0 = mt * 256;
    f32x16 acc[2][2];
    ACC_ZERO(acc);
    int n0;
    if (nt < 6) { n0 = nt * 128; gemm_mainloop(R + (size_t)m0 * 1536 + 768, 1536, wl + WO_QB + (size_t)n0 * 384, 384, 384, acc, lds); }
    else { n0 = (nt - 6) * 128; gemm_mainloop(R + (size_t)m0 * 1536 + 1152, 1536, wl + WO_KVB + (size_t)n0 * 256, 256, 256, acc, lds); n0 += 768; }
    stage_store_bf16(acc, QK, 1792, m0, n0, lds);
  }
}

DI void phase_p5(const Params& p, int l, float* lds) {
  const int tid = ltid(), lane = tid & 63, w = tid >> 6;
  u16* QK = (u16*)(p.ws + OFF_A);
  u16* KM = (u16*)(p.ws + OFF_KM);
  const u16* R = (const u16*)(p.ws + OFF_R);
  float* rb = lds + w * 1856;
  float* hs = rb + 1824;
  const float* qn = p.mla_q_norm + l * 96;
  const float* kn = p.mla_k_norm + l * 96;
  const float* ropem = (const float*)(p.ws + OFF_ROPEM);
  const float qscale = 0.10206207261596575f * LOG2E;
  const int rstride = gridDim.x * 8;
  uint4 nv[4];
  {
    const int rn = lbid() * 8 + w;
#pragma unroll
    for (int i = 0; i < 4; ++i) {
      const int ch = lane + 64 * i;
      nv[i] = (ch < 224) ? *(const uint4*)(QK + (size_t)rn * 1792 + ch * 8)
                         : (ch < 228 ? *(const uint4*)(R + (size_t)rn * 1536 + 1408 + (ch - 224) * 8) : make_uint4(0u, 0u, 0u, 0u));
    }
  }
  for (int r0 = lbid() * 8; r0 < MALL; r0 += rstride) {
    const int r = r0 + w;
    u16* rowp = QK + (size_t)r * 1792;
#pragma unroll
    for (int i = 0; i < 4; ++i) {
      const int ch = lane + 64 * i;
      if (ch < 228) {
        const unsigned uu[4] = {nv[i].x, nv[i].y, nv[i].z, nv[i].w};
#pragma unroll
        for (int k = 0; k < 4; ++k) { rb[ch * 8 + 2 * k] = __uint_as_float(uu[k] << 16); rb[ch * 8 + 2 * k + 1] = __uint_as_float(uu[k] & 0xffff0000u); }
      }
    }
    if (r + rstride < MALL) {
      const int rn = r + rstride;
#pragma unroll
      for (int i = 0; i < 4; ++i) {
        const int ch = lane + 64 * i;
        if (ch < 224) nv[i] = VLOAD16(QK + (size_t)rn * 1792 + ch * 8);
        else if (ch < 228) nv[i] = VLOAD16(R + (size_t)rn * 1536 + 1408 + (ch - 224) * 8);
      }
    }
    __builtin_amdgcn_wave_barrier();
    {
      const int hd = lane >> 3, j = lane & 7;
      float s = 0.f, s2 = 0.f;
#pragma unroll
      for (int i = 0; i < 12; ++i) {
        const int d = j * 12 + i;
        const float v = rb[hd * 96 + d];
        s += v * v;
        const float kv = (d < 64) ? rb[768 + hd * 128 + d] : rb[1792 + d - 64];
        s2 += kv * kv;
      }
      s += __shfl_xor(s, 1); s += __shfl_xor(s, 2); s += __shfl_xor(s, 4);
      s2 += __shfl_xor(s2, 1); s2 += __shfl_xor(s2, 2); s2 += __shfl_xor(s2, 4);
      if (j == 0) { hs[hd] = rsqrtf(s * (1.0f / 96.0f) + EPSV); hs[8 + hd] = rsqrtf(s2 * (1.0f / 96.0f) + EPSV); }
    }
    __builtin_amdgcn_wave_barrier();
    {
      const bool lat = r < ML;
      const int t = r & (LSEQ - 1);
#pragma unroll
      for (int i = 0; i < 12; ++i) {
        const int e = lane + 64 * i;
        const int hd = e / 96, d = e - hd * 96;
        const float rq = hs[hd], rk = hs[8 + hd];
        float qv = rb[hd * 96 + d] * rq * qn[d];
        float kv = ((d < 64) ? rb[768 + hd * 128 + d] : rb[1792 + d - 64]) * rk * kn[d];
        if (d >= 64 && lat) {
          const int a = (d - 64) & 15;
          const float cs = ropem[(t * 16 + a) * 2], sn = ropem[(t * 16 + a) * 2 + 1];
          const int dp = (d < 80) ? d + 16 : d - 16;
          const float qp = rb[hd * 96 + dp] * rq * qn[dp];
          const float kp = rb[1792 + dp - 64] * rk * kn[dp];
          if (d < 80) { qv = qv * cs - qp * sn; kv = kv * cs - kp * sn; }
          else { qv = qp * sn + qv * cs; kv = kp * sn + kv * cs; }
        }
        rowp[e] = f2bf(qv * qscale);
        KM[(size_t)r * 768 + e] = f2bf(kv);
      }
    }
    __builtin_amdgcn_wave_barrier();
  }
}

template <int DQK>
DI void attn_block(const u16* __restrict__ Qp, int q_ld, const u16* __restrict__ Kp, int k_ld, const u16* __restrict__ Vp,
                   int v_ld, u16* __restrict__ Op, int o_ld, int qrow0, int nq, int qt0, int s0_row0, int s0_n, int s0_t0,
                   int masked0, int s1_row0, int s1_n, float sink_l2, int has_sink, u16* lds) {
  constexpr int KS = DQK + 8, NS = DQK / 16, CPK = DQK / 8;
  const int tid = ltid(), lane = tid & 63, w = tid >> 6, l32 = lane & 31, hh = lane >> 5;
  u16* Ks = lds;
  u16* Vt = lds + 2 * 64 * KS;
  bf16x8 qf[2][NS];
  f32x16 ot[2][2];
  float m[2], lsum[2];
#pragma unroll
  for (int qs = 0; qs < 2; ++qs) {
    const int qi = 64 * w + 32 * qs + l32;
    const int qr = qrow0 + ((qi < nq) ? qi : nq - 1);
#pragma unroll
    for (int s = 0; s < NS; ++s) qf[qs][s] = *(const bf16x8*)(Qp + (size_t)qr * q_ld + 16 * s + 8 * hh);
#pragma unroll
    for (int i = 0; i < 16; ++i) { ot[qs][0][i] = 0.f; ot[qs][1][i] = 0.f; }
    m[qs] = -1e30f; lsum[qs] = 0.f;
  }
  const int nt0 = s0_n >> 6, nt = nt0 + (s1_n >> 6);
  const int kkey0 = tid / CPK, kch0 = tid - kkey0 * CPK;
  const int c1 = tid + 512;
  const bool has1 = c1 < 64 * CPK;
  const int kkey1 = has1 ? c1 / CPK : 0, kch1 = has1 ? c1 - kkey1 * CPK : 0;
  const int vkey = tid & 63, vch = tid >> 6;
  uint4 rk0, rk1, rv;
  rk1 = make_uint4(0, 0, 0, 0);
  {
    const int row0 = (0 < nt0) ? s0_row0 : s1_row0;
    rk0 = *(const uint4*)(Kp + (size_t)(row0 + kkey0) * k_ld + kch0 * 8);
    if (has1) rk1 = *(const uint4*)(Kp + (size_t)(row0 + kkey1) * k_ld + kch1 * 8);
    rv = *(const uint4*)(Vp + (size_t)(row0 + vkey) * v_ld + vch * 8);
  }
  {
    *(uint4*)(Ks + kkey0 * KS + kch0 * 8) = rk0;
    if (has1) *(uint4*)(Ks + kkey1 * KS + kch1 * 8) = rk1;
    const unsigned uu[4] = {rv.x, rv.y, rv.z, rv.w};
#pragma unroll
    for (int i = 0; i < 4; ++i) {
      Vt[(vch * 8 + 2 * i) * 68 + vkey] = (u16)(uu[i] & 0xffffu);
      Vt[(vch * 8 + 2 * i + 1) * 68 + vkey] = (u16)(uu[i] >> 16);
    }
  }
  __syncthreads();
  const int tql = qt0 + 64 * w;
  for (int j = 0; j < nt; ++j) {
    const int cur = j & 1;
    {
      const int jn = (j + 1 < nt) ? j + 1 : j;
      const int row0 = (jn < nt0) ? s0_row0 + 64 * jn : s1_row0 + 64 * (jn - nt0);
      rk0 = VLOAD16(Kp + (size_t)(row0 + kkey0) * k_ld + kch0 * 8);
      if (DQK == 96) rk1 = VLOAD16(Kp + (size_t)(row0 + kkey1) * k_ld + kch1 * 8);
      rv = VLOAD16(Vp + (size_t)(row0 + vkey) * v_ld + vch * 8);
    }
    __builtin_amdgcn_sched_barrier(0);
    const bool mtile = masked0 && (j < nt0);
    const int tk0 = s0_t0 + 64 * j;
    bool active = true;
    if (mtile) active = (tk0 + 63 >= tql - 128) && (tk0 <= tql + 63 + 128);
    if (active) {
      const u16* kb = Ks + cur * 64 * KS + l32 * KS + hh * 8;
      f32x16 st[2][2];
#pragma unroll
      for (int i = 0; i < 16; ++i) { st[0][0][i] = 0.f; st[0][1][i] = 0.f; st[1][0][i] = 0.f; st[1][1][i] = 0.f; }
#pragma unroll
      for (int s = 0; s < NS; ++s) {
        const bf16x8 a0 = *(const bf16x8*)(kb + s * 16);
        const bf16x8 a1 = *(const bf16x8*)(kb + 32 * KS + s * 16);
        st[0][0] = MFMA(a0, qf[0][s], st[0][0]);
        st[0][1] = MFMA(a1, qf[0][s], st[0][1]);
        st[1][0] = MFMA(a0, qf[1][s], st[1][0]);
        st[1][1] = MFMA(a1, qf[1][s], st[1][1]);
      }
#pragma unroll
      for (int qs = 0; qs < 2; ++qs) {
        if (mtile) {
          const int tq = tql + 32 * qs + l32;
#pragma unroll
          for (int kt = 0; kt < 2; ++kt)
#pragma unroll
            for (int rg = 0; rg < 16; ++rg) {
              const int tk = tk0 + 32 * kt + (rg & 3) + 8 * (rg >> 2) + 4 * hh;
              const int dlt = tk - tq;
              if (dlt > 128 || dlt < -128) st[qs][kt][rg] = -1e30f;
            }
        }
        float mloc = st[qs][0][0];
#pragma unroll
        for (int rg = 1; rg < 16; ++rg) mloc = fmaxf(mloc, st[qs][0][rg]);
#pragma unroll
        for (int rg = 0; rg < 16; ++rg) mloc = fmaxf(mloc, st[qs][1][rg]);
        mloc = fmaxf(mloc, __shfl_xor(mloc, 32));
        const bool grow = mloc > m[qs] + 8.0f;
        if (__builtin_amdgcn_ballot_w64(grow) != 0ull) {
          const float mnew = fmaxf(m[qs], mloc);
          const float alpha = __builtin_amdgcn_exp2f(m[qs] - mnew);
          m[qs] = mnew;
          lsum[qs] *= alpha;
          const f32x2_t a2 = {alpha, alpha};
#pragma unroll
          for (int i = 0; i < 8; ++i) {
            f32x2_t o0 = {ot[qs][0][2 * i], ot[qs][0][2 * i + 1]}, o1 = {ot[qs][1][2 * i], ot[qs][1][2 * i + 1]};
            o0 *= a2; o1 *= a2;
            ot[qs][0][2 * i] = o0.x; ot[qs][0][2 * i + 1] = o0.y; ot[qs][1][2 * i] = o1.x; ot[qs][1][2 * i + 1] = o1.y;
          }
        }
        const f32x2_t nm2 = {-m[qs], -m[qs]};
        f32x2_t ps2 = {0.f, 0.f};
#pragma unroll
        for (int kt = 0; kt < 2; ++kt)
#pragma unroll
          for (int rg = 0; rg < 16; rg += 2) {
            f32x2_t sv = {st[qs][kt][rg], st[qs][kt][rg + 1]};
            sv += nm2;
            float p0 = __builtin_amdgcn_exp2f(sv.x), p1 = __builtin_amdgcn_exp2f(sv.y);
            if (mtile) { p0 = (st[qs][kt][rg] < -1e29f) ? 0.f : p0; p1 = (st[qs][kt][rg + 1] < -1e29f) ? 0.f : p1; }
            st[qs][kt][rg] = p0; st[qs][kt][rg + 1] = p1;
            const f32x2_t pv = {p0, p1};
            ps2 += pv;
          }
        lsum[qs] += ps2.x + ps2.y;
        __builtin_amdgcn_sched_barrier(0);
      }
      const u16* vb = Vt + cur * 64 * 68 + l32 * 68 + 4 * hh;
#pragma unroll
      for (int kt = 0; kt < 2; ++kt)
#pragma unroll
        for (int s = 0; s < 2; ++s) {
          bf16x8 pf[2];
#pragma unroll
          for (int qs = 0; qs < 2; ++qs) {
            unsigned pw[4];
#pragma unroll
            for (int i = 0; i < 4; ++i) pw[i] = pk2(st[qs][kt][8 * s + 2 * i], st[qs][kt][8 * s + 2 * i + 1]);
            const uint4 pu = make_uint4(pw[0], pw[1], pw[2], pw[3]);
            pf[qs] = __builtin_bit_cast(bf16x8, pu);
          }
#pragma unroll
          for (int dt = 0; dt < 2; ++dt) {
            const u16* vp = vb + dt * 32 * 68 + 32 * kt + 16 * s;
            const uint2 lo = *(const uint2*)(vp);
            const uint2 hi = *(const uint2*)(vp + 8);
            const uint4 au = make_uint4(lo.x, lo.y, hi.x, hi.y);
            const bf16x8 vf = __builtin_bit_cast(bf16x8, au);
            ot[0][dt] = MFMA(vf, pf[0], ot[0][dt]);
            ot[1][dt] = MFMA(vf, pf[1], ot[1][dt]);
          }
        }
    }
    __builtin_amdgcn_sched_barrier(0);
    {
      u16* Kw = Ks + (cur ^ 1) * 64 * KS;
      u16* Vw = Vt + (cur ^ 1) * 64 * 68;
      *(uint4*)(Kw + kkey0 * KS + kch0 * 8) = rk0;
      if (has1) *(uint4*)(Kw + kkey1 * KS + kch1 * 8) = rk1;
      const unsigned uu[4] = {rv.x, rv.y, rv.z, rv.w};
#pragma unroll
      for (int i = 0; i < 4; ++i) {
        Vw[(vch * 8 + 2 * i) * 68 + vkey] = (u16)(uu[i] & 0xffffu);
        Vw[(vch * 8 + 2 * i + 1) * 68 + vkey] = (u16)(uu[i] >> 16);
      }
    }
    __syncthreads();
  }
#pragma unroll
  for (int qs = 0; qs < 2; ++qs) {
    float ltot = lsum[qs] + __shfl_xor(lsum[qs], 32);
    if (has_sink) ltot += __builtin_amdgcn_exp2f(sink_l2 - m[qs]);
    const float inv = 1.0f / ltot;
    if (64 * w + 32 * qs + l32 < nq) {
#pragma unroll
      for (int dt = 0; dt < 2; ++dt)
#pragma unroll
        for (int g = 0; g < 4; ++g) {
          uint2 pk;
          pk.x = pk2(ot[qs][dt][4 * g] * inv, ot[qs][dt][4 * g + 1] * inv);
          pk.y = pk2(ot[qs][dt][4 * g + 2] * inv, ot[qs][dt][4 * g + 3] * inv);
          *(uint2*)(Op + (size_t)(qrow0 + 64 * w + 32 * qs + l32) * o_ld + dt * 32 + 8 * g + 4 * hh) = pk;
        }
    }
  }
}

DI void phase_attn(const Params& p, int l, u16* lds) {
  const u16* R = (const u16*)(p.ws + OFF_R);
  const u16* QK = (const u16*)(p.ws + OFF_A);
  const u16* KM = (const u16*)(p.ws + OFF_KM);
  u16* Y = (u16*)(p.ws + OFF_Y);
  const float* sink = p.gqa_sink + l * 8;
  const int n_mla = 1024, n_gqa = 1024, n_ctx = (l < 3) ? 128 : 0;
  const int n_all = n_mla + n_gqa + n_ctx;
  for (int it_ = lbid(); it_ < ((n_all + 255) & ~255); it_ += gridDim.x) {
    const int item = xcd_remap(it_);
    if (item >= n_all) continue;
    int kind, qb, hd, b, isctx;
    if (item < n_mla) { kind = 0; isctx = 0; qb = item & 15; hd = (item >> 4) & 7; b = item >> 7; }
    else if (item < n_mla + n_gqa) { const int it = item - n_mla; kind = 1; isctx = 0; qb = it & 15; hd = (it >> 4) & 7; b = it >> 7; }
    else { const int it = item - n_mla - n_gqa; isctx = 1; qb = 0; hd = it & 7; b = (it >> 3) & 7; kind = it >> 6; }
    const int crow0 = ML + b * LCTX;
    if (kind == 0) {
      int qrow0, nq, qt0, s0r, s0n, s1n;
      if (isctx) { qrow0 = crow0; nq = LCTX; qt0 = 0; s0r = crow0; s0n = LCTX; s1n = 0; }
      else { qrow0 = b * LSEQ + qb * 512; nq = 512; qt0 = qb * 512; s0r = b * LSEQ; s0n = LSEQ; s1n = LCTX; }
      attn_block<96>(QK + hd * 96, 1792, KM + hd * 96, 768, QK + 768 + hd * 128 + 64, 1792, Y + 1024 + hd * 64, 1536,
                     qrow0, nq, qt0, s0r, s0n, 0, 0, crow0, s1n, 0.f, 0, lds);
    } else {
      const int kvh = hd >> 2;
      int qrow0, nq, qt0, s0r, s0n, s0t, msk, s1n;
      if (isctx) { qrow0 = crow0; nq = LCTX; qt0 = 0; s0r = crow0; s0n = LCTX; s0t = 0; msk = 0; s1n = 0; }
      else {
        const int t0 = qb * 512;
        const int lo = (t0 - 128 < 0) ? 0 : t0 - 128;
        const int hi = (t0 + 640 > LSEQ) ? LSEQ : t0 + 640;
        qrow0 = b * LSEQ + t0; nq = 512; qt0 = t0; s0r = b * LSEQ + lo; s0n = hi - lo; s0t = lo; msk = 1; s1n = LCTX;
      }
      attn_block<64>(R + hd * 64, 1536, R + 512 + kvh * 64, 1536, R + 640 + kvh * 64, 1536, Y + 512 + hd * 64, 1536,
                     qrow0, nq, qt0, s0r, s0n, s0t, msk, crow0, s1n, sink[hd] * LOG2E, 1, lds);
    }
  }
}

DI void phase_p7a(const Params& p, int l, int nrows, u16* lds) {
  const u16* hn = (const u16*)(p.ws + OFF_A);
  const u16* wt = (const u16*)(p.ws + OFF_W) + (size_t)l * W_LAYER + WO_TG;
  u16* Gt = (u16*)(p.ws + OFF_B);
  const int NT = 24, nitems = (nrows / 256) * NT;
  for (int it_ = lbid(); it_ < ((nitems + 255) & ~255); it_ += gridDim.x) {
    const int item = xcd_remap(it_);
    if (item >= nitems) continue;
    const int m0 = (item / NT) * 256, n0 = (item % NT) * 128;
    f32x16 acc[2][2];
    ACC_ZERO(acc);
    gemm_mainloop(hn + (size_t)m0 * 1024, 1024, wt + (size_t)n0 * 1024, 1024, 1024, acc, lds);
    ACC_FOREACH(acc, m0, n0, { acc[mi_][ni_][r_] = sigmoidf_(val); });
    stage_store_bf16(acc, Gt, 3072, m0, n0, lds);
  }
}
DI void phase_p7b(const Params& p, int l, int nrows, u16* lds) {
  const u16* Y = (const u16*)(p.ws + OFF_Y);
  const u16* Gt = (const u16*)(p.ws + OFF_B);
  const u16* wb = (const u16*)(p.ws + OFF_W) + (size_t)l * W_LAYER + WO_BR;
  u16* mg = (u16*)(p.ws + OFF_A);
  const int NT = 8, nitems = (nrows / 256) * NT;
  for (int it_ = lbid(); it_ < ((nitems + 255) & ~255); it_ += gridDim.x) {
    const int item = xcd_remap(it_);
    if (item >= nitems) continue;
    const int m0 = (item / NT) * 256, n0 = (item % NT) * 128;
    f32x16 mrg[2][2];
    ACC_ZERO(mrg);
#pragma unroll 1
    for (int nb = 0; nb < 3; ++nb) {
      f32x16 acc[2][2];
      ACC_ZERO(acc);
      gemm_mainloop<true>(Y + (size_t)m0 * 1536 + nb * 512, 1536, wb + (size_t)nb * 1024 * 512 + (size_t)n0 * 512, 512, 512, acc, lds);
      {
        u16* gs = lds;
        const int tid = ltid();
#pragma unroll
        for (int i = 0; i < 8; ++i) {
          const int ch = tid + 512 * i, rr = ch >> 4, c16 = ch & 15;
          const uint4 v = *(const uint4*)(Gt + (size_t)(m0 + rr) * 3072 + nb * 1024 + n0 + c16 * 8);
          *(uint4*)(gs + rr * 136 + c16 * 8) = v;
        }
        __syncthreads();
        ACC_FOREACH(acc, 0, 0, { mrg[mi_][ni_][r_] += bf2f(gs[row * 136 + col]) * val; });
        __syncthreads();
      }
    }
    stage_store_bf16(mrg, mg, 1024, m0, n0, lds);
  }
}
DI void phase_p8(const Params& p, int l, int nrows, u16* lds) {
  const u16* mg = (const u16*)(p.ws + OFF_A);
  const u16* wt = (const u16*)(p.ws + OFF_W) + (size_t)l * W_LAYER + WO_OUT;
  const float* xs = (l == 0) ? p.x : p.out;
  const float* cs = (l == 0) ? p.ctx : (const float*)(p.ws + OFF_CTX);
  float* cd = (float*)(p.ws + OFF_CTX);
  const int NT = 8, nitems = (nrows / 256) * NT;
  for (int it_ = lbid(); it_ < ((nitems + 255) & ~255); it_ += gridDim.x) {
    const int item = xcd_remap(it_);
    if (item >= nitems) continue;
    const int m0 = (item / NT) * 256, n0 = (item % NT) * 128;
    f32x16 acc[2][2];
    ACC_ZERO(acc);
    gemm_mainloop(mg + (size_t)m0 * 1024, 1024, wt + (size_t)n0 * 1024, 1024, 1024, acc, lds);
    const int mrow = (m0 < ML) ? (m0 >> 13) : 8;
    const float* gate = mods_ptr(p, l, mrow, 2);
    ACC_FOREACH(acc, m0, n0, {
      const float g = gate[col];
      if (row < ML) p.out[(size_t)row * 1024 + col] = xs[(size_t)row * 1024 + col] + g * val;
      else cd[(size_t)(row - ML) * 1024 + col] = cs[(size_t)(row - ML) * 1024 + col] + g * val;
    });
  }
}
DI void phase_p10(const Params& p, int l, int nrows, u16* lds) {
  const u16* hn = (const u16*)(p.ws + OFF_A);
  const u16* wt = (const u16*)(p.ws + OFF_W) + (size_t)l * W_LAYER + WO_W1;
  u16* h1 = (u16*)(p.ws + OFF_B);
  const int NT = 32, nitems = (nrows / 256) * NT;
  for (int it_ = lbid(); it_ < ((nitems + 255) & ~255); it_ += gridDim.x) {
    const int item = xcd_remap(it_);
    if (item >= nitems) continue;
    const int m0 = (item / NT) * 256, n0 = (item % NT) * 128;
    f32x16 acc[2][2];
    ACC_ZERO(acc);
    gemm_mainloop(hn + (size_t)m0 * 1024, 1024, wt + (size_t)n0 * 1024, 1024, 1024, acc, lds);
    ACC_FOREACH(acc, m0, n0, { const float rl = fmaxf(val, 0.f); acc[mi_][ni_][r_] = rl * rl; });
    stage_store_bf16(acc, h1, 4096, m0, n0, lds);
  }
}
DI void phase_p11(const Params& p, int l, int nrows, u16* lds) {
  const u16* h1 = (const u16*)(p.ws + OFF_B);
  const u16* wt = (const u16*)(p.ws + OFF_W) + (size_t)l * W_LAYER + WO_W2;
  float* cd = (float*)(p.ws + OFF_CTX);
  const int NT = 8, nitems = (nrows / 256) * NT;
  for (int it_ = lbid(); it_ < ((nitems + 255) & ~255); it_ += gridDim.x) {
    const int item = xcd_remap(it_);
    if (item >= nitems) continue;
    const int m0 = (item / NT) * 256, n0 = (item % NT) * 128;
    f32x16 acc[2][2];
    ACC_ZERO(acc);
    gemm_mainloop(h1 + (size_t)m0 * 4096, 4096, wt + (size_t)n0 * 4096, 4096, 4096, acc, lds);
    const int mrow = (m0 < ML) ? (m0 >> 13) : 8;
    const float* gate = mods_ptr(p, l, mrow, 5);
    ACC_FOREACH(acc, m0, n0, {
      const float g = gate[col];
      float* dp = (row < ML) ? p.out + (size_t)row * 1024 + col : cd + (size_t)(row - ML) * 1024 + col;
      *dp = *dp + g * val;
    });
  }
}

DI void phase_gemm1_b(const Params& p, int l, char* lds) {
  EpiRouteBf16 E; E.ws = p.ws;
  run_gemm256((const u16*)(p.ws + OFF_A), (const u16*)(p.ws + OFF_W) + (size_t)l * W_LAYER + WO_T1, MALL, 3072, 1024, E, lds);
}
DI void phase_p4_b(const Params& p, int l, char* lds) {
  const u16* R = (const u16*)(p.ws + OFF_R);
  const u16* wl = (const u16*)(p.ws + OFF_W) + (size_t)l * W_LAYER;
  EpiActBf16<0> E; E.ldc = 1792;
  E.O = (u16*)(p.ws + OFF_A);
  run_gemm256(R + 768, wl + WO_QB, MALL, 768, 384, E, lds, 1536);
  E.O = (u16*)(p.ws + OFF_A) + 768;
  run_gemm256(R + 1152, wl + WO_KVB, MALL, 1024, 256, E, lds, 1536);
}
DI void phase_p7a_b(const Params& p, int l, int nrows, char* lds) {
  EpiActBf16<1> E; E.O = (u16*)(p.ws + OFF_B); E.ldc = 3072;
  run_gemm256((const u16*)(p.ws + OFF_A), (const u16*)(p.ws + OFF_W) + (size_t)l * W_LAYER + WO_TG, nrows, 3072, 1024, E, lds);
}
DI void phase_p10_b(const Params& p, int l, int nrows, char* lds) {
  EpiActBf16<2> E; E.O = (u16*)(p.ws + OFF_B); E.ldc = 4096;
  run_gemm256((const u16*)(p.ws + OFF_A), (const u16*)(p.ws + OFF_W) + (size_t)l * W_LAYER + WO_W1, nrows, 4096, 1024, E, lds);
}
DI void phase_p8_b(const Params& p, int l, int nrows, char* lds) {
  EpiResid E;
  E.xs = (l == 0) ? p.x : p.out; E.cs = (l == 0) ? p.ctx : (const float*)(p.ws + OFF_CTX);
  E.xo = p.out; E.co = (float*)(p.ws + OFF_CTX); E.gbase = mods_ptr(p, l, 0, 2);
  run_gemm256((const u16*)(p.ws + OFF_A), (const u16*)(p.ws + OFF_W) + (size_t)l * W_LAYER + WO_OUT, nrows, 1024, 1024, E, lds);
}
DI void phase_p11_b(const Params& p, int l, int nrows, char* lds) {
  EpiResid E;
  E.xs = p.out; E.cs = (const float*)(p.ws + OFF_CTX);
  E.xo = p.out; E.co = (float*)(p.ws + OFF_CTX); E.gbase = mods_ptr(p, l, 0, 5);
  run_gemm256((const u16*)(p.ws + OFF_B), (const u16*)(p.ws + OFF_W) + (size_t)l * W_LAYER + WO_W2, nrows, 1024, 4096, E, lds);
}

#define OFF_BAR 985907200ull
#define XB_TMO      128
#define XB_XCNT(j)  (256  + 64 * (j))
#define XB_XSUB(j)  (1280 + 64 * (j))
#define XB_XGEN(j)  (2304 + 64 * (j))
#define XB_TOP      3328
#define XB_TOPGEN   3392
#define XCD_BAR_WORDS 3456
#define XB_SPIN_CAP (1u << 18)
#define LAS __attribute__((address_space(3)))
DI unsigned xb_ld(unsigned* p) { return __hip_atomic_load(p, __ATOMIC_RELAXED, __HIP_MEMORY_SCOPE_AGENT); }
DI unsigned xb_add(unsigned* p, unsigned v) { return __hip_atomic_fetch_add(p, v, __ATOMIC_RELAXED, __HIP_MEMORY_SCOPE_AGENT); }
DI unsigned xb_xcc_id() { return (unsigned)__builtin_amdgcn_s_getreg((3 << 11) | 20) & 0xFu; }
#define XB_SPIN(cond, bar) do { unsigned _sp = 0; while (cond) { __builtin_amdgcn_s_sleep(1); \
    if ((++_sp & 255u) == 0u) { if (xb_ld(&(bar)[XB_TMO])) break; if (_sp > XB_SPIN_CAP) { atomicAdd(&(bar)[XB_TMO], 1u); break; } } } } while (0)
struct XcdBarrier { unsigned* bar; unsigned x; volatile LAS unsigned* st; };
DI XcdBarrier xcd_barrier_post(unsigned* bar, volatile LAS unsigned* st) {
  XcdBarrier b; b.bar = bar; b.x = xb_xcc_id(); b.st = st;
  if (threadIdx.x == 0) (void)xb_add(&bar[XB_XCNT(b.x)], 1u);
  return b;
}
DI void xcd_barrier_complete(unsigned* bar, unsigned x, unsigned& nloc, unsigned& nx) {
  const unsigned G = gridDim.x * gridDim.y * gridDim.z;
  unsigned sum, cnt, mine, sp = 0u;
  for (;;) {
    sum = 0u; cnt = 0u; mine = 0u;
#pragma unroll
    for (unsigned j = 0; j < 16; ++j) { const unsigned c = xb_ld(&bar[XB_XCNT(j)]); sum += c; cnt += (c > 0u) ? 1u : 0u; mine = (j == x) ? c : mine; }
    if (sum == G) break;
    __builtin_amdgcn_s_sleep(1);
    if ((++sp & 255u) == 0u) { if (xb_ld(&bar[XB_TMO])) break; if (sp > XB_SPIN_CAP) { atomicAdd(&bar[XB_TMO], 1u); break; } }
  }
  nloc = mine > 0u ? mine : 1u; nx = cnt > 0u ? cnt : 1u;
}
DI void xcd_barrier(const XcdBarrier& b) {
  asm volatile("s_waitcnt vmcnt(0) lgkmcnt(0)" ::: "memory");
  __syncthreads();
  if (threadIdx.x == 0) {
    unsigned* bar = b.bar;
    __builtin_amdgcn_s_waitcnt(0);
    unsigned nloc = b.st[0], nx = b.st[1];
    if (nloc == 0u) { xcd_barrier_complete(bar, b.x, nloc, nx); b.st[0] = nloc; b.st[1] = nx; }
    const unsigned old = xb_add(&bar[XB_XSUB(b.x)], 1u);
    const unsigned gen = old / nloc;
    if (old + 1u == (gen + 1u) * nloc) {
      __builtin_amdgcn_fence(__ATOMIC_RELEASE, "agent");
      asm volatile("s_waitcnt vmcnt(0)" ::: "memory");
      const unsigned og = xb_add(&bar[XB_TOP], 1u);
      const unsigned tg = og / nx;
      if (og + 1u == (tg + 1u) * nx) xb_add(&bar[XB_TOPGEN], 1u);
      else XB_SPIN(xb_ld(&bar[XB_TOPGEN]) == tg, bar);
      __builtin_amdgcn_fence(__ATOMIC_ACQUIRE, "agent");
      xb_add(&bar[XB_XGEN(b.x)], 1u);
      asm volatile("s_waitcnt vmcnt(0)" ::: "memory");
    } else {
      XB_SPIN(xb_ld(&bar[XB_XGEN(b.x)]) == gen, bar);
      __builtin_amdgcn_fence(__ATOMIC_ACQUIRE, "agent");
      asm volatile("s_waitcnt vmcnt(0)" ::: "memory");
    }
  }
  __syncthreads();
}

DI void gsync(cg::grid_group& grid) {
  asm volatile("s_waitcnt vmcnt(0) lgkmcnt(0)" ::: "memory");
  grid.sync();
  if (ltid() < 64) {
    __builtin_amdgcn_fence(__ATOMIC_ACQUIRE, "agent");
    asm volatile("s_waitcnt vmcnt(0)" ::: "memory");
  }
  __syncthreads();
}

__global__ void __launch_bounds__(512) fwd_megakernel(Params p) {
  __shared__ __attribute__((aligned(16))) char lds[131072];
  __shared__ uint4 xb_words;
  cg::grid_group grid = cg::this_grid();
  if (threadIdx.x == 0) xb_words = make_uint4(0u, 0u, 0u, 0u);
  __syncthreads();
  const XcdBarrier xb = xcd_barrier_post((unsigned*)(p.ws + OFF_BAR), (volatile LAS unsigned*)&xb_words);
  phase0(p, lds);
  gsync(grid);
  for (int l = 0; l < 4; ++l) {
    const int nrows2 = (l < 3) ? MALL : ML;
#ifdef PROBE_SYNC10
    for (int q = 0; q < 10; ++q) xcd_barrier(xb);
#endif
#ifdef PROBE_FILT
    filter_tiles(p, l, LSEQ, 2 * FFTN, (float*)(p.ws + OFF_KF), (float*)(p.ws + OFF_PART), (float*)lds);
    xcd_barrier(xb);
    phase_filter_fft(p, l, (float*)lds);
    xcd_barrier(xb);
#endif
    phase_rownorm(p, l, 0, MALL);
#ifdef PROBE_ELEM
    phase_rownorm(p, l, 0, MALL);
    phase_rownorm(p, l, 0, MALL);
    phase_rownorm(p, l, 0, MALL);
#endif
    filter_tiles(p, l, LSEQ, 2 * FFTN, (float*)(p.ws + OFF_KF), (float*)(p.ws + OFF_PART), (float*)lds);
    if (l < 3) filter_tiles(p, l, LCTX, 512, (float*)(p.ws + OFF_KC), (float*)(p.ws + OFF_PART) + 128 * 1024, (float*)lds);
    xcd_barrier(xb);
    phase_gemm1_b(p, l, lds);
#ifdef PROBE_BIGG
    phase_gemm1_b(p, l, lds);
#endif
    phase_filter_fft(p, l, (float*)lds);
    xcd_barrier(xb);
    phase_h1(p, l, (float*)lds);
#ifdef PROBE_ELEM
    phase_h1(p, l, (float*)lds);
#endif
    phase_p3(p, l, (float*)lds);
    xcd_barrier(xb);
    phase_h2(p, l, (float*)lds);
    xcd_barrier(xb);
#ifdef PROBE_H2
    phase_h1(p, l, (float*)lds);
    xcd_barrier(xb);
    phase_h2(p, l, (float*)lds);
    xcd_barrier(xb);
#endif
    phase_h3(p, l, (float*)lds);
#ifdef PROBE_ELEM
    phase_h3(p, l, (float*)lds);
#endif
    xcd_barrier(xb);
    phase_p4(p, l, (u16*)lds);
#ifdef PROBE_SMALLG
    phase_p4(p, l, (u16*)lds);
#endif
    xcd_barrier(xb);
    phase_p5(p, l, (float*)lds);
    xcd_barrier(xb);
    phase_attn(p, l, (u16*)lds);
#ifdef PROBE_ATTN2
    xcd_barrier(xb);
    phase_attn(p, l, (u16*)lds);
#endif
    xcd_barrier(xb);
    phase_rownorm(p, l, 0, nrows2);
    xcd_barrier(xb);
    phase_p7a_b(p, l, nrows2, lds);
#ifdef PROBE_BIGG
    phase_p7a_b(p, l, nrows2, lds);
#endif
    xcd_barrier(xb);
    phase_p7b(p, l, nrows2, (u16*)lds);
#ifdef PROBE_SMALLG
    phase_p7b(p, l, nrows2, (u16*)lds);
#endif
    xcd_barrier(xb);
    phase_p8_b(p, l, nrows2, lds);
    xcd_barrier(xb);
    phase_rownorm(p, l, 1, nrows2);
    xcd_barrier(xb);
    phase_p10_b(p, l, nrows2, lds);
#ifdef PROBE_BIGG
    phase_p10_b(p, l, nrows2, lds);
#endif
    xcd_barrier(xb);
    phase_p11_b(p, l, nrows2, lds);
    xcd_barrier(xb);
  }
}

extern "C" void kernel_launch(void* const* d_in, const int* in_sizes, int n_in, void* d_out, int out_size, void* d_ws,
                              size_t ws_size, hipStream_t stream) {
  static int grid_blocks = 0;
  if (!grid_blocks) {
    int dev = 0, cus = 0, per_cu = 0;
    hipGetDevice(&dev);
    hipDeviceGetAttribute(&cus, hipDeviceAttributeMultiprocessorCount, dev);
    hipOccupancyMaxActiveBlocksPerMultiprocessor(&per_cu, fwd_megakernel, 512, 0);
    if (per_cu < 1) per_cu = 1;
    if (per_cu > 1) per_cu = 1;
    grid_blocks = cus * per_cu;
  }
  Params p{};
  const float** pp = (const float**)&p;
  for (int i = 0; i < 30; ++i) pp[i] = (const float*)d_in[i];
  p.out = (float*)d_out;
  p.ws = (char*)d_ws;
  hipMemsetAsync((char*)d_ws + OFF_BAR, 0, XCD_BAR_WORDS * sizeof(unsigned), stream);
  void* args[] = {&p};
  hipError_t e = hipLaunchCooperativeKernel((void*)fwd_megakernel, dim3(grid_blocks), dim3(512), args, 0, stream);
  if (e != hipSuccess) fprintf(stderr, "cooperative launch failed: %s (grid %d)\n", hipGetErrorString(e), grid_blocks);
}
```

```cpp
#include <hip/hip_runtime.h>
#include <hip/hip_cooperative_groups.h>
#include <cstdio>
namespace cg = cooperative_groups;

typedef unsigned short u16;
typedef short bf16x8 __attribute__((ext_vector_type(8)));
typedef float f32x16 __attribute__((ext_vector_type(16)));
typedef unsigned u32x4 __attribute__((ext_vector_type(4)));
#define VLOAD16(ptr) __builtin_bit_cast(uint4, *(const volatile u32x4*)(ptr))
typedef __bf16 bf16x2_t __attribute__((ext_vector_type(2)));
typedef float f32x2_t __attribute__((ext_vector_type(2)));
#define DI __device__ __forceinline__
#define MFMA(a, b, c) __builtin_amdgcn_mfma_f32_32x32x16_bf16((a), (b), (c), 0, 0, 0)

#define DM 1024
#define NBATCH 8
#define LSEQ 8192
#define LCTX 256
#define ML 65536
#define MC 2048
#define MALL 67584
#define NIN 6048
#define FFTN 16384
#define EPSV 1e-6f
#define LOG2E 1.4426950408889634f

#define W_LAYER 17858560ull
#define WO_T1 0ull
#define WO_TG 3145728ull
#define WO_QB 6291456ull
#define WO_KVB 6586368ull
#define WO_BR 6848512ull
#define WO_OUT 8421376ull
#define WO_W1 9469952ull
#define WO_W2 13664256ull
#define OFF_W 0ull
#define OFF_CTX 142868480ull
#define OFF_KF 151257088ull
#define OFF_KC 218365952ull
#define OFF_MODS 219414528ull
#define OFF_SUMSQ 220299264ull
#define OFF_ROPEG 220315648ull
#define OFF_ROPEM 222412800ull
#define OFF_TW 223461376ull
#define OFF_A 223592448ull
#define OFF_B 362004480ull
#define OFF_C 431210496ull
#define OFF_R 569622528ull
#define OFF_Y 777240576ull
#define OFF_KM (OFF_A + 242221056ull)
#define OFF_PART 984858624ull
#define ZC_OFF 33554432

struct Params {
  const float *x, *c, *ctx, *c_ctx, *w_mod, *b_mod, *norm_mix_g, *norm_mlp_g, *w_in, *hy_short_w, *hy_f1_w, *hy_f1_b,
      *hy_f2_w, *hy_f2_b, *hy_sin_freq, *hy_f3_w, *hy_skip, *gqa_q_norm, *gqa_k_norm, *gqa_sink, *mla_q_a_norm,
      *mla_kv_a_norm, *w_q_b, *w_kv_b, *mla_q_norm, *mla_k_norm, *w_branch, *w_out, *w_mlp1, *w_mlp2;
  float* out;
  char* ws;
};

DI int ltid() { int t = threadIdx.x; asm volatile("" : "+v"(t)); return t; }
DI int lbid() { int t = blockIdx.x; asm volatile("" : "+s"(t)); return t; }
DI u16 f2bf(float x) { return __builtin_bit_cast(u16, (__bf16)x); }
DI float bf2f(u16 v) { return __uint_as_float(((unsigned)v) << 16); }
DI unsigned pk2(float a, float b) {
  f32x2_t f = {a, b};
  return __builtin_bit_cast(unsigned, __builtin_convertvector(f, bf16x2_t));
}
DI float wave_sum(float v) {
#pragma unroll
  for (int o = 32; o > 0; o >>= 1) v += __shfl_xor(v, o);
  return v;
}
DI float sigmoidf_(float x) { return 1.0f / (1.0f + __expf(-x)); }
DI const float* mods_ptr(const Params& p, int l, int mrow, int j) {
  return (const float*)(p.ws + OFF_MODS) + ((size_t)(l * 9 + mrow) * 6144 + j * 1024);
}

template <bool LOWREG = false>
DI void gemm_mainloop(const u16* __restrict__ Ag, int lda, const u16* __restrict__ Bg, int ldb, int K,
                      f32x16 (&acc)[2][2], u16* lds) {
  const int tid = ltid(), lane = tid & 63, w = tid >> 6, l32 = lane & 31, hh = lane >> 5;
  const int wm = w >> 1, wn = w & 1;
  u16* As = lds;
  u16* Bs = lds + 2 * 256 * 72;
  const int arow = tid >> 3, ach = tid & 7;
  const u16* ap = Ag + (size_t)arow * lda + ach * 8;
  const u16* bp = Bg + (size_t)arow * ldb + ach * 8;
  const int nk = K >> 6;
  uint4 ra0[4], rb0[2], ra1[4], rb1[2];
#define G_LOAD(RA, RB, T)                                                                   \
  {                                                                                         \
    const int t_ = ((T) < nk) ? (T) : nk - 1;                                               \
    _Pragma("unroll") for (int i = 0; i < 4; ++i) RA[i] = VLOAD16(ap + (size_t)(64 * i) * lda + 64 * t_); \
    _Pragma("unroll") for (int i = 0; i < 2; ++i) RB[i] = VLOAD16(bp + (size_t)(64 * i) * ldb + 64 * t_); \
  }
#define G_STORE(RA, RB, BUF)                                                                \
  {                                                                                         \
    u16* Aw = As + (BUF) * 256 * 72;                                                        \
    u16* Bw = Bs + (BUF) * 128 * 72;                                                        \
    _Pragma("unroll") for (int i = 0; i < 4; ++i) *(uint4*)(Aw + (arow + 64 * i) * 72 + ach * 8) = RA[i]; \
    _Pragma("unroll") for (int i = 0; i < 2; ++i) *(uint4*)(Bw + (arow + 64 * i) * 72 + ach * 8) = RB[i]; \
  }
#define G_COMPUTE(BUF, RA, RB, WBUF)                                                        \
  {                                                                                         \
    const u16* as = As + (BUF) * 256 * 72 + (wm * 64 + l32) * 72 + hh * 8;                  \
    const u16* bs = Bs + (BUF) * 128 * 72 + (wn * 64 + l32) * 72 + hh * 8;                  \
    u16* Aw = As + (WBUF) * 256 * 72 + arow * 72 + ach * 8;                                 \
    u16* Bw = Bs + (WBUF) * 128 * 72 + arow * 72 + ach * 8;                                 \
    _Pragma("unroll") for (int s = 0; s < 4; ++s) {                                         \
      bf16x8 a0 = *(const bf16x8*)(as + s * 16), a1 = *(const bf16x8*)(as + 32 * 72 + s * 16); \
      bf16x8 b0 = *(const bf16x8*)(bs + s * 16), b1 = *(const bf16x8*)(bs + 32 * 72 + s * 16); \
      acc[0][0] = MFMA(a0, b0, acc[0][0]);                                                  \
      acc[0][1] = MFMA(a0, b1, acc[0][1]);                                                  \
      acc[1][0] = MFMA(a1, b0, acc[1][0]);                                                  \
      acc[1][1] = MFMA(a1, b1, acc[1][1]);                                                  \
      if (s == 0) { *(uint4*)(Aw) = RA[0]; *(uint4*)(Aw + 64 * 72) = RA[1]; }               \
      if (s == 1) { *(uint4*)(Aw + 128 * 72) = RA[2]; *(uint4*)(Aw + 192 * 72) = RA[3]; }   \
      if (s == 2) { *(uint4*)(Bw) = RB[0]; *(uint4*)(Bw + 64 * 72) = RB[1]; }               \
      if (LOWREG) __builtin_amdgcn_sched_barrier(0);                                        \
    }                                                                                       \
  }
  G_LOAD(ra0, rb0, 0);
  G_LOAD(ra1, rb1, 1);
  __builtin_amdgcn_sched_barrier(0);
  G_STORE(ra0, rb0, 0);
  __syncthreads();
  for (int kt = 0; kt < nk; kt += 2) {
    G_LOAD(ra0, rb0, kt + 2);
    __builtin_amdgcn_sched_barrier(0);
    G_COMPUTE(0, ra1, rb1, 1);
    __syncthreads();
    G_LOAD(ra1, rb1, kt + 3);
    __builtin_amdgcn_sched_barrier(0);
    G_COMPUTE(1, ra0, rb0, 0);
    __syncthreads();
  }
#undef G_LOAD
#undef G_STORE
#undef G_COMPUTE
}

DI int xcd_remap(int it) { const int r = it & 255; return (it & ~255) + ((r & 7) << 5) + (r >> 3); }

#define ACC_ZERO(acc)                                                                      \
  _Pragma("unroll") for (int mi_ = 0; mi_ < 2; ++mi_) _Pragma("unroll") for (int ni_ = 0; ni_ < 2; ++ni_) \
      _Pragma("unroll") for (int r_ = 0; r_ < 16; ++r_) acc[mi_][ni_][r_] = 0.f;

#define ACC_FOREACH(acc, m0, n0, BODY)                                                     \
  {                                                                                        \
    const int lane_ = ltid() & 63, w_ = ltid() >> 6;                             \
    const int l32_ = lane_ & 31, hh_ = lane_ >> 5, wm_ = w_ >> 1, wn_ = w_ & 1;            \
    _Pragma("unroll") for (int mi_ = 0; mi_ < 2; ++mi_) _Pragma("unroll") for (int ni_ = 0; ni_ < 2; ++ni_) { \
        __builtin_amdgcn_sched_barrier(0);                                                 \
        _Pragma("unroll") for (int r_ = 0; r_ < 16; ++r_) {                                \
      const int row = (m0) + wm_ * 64 + mi_ * 32 + (r_ & 3) + 8 * (r_ >> 2) + 4 * hh_;     \
      const int col = (n0) + wn_ * 64 + ni_ * 32 + l32_;                                   \
      const float val = acc[mi_][ni_][r_];                                                    \
      BODY                                                                                 \
    } }                                                                                    \
  }

DI void stage_store_bf16(f32x16 (&acc)[2][2], u16* __restrict__ dst, int ld, int m0, int c0, u16* lds) {
  u16* cs = lds;
  ACC_FOREACH(acc, 0, 0, { cs[row * 136 + col] = f2bf(val); });
  __syncthreads();
  const int tid = ltid();
#pragma unroll
  for (int i = 0; i < 8; ++i) {
    const int ch = tid + 512 * i, rr = ch >> 4, c16 = ch & 15;
    const uint4 v = *(const uint4*)(cs + rr * 136 + c16 * 8);
    *(uint4*)(dst + (size_t)(m0 + rr) * ld + c0 + c16 * 8) = v;
  }
  __syncthreads();
}

namespace pg8 {
#define PG8_LAS __attribute__((address_space(3)))
typedef unsigned short bf16_t;
typedef short bf16x8 __attribute__((ext_vector_type(8)));
typedef float f32x4 __attribute__((ext_vector_type(4)));
typedef unsigned u32x4 __attribute__((ext_vector_type(4)));
constexpr int BM = 256, BK = 64, HALF = 128, HTB = HALF * BK * 2  , STAGE_BYTES = 8 * HTB, NXCD = 8, WGM = 8;

__host__ __device__ __forceinline__ int lds_byte(int r, int c) { const int st = (r >> 4) * 2 + (c >> 5), rr = r & 15, cc = c & 31, ob = rr * 64 + cc * 2; return st * 1024 + (ob ^ (((ob >> 9) & 1) << 5)); }
__host__ __device__ __forceinline__ void stage_rc(int b, int& R, int& C) { const int st = b / 1024, sb = b % 1024, swz = sb ^ (((sb >> 9) & 1) << 5); R = (st >> 1) * 16 + swz / 64; C = (st & 1) * 32 + (swz % 64) / 2; }
__host__ __device__ __forceinline__ int perm32(int rho) { const int n = rho >> 4, i = rho & 15; return 8 * (i >> 2) + 4 * n + (i & 3); }

struct Unit { int pm, pn; };
struct Gemm { const bf16_t* A; const bf16_t* Bt; int M, N, K, lda; };

struct StaticOrder {
    int nM, nN, nwg, G, c;
    __host__ __device__ void init(int M, int N, int G_, int c_) { nM = M / BM; nN = N / BM; nwg = nM * nN; G = G_; c = c_; }
    __host__ __device__ bool next(int i, Unit& u) const {
        const long L = (long)i * G + c; if (L >= nwg) return false;
        int wgid = (int)L; { const int q = nwg / NXCD, r = nwg % NXCD, xcd = wgid % NXCD, off = wgid / NXCD; wgid = (xcd < r ? xcd * (q + 1) : r * (q + 1) + (xcd - r) * q) + off; }
        const int nig = WGM * nN, gid = wgid / nig, fm = gid * WGM, gsz = (nM - fm) < WGM ? (nM - fm) : WGM;
        u.pm = fm + ((wgid % nig) % gsz); u.pn = (wgid % nig) / gsz; return true;
    }
    __device__ __forceinline__ void a_ready(const Unit&) const {}
    __device__ __forceinline__ void done(const Unit&) const {}
};
template <class Epi, class Sched, bool STAMP = false>
__device__ __forceinline__ void gemm_phase(PG8_LAS unsigned char* lds, const Gemm g, const Sched& S, const Epi& E, unsigned long long* stamps) {
    const int tid = ltid(), wid = __builtin_amdgcn_readfirstlane(tid >> 6), lane = tid & 63, wr = wid >> 2, wc = wid & 3, fr = lane & 15, fq = lane >> 4;
    const int K = g.K, nt = K / BK;
    int ts_lo = 0, ts_hi = 0, nts = 0; const unsigned long long rt_entry = STAMP ? (unsigned long long)wall_clock64() : 0ull;
#define PG8_STAMP() do { if (STAMP && wid == 0 && nts < 64) { const unsigned long long _c = (unsigned long long)clock64(); \
        ts_lo = (lane == nts) ? (int)(unsigned)_c : ts_lo; ts_hi = (lane == nts) ? (int)(unsigned)(_c >> 32) : ts_hi; ++nts; } } while (0)
    PG8_STAMP();
    unsigned voffA[2], voffB[2];
#pragma unroll
    for (int i = 0; i < 2; ++i) { int R, C; stage_rc(tid * 16 + i * 8192, R, C); const int Rb = Epi::PERM ? ((R & ~31) + perm32(R & 31)) : R;
        voffA[i] = (unsigned)(R * g.lda + C) * 2u; voffB[i] = (unsigned)(Rb * K + C) * 2u; }
    const size_t kstep = (size_t)(BK * 2);
    const size_t hstep = (size_t)HALF * K * 2;
    const size_t tstep = 2 * hstep;
    const size_t hstepA = (size_t)HALF * g.lda * 2, tstepA = 2 * hstepA;
    const unsigned ldsw = (unsigned)wid * 1024u;
    const int aoff = lds_byte(wr * 64 + fr, fq * 8), boff = lds_byte(wc * 32 + fr, fq * 8);
#define PG8_SA(b, h) (((b) * 2 + (h)) * HTB)
#define PG8_SB(b, h) ((4 + (b) * 2 + (h)) * HTB)
#define PG8_STAGE(bufoff, gbase, voff) do { _Pragma("unroll") for (int _i = 0; _i < 2; ++_i) \
        __builtin_amdgcn_global_load_lds((const unsigned*)((const char*)(gbase) + (voff)[_i]), (PG8_LAS unsigned*)(lds + (bufoff) + ldsw + _i * 8192), 16, 0, 0); } while (0)
#define PG8_LDA(dst, b, h) do { _Pragma("unroll") for (int m = 0; m < 4; ++m) _Pragma("unroll") for (int k = 0; k < 2; ++k) dst[m][k] = *(const PG8_LAS bf16x8*)(lds + PG8_SA(b, h) + aoff + m * 2048 + k * 1024); } while (0)
#define PG8_LDB(dst, b, h) do { _Pragma("unroll") for (int n = 0; n < 2; ++n) _Pragma("unroll") for (int k = 0; k < 2; ++k) dst[n][k] = *(const PG8_LAS bf16x8*)(lds + PG8_SB(b, h) + boff + n * 2048 + k * 1024); } while (0)
#define PG8_MMA(ai, bj, At, Bt) do { __builtin_amdgcn_s_setprio(1); _Pragma("unroll") for (int m = 0; m < 4; ++m) _Pragma("unroll") for (int n = 0; n < 2; ++n) _Pragma("unroll") for (int k = 0; k < 2; ++k) \
        acc[ai][bj][m][n] = __builtin_amdgcn_mfma_f32_16x16x32_bf16(Bt[n][k], At[m][k], acc[ai][bj][m][n], 0, 0, 0); __builtin_amdgcn_s_setprio(0); } while (0)
#define PG8_WAIT_V(n) asm volatile("s_waitcnt vmcnt(" #n ")" ::: "memory")
#define PG8_WAIT_L(n) asm volatile("s_waitcnt lgkmcnt(" #n ")" ::: "memory")
#define PG8_BAR __builtin_amdgcn_s_barrier()
#define PG8_SCHED __builtin_amdgcn_sched_barrier(0)
    Unit cur, nxt; int ui = 0;
    if (!S.next(0, cur)) return;
    f32x4 acc[2][2][4][2];
#pragma unroll
    for (int a = 0; a < 2; ++a)
#pragma unroll
        for (int b = 0; b < 2; ++b)
#pragma unroll
            for (int m = 0; m < 4; ++m)
#pragma unroll
                for (int n = 0; n < 2; ++n) acc[a][b][m][n] = (f32x4){0.f, 0.f, 0.f, 0.f};
    bf16x8 At[4][2], B0[2][2], B1[2][2];
    const char* cA = (const char*)g.A + (size_t)cur.pm * tstepA; const char* cB = (const char*)g.Bt + (size_t)cur.pn * tstep;
    S.a_ready(cur);
    PG8_STAGE(PG8_SB(0, 0), cB, voffB); PG8_STAGE(PG8_SA(0, 0), cA, voffA); PG8_STAGE(PG8_SB(0, 1), cB + hstep, voffB); PG8_STAGE(PG8_SA(0, 1), cA + hstepA, voffA);
    if (wr == 1) PG8_BAR;
    PG8_WAIT_V(4); PG8_BAR;
    PG8_STAGE(PG8_SB(1, 0), cB + kstep, voffB); PG8_STAGE(PG8_SA(1, 0), cA + kstep, voffA); PG8_STAGE(PG8_SB(1, 1), cB + hstep + kstep, voffB);
    PG8_WAIT_V(6); PG8_BAR;
    PG8_STAMP();
    for (;;) {
        const bool has_next = S.next(ui + 1, nxt);
        const char* nA = has_next ? (const char*)g.A + (size_t)nxt.pm * tstepA : cA; const char* nB = has_next ? (const char*)g.Bt + (size_t)nxt.pn * tstep : cB;
        for (int t = 0; t < nt; t += 2) {
            const bool last = (t == nt - 2);
            const char* a1 = cA + (size_t)(t + 1) * kstep;
            const char* a2 = last ? nA : cA + (size_t)(t + 2) * kstep; const char* b2 = last ? nB : cB + (size_t)(t + 2) * kstep;
            const char* a3 = a2 + kstep; const char* b3 = b2 + kstep;
            if (last && has_next) S.a_ready(nxt);
            PG8_LDB(B0, 0, 0); PG8_SCHED; PG8_LDA(At, 0, 0); PG8_STAGE(PG8_SA(1, 1), a1 + hstepA, voffA);
            PG8_WAIT_L(8); PG8_BAR; PG8_WAIT_L(0); PG8_MMA(0, 0, At, B0); PG8_BAR; PG8_SCHED;
            PG8_LDB(B1, 0, 1); PG8_STAGE(PG8_SB(0, 0), b2, voffB);
            PG8_BAR; PG8_WAIT_L(0); PG8_MMA(0, 1, At, B1); PG8_BAR;
            PG8_LDA(At, 0, 1); PG8_STAGE(PG8_SA(0, 0), a2, voffA);
            PG8_BAR; PG8_WAIT_L(0); PG8_MMA(1, 0, At, B0); PG8_BAR; PG8_SCHED;
            PG8_STAGE(PG8_SB(0, 1), b2 + hstep, voffB);
            PG8_WAIT_V(6); PG8_BAR; PG8_MMA(1, 1, At, B1); PG8_BAR;
            PG8_LDB(B0, 1, 0); PG8_SCHED; PG8_LDA(At, 1, 0); PG8_STAGE(PG8_SA(0, 1), a2 + hstepA, voffA);
            PG8_WAIT_L(8); PG8_BAR; PG8_WAIT_L(0); PG8_MMA(0, 0, At, B0); PG8_BAR; PG8_SCHED;
            PG8_LDB(B1, 1, 1); PG8_STAGE(PG8_SB(1, 0), b3, voffB);
            PG8_BAR; PG8_WAIT_L(0); PG8_MMA(0, 1, At, B1); PG8_BAR;
            PG8_LDA(At, 1, 1); PG8_STAGE(PG8_SA(1, 0), a3, voffA);
            PG8_BAR; PG8_WAIT_L(0); PG8_MMA(1, 0, At, B0); PG8_BAR; PG8_SCHED;
            PG8_STAGE(PG8_SB(1, 1), b3 + hstep, voffB);
            PG8_WAIT_V(6); PG8_BAR; PG8_MMA(1, 1, At, B1); PG8_BAR;
        }
        PG8_STAMP();
        if constexpr (!Epi::AFTER_DRAIN) { E(acc, cur, wr, wc, fr, fq); S.done(cur); }
        PG8_STAMP();
        if (!has_next) break;
#pragma unroll
        for (int a = 0; a < 2; ++a)
#pragma unroll
            for (int b = 0; b < 2; ++b)
#pragma unroll
                for (int m = 0; m < 4; ++m)
#pragma unroll
                    for (int n = 0; n < 2; ++n) acc[a][b][m][n] = (f32x4){0.f, 0.f, 0.f, 0.f};
        cur = nxt; cA = nA; cB = nB; ++ui;
    }
    PG8_WAIT_V(0);
    if (wr == 0) PG8_BAR;
    PG8_BAR;
    if constexpr (Epi::AFTER_DRAIN) { E.fused(acc, cur, wr, wc, fr, fq, lds, wid, lane); S.done(cur); }
    PG8_STAMP();
    if (STAMP && wid == 0) { stamps[lane] = lane < nts ? (((unsigned long long)(unsigned)ts_hi << 32) | (unsigned)ts_lo) : 0ull;
        if (lane == 62) stamps[62] = rt_entry; if (lane == 63) stamps[63] = (unsigned long long)wall_clock64(); }
#undef PG8_STAMP
#undef PG8_SA
#undef PG8_SB
#undef PG8_STAGE
#undef PG8_LDA
#undef PG8_LDB
#undef PG8_MMA
#undef PG8_WAIT_V
#undef PG8_WAIT_L
#undef PG8_BAR
#undef PG8_SCHED
}
}

DI uint4 pack8_bf16(const pg8::f32x4& v0, const pg8::f32x4& v1) {
  uint4 w; w.x = pk2(v0[0], v0[1]); w.y = pk2(v0[2], v0[3]); w.z = pk2(v1[0], v1[1]); w.w = pk2(v1[2], v1[3]); return w;
}
struct EpiRouteBf16 {
  static constexpr bool PERM = true, AFTER_DRAIN = false;
  char* ws;
  DI void operator()(const pg8::f32x4 (&acc)[2][2][4][2], const pg8::Unit& u, int wr, int wc, int fr, int fq) const {
    const int row0 = u.pm * 256 + wr * 64 + fr;
    u16* base; int ld, colt;
    if (u.pn < 2) { base = (u16*)(ws + OFF_B); ld = 512; colt = u.pn * 256; }
    else if (u.pn < 6) { base = (u16*)(ws + OFF_C); ld = 1024; colt = u.pn * 256 - 512; }
    else { base = (u16*)(ws + OFF_R); ld = 1536; colt = u.pn * 256 - 1536; }
    const int col0 = colt + wc * 32 + 8 * fq;
#pragma unroll
    for (int ai = 0; ai < 2; ++ai)
#pragma unroll
      for (int m = 0; m < 4; ++m) {
        u16* rowp = base + (size_t)(row0 + ai * 128 + m * 16) * ld + col0;
#pragma unroll
        for (int bj = 0; bj < 2; ++bj) *(uint4*)(rowp + bj * 128) = pack8_bf16(acc[ai][bj][m][0], acc[ai][bj][m][1]);
      }
  }
};
template <int ACT  > struct EpiActBf16 {
  static constexpr bool PERM = true, AFTER_DRAIN = false;
  u16* O; int ldc;
  DI void operator()(const pg8::f32x4 (&acc)[2][2][4][2], const pg8::Unit& u, int wr, int wc, int fr, int fq) const {
    const int row0 = u.pm * 256 + wr * 64 + fr, col0 = u.pn * 256 + wc * 32 + 8 * fq;
#pragma unroll
    for (int ai = 0; ai < 2; ++ai)
#pragma unroll
      for (int m = 0; m < 4; ++m) {
        u16* rowp = O + (size_t)(row0 + ai * 128 + m * 16) * ldc + col0;
#pragma unroll
        for (int bj = 0; bj < 2; ++bj) {
          pg8::f32x4 v0 = acc[ai][bj][m][0], v1 = acc[ai][bj][m][1];
#pragma unroll
          for (int j = 0; j < 4; ++j) {
            if (ACT == 1) { v0[j] = sigmoidf_(v0[j]); v1[j] = sigmoidf_(v1[j]); }
            else if (ACT == 2) { const float a = fmaxf(v0[j], 0.f), b = fmaxf(v1[j], 0.f); v0[j] = a * a; v1[j] = b * b; }
          }
          *(uint4*)(rowp + bj * 128) = pack8_bf16(v0, v1);
        }
      }
  }
};
struct EpiResid {
  static constexpr bool PERM = false, AFTER_DRAIN = false;
  const float* xs; const float* cs; float* xo; float* co; const float* gbase;
  DI void operator()(const pg8::f32x4 (&acc)[2][2][4][2], const pg8::Unit& u, int wr, int wc, int fr, int fq) const {
    const int rowt = u.pm * 256;
    const int row0 = rowt + wr * 64 + fr, col0 = u.pn * 256 + wc * 32 + 4 * fq;
    const bool lat = rowt < ML;
    const int mrow = lat ? (rowt >> 13) : 8;
    const float* gate = gbase + (size_t)mrow * 6144;
    const float* src = lat ? xs : cs - (size_t)ML * 1024;
    float* dst = lat ? xo : co - (size_t)ML * 1024;
    pg8::f32x4 gv[2][2];
#pragma unroll
    for (int bj = 0; bj < 2; ++bj)
#pragma unroll
      for (int n = 0; n < 2; ++n) gv[bj][n] = *(const pg8::f32x4*)(gate + col0 + bj * 128 + n * 16);
#pragma unroll
    for (int ai = 0; ai < 2; ++ai)
#pragma unroll
      for (int m = 0; m < 4; ++m) {
        const size_t off = (size_t)(row0 + ai * 128 + m * 16) * 1024 + col0;
#pragma unroll
        for (int bj = 0; bj < 2; ++bj)
#pragma unroll
          for (int n = 0; n < 2; ++n) {
            const pg8::f32x4 xv = *(const pg8::f32x4*)(src + off + bj * 128 + n * 16);
            *(pg8::f32x4*)(dst + off + bj * 128 + n * 16) = xv + gv[bj][n] * acc[ai][bj][m][n];
          }
      }
  }
};
template <class Epi>
DI void run_gemm256(const u16* A, const u16* Bt, int M, int N, int K, const Epi& E, char* lds, int lda = 0) {
  pg8::Gemm g; g.A = A; g.Bt = Bt; g.M = M; g.N = N; g.K = K; g.lda = lda ? lda : K;
  pg8::StaticOrder S; S.init(M, N, (int)gridDim.x, lbid());
  pg8::gemm_phase<Epi, pg8::StaticOrder, false>((PG8_LAS unsigned char*)lds, g, S, E, nullptr);
  __syncthreads();
}

DI void conv_job(const float* __restrict__ src, int ld, int K, int col0, int nvalid, int npad, u16* __restrict__ dst,
                 int& off, float* ts) {
  const int tid = ltid();
  const int tk = K >> 6, tn = npad >> 6, ntiles = tk * tn;
  const int G = gridDim.x;
  int first = ((int)lbid() - (off % G) + G) % G;
  for (int tile = first; tile < ntiles; tile += G) {
    const int k0 = (tile % tk) * 64, n0 = (tile / tk) * 64;
    {
      const int cc = tid & 63, rg = tid >> 6;
      const bool ok = (n0 + cc) < nvalid;
#pragma unroll
      for (int i = 0; i < 8; ++i) {
        const int rr = rg * 8 + i;
        ts[rr * 65 + cc] = ok ? src[(size_t)(k0 + rr) * ld + col0 + n0 + cc] : 0.f;
      }
    }
    __syncthreads();
    {
      const int kk = tid & 63, ng = tid >> 6;
#pragma unroll
      for (int i = 0; i < 8; ++i) {
        const int nn = ng * 8 + i;
        dst[(size_t)(n0 + nn) * K + k0 + kk] = f2bf(ts[kk * 65 + nn]);
      }
    }
    __syncthreads();
  }
  off += ntiles;
}

DI void phase0(const Params& p, char* ldsc) {
  float* ldsf = (float*)ldsc;
  const int tid = ltid();
  const int G = gridDim.x;
  int off = 0;
  for (int l = 0; l < 4; ++l) {
    u16* wl = (u16*)(p.ws + OFF_W) + (size_t)l * W_LAYER;
    conv_job(p.w_in + (size_t)l * 1024 * NIN, NIN, 1024, 0, 2976, 3072, wl + WO_T1, off, ldsf);
    conv_job(p.w_in + (size_t)l * 1024 * NIN, NIN, 1024, 2976, 3072, 3072, wl + WO_TG, off, ldsf);
    conv_job(p.w_q_b + (size_t)l * 384 * 768, 768, 384, 0, 768, 768, wl + WO_QB, off, ldsf);
    conv_job(p.w_kv_b + (size_t)l * 256 * 1024, 1024, 256, 0, 1024, 1024, wl + WO_KVB, off, ldsf);
    for (int nb = 0; nb < 3; ++nb)
      conv_job(p.w_branch + (size_t)(l * 3 + nb) * 512 * 1024, 1024, 512, 0, 1024, 1024, wl + WO_BR + (size_t)nb * 1024 * 512, off, ldsf);
    conv_job(p.w_out + (size_t)l * 1024 * 1024, 1024, 1024, 0, 1024, 1024, wl + WO_OUT, off, ldsf);
    conv_job(p.w_mlp1 + (size_t)l * 1024 * 4096, 4096, 1024, 0, 4096, 4096, wl + WO_W1, off, ldsf);
    conv_job(p.w_mlp2 + (size_t)l * 4096 * 1024, 1024, 4096, 0, 1024, 1024, wl + WO_W2, off, ldsf);
  }
  {
    float* sc = ldsf;
    float* red = ldsf + 9 * 1024;
    for (int i = tid; i < 9 * 1024; i += 512) {
      float v = (i < 8 * 1024) ? p.c[i] : p.c_ctx[i - 8 * 1024];
      sc[i] = v / (1.0f + expf(-v));
    }
    __syncthreads();
    float* mods = (float*)(p.ws + OFF_MODS);
    const int ol = tid & 63, kg = tid >> 6;
    for (int item = lbid(); item < 384; item += G) {
      const int l = item / 96, o = (item % 96) * 64 + ol;
      const float* wp = p.w_mod + (size_t)l * 1024 * 6144 + o;
      float acc[9];
#pragma unroll
      for (int b = 0; b < 9; ++b) acc[b] = 0.f;
#pragma unroll 4
      for (int k = kg * 128; k < kg * 128 + 128; ++k) {
        const float wv = wp[(size_t)k * 6144];
#pragma unroll
        for (int b = 0; b < 9; ++b) acc[b] += sc[b * 1024 + k] * wv;
      }
#pragma unroll
      for (int b = 0; b < 9; ++b) red[(kg * 9 + b) * 64 + ol] = acc[b];
      __syncthreads();
      for (int i = tid; i < 576; i += 512) {
        const int b = i >> 6, o2 = i & 63;
        float s = 0.f;
#pragma unroll
        for (int g = 0; g < 8; ++g) s += red[(g * 9 + b) * 64 + o2];
        const int oc = (item % 96) * 64 + o2;
        mods[(size_t)(l * 9 + b) * 6144 + oc] = s + p.b_mod[l * 6144 + oc];
      }
      __syncthreads();
    }
  }
  {
    const int gt = lbid() * 512 + tid, GT = G * 512;
    float* rg = (float*)(p.ws + OFF_ROPEG);
    float* rm = (float*)(p.ws + OFF_ROPEM);
    float* tw = (float*)(p.ws + OFF_TW);
    for (int i = gt; i < LSEQ * 32; i += GT) {
      const int t = i >> 5, a = i & 31;
      const float pos = (a < 16) ? (float)(t >> 6) : (float)(t & 63);
      const float inv = powf(10000.0f, -(float)(a & 15) / 16.0f);
      const float ang = pos * inv;
      rg[2 * i] = cosf(ang);
      rg[2 * i + 1] = sinf(ang);
    }
    for (int i = gt; i < LSEQ * 16; i += GT) {
      const int t = i >> 4, a = i & 15;
      const float pos = (a < 8) ? (float)(t >> 6) : (float)(t & 63);
      const float inv = powf(10000.0f, -(float)(a & 7) / 8.0f);
      const float ang = pos * inv;
      rm[2 * i] = cosf(ang);
      rm[2 * i + 1] = sinf(ang);
    }
    for (int i = gt; i < FFTN; i += GT) {
      float sn, cs;
      sincospif(2.0f * (float)i / (float)FFTN, &sn, &cs);
      tw[2 * i] = cs;
      tw[2 * i + 1] = -sn;
    }
  }
}

DI void phase_rownorm(const Params& p, int l, int which, int nrows) {
  const int tid = ltid(), lane = tid & 63, w = tid >> 6;
  u16* hn = (u16*)(p.ws + OFF_A);
  const float* g = (which ? p.norm_mlp_g : p.norm_mix_g) + l * 1024;
  const bool first = (which == 0 && l == 0);
  const float* xs = first ? p.x : p.out;
  const float* cs = first ? p.ctx : (const float*)(p.ws + OFF_CTX);
  const int stride = gridDim.x * 8;
  for (int r = lbid() * 8 + w; r < nrows; r += 2 * stride) {
    int rr[2]; rr[0] = r; rr[1] = r + stride;
    const bool has2 = rr[1] < nrows;
    if (!has2) rr[1] = r;
    rr[0] = __builtin_amdgcn_readfirstlane(rr[0]);
    rr[1] = __builtin_amdgcn_readfirstlane(rr[1]);
    float4 v[2][4];
    float ss[2] = {0.f, 0.f};
#pragma unroll
    for (int q = 0; q < 2; ++q) {
      const float* src = (rr[q] < ML) ? xs + (size_t)rr[q] * 1024 : cs + (size_t)(rr[q] - ML) * 1024;
#pragma unroll
      for (int i = 0; i < 4; ++i) v[q][i] = *(const float4*)(src + 4 * (lane + 64 * i));
    }
#pragma unroll
    for (int q = 0; q < 2; ++q) {
#pragma unroll
      for (int i = 0; i < 4; ++i) ss[q] += v[q][i].x * v[q][i].x + v[q][i].y * v[q][i].y + v[q][i].z * v[q][i].z + v[q][i].w * v[q][i].w;
      ss[q] = wave_sum(ss[q]);
    }
#pragma unroll
    for (int q = 0; q < 2; ++q) {
      if (q == 1 && !has2) break;
      const int mrow = (rr[q] < ML) ? (rr[q] >> 13) : 8;
      const float* shift = mods_ptr(p, l, mrow, which ? 3 : 0);
      const float* scale = mods_ptr(p, l, mrow, which ? 4 : 1);
      const float rstd = rsqrtf(ss[q] * (1.0f / 1024.0f) + EPSV);
#pragma unroll
      for (int i = 0; i < 4; ++i) {
        const int c0 = 4 * (lane + 64 * i);
        const float4 gg = *(const float4*)(g + c0), sh = *(const float4*)(shift + c0), sc = *(const float4*)(scale + c0);
        const float o0 = v[q][i].x * rstd * gg.x * (1.f + sc.x) + sh.x;
        const float o1 = v[q][i].y * rstd * gg.y * (1.f + sc.y) + sh.y;
        const float o2 = v[q][i].z * rstd * gg.z * (1.f + sc.z) + sh.z;
        const float o3 = v[q][i].w * rstd * gg.w * (1.f + sc.w) + sh.w;
        uint2 pk;
        pk.x = pk2(o0, o1);
        pk.y = pk2(o2, o3);
        *(uint2*)(hn + (size_t)rr[q] * 1024 + c0) = pk;
      }
    }
  }
}

DI void filter_tiles(const Params& p, int l, int Lf, int cstride, float* __restrict__ kdst, float* __restrict__ part, float* lds) {
  const int tid = ltid(), lane = tid & 63, w = tid >> 6;
  float* zs = lds;
  float* h1s = lds + 64 * 33;
  float* h2s = h1s + 64 * 65;
  float* w3s = h2s + 64 * 65;
  const float* f1w = p.hy_f1_w + l * 33 * 64;
  const float* f1b = p.hy_f1_b + l * 64;
  const float* f2w = p.hy_f2_w + l * 64 * 64;
  const float* f2b = p.hy_f2_b + l * 64;
  const float* sf = p.hy_sin_freq + l * 128;
  const float* f3w = p.hy_f3_w + (size_t)l * 64 * 1024;
  const int nitem = (Lf >> 6) * 4;
  const float min_decay = logf(1e-2f) / 1.5f, max_decay = logf(1e-2f) / 0.3f;
  for (int item = lbid(); item < nitem; item += gridDim.x) {
    const int tile = item >> 2, quarter = item & 3;
    const int t0 = tile * 64;
    for (int idx = tid; idx < 64 * 33; idx += 512) {
      const int tt = idx / 33, e = idx - tt * 33;
      const int t = t0 + tt;
      float val;
      if (e == 0) {
        val = (float)t / (float)(Lf - 1);
      } else {
        const float wt = 6.283185307179586f * (float)t / (float)Lf;
        const int bi = (e - 1) & 15;
        const float f = 1e-4f + (float)bi * ((15.0f - 1e-4f) / 15.0f);
        val = (e <= 16) ? cosf(f * wt) : -sinf(f * wt);
      }
      zs[idx] = val;
    }
    for (int idx = tid; idx < 64 * 64; idx += 512) {
      const int i = idx >> 6, c4 = (idx & 63) * 4;
      *(float4*)(w3s + i * 256 + c4) = *(const float4*)(f3w + i * 1024 + quarter * 256 + c4);
    }
    __syncthreads();
    {
      const int tt = tid & 63, jg = tid >> 6;
#pragma unroll 1
      for (int jj = 0; jj < 8; ++jj) {
        const int j = jg * 8 + jj;
        float a = f1b[j];
#pragma unroll 3
        for (int e = 0; e < 33; ++e) a += zs[tt * 33 + e] * f1w[e * 64 + j];
        h1s[tt * 65 + j] = sinf(sf[j] * a);
      }
    }
    __syncthreads();
    {
      const int tt = tid & 63, jg = tid >> 6;
#pragma unroll 1
      for (int jj = 0; jj < 8; ++jj) {
        const int j = jg * 8 + jj;
        float a = f2b[j];
#pragma unroll 4
        for (int e = 0; e < 64; ++e) a += h1s[tt * 65 + e] * f2w[e * 64 + j];
        h2s[tt * 65 + j] = sinf(sf[64 + j] * a);
      }
    }
    __syncthreads();
    {
      const int tt = lane, t = t0 + tt;
      const float tn = (float)t / (float)(Lf - 1);
#pragma unroll 1
      for (int ob = w * 32; ob < w * 32 + 32; ob += 16) {
        float acc[16];
#pragma unroll
        for (int q = 0; q < 16; ++q) acc[q] = 0.f;
#pragma unroll 4
        for (int i = 0; i < 64; ++i) {
          const float hv = h2s[tt * 65 + i];
          const float* wr = w3s + i * 256 + ob;
#pragma unroll
          for (int q4 = 0; q4 < 4; ++q4) {
            const float4 wv = *(const float4*)(wr + 4 * q4);
            acc[4 * q4] += hv * wv.x; acc[4 * q4 + 1] += hv * wv.y; acc[4 * q4 + 2] += hv * wv.z; acc[4 * q4 + 3] += hv * wv.w;
          }
        }
#pragma unroll
        for (int q = 0; q < 16; ++q) {
          const int o = quarter * 256 + ob + q, dir = o >> 9, c = o & 511;
          const float delta = fabsf(min_decay + (float)c * ((max_decay - min_decay) / 511.0f));
          float val = acc[q] * expf(-tn * delta);
          int pos;
          if (dir == 0) pos = t;
          else if (t == 0) { pos = Lf; val = 0.f; }
          else pos = 2 * Lf - t;
          kdst[(size_t)c * cstride + pos] = val;
          const float s2 = wave_sum(val * val);
          if (lane == 0) part[tile * 1024 + o] = s2;
        }
      }
    }
    __syncthreads();
  }
}

DI int fsw(int i) { return (i & ~15) | ((((i >> 2) + (i >> 6)) & 3) << 2) | (i & 3); }

DI void r16_fwd(float (&xr)[16], float (&xi)[16]) {
#pragma unroll
  for (int st = 0; st < 2; ++st) {
    const int q = (st == 0) ? 4 : 1;
#pragma unroll
    for (int bi = 0; bi < 4; ++bi) {
      const int j = bi & (q - 1), g = bi / q;
      const int i0 = g * 4 * q + j, i1 = i0 + q, i2 = i1 + q, i3 = i2 + q;
      const float ar = xr[i0], ai = xi[i0], br = xr[i1], bi_ = xi[i1], cr = xr[i2], ci = xi[i2], dr = xr[i3], di = xi[i3];
      const float t0r = ar + cr, t0i = ai + ci, t1r = ar - cr, t1i = ai - ci;
      const float t2r = br + dr, t2i = bi_ + di;
      const float er = br - dr, ei = bi_ - di;
      const float t3r = ei, t3i = -er;
      const float y1r = t1r + t3r, y1i = t1i + t3i, y2r = t0r - t2r, y2i = t0i - t2i, y3r = t1r - t3r, y3i = t1i - t3i;
      xr[i0] = t0r + t2r; xi[i0] = t0i + t2i;
      if (q == 1 || j == 0) {
        xr[i1] = y1r; xi[i1] = y1i; xr[i2] = y2r; xi[i2] = y2i; xr[i3] = y3r; xi[i3] = y3i;
      } else {
        const float ang = -6.283185307179586f * (float)j / (float)(4 * q);
        const float w1r = __builtin_cosf(ang), w1i = __builtin_sinf(ang);
        const float w2r = __builtin_cosf(2.f * ang), w2i = __builtin_sinf(2.f * ang);
        const float w3r = __builtin_cosf(3.f * ang), w3i = __builtin_sinf(3.f * ang);
        xr[i1] = y1r * w1r - y1i * w1i; xi[i1] = y1r * w1i + y1i * w1r;
        xr[i2] = y2r * w2r - y2i * w2i; xi[i2] = y2r * w2i + y2i * w2r;
        xr[i3] = y3r * w3r - y3i * w3i; xi[i3] = y3r * w3i + y3i * w3r;
      }
    }
  }
}
DI void r16_inv(float (&xr)[16], float (&xi)[16]) {
#pragma unroll
  for (int st = 0; st < 2; ++st) {
    const int q = (st == 0) ? 1 : 4;
#pragma unroll
    for (int bi = 0; bi < 4; ++bi) {
      const int j = bi & (q - 1), g = bi / q;
      const int i0 = g * 4 * q + j, i1 = i0 + q, i2 = i1 + q, i3 = i2 + q;
      const float ar = xr[i0], ai = xi[i0];
      float br = xr[i1], bi_ = xi[i1], cr = xr[i2], ci = xi[i2], dr = xr[i3], di = xi[i3];
      if (!(q == 1 || j == 0)) {
        const float ang = 6.283185307179586f * (float)j / (float)(4 * q);
        const float w1r = __builtin_cosf(ang), w1i = __builtin_sinf(ang);
        const float w2r = __builtin_cosf(2.f * ang), w2i = __builtin_sinf(2.f * ang);
        const float w3r = __builtin_cosf(3.f * ang), w3i = __builtin_sinf(3.f * ang);
        const float b0 = br, c0 = cr, d0 = dr;
        br = b0 * w1r - bi_ * w1i; bi_ = b0 * w1i + bi_ * w1r;
        cr = c0 * w2r - ci * w2i;  ci = c0 * w2i + ci * w2r;
        dr = d0 * w3r - di * w3i;  di = d0 * w3i + di * w3r;
      }
      const float t0r = ar + cr, t0i = ai + ci, t1r = ar - cr, t1i = ai - ci;
      const float t2r = br + dr, t2i = bi_ + di;
      const float er = br - dr, ei = bi_ - di;
      const float t3r = -ei, t3i = er;
      xr[i0] = t0r + t2r; xi[i0] = t0i + t2i;
      xr[i1] = t1r + t3r; xi[i1] = t1i + t3i;
      xr[i2] = t0r - t2r; xi[i2] = t0i - t2i;
      xr[i3] = t1r - t3r; xi[i3] = t1i - t3i;
    }
  }
}

template <bool INV>
DI void fft_lds_stage(float* re, float* im, const float2* __restrict__ tw, const int s) {
  const int tid = ltid();
  const int qs = 12 - 2 * s;
  const int q = 1 << qs;
  float2 wb = tw[(tid & (q - 1)) << (2 * s)];
  if (INV) wb.y = -wb.y;
  float vr[8][4], vi[8][4];
  int idx[8][4];
#pragma unroll
  for (int k = 0; k < 8; ++k) {
    const int bi = tid + 512 * k;
    const int j = bi & (q - 1), g = bi >> qs;
    const int l0 = (g << (qs + 2)) + j;
#pragma unroll
    for (int m = 0; m < 4; ++m) { idx[k][m] = fsw(l0 + m * q); vr[k][m] = re[idx[k][m]]; vi[k][m] = im[idx[k][m]]; }
  }
#pragma unroll
  for (int k = 0; k < 8; ++k) {
    const int delta = (512 * k) & (q - 1);
    const float ang = (INV ? 6.283185307179586f : -6.283185307179586f) * (float)(delta << (2 * s)) / 16384.0f;
    const float cr_ = __builtin_cosf(ang), ci_ = __builtin_sinf(ang);
    const float w1r = (delta == 0) ? wb.x : wb.x * cr_ - wb.y * ci_;
    const float w1i = (delta == 0) ? wb.y : wb.x * ci_ + wb.y * cr_;
    const float w2r = w1r * w1r - w1i * w1i, w2i = 2.f * w1r * w1i;
    const float w3r = w2r * w1r - w2i * w1i, w3i = w2r * w1i + w2i * w1r;
    if (!INV) {
      const float ar = vr[k][0], ai = vi[k][0], br = vr[k][1], bi_ = vi[k][1], cr = vr[k][2], ci = vi[k][2], dr = vr[k][3], di = vi[k][3];
      const float t0r = ar + cr, t0i = ai + ci, t1r = ar - cr, t1i = ai - ci;
      const float t2r = br + dr, t2i = bi_ + di;
      const float er = br - dr, ei = bi_ - di;
      const float t3r = ei, t3i = -er;
      const float y1r = t1r + t3r, y1i = t1i + t3i, y2r = t0r - t2r, y2i = t0i - t2i, y3r = t1r - t3r, y3i = t1i - t3i;
      re[idx[k][0]] = t0r + t2r; im[idx[k][0]] = t0i + t2i;
      re[idx[k][1]] = y1r * w1r - y1i * w1i; im[idx[k][1]] = y1r * w1i + y1i * w1r;
      re[idx[k][2]] = y2r * w2r - y2i * w2i; im[idx[k][2]] = y2r * w2i + y2i * w2r;
      re[idx[k][3]] = y3r * w3r - y3i * w3i; im[idx[k][3]] = y3r * w3i + y3i * w3r;
    } else {
      const float ar = vr[k][0], ai = vi[k][0];
      const float br = vr[k][1] * w1r - vi[k][1] * w1i, bi_ = vr[k][1] * w1i + vi[k][1] * w1r;
      const float cr = vr[k][2] * w2r - vi[k][2] * w2i, ci = vr[k][2] * w2i + vi[k][2] * w2r;
      const float dr = vr[k][3] * w3r - vi[k][3] * w3i, di = vr[k][3] * w3i + vi[k][3] * w3r;
      const float t0r = ar + cr, t0i = ai + ci, t1r = ar - cr, t1i = ai - ci;
      const float t2r = br + dr, t2i = bi_ + di;
      const float er = br - dr, ei = bi_ - di;
      const float t3r = -ei, t3i = er;
      re[idx[k][0]] = t0r + t2r; im[idx[k][0]] = t0i + t2i;
      re[idx[k][1]] = t1r + t3r; im[idx[k][1]] = t1i + t3i;
      re[idx[k][2]] = t0r - t2r; im[idx[k][2]] = t0i - t2i;
      re[idx[k][3]] = t1r - t3r; im[idx[k][3]] = t1i - t3i;
    }
  }
  __syncthreads();
}
DI void fft_fwd4(float* re, float* im, const float2* __restrict__ tw) {
  fft_lds_stage<false>(re, im, tw, 0);
  fft_lds_stage<false>(re, im, tw, 1);
  fft_lds_stage<false>(re, im, tw, 2);
  fft_lds_stage<false>(re, im, tw, 3);
  fft_lds_stage<false>(re, im, tw, 4);
}
DI void fft_inv4(float* re, float* im, const float2* __restrict__ tw) {
  fft_lds_stage<true>(re, im, tw, 4);
  fft_lds_stage<true>(re, im, tw, 3);
  fft_lds_stage<true>(re, im, tw, 2);
  fft_lds_stage<true>(re, im, tw, 1);
  fft_lds_stage<true>(re, im, tw, 0);
}
DI void r16_load(const float* re, const float* im, int b, float (&xr)[16], float (&xi)[16]) {
#pragma unroll
  for (int c = 0; c < 4; ++c) {
    const int ph = 16 * b + 4 * ((c + (b >> 2)) & 3);
    const float4 vr = *(const float4*)(re + ph), vi = *(const float4*)(im + ph);
    xr[4 * c] = vr.x; xr[4 * c + 1] = vr.y; xr[4 * c + 2] = vr.z; xr[4 * c + 3] = vr.w;
    xi[4 * c] = vi.x; xi[4 * c + 1] = vi.y; xi[4 * c + 2] = vi.z; xi[4 * c + 3] = vi.w;
  }
}
DI void r16_store(float* re, float* im, int b, const float (&xr)[16], const float (&xi)[16]) {
#pragma unroll
  for (int c = 0; c < 4; ++c) {
    const int ph = 16 * b + 4 * ((c + (b >> 2)) & 3);
    *(float4*)(re + ph) = make_float4(xr[4 * c], xr[4 * c + 1], xr[4 * c + 2], xr[4 * c + 3]);
    *(float4*)(im + ph) = make_float4(xi[4 * c], xi[4 * c + 1], xi[4 * c + 2], xi[4 * c + 3]);
  }
}

DI void phase_filter_fft(const Params& p, int l, float* lds) {
  const int tid = ltid();
  float* re = lds;
  float* im = lds + FFTN;
  float* kf = (float*)(p.ws + OFF_KF);
  const float2* tw = (const float2*)(p.ws + OFF_TW);
  const float* part = (const float*)(p.ws + OFF_PART);
  for (int c = lbid(); c < 512; c += gridDim.x) {
    float* slot = kf + (size_t)c * (2 * FFTN);
    float pv = 0.f;
    if (tid < 128) pv = part[tid * 1024 + c] + part[tid * 1024 + 512 + c];
    pv = wave_sum(pv);
    if ((tid & 63) == 0) lds[tid >> 6] = pv;
    __syncthreads();
    const float ssq = lds[0] + lds[1];
    __syncthreads();
    const float sc = rsqrtf(ssq + EPSV) * (1.0f / (float)FFTN);
    for (int i = tid; i < FFTN; i += 512) { const int ph = fsw(i); re[ph] = slot[i] * sc; im[ph] = 0.f; }
    __syncthreads();
    fft_fwd4(re, im, tw);
    {
      float2* so = (float2*)slot;
#pragma unroll 1
      for (int b = tid; b < 1024; b += 512) {
        float xr[16], xi[16];
        r16_load(re, im, b, xr, xi);
        r16_fwd(xr, xi);
#pragma unroll
        for (int e = 0; e < 16; ++e) { float2 v; v.x = xr[e]; v.y = xi[e]; so[e * 1024 + b] = v; }
      }
    }
    __syncthreads();
  }
}

DI void phase_gemm1(const Params& p, int l, u16* lds) {
  const u16* hn = (const u16*)(p.ws + OFF_A);
  const u16* wt = (const u16*)(p.ws + OFF_W) + (size_t)l * W_LAYER + WO_T1;
  const int NT = 24, nitems = (MALL / 256) * NT;
  for (int it_ = lbid(); it_ < ((nitems + 255) & ~255); it_ += gridDim.x) {
    const int item = xcd_remap(it_);
    if (item >= nitems) continue;
    const int mt = item / NT, nt = item % NT;
    const int m0 = mt * 256, n0 = nt * 128;
    f32x16 acc[2][2];
    ACC_ZERO(acc);
    gemm_mainloop(hn + (size_t)m0 * 1024, 1024, wt + (size_t)n0 * 1024, 1024, 1024, acc, lds);
    u16* dst; int ld, cofs;
    if (nt < 4) { dst = (u16*)(p.ws + OFF_B); ld = 512; cofs = 0; }
    else if (nt < 12) { dst = (u16*)(p.ws + OFF_C); ld = 1024; cofs = 512; }
    else { dst = (u16*)(p.ws + OFF_R); ld = 1536; cofs = 1536; }
    stage_store_bf16(acc, dst, ld, m0, n0 - cofs, lds);
  }
}

DI void phase_h1(const Params& p, int l, float* lds) {
  const int tid = ltid();
  const u16* U12 = (const u16*)(p.ws + OFF_C);
  float* zT = (float*)(p.ws + OFF_A);
  const float* sw = p.hy_short_w + l * 3 * 1536;
  const int nlat = 8 * 128 * 8, nctx = (l < 3) ? 8 * 4 * 8 : 0;
  int par = 0;
  for (int item = lbid(); item < nlat + nctx; item += gridDim.x) {
    float* xs = lds + par * (2 * 66 * 65);
    float* vs = xs + 66 * 65;
    par ^= 1;
    int b, tt0, c0, Ls, rowbase; size_t zbase;
    if (item < nlat) { b = item >> 10; tt0 = ((item >> 3) & 127) * 64; c0 = (item & 7) * 64; Ls = LSEQ; rowbase = b * LSEQ; zbase = (size_t)b * 512 * LSEQ; }
    else { const int it = item - nlat; b = it >> 5; tt0 = ((it >> 3) & 3) * 64; c0 = (it & 7) * 64; Ls = LCTX; rowbase = ML + b * LCTX; zbase = (size_t)ZC_OFF + (size_t)b * 512 * LCTX; }
    for (int ch = tid; ch < 66 * 16; ch += 512) {
      const int arr = ch / 528, rem = ch - arr * 528;
      const int rr = rem >> 3, cc8 = (rem & 7) * 8;
      const int t = tt0 - 1 + rr;
      float* dstp = (arr ? vs : xs) + rr * 65 + cc8;
      if (t >= 0 && t < Ls) {
        const uint4 v = *(const uint4*)(U12 + (size_t)(rowbase + t) * 1024 + arr * 512 + c0 + cc8);
        const unsigned uu[4] = {v.x, v.y, v.z, v.w};
#pragma unroll
        for (int i = 0; i < 4; ++i) { dstp[2 * i] = __uint_as_float(uu[i] << 16); dstp[2 * i + 1] = __uint_as_float(uu[i] & 0xffff0000u); }
      } else {
#pragma unroll
        for (int i = 0; i < 8; ++i) dstp[i] = 0.f;
      }
    }
    __syncthreads();
    {
      const int tt = tid & 63, cgp = tid >> 6;
#pragma unroll
      for (int i = 0; i < 8; ++i) {
        const int cc = cgp * 8 + i, c = c0 + cc;
        float x1 = 0.f, vv = 0.f;
#pragma unroll
        for (int j = 0; j < 3; ++j) {
          x1 += sw[j * 1536 + 512 + c] * xs[(tt + j) * 65 + cc];
          vv += sw[j * 1536 + 1024 + c] * vs[(tt + j) * 65 + cc];
        }
        zT[zbase + (size_t)c * Ls + tt0 + tt] = x1 * vv;
      }
    }
  }
  __syncthreads();
}

DI void phase_p3(const Params& p, int l, float* lds) {
  const int tid = ltid(), lane = tid & 63, w = tid >> 6;
  u16* R = (u16*)(p.ws + OFF_R);
  float* rb = lds + w * 1472;
  float* hs = rb + 1440;
  const float* qn = p.gqa_q_norm + l * 64;
  const float* kn = p.gqa_k_norm + l * 64;
  const float* qan = p.mla_q_a_norm + l * 384;
  const float* kvan = p.mla_kv_a_norm + l * 256;
  const float* ropeg = (const float*)(p.ws + OFF_ROPEG);
  const float qscale = 0.125f * LOG2E;
  const int rstride = gridDim.x * 8;
  uint4 nv[3];
  {
    const u16* np_ = R + (size_t)(lbid() * 8 + w) * 1536;
#pragma unroll
    for (int i = 0; i < 3; ++i) { const int ch = lane + 64 * i; nv[i] = (ch < 180) ? *(const uint4*)(np_ + ch * 8) : make_uint4(0u, 0u, 0u, 0u); }
  }
  for (int r0 = lbid() * 8; r0 < MALL; r0 += rstride) {
    const int r = r0 + w;
    u16* rowp = R + (size_t)r * 1536;
#pragma unroll
    for (int i = 0; i < 3; ++i) {
      const int ch = lane + 64 * i;
      if (ch < 180) {
        const unsigned uu[4] = {nv[i].x, nv[i].y, nv[i].z, nv[i].w};
#pragma unroll
        for (int k = 0; k < 4; ++k) { rb[ch * 8 + 2 * k] = __uint_as_float(uu[k] << 16); rb[ch * 8 + 2 * k + 1] = __uint_as_float(uu[k] & 0xffff0000u); }
      }
    }
    if (r + rstride < MALL) {
      const u16* np_ = R + (size_t)(r + rstride) * 1536;
#pragma unroll
      for (int i = 0; i < 3; ++i) { const int ch = lane + 64 * i; if (ch < 180) nv[i] = VLOAD16(np_ + ch * 8); }
    }
    __builtin_amdgcn_wave_barrier();
    {
      float s = 0.f;
#pragma unroll
      for (int i = 0; i < 8; ++i) { const float v = rb[lane * 8 + i]; s += v * v; }
      s += __shfl_xor(s, 1); s += __shfl_xor(s, 2); s += __shfl_xor(s, 4);
      if ((lane & 7) == 0) hs[lane >> 3] = rsqrtf(s * (1.0f / 64.0f) + EPSV);
      float s2 = 0.f;
      if (lane < 16) {
#pragma unroll
        for (int i = 0; i < 8; ++i) { const float v = rb[512 + lane * 8 + i]; s2 += v * v; }
      }
      s2 += __shfl_xor(s2, 1); s2 += __shfl_xor(s2, 2); s2 += __shfl_xor(s2, 4);
      if (lane < 16 && (lane & 7) == 0) hs[8 + (lane >> 3)] = rsqrtf(s2 * (1.0f / 64.0f) + EPSV);
      float s3 = 0.f, s4 = 0.f;
#pragma unroll
      for (int i = 0; i < 6; ++i) { const float v = rb[768 + lane * 6 + i]; s3 += v * v; }
#pragma unroll
      for (int i = 0; i < 4; ++i) { const float v = rb[1152 + lane * 4 + i]; s4 += v * v; }
      s3 = wave_sum(s3); s4 = wave_sum(s4);
      if (lane == 0) { hs[10] = rsqrtf(s3 * (1.0f / 384.0f) + EPSV); hs[11] = rsqrtf(s4 * (1.0f / 256.0f) + EPSV); }
    }
    __builtin_amdgcn_wave_barrier();
    {
      const bool lat = r < ML;
      const int t = r & (LSEQ - 1);
      const int d = lane, a = d & 31;
      float cs = 1.f, sn = 0.f;
      if (lat) { cs = ropeg[(t * 32 + a) * 2]; sn = ropeg[(t * 32 + a) * 2 + 1]; }
#pragma unroll
      for (int hd = 0; hd < 10; ++hd) {
        const float* gq = (hd < 8) ? qn : kn;
        const float rs = hs[hd];
        const float v = rb[hd * 64 + d] * rs * gq[d];
        const int dp = d ^ 32;
        const float vp = rb[hd * 64 + dp] * rs * gq[dp];
        float o = (d < 32) ? (v * cs - vp * sn) : (vp * sn + v * cs);
        if (hd < 8) o *= qscale;
        rowp[hd * 64 + d] = f2bf(o);
      }
#pragma unroll
      for (int i = 0; i < 6; ++i) { const int e = lane + 64 * i; rowp[768 + e] = f2bf(rb[768 + e] * hs[10] * qan[e]); }
#pragma unroll
      for (int i = 0; i < 4; ++i) { const int e = lane + 64 * i; rowp[1152 + e] = f2bf(rb[1152 + e] * hs[11] * kvan[e]); }
    }
    __builtin_amdgcn_wave_barrier();
  }
}

DI void phase_h2(const Params& p, int l, float* lds) {
  const int tid = ltid(), lane = tid & 63, w = tid >> 6;
  float* zT = (float*)(p.ws + OFF_A);
  const float2* kf = (const float2*)(p.ws + OFF_KF);
  const float2* tw = (const float2*)(p.ws + OFF_TW);
  const float* skip = p.hy_skip + l * 512;
  float* re = lds;
  float* im = lds + FFTN;
  float za[16], zb[16], na[16], nb_[16];
  {
    const int it0 = lbid();
    if (it0 < 2048) {
      const int c0 = it0 >> 2, bp0 = it0 & 3;
      const float* s1 = zT + ((size_t)(2 * bp0) * 512 + c0) * LSEQ;
      const float* s2 = zT + ((size_t)(2 * bp0 + 1) * 512 + c0) * LSEQ;
#pragma unroll
      for (int k = 0; k < 16; ++k) { na[k] = s1[tid + 512 * k]; nb_[k] = s2[tid + 512 * k]; }
    }
  }
  for (int item = lbid(); item < 2048; item += gridDim.x) {
    const int c = item >> 2, bp = item & 3;
    float* z1 = zT + ((size_t)(2 * bp) * 512 + c) * LSEQ;
    float* z2 = zT + ((size_t)(2 * bp + 1) * 512 + c) * LSEQ;
#pragma unroll
    for (int k = 0; k < 16; ++k) {
      const int i = tid + 512 * k;
      za[k] = na[k]; zb[k] = nb_[k];
      const int p0 = fsw(i), p1 = fsw(i + LSEQ);
      re[p0] = za[k]; im[p0] = zb[k]; re[p1] = 0.f; im[p1] = 0.f;
    }
    __syncthreads();
    fft_fwd4(re, im, tw);
    {
      const float2* kc = kf + (size_t)c * FFTN;
#pragma unroll 1
      for (int b = tid; b < 1024; b += 512) {
        float xr[16], xi[16];
        r16_load(re, im, b, xr, xi);
        r16_fwd(xr, xi);
#pragma unroll
        for (int e = 0; e < 16; ++e) {
          const float2 k = kc[e * 1024 + b];
          const float a = xr[e], b2 = xi[e];
          xr[e] = a * k.x - b2 * k.y;
          xi[e] = a * k.y + b2 * k.x;
        }
        r16_inv(xr, xi);
        r16_store(re, im, b, xr, xi);
      }
    }
    {
      const int nit = item + gridDim.x;
      if (nit < 2048) {
        const int cn = nit >> 2, bpn = nit & 3;
        const float* s1 = zT + ((size_t)(2 * bpn) * 512 + cn) * LSEQ;
        const float* s2 = zT + ((size_t)(2 * bpn + 1) * 512 + cn) * LSEQ;
#pragma unroll
        for (int k = 0; k < 16; ++k) {
          na[k] = __builtin_bit_cast(float, *(const volatile unsigned*)(s1 + tid + 512 * k));
          nb_[k] = __builtin_bit_cast(float, *(const volatile unsigned*)(s2 + tid + 512 * k));
        }
      }
    }
    __syncthreads();
    fft_inv4(re, im, tw);
    const float sk = skip[c];
#pragma unroll
    for (int k = 0; k < 16; ++k) {
      const int i = tid + 512 * k;
      const int p0 = fsw(i);
      z1[i] = re[p0] + za[k] * sk;
      z2[i] = im[p0] + zb[k] * sk;
    }
    __syncthreads();
  }
  if (l < 3) {
    const float* kcb = (const float*)(p.ws + OFF_KC);
    const float* partc = (const float*)(p.ws + OFF_PART) + 128 * 1024;
    float* zs = lds + w * 768;
    float* ks = zs + 256;
    for (int item = lbid(); item < 512; item += gridDim.x) {
      const int b = item >> 6, c = (item & 63) * 8 + w;
      float* z = zT + (size_t)ZC_OFF + ((size_t)b * 512 + c) * LCTX;
      float pv = (lane < 4) ? partc[lane * 1024 + c] + partc[lane * 1024 + 512 + c] : 0.f;
      pv = wave_sum(pv);
      const float sc = rsqrtf(pv + EPSV);
      for (int i = lane; i < 256; i += 64) zs[i] = z[i];
      for (int i = lane; i < 512; i += 64) ks[i] = kcb[c * 512 + i] * sc;
      __syncthreads();
      const float sk = skip[c];
      float acc[4] = {0.f, 0.f, 0.f, 0.f};
      for (int s = 0; s < 256; ++s) {
        const float zv = zs[s];
#pragma unroll
        for (int i = 0; i < 4; ++i) acc[i] += ks[(lane + 64 * i - s) & 511] * zv;
      }
#pragma unroll
      for (int i = 0; i < 4; ++i) z[lane + 64 * i] = acc[i] + zs[lane + 64 * i] * sk;
      __syncthreads();
    }
  }
}

DI void phase_h3(const Params& p, int l, float* lds) {
  const int tid = ltid();
  const u16* U0 = (const u16*)(p.ws + OFF_B);
  const float* zT = (const float*)(p.ws + OFF_A);
  u16* Y = (u16*)(p.ws + OFF_Y);
  const float* sw = p.hy_short_w + l * 3 * 1536;
  const int nlat = 8 * 128 * 8, nctx = (l < 3) ? 8 * 4 * 8 : 0;
  int par = 0;
  for (int item = lbid(); item < nlat + nctx; item += gridDim.x) {
    float* xs = lds + par * (66 * 65 + 64 * 65);
    float* ys = xs + 66 * 65;
    par ^= 1;
    int b, tt0, c0, Ls, rowbase; size_t zbase;
    if (item < nlat) { b = item >> 10; tt0 = ((item >> 3) & 127) * 64; c0 = (item & 7) * 64; Ls = LSEQ; rowbase = b * LSEQ; zbase = (size_t)b * 512 * LSEQ; }
    else { const int it = item - nlat; b = it >> 5; tt0 = ((it >> 3) & 3) * 64; c0 = (it & 7) * 64; Ls = LCTX; rowbase = ML + b * LCTX; zbase = (size_t)ZC_OFF + (size_t)b * 512 * LCTX; }
    for (int ch = tid; ch < 66 * 8; ch += 512) {
      const int rr = ch >> 3, cc8 = (ch & 7) * 8;
      const int t = tt0 - 1 + rr;
      float* dstp = xs + rr * 65 + cc8;
      if (t >= 0 && t < Ls) {
        const uint4 v = *(const uint4*)(U0 + (size_t)(rowbase + t) * 512 + c0 + cc8);
        const unsigned uu[4] = {v.x, v.y, v.z, v.w};
#pragma unroll
        for (int i = 0; i < 4; ++i) { dstp[2 * i] = __uint_as_float(uu[i] << 16); dstp[2 * i + 1] = __uint_as_float(uu[i] & 0xffff0000u); }
      } else {
#pragma unroll
        for (int i = 0; i < 8; ++i) dstp[i] = 0.f;
      }
    }
    {
      const int tt = tid & 63, cgp = tid >> 6;
#pragma unroll
      for (int i = 0; i < 8; ++i) {
        const int cc = cgp * 8 + i;
        ys[cc * 65 + tt] = zT[zbase + (size_t)(c0 + cc) * Ls + tt0 + tt];
      }
    }
    __syncthreads();
    {
      const int cc = tid & 63, tg = tid >> 6, c = c0 + cc;
      const float w0 = sw[c], w1 = sw[1536 + c], w2 = sw[2 * 1536 + c];
#pragma unroll
      for (int i = 0; i < 8; ++i) {
        const int tt = tg * 8 + i;
        const float x0 = w0 * xs[tt * 65 + cc] + w1 * xs[(tt + 1) * 65 + cc] + w2 * xs[(tt + 2) * 65 + cc];
        Y[(size_t)(rowbase + tt0 + tt) * 1536 + c] = f2bf(x0 * ys[cc * 65 + tt]);
      }
    }
  }
  __syncthreads();
}

DI void phase_p4(const Params& p, int l, u16* lds) {
  const u16* R = (const u16*)(p.ws + OFF_R);
  u16* QK = (u16*)(p.ws + OFF_A);
  const u16* wl = (const u16*)(p.ws + OFF_W) + (size_t)l * W_LAYER;
  const int NT = 14, nitems = (MALL / 256) * NT;
  for (int it_ = lbid(); it_ < ((nitems + 255) & ~255); it_ += gridDim.x) {
    const int item = xcd_remap(it_);
    if (item >= nitems) continue;
    const int mt = item / NT, nt = item % NT;
    const int m0 = mt * 256;
    f32x16 acc[2][2];
    ACC_ZERO(acc);
    int n0;
    if (nt < 6) { n0 = nt * 128; gemm_mainloop(R + (size_t)m0 * 1536 + 768, 1536, wl + WO_QB + (size_t)n0 * 384, 384, 384, acc, lds); }
    else { n0 = (nt - 6) * 128; gemm_mainloop(R + (size_t)m0 * 1536 + 1152, 1536, wl + WO_KVB + (size_t)n0 * 256, 256, 256, acc, lds); n0 += 768; }
    stage_store_bf16(acc, QK, 1792, m0, n0, lds);
  }
}

DI void phase_p5(const Params& p, int l, float* lds) {
  const int tid = ltid(), lane = tid & 63, w = tid >> 6;
  u16* QK = (u16*)(p.ws + OFF_A);
  u16* KM = (u16*)(p.ws + OFF_KM);
  const u16* R = (const u16*)(p.ws + OFF_R);
  const float* qn = p.mla_q_norm + l * 96;
  const float* kn = p.mla_k_norm + l * 96;
  const float* ropem = (const float*)(p.ws + OFF_ROPEM);
  const float qscale = 0.10206207261596575f * LOG2E;
  const bool act = lane < 48;
  const int hd = act ? lane / 6 : 0, j = act ? lane - hd * 6 : 0;
  float gq[16], gk[16];
#pragma unroll
  for (int i = 0; i < 16; ++i) { gq[i] = qn[16 * j + i]; gk[i] = kn[16 * j + i]; }
  for (int r = lbid() * 8 + w; r < MALL; r += gridDim.x * 8) {
    u16* rowp = QK + (size_t)r * 1792;
    const u16* qsrc = rowp + hd * 96 + 16 * j;
    const u16* ksrc = (j < 4) ? rowp + 768 + hd * 128 + 16 * j : R + (size_t)r * 1536 + 1408 + 16 * (j - 4);
    const uint4 qa = *(const uint4*)(qsrc), qb = *(const uint4*)(qsrc + 8);
    const uint4 ka = *(const uint4*)(ksrc), kb = *(const uint4*)(ksrc + 8);
    float q[16], k[16];
    {
      const unsigned qu[8] = {qa.x, qa.y, qa.z, qa.w, qb.x, qb.y, qb.z, qb.w};
      const unsigned ku[8] = {ka.x, ka.y, ka.z, ka.w, kb.x, kb.y, kb.z, kb.w};
#pragma unroll
      for (int i = 0; i < 8; ++i) {
        q[2 * i] = __uint_as_float(qu[i] << 16); q[2 * i + 1] = __uint_as_float(qu[i] & 0xffff0000u);
        k[2 * i] = __uint_as_float(ku[i] << 16); k[2 * i + 1] = __uint_as_float(ku[i] & 0xffff0000u);
      }
    }
    float sq = 0.f, sk = 0.f;
#pragma unroll
    for (int i = 0; i < 16; ++i) { sq += q[i] * q[i]; sk += k[i] * k[i]; }
    float tq = 0.f, tk = 0.f;
#pragma unroll
    for (int u = 0; u < 6; ++u) { tq += __shfl(sq, hd * 6 + u); tk += __shfl(sk, hd * 6 + u); }
    const float rq = rsqrtf(tq * (1.0f / 96.0f) + EPSV) * qscale, rk = rsqrtf(tk * (1.0f / 96.0f) + EPSV);
#pragma unroll
    for (int i = 0; i < 16; ++i) { q[i] *= rq * gq[i]; k[i] *= rk * gk[i]; }
    const bool lat = r < ML;
    const int t = r & (LSEQ - 1);
    const int plane = (j == 4) ? lane + 1 : lane - 1;
    const bool rot = lat && act && (j >= 4);
    const float sgn = (j == 4) ? -1.f : 1.f;
    float qp[16], kp[16];
#pragma unroll
    for (int i = 0; i < 16; ++i) { qp[i] = __shfl(q[i], plane); kp[i] = __shfl(k[i], plane); }
    const float* rp = ropem + (size_t)t * 32;
#pragma unroll
    for (int i = 0; i < 16; ++i) {
      const float cs = rot ? rp[2 * i] : 1.f, sn = rot ? rp[2 * i + 1] * sgn : 0.f;
      q[i] = q[i] * cs + qp[i] * sn;
      k[i] = k[i] * cs + kp[i] * sn;
    }
    if (act) {
      uint4 o0, o1;
      o0.x = pk2(q[0], q[1]); o0.y = pk2(q[2], q[3]); o0.z = pk2(q[4], q[5]); o0.w = pk2(q[6], q[7]);
      o1.x = pk2(q[8], q[9]); o1.y = pk2(q[10], q[11]); o1.z = pk2(q[12], q[13]); o1.w = pk2(q[14], q[15]);
      *(uint4*)(rowp + hd * 96 + 16 * j) = o0;
      *(uint4*)(rowp + hd * 96 + 16 * j + 8) = o1;
      o0.x = pk2(k[0], k[1]); o0.y = pk2(k[2], k[3]); o0.z = pk2(k[4], k[5]); o0.w = pk2(k[6], k[7]);
      o1.x = pk2(k[8], k[9]); o1.y = pk2(k[10], k[11]); o1.z = pk2(k[12], k[13]); o1.w = pk2(k[14], k[15]);
      u16* kd = KM + (size_t)r * 768 + hd * 96 + 16 * j;
      *(uint4*)(kd) = o0;
      *(uint4*)(kd + 8) = o1;
    }
  }
}

template <int DQK>
DI void attn_block(const u16* __restrict__ Qp, int q_ld, const u16* __restrict__ Kp, int k_ld, const u16* __restrict__ Vp,
                   int v_ld, u16* __restrict__ Op, int o_ld, int qrow0, int nq, int qt0, int s0_row0, int s0_n, int s0_t0,
                   int masked0, int s1_row0, int s1_n, float sink_l2, int has_sink, u16* lds) {
  constexpr int KS = DQK + 8, NS = DQK / 16, CPK = DQK / 8;
  const int tid = ltid(), lane = tid & 63, w = tid >> 6, l32 = lane & 31, hh = lane >> 5;
  u16* Ks = lds;
  u16* Vt = lds + 2 * 64 * KS;
  bf16x8 qf[2][NS];
  f32x16 ot[2][2];
  float m[2], lsum[2];
#pragma unroll
  for (int qs = 0; qs < 2; ++qs) {
    const int qi = 64 * w + 32 * qs + l32;
    const int qr = qrow0 + ((qi < nq) ? qi : nq - 1);
#pragma unroll
    for (int s = 0; s < NS; ++s) qf[qs][s] = *(const bf16x8*)(Qp + (size_t)qr * q_ld + 16 * s + 8 * hh);
#pragma unroll
    for (int i = 0; i < 16; ++i) { ot[qs][0][i] = 0.f; ot[qs][1][i] = 0.f; }
    m[qs] = -1e30f; lsum[qs] = 0.f;
  }
  const int nt0 = s0_n >> 6, nt = nt0 + (s1_n >> 6);
  const int kkey0 = tid / CPK, kch0 = tid - kkey0 * CPK;
  const int c1 = tid + 512;
  const bool has1 = c1 < 64 * CPK;
  const int kkey1 = has1 ? c1 / CPK : 0, kch1 = has1 ? c1 - kkey1 * CPK : 0;
  const int vkey = tid & 63, vch = tid >> 6;
  uint4 rk0, rk1, rv;
  rk1 = make_uint4(0, 0, 0, 0);
  {
    const int row0 = (0 < nt0) ? s0_row0 : s1_row0;
    rk0 = *(const uint4*)(Kp + (size_t)(row0 + kkey0) * k_ld + kch0 * 8);
    if (has1) rk1 = *(const uint4*)(Kp + (size_t)(row0 + kkey1) * k_ld + kch1 * 8);
    rv = *(const uint4*)(Vp + (size_t)(row0 + vkey) * v_ld + vch * 8);
  }
  {
    *(uint4*)(Ks + kkey0 * KS + kch0 * 8) = rk0;
    if (has1) *(uint4*)(Ks + kkey1 * KS + kch1 * 8) = rk1;
    const unsigned uu[4] = {rv.x, rv.y, rv.z, rv.w};
#pragma unroll
    for (int i = 0; i < 4; ++i) {
      Vt[(vch * 8 + 2 * i) * 68 + vkey] = (u16)(uu[i] & 0xffffu);
      Vt[(vch * 8 + 2 * i + 1) * 68 + vkey] = (u16)(uu[i] >> 16);
    }
  }
  __syncthreads();
  const int tql = qt0 + 64 * w;
  for (int j = 0; j < nt; ++j) {
    const int cur = j & 1;
    {
      const int jn = (j + 1 < nt) ? j + 1 : j;
      const int row0 = (jn < nt0) ? s0_row0 + 64 * jn : s1_row0 + 64 * (jn - nt0);
      rk0 = VLOAD16(Kp + (size_t)(row0 + kkey0) * k_ld + kch0 * 8);
      if (DQK == 96) rk1 = VLOAD16(Kp + (size_t)(row0 + kkey1) * k_ld + kch1 * 8);
      rv = VLOAD16(Vp + (size_t)(row0 + vkey) * v_ld + vch * 8);
    }
    __builtin_amdgcn_sched_barrier(0);
    const bool mtile = masked0 && (j < nt0);
    const int tk0 = s0_t0 + 64 * j;
    bool active = true;
    if (mtile) active = (tk0 + 63 >= tql - 128) && (tk0 <= tql + 63 + 128);
    if (active) {
      const u16* kb = Ks + cur * 64 * KS + l32 * KS + hh * 8;
      f32x16 st[2][2];
#pragma unroll
      for (int i = 0; i < 16; ++i) { st[0][0][i] = 0.f; st[0][1][i] = 0.f; st[1][0][i] = 0.f; st[1][1][i] = 0.f; }
#pragma unroll
      for (int s = 0; s < NS; ++s) {
        const bf16x8 a0 = *(const bf16x8*)(kb + s * 16);
        const bf16x8 a1 = *(const bf16x8*)(kb + 32 * KS + s * 16);
        st[0][0] = MFMA(a0, qf[0][s], st[0][0]);
        st[0][1] = MFMA(a1, qf[0][s], st[0][1]);
        st[1][0] = MFMA(a0, qf[1][s], st[1][0]);
        st[1][1] = MFMA(a1, qf[1][s], st[1][1]);
      }
#pragma unroll
      for (int qs = 0; qs < 2; ++qs) {
        if (mtile) {
          const int tq = tql + 32 * qs + l32;
#pragma unroll
          for (int kt = 0; kt < 2; ++kt)
#pragma unroll
            for (int rg = 0; rg < 16; ++rg) {
              const int tk = tk0 + 32 * kt + (rg & 3) + 8 * (rg >> 2) + 4 * hh;
              const int dlt = tk - tq;
              if (dlt > 128 || dlt < -128) st[qs][kt][rg] = -1e30f;
            }
        }
        float mloc = st[qs][0][0];
#pragma unroll
        for (int rg = 1; rg < 16; ++rg) mloc = fmaxf(mloc, st[qs][0][rg]);
#pragma unroll
        for (int rg = 0; rg < 16; ++rg) mloc = fmaxf(mloc, st[qs][1][rg]);
        mloc = fmaxf(mloc, __shfl_xor(mloc, 32));
        const bool grow = mloc > m[qs] + 8.0f;
        if (__builtin_amdgcn_ballot_w64(grow) != 0ull) {
          const float mnew = fmaxf(m[qs], mloc);
          const float alpha = __builtin_amdgcn_exp2f(m[qs] - mnew);
          m[qs] = mnew;
          lsum[qs] *= alpha;
          const f32x2_t a2 = {alpha, alpha};
#pragma unroll
          for (int i = 0; i < 8; ++i) {
            f32x2_t o0 = {ot[qs][0][2 * i], ot[qs][0][2 * i + 1]}, o1 = {ot[qs][1][2 * i], ot[qs][1][2 * i + 1]};
            o0 *= a2; o1 *= a2;
            ot[qs][0][2 * i] = o0.x; ot[qs][0][2 * i + 1] = o0.y; ot[qs][1][2 * i] = o1.x; ot[qs][1][2 * i + 1] = o1.y;
          }
        }
        const f32x2_t nm2 = {-m[qs], -m[qs]};
        f32x2_t ps2 = {0.f, 0.f};
#pragma unroll
        for (int kt = 0; kt < 2; ++kt)
#pragma unroll
          for (int rg = 0; rg < 16; rg += 2) {
            f32x2_t sv = {st[qs][kt][rg], st[qs][kt][rg + 1]};
            sv += nm2;
            float p0 = __builtin_amdgcn_exp2f(sv.x), p1 = __builtin_amdgcn_exp2f(sv.y);
            if (mtile) { p0 = (st[qs][kt][rg] < -1e29f) ? 0.f : p0; p1 = (st[qs][kt][rg + 1] < -1e29f) ? 0.f : p1; }
            st[qs][kt][rg] = p0; st[qs][kt][rg + 1] = p1;
            const f32x2_t pv = {p0, p1};
            ps2 += pv;
          }
        lsum[qs] += ps2.x + ps2.y;
        __builtin_amdgcn_sched_barrier(0);
      }
      const u16* vb = Vt + cur * 64 * 68 + l32 * 68 + 4 * hh;
#pragma unroll
      for (int kt = 0; kt < 2; ++kt)
#pragma unroll
        for (int s = 0; s < 2; ++s) {
          bf16x8 pf[2];
#pragma unroll
          for (int qs = 0; qs < 2; ++qs) {
            unsigned pw[4];
#pragma unroll
            for (int i = 0; i < 4; ++i) pw[i] = pk2(st[qs][kt][8 * s + 2 * i], st[qs][kt][8 * s + 2 * i + 1]);
            const uint4 pu = make_uint4(pw[0], pw[1], pw[2], pw[3]);
            pf[qs] = __builtin_bit_cast(bf16x8, pu);
          }
#pragma unroll
          for (int dt = 0; dt < 2; ++dt) {
            const u16* vp = vb + dt * 32 * 68 + 32 * kt + 16 * s;
            const uint2 lo = *(const uint2*)(vp);
            const uint2 hi = *(const uint2*)(vp + 8);
            const uint4 au = make_uint4(lo.x, lo.y, hi.x, hi.y);
            const bf16x8 vf = __builtin_bit_cast(bf16x8, au);
            ot[0][dt] = MFMA(vf, pf[0], ot[0][dt]);
            ot[1][dt] = MFMA(vf, pf[1], ot[1][dt]);
          }
        }
    }
    __builtin_amdgcn_sched_barrier(0);
    {
      u16* Kw = Ks + (cur ^ 1) * 64 * KS;
      u16* Vw = Vt + (cur ^ 1) * 64 * 68;
      *(uint4*)(Kw + kkey0 * KS + kch0 * 8) = rk0;
      if (has1) *(uint4*)(Kw + kkey1 * KS + kch1 * 8) = rk1;
      const unsigned uu[4] = {rv.x, rv.y, rv.z, rv.w};
#pragma unroll
      for (int i = 0; i < 4; ++i) {
        Vw[(vch * 8 + 2 * i) * 68 + vkey] = (u16)(uu[i] & 0xffffu);
        Vw[(vch * 8 + 2 * i + 1) * 68 + vkey] = (u16)(uu[i] >> 16);
      }
    }
    __syncthreads();
  }
#pragma unroll
  for (int qs = 0; qs < 2; ++qs) {
    float ltot = lsum[qs] + __shfl_xor(lsum[qs], 32);
    if (has_sink) ltot += __builtin_amdgcn_exp2f(sink_l2 - m[qs]);
    const float inv = 1.0f / ltot;
    if (64 * w + 32 * qs + l32 < nq) {
#pragma unroll
      for (int dt = 0; dt < 2; ++dt)
#pragma unroll
        for (int g = 0; g < 4; ++g) {
          uint2 pk;
          pk.x = pk2(ot[qs][dt][4 * g] * inv, ot[qs][dt][4 * g + 1] * inv);
          pk.y = pk2(ot[qs][dt][4 * g + 2] * inv, ot[qs][dt][4 * g + 3] * inv);
          *(uint2*)(Op + (size_t)(qrow0 + 64 * w + 32 * qs + l32) * o_ld + dt * 32 + 8 * g + 4 * hh) = pk;
        }
    }
  }
}

DI void phase_attn(const Params& p, int l, u16* lds) {
  const u16* R = (const u16*)(p.ws + OFF_R);
  const u16* QK = (const u16*)(p.ws + OFF_A);
  const u16* KM = (const u16*)(p.ws + OFF_KM);
  u16* Y = (u16*)(p.ws + OFF_Y);
  const float* sink = p.gqa_sink + l * 8;
  const int n_mla = 1024, n_gqa = 1024, n_ctx = (l < 3) ? 128 : 0;
  const int n_all = n_mla + n_gqa + n_ctx;
  for (int it_ = lbid(); it_ < ((n_all + 255) & ~255); it_ += gridDim.x) {
    const int item = xcd_remap(it_);
    if (item >= n_all) continue;
    int kind, qb, hd, b, isctx;
    if (item < n_mla) { kind = 0; isctx = 0; qb = item & 15; hd = (item >> 4) & 7; b = item >> 7; }
    else if (item < n_mla + n_gqa) { const int it = item - n_mla; kind = 1; isctx = 0; qb = it & 15; hd = (it >> 4) & 7; b = it >> 7; }
    else { const int it = item - n_mla - n_gqa; isctx = 1; qb = 0; hd = it & 7; b = (it >> 3) & 7; kind = it >> 6; }
    const int crow0 = ML + b * LCTX;
    if (kind == 0) {
      int qrow0, nq, qt0, s0r, s0n, s1n;
      if (isctx) { qrow0 = crow0; nq = LCTX; qt0 = 0; s0r = crow0; s0n = LCTX; s1n = 0; }
      else { qrow0 = b * LSEQ + qb * 512; nq = 512; qt0 = qb * 512; s0r = b * LSEQ; s0n = LSEQ; s1n = LCTX; }
      attn_block<96>(QK + hd * 96, 1792, KM + hd * 96, 768, QK + 768 + hd * 128 + 64, 1792, Y + 1024 + hd * 64, 1536,
                     qrow0, nq, qt0, s0r, s0n, 0, 0, crow0, s1n, 0.f, 0, lds);
    } else {
      const int kvh = hd >> 2;
      int qrow0, nq, qt0, s0r, s0n, s0t, msk, s1n;
      if (isctx) { qrow0 = crow0; nq = LCTX; qt0 = 0; s0r = crow0; s0n = LCTX; s0t = 0; msk = 0; s1n = 0; }
      else {
        const int t0 = qb * 512;
        const int lo = (t0 - 128 < 0) ? 0 : t0 - 128;
        const int hi = (t0 + 640 > LSEQ) ? LSEQ : t0 + 640;
        qrow0 = b * LSEQ + t0; nq = 512; qt0 = t0; s0r = b * LSEQ + lo; s0n = hi - lo; s0t = lo; msk = 1; s1n = LCTX;
      }
      attn_block<64>(R + hd * 64, 1536, R + 512 + kvh * 64, 1536, R + 640 + kvh * 64, 1536, Y + 512 + hd * 64, 1536,
                     qrow0, nq, qt0, s0r, s0n, s0t, msk, crow0, s1n, sink[hd] * LOG2E, 1, lds);
    }
  }
}

DI void phase_p7a(const Params& p, int l, int nrows, u16* lds) {
  const u16* hn = (const u16*)(p.ws + OFF_A);
  const u16* wt = (const u16*)(p.ws + OFF_W) + (size_t)l * W_LAYER + WO_TG;
  u16* Gt = (u16*)(p.ws + OFF_B);
  const int NT = 24, nitems = (nrows / 256) * NT;
  for (int it_ = lbid(); it_ < ((nitems + 255) & ~255); it_ += gridDim.x) {
    const int item = xcd_remap(it_);
    if (item >= nitems) continue;
    const int m0 = (item / NT) * 256, n0 = (item % NT) * 128;
    f32x16 acc[2][2];
    ACC_ZERO(acc);
    gemm_mainloop(hn + (size_t)m0 * 1024, 1024, wt + (size_t)n0 * 1024, 1024, 1024, acc, lds);
    ACC_FOREACH(acc, m0, n0, { acc[mi_][ni_][r_] = sigmoidf_(val); });
    stage_store_bf16(acc, Gt, 3072, m0, n0, lds);
  }
}
DI void phase_p7b(const Params& p, int l, int nrows, u16* lds) {
  const u16* Y = (const u16*)(p.ws + OFF_Y);
  const u16* Gt = (const u16*)(p.ws + OFF_B);
  const u16* wb = (const u16*)(p.ws + OFF_W) + (size_t)l * W_LAYER + WO_BR;
  u16* mg = (u16*)(p.ws + OFF_A);
  const int NT = 8, nitems = (nrows / 256) * NT;
  for (int it_ = lbid(); it_ < ((nitems + 255) & ~255); it_ += gridDim.x) {
    const int item = xcd_remap(it_);
    if (item >= nitems) continue;
    const int m0 = (item / NT) * 256, n0 = (item % NT) * 128;
    f32x16 mrg[2][2];
    ACC_ZERO(mrg);
#pragma unroll 1
    for (int nb = 0; nb < 3; ++nb) {
      f32x16 acc[2][2];
      ACC_ZERO(acc);
      gemm_mainloop<true>(Y + (size_t)m0 * 1536 + nb * 512, 1536, wb + (size_t)nb * 1024 * 512 + (size_t)n0 * 512, 512, 512, acc, lds);
      {
        u16* gs = lds;
        const int tid = ltid();
#pragma unroll
        for (int i = 0; i < 8; ++i) {
          const int ch = tid + 512 * i, rr = ch >> 4, c16 = ch & 15;
          const uint4 v = *(const uint4*)(Gt + (size_t)(m0 + rr) * 3072 + nb * 1024 + n0 + c16 * 8);
          *(uint4*)(gs + rr * 136 + c16 * 8) = v;
        }
        __syncthreads();
        ACC_FOREACH(acc, 0, 0, { mrg[mi_][ni_][r_] += bf2f(gs[row * 136 + col]) * val; });
        __syncthreads();
      }
    }
    stage_store_bf16(mrg, mg, 1024, m0, n0, lds);
  }
}
DI void phase_p8(const Params& p, int l, int nrows, u16* lds) {
  const u16* mg = (const u16*)(p.ws + OFF_A);
  const u16* wt = (const u16*)(p.ws + OFF_W) + (size_t)l * W_LAYER + WO_OUT;
  const float* xs = (l == 0) ? p.x : p.out;
  const float* cs = (l == 0) ? p.ctx : (const float*)(p.ws + OFF_CTX);
  float* cd = (float*)(p.ws + OFF_CTX);
  const int NT = 8, nitems = (nrows / 256) * NT;
  for (int it_ = lbid(); it_ < ((nitems + 255) & ~255); it_ += gridDim.x) {
    const int item = xcd_remap(it_);
    if (item >= nitems) continue;
    const int m0 = (item / NT) * 256, n0 = (item % NT) * 128;
    f32x16 acc[2][2];
    ACC_ZERO(acc);
    gemm_mainloop(mg + (size_t)m0 * 1024, 1024, wt + (size_t)n0 * 1024, 1024, 1024, acc, lds);
    const int mrow = (m0 < ML) ? (m0 >> 13) : 8;
    const float* gate = mods_ptr(p, l, mrow, 2);
    ACC_FOREACH(acc, m0, n0, {
      const float g = gate[col];
      if (row < ML) p.out[(size_t)row * 1024 + col] = xs[(size_t)row * 1024 + col] + g * val;
      else cd[(size_t)(row - ML) * 1024 + col] = cs[(size_t)(row - ML) * 1024 + col] + g * val;
    });
  }
}
DI void phase_p10(const Params& p, int l, int nrows, u16* lds) {
  const u16* hn = (const u16*)(p.ws + OFF_A);
  const u16* wt = (const u16*)(p.ws + OFF_W) + (size_t)l * W_LAYER + WO_W1;
  u16* h1 = (u16*)(p.ws + OFF_B);
  const int NT = 32, nitems = (nrows / 256) * NT;
  for (int it_ = lbid(); it_ < ((nitems + 255) & ~255); it_ += gridDim.x) {
    const int item = xcd_remap(it_);
    if (item >= nitems) continue;
    const int m0 = (item / NT) * 256, n0 = (item % NT) * 128;
    f32x16 acc[2][2];
    ACC_ZERO(acc);
    gemm_mainloop(hn + (size_t)m0 * 1024, 1024, wt + (size_t)n0 * 1024, 1024, 1024, acc, lds);
    ACC_FOREACH(acc, m0, n0, { const float rl = fmaxf(val, 0.f); acc[mi_][ni_][r_] = rl * rl; });
    stage_store_bf16(acc, h1, 4096, m0, n0, lds);
  }
}
DI void phase_p11(const Params& p, int l, int nrows, u16* lds) {
  const u16* h1 = (const u16*)(p.ws + OFF_B);
  const u16* wt = (const u16*)(p.ws + OFF_W) + (size_t)l * W_LAYER + WO_W2;
  float* cd = (float*)(p.ws + OFF_CTX);
  const int NT = 8, nitems = (nrows / 256) * NT;
  for (int it_ = lbid(); it_ < ((nitems + 255) & ~255); it_ += gridDim.x) {
    const int item = xcd_remap(it_);
    if (item >= nitems) continue;
    const int m0 = (item / NT) * 256, n0 = (item % NT) * 128;
    f32x16 acc[2][2];
    ACC_ZERO(acc);
    gemm_mainloop(h1 + (size_t)m0 * 4096, 4096, wt + (size_t)n0 * 4096, 4096, 4096, acc, lds);
    const int mrow = (m0 < ML) ? (m0 >> 13) : 8;
    const float* gate = mods_ptr(p, l, mrow, 5);
    ACC_FOREACH(acc, m0, n0, {
      const float g = gate[col];
      float* dp = (row < ML) ? p.out + (size_t)row * 1024 + col : cd + (size_t)(row - ML) * 1024 + col;
      *dp = *dp + g * val;
    });
  }
}

DI void phase_gemm1_b(const Params& p, int l, char* lds) {
  EpiRouteBf16 E; E.ws = p.ws;
  run_gemm256((const u16*)(p.ws + OFF_A), (const u16*)(p.ws + OFF_W) + (size_t)l * W_LAYER + WO_T1, MALL, 3072, 1024, E, lds);
}
DI void phase_p4_b(const Params& p, int l, char* lds) {
  const u16* R = (const u16*)(p.ws + OFF_R);
  const u16* wl = (const u16*)(p.ws + OFF_W) + (size_t)l * W_LAYER;
  EpiActBf16<0> E; E.ldc = 1792;
  E.O = (u16*)(p.ws + OFF_A);
  run_gemm256(R + 768, wl + WO_QB, MALL, 768, 384, E, lds, 1536);
  E.O = (u16*)(p.ws + OFF_A) + 768;
  run_gemm256(R + 1152, wl + WO_KVB, MALL, 1024, 256, E, lds, 1536);
}
DI void phase_p7a_b(const Params& p, int l, int nrows, char* lds) {
  EpiActBf16<1> E; E.O = (u16*)(p.ws + OFF_B); E.ldc = 3072;
  run_gemm256((const u16*)(p.ws + OFF_A), (const u16*)(p.ws + OFF_W) + (size_t)l * W_LAYER + WO_TG, nrows, 3072, 1024, E, lds);
}
DI void phase_p10_b(const Params& p, int l, int nrows, char* lds) {
  EpiActBf16<2> E; E.O = (u16*)(p.ws + OFF_B); E.ldc = 4096;
  run_gemm256((const u16*)(p.ws + OFF_A), (const u16*)(p.ws + OFF_W) + (size_t)l * W_LAYER + WO_W1, nrows, 4096, 1024, E, lds);
}
DI void phase_p8_b(const Params& p, int l, int nrows, char* lds) {
  EpiResid E;
  E.xs = (l == 0) ? p.x : p.out; E.cs = (l == 0) ? p.ctx : (const float*)(p.ws + OFF_CTX);
  E.xo = p.out; E.co = (float*)(p.ws + OFF_CTX); E.gbase = mods_ptr(p, l, 0, 2);
  run_gemm256((const u16*)(p.ws + OFF_A), (const u16*)(p.ws + OFF_W) + (size_t)l * W_LAYER + WO_OUT, nrows, 1024, 1024, E, lds);
}
DI void phase_p11_b(const Params& p, int l, int nrows, char* lds) {
  EpiResid E;
  E.xs = p.out; E.cs = (const float*)(p.ws + OFF_CTX);
  E.xo = p.out; E.co = (float*)(p.ws + OFF_CTX); E.gbase = mods_ptr(p, l, 0, 5);
  run_gemm256((const u16*)(p.ws + OFF_B), (const u16*)(p.ws + OFF_W) + (size_t)l * W_LAYER + WO_W2, nrows, 1024, 4096, E, lds);
}

#define OFF_BAR 985907200ull
#define XB_TMO      128
#define XB_XCNT(j)  (256  + 64 * (j))
#define XB_XSUB(j)  (1280 + 64 * (j))
#define XB_XGEN(j)  (2304 + 64 * (j))
#define XB_TOP      3328
#define XB_TOPGEN   3392
#define XCD_BAR_WORDS 3456
#define XB_SPIN_CAP (1u << 18)
#define LAS __attribute__((address_space(3)))
DI unsigned xb_ld(unsigned* p) { return __hip_atomic_load(p, __ATOMIC_RELAXED, __HIP_MEMORY_SCOPE_AGENT); }
DI unsigned xb_add(unsigned* p, unsigned v) { return __hip_atomic_fetch_add(p, v, __ATOMIC_RELAXED, __HIP_MEMORY_SCOPE_AGENT); }
DI unsigned xb_xcc_id() { return (unsigned)__builtin_amdgcn_s_getreg((3 << 11) | 20) & 0xFu; }
#define XB_SPIN(cond, bar) do { unsigned _sp = 0; while (cond) { __builtin_amdgcn_s_sleep(1); \
    if ((++_sp & 255u) == 0u) { if (xb_ld(&(bar)[XB_TMO])) break; if (_sp > XB_SPIN_CAP) { atomicAdd(&(bar)[XB_TMO], 1u); break; } } } } while (0)
struct XcdBarrier { unsigned* bar; unsigned x; volatile LAS unsigned* st; };
DI XcdBarrier xcd_barrier_post(unsigned* bar, volatile LAS unsigned* st) {
  XcdBarrier b; b.bar = bar; b.x = xb_xcc_id(); b.st = st;
  if (threadIdx.x == 0) (void)xb_add(&bar[XB_XCNT(b.x)], 1u);
  return b;
}
DI void xcd_barrier_complete(unsigned* bar, unsigned x, unsigned& nloc, unsigned& nx) {
  const unsigned G = gridDim.x * gridDim.y * gridDim.z;
  unsigned sum, cnt, mine, sp = 0u;
  for (;;) {
    sum = 0u; cnt = 0u; mine = 0u;
#pragma unroll
    for (unsigned j = 0; j < 16; ++j) { const unsigned c = xb_ld(&bar[XB_XCNT(j)]); sum += c; cnt += (c > 0u) ? 1u : 0u; mine = (j == x) ? c : mine; }
    if (sum == G) break;
    __builtin_amdgcn_s_sleep(1);
    if ((++sp & 255u) == 0u) { if (xb_ld(&bar[XB_TMO])) break; if (sp > XB_SPIN_CAP) { atomicAdd(&bar[XB_TMO], 1u); break; } }
  }
  nloc = mine > 0u ? mine : 1u; nx = cnt > 0u ? cnt : 1u;
}
DI void xcd_barrier(const XcdBarrier& b) {
  asm volatile("s_waitcnt vmcnt(0) lgkmcnt(0)" ::: "memory");
  __syncthreads();
  if (threadIdx.x == 0) {
    unsigned* bar = b.bar;
    __builtin_amdgcn_s_waitcnt(0);
    unsigned nloc = b.st[0], nx = b.st[1];
    if (nloc == 0u) { xcd_barrier_complete(bar, b.x, nloc, nx); b.st[0] = nloc; b.st[1] = nx; }
    const unsigned old = xb_add(&bar[XB_XSUB(b.x)], 1u);
    const unsigned gen = old / nloc;
    if (old + 1u == (gen + 1u) * nloc) {
      __builtin_amdgcn_fence(__ATOMIC_RELEASE, "agent");
      asm volatile("s_waitcnt vmcnt(0)" ::: "memory");
      const unsigned og = xb_add(&bar[XB_TOP], 1u);
      const unsigned tg = og / nx;
      if (og + 1u == (tg + 1u) * nx) xb_add(&bar[XB_TOPGEN], 1u);
      else XB_SPIN(xb_ld(&bar[XB_TOPGEN]) == tg, bar);
      __builtin_amdgcn_fence(__ATOMIC_ACQUIRE, "agent");
      xb_add(&bar[XB_XGEN(b.x)], 1u);
      asm volatile("s_waitcnt vmcnt(0)" ::: "memory");
    } else {
      XB_SPIN(xb_ld(&bar[XB_XGEN(b.x)]) == gen, bar);
      __builtin_amdgcn_fence(__ATOMIC_ACQUIRE, "agent");
      asm volatile("s_waitcnt vmcnt(0)" ::: "memory");
    }
  }
  __syncthreads();
}

DI void gsync(cg::grid_group& grid) {
  asm volatile("s_waitcnt vmcnt(0) lgkmcnt(0)" ::: "memory");
  grid.sync();
  if (ltid() < 64) {
    __builtin_amdgcn_fence(__ATOMIC_ACQUIRE, "agent");
    asm volatile("s_waitcnt vmcnt(0)" ::: "memory");
  }
  __syncthreads();
}

__global__ void __launch_bounds__(512) fwd_megakernel(Params p) {
  __shared__ __attribute__((aligned(16))) char lds[131072];
  __shared__ uint4 xb_words;
  cg::grid_group grid = cg::this_grid();
  if (threadIdx.x == 0) xb_words = make_uint4(0u, 0u, 0u, 0u);
  __syncthreads();
  const XcdBarrier xb = xcd_barrier_post((unsigned*)(p.ws + OFF_BAR), (volatile LAS unsigned*)&xb_words);
  phase0(p, lds);
  gsync(grid);
  for (int l = 0; l < 4; ++l) {
    const int nrows2 = (l < 3) ? MALL : ML;
#ifdef PROBE_SYNC10
    for (int q = 0; q < 10; ++q) xcd_barrier(xb);
#endif
#ifdef PROBE_FILT
    filter_tiles(p, l, LSEQ, 2 * FFTN, (float*)(p.ws + OFF_KF), (float*)(p.ws + OFF_PART), (float*)lds);
    xcd_barrier(xb);
    phase_filter_fft(p, l, (float*)lds);
    xcd_barrier(xb);
#endif
    phase_rownorm(p, l, 0, MALL);
#ifdef PROBE_ELEM
    phase_rownorm(p, l, 0, MALL);
    phase_rownorm(p, l, 0, MALL);
    phase_rownorm(p, l, 0, MALL);
#endif
    filter_tiles(p, l, LSEQ, 2 * FFTN, (float*)(p.ws + OFF_KF), (float*)(p.ws + OFF_PART), (float*)lds);
    if (l < 3) filter_tiles(p, l, LCTX, 512, (float*)(p.ws + OFF_KC), (float*)(p.ws + OFF_PART) + 128 * 1024, (float*)lds);
    xcd_barrier(xb);
    phase_gemm1_b(p, l, lds);
#ifdef PROBE_BIGG
    phase_gemm1_b(p, l, lds);
#endif
    phase_filter_fft(p, l, (float*)lds);
    xcd_barrier(xb);
    phase_h1(p, l, (float*)lds);
#ifdef PROBE_ELEM
    phase_h1(p, l, (float*)lds);
#endif
    phase_p3(p, l, (float*)lds);
    xcd_barrier(xb);
    phase_h2(p, l, (float*)lds);
    xcd_barrier(xb);
#ifdef PROBE_H2
    phase_h1(p, l, (float*)lds);
    xcd_barrier(xb);
    phase_h2(p, l, (float*)lds);
    xcd_barrier(xb);
#endif
    phase_h3(p, l, (float*)lds);
#ifdef PROBE_ELEM
    phase_h3(p, l, (float*)lds);
#endif
    xcd_barrier(xb);
    phase_p4(p, l, (u16*)lds);
#ifdef PROBE_SMALLG
    phase_p4(p, l, (u16*)lds);
#endif
    xcd_barrier(xb);
    phase_p5(p, l, (float*)lds);
    xcd_barrier(xb);
#ifdef PROBE_P45
    phase_p4(p, l, (u16*)lds);
    xcd_barrier(xb);
    phase_p5(p, l, (float*)lds);
    xcd_barrier(xb);
#endif
    phase_attn(p, l, (u16*)lds);
#ifdef PROBE_ATTN2
    xcd_barrier(xb);
    phase_attn(p, l, (u16*)lds);
#endif
    xcd_barrier(xb);
    phase_rownorm(p, l, 0, nrows2);
    xcd_barrier(xb);
    phase_p7a_b(p, l, nrows2, lds);
#ifdef PROBE_BIGG
    phase_p7a_b(p, l, nrows2, lds);
#endif
    xcd_barrier(xb);
    phase_p7b(p, l, nrows2, (u16*)lds);
#ifdef PROBE_SMALLG
    phase_p7b(p, l, nrows2, (u16*)lds);
#endif
    xcd_barrier(xb);
    phase_p8_b(p, l, nrows2, lds);
    xcd_barrier(xb);
    phase_rownorm(p, l, 1, nrows2);
    xcd_barrier(xb);
    phase_p10_b(p, l, nrows2, lds);
#ifdef PROBE_BIGG
    phase_p10_b(p, l, nrows2, lds);
#endif
    xcd_barrier(xb);
    phase_p11_b(p, l, nrows2, lds);
    xcd_barrier(xb);
  }
}

extern "C" void kernel_launch(void* const* d_in, const int* in_sizes, int n_in, void* d_out, int out_size, void* d_ws,
                              size_t ws_size, hipStream_t stream) {
  static int grid_blocks = 0;
  if (!grid_blocks) {
    int dev = 0, cus = 0, per_cu = 0;
    hipGetDevice(&dev);
    hipDeviceGetAttribute(&cus, hipDeviceAttributeMultiprocessorCount, dev);
    hipOccupancyMaxActiveBlocksPerMultiprocessor(&per_cu, fwd_megakernel, 512, 0);
    if (per_cu < 1) per_cu = 1;
    if (per_cu > 1) per_cu = 1;
    grid_blocks = cus * per_cu;
  }
  Params p{};
  const float** pp = (const float**)&p;
  for (int i = 0; i < 30; ++i) pp[i] = (const float*)d_in[i];
  p.out = (float*)d_out;
  p.ws = (char*)d_ws;
  hipMemsetAsync((char*)d_ws + OFF_BAR, 0, XCD_BAR_WORDS * sizeof(unsigned), stream);
  void* args[] = {&p};
  hipError_t e = hipLaunchCooperativeKernel((void*)fwd_megakernel, dim3(grid_blocks), dim3(512), args, 0, stream);
  if (e != hipSuccess) fprintf(stderr, "cooperative launch failed: %s (grid %d)\n", hipGetErrorString(e), grid_blocks);
}
```

```cpp
#include <hip/hip_runtime.h>
#include <hip/hip_cooperative_groups.h>
#include <cstdio>
namespace cg = cooperative_groups;

typedef unsigned short u16;
typedef short bf16x8 __attribute__((ext_vector_type(8)));
typedef float f32x16 __attribute__((ext_vector_type(16)));
typedef unsigned u32x4 __attribute__((ext_vector_type(4)));
#define VLOAD16(ptr) __builtin_bit_cast(uint4, *(const volatile u32x4*)(ptr))
typedef __bf16 bf16x2_t __attribute__((ext_vector_type(2)));
typedef float f32x2_t __attribute__((ext_vector_type(2)));
#define DI __device__ __forceinline__
#define MFMA(a, b, c) __builtin_amdgcn_mfma_f32_32x32x16_bf16((a), (b), (c), 0, 0, 0)

#define DM 1024
#define NBATCH 8
#define LSEQ 8192
#define LCTX 256
#define ML 65536
#define MC 2048
#define MALL 67584
#define NIN 6048
#define FFTN 16384
#define EPSV 1e-6f
#define LOG2E 1.4426950408889634f

#define W_LAYER 17858560ull
#define WO_T1 0ull
#define WO_TG 3145728ull
#define WO_QB 6291456ull
#define WO_KVB 6586368ull
#define WO_BR 6848512ull
#define WO_OUT 8421376ull
#define WO_W1 9469952ull
#define WO_W2 13664256ull
#define OFF_W 0ull
#define OFF_CTX 142868480ull
#define OFF_KF 151257088ull
#define OFF_KC 218365952ull
#define OFF_MODS 219414528ull
#define OFF_SUMSQ 220299264ull
#define OFF_ROPEG 220315648ull
#define OFF_ROPEM 222412800ull
#define OFF_TW 223461376ull
#define OFF_A 223592448ull
#define OFF_B 362004480ull
#define OFF_C 431210496ull
#define OFF_R 569622528ull
#define OFF_Y 777240576ull
#define OFF_KM (OFF_A + 242221056ull)
#define OFF_PART 984858624ull
#define ZC_OFF 33554432

struct Params {
  const float *x, *c, *ctx, *c_ctx, *w_mod, *b_mod, *norm_mix_g, *norm_mlp_g, *w_in, *hy_short_w, *hy_f1_w, *hy_f1_b,
      *hy_f2_w, *hy_f2_b, *hy_sin_freq, *hy_f3_w, *hy_skip, *gqa_q_norm, *gqa_k_norm, *gqa_sink, *mla_q_a_norm,
      *mla_kv_a_norm, *w_q_b, *w_kv_b, *mla_q_norm, *mla_k_norm, *w_branch, *w_out, *w_mlp1, *w_mlp2;
  float* out;
  char* ws;
};

DI int ltid() { int t = threadIdx.x; asm volatile("" : "+v"(t)); return t; }
DI int lbid() { int t = blockIdx.x; asm volatile("" : "+s"(t)); return t; }
DI u16 f2bf(float x) { return __builtin_bit_cast(u16, (__bf16)x); }
DI float bf2f(u16 v) { return __uint_as_float(((unsigned)v) << 16); }
DI unsigned pk2(float a, float b) {
  f32x2_t f = {a, b};
  return __builtin_bit_cast(unsigned, __builtin_convertvector(f, bf16x2_t));
}
DI float wave_sum(float v) {
#pragma unroll
  for (int o = 32; o > 0; o >>= 1) v += __shfl_xor(v, o);
  return v;
}
DI float sigmoidf_(float x) { return 1.0f / (1.0f + __expf(-x)); }
DI const float* mods_ptr(const Params& p, int l, int mrow, int j) {
  return (const float*)(p.ws + OFF_MODS) + ((size_t)(l * 9 + mrow) * 6144 + j * 1024);
}

template <bool LOWREG = false>
DI void gemm_mainloop(const u16* __restrict__ Ag, int lda, const u16* __restrict__ Bg, int ldb, int K,
                      f32x16 (&acc)[2][2], u16* lds) {
  const int tid = ltid(), lane = tid & 63, w = tid >> 6, l32 = lane & 31, hh = lane >> 5;
  const int wm = w >> 1, wn = w & 1;
  u16* As = lds;
  u16* Bs = lds + 2 * 256 * 72;
  const int arow = tid >> 3, ach = tid & 7;
  const u16* ap = Ag + (size_t)arow * lda + ach * 8;
  const u16* bp = Bg + (size_t)arow * ldb + ach * 8;
  const int nk = K >> 6;
  uint4 ra0[4], rb0[2], ra1[4], rb1[2];
#define G_LOAD(RA, RB, T)                                                                   \
  {                                                                                         \
    const int t_ = ((T) < nk) ? (T) : nk - 1;                                               \
    _Pragma("unroll") for (int i = 0; i < 4; ++i) RA[i] = VLOAD16(ap + (size_t)(64 * i) * lda + 64 * t_); \
    _Pragma("unroll") for (int i = 0; i < 2; ++i) RB[i] = VLOAD16(bp + (size_t)(64 * i) * ldb + 64 * t_); \
  }
#define G_STORE(RA, RB, BUF)                                                                \
  {                                                                                         \
    u16* Aw = As + (BUF) * 256 * 72;                                                        \
    u16* Bw = Bs + (BUF) * 128 * 72;                                                        \
    _Pragma("unroll") for (int i = 0; i < 4; ++i) *(uint4*)(Aw + (arow + 64 * i) * 72 + ach * 8) = RA[i]; \
    _Pragma("unroll") for (int i = 0; i < 2; ++i) *(uint4*)(Bw + (arow + 64 * i) * 72 + ach * 8) = RB[i]; \
  }
#define G_COMPUTE(BUF, RA, RB, WBUF)                                                        \
  {                                                                                         \
    const u16* as = As + (BUF) * 256 * 72 + (wm * 64 + l32) * 72 + hh * 8;                  \
    const u16* bs = Bs + (BUF) * 128 * 72 + (wn * 64 + l32) * 72 + hh * 8;                  \
    u16* Aw = As + (WBUF) * 256 * 72 + arow * 72 + ach * 8;                                 \
    u16* Bw = Bs + (WBUF) * 128 * 72 + arow * 72 + ach * 8;                                 \
    _Pragma("unroll") for (int s = 0; s < 4; ++s) {                                         \
      bf16x8 a0 = *(const bf16x8*)(as + s * 16), a1 = *(const bf16x8*)(as + 32 * 72 + s * 16); \
      bf16x8 b0 = *(const bf16x8*)(bs + s * 16), b1 = *(const bf16x8*)(bs + 32 * 72 + s * 16); \
      acc[0][0] = MFMA(a0, b0, acc[0][0]);                                                  \
      acc[0][1] = MFMA(a0, b1, acc[0][1]);                                                  \
      acc[1][0] = MFMA(a1, b0, acc[1][0]);                                                  \
      acc[1][1] = MFMA(a1, b1, acc[1][1]);                                                  \
      if (s == 0) { *(uint4*)(Aw) = RA[0]; *(uint4*)(Aw + 64 * 72) = RA[1]; }               \
      if (s == 1) { *(uint4*)(Aw + 128 * 72) = RA[2]; *(uint4*)(Aw + 192 * 72) = RA[3]; }   \
      if (s == 2) { *(uint4*)(Bw) = RB[0]; *(uint4*)(Bw + 64 * 72) = RB[1]; }               \
      if (LOWREG) __builtin_amdgcn_sched_barrier(0);                                        \
    }                                                                                       \
  }
  G_LOAD(ra0, rb0, 0);
  G_LOAD(ra1, rb1, 1);
  __builtin_amdgcn_sched_barrier(0);
  G_STORE(ra0, rb0, 0);
  __syncthreads();
  for (int kt = 0; kt < nk; kt += 2) {
    G_LOAD(ra0, rb0, kt + 2);
    __builtin_amdgcn_sched_barrier(0);
    G_COMPUTE(0, ra1, rb1, 1);
    __syncthreads();
    G_LOAD(ra1, rb1, kt + 3);
    __builtin_amdgcn_sched_barrier(0);
    G_COMPUTE(1, ra0, rb0, 0);
    __syncthreads();
  }
#undef G_LOAD
#undef G_STORE
#undef G_COMPUTE
}

DI int xcd_remap(int it) { const int r = it & 255; return (it & ~255) + ((r & 7) << 5) + (r >> 3); }

#define ACC_ZERO(acc)                                                                      \
  _Pragma("unroll") for (int mi_ = 0; mi_ < 2; ++mi_) _Pragma("unroll") for (int ni_ = 0; ni_ < 2; ++ni_) \
      _Pragma("unroll") for (int r_ = 0; r_ < 16; ++r_) acc[mi_][ni_][r_] = 0.f;

#define ACC_FOREACH(acc, m0, n0, BODY)                                                     \
  {                                                                                        \
    const int lane_ = ltid() & 63, w_ = ltid() >> 6;                             \
    const int l32_ = lane_ & 31, hh_ = lane_ >> 5, wm_ = w_ >> 1, wn_ = w_ & 1;            \
    _Pragma("unroll") for (int mi_ = 0; mi_ < 2; ++mi_) _Pragma("unroll") for (int ni_ = 0; ni_ < 2; ++ni_) { \
        __builtin_amdgcn_sched_barrier(0);                                                 \
        _Pragma("unroll") for (int r_ = 0; r_ < 16; ++r_) {                                \
      const int row = (m0) + wm_ * 64 + mi_ * 32 + (r_ & 3) + 8 * (r_ >> 2) + 4 * hh_;     \
      const int col = (n0) + wn_ * 64 + ni_ * 32 + l32_;                                   \
      const float val = acc[mi_][ni_][r_];                                                    \
      BODY                                                                                 \
    } }                                                                                    \
  }

DI void stage_store_bf16(f32x16 (&acc)[2][2], u16* __restrict__ dst, int ld, int m0, int c0, u16* lds) {
  u16* cs = lds;
  ACC_FOREACH(acc, 0, 0, { cs[row * 136 + col] = f2bf(val); });
  __syncthreads();
  const int tid = ltid();
#pragma unroll
  for (int i = 0; i < 8; ++i) {
    const int ch = tid + 512 * i, rr = ch >> 4, c16 = ch & 15;
    const uint4 v = *(const uint4*)(cs + rr * 136 + c16 * 8);
    *(uint4*)(dst + (size_t)(m0 + rr) * ld + c0 + c16 * 8) = v;
  }
  __syncthreads();
}

namespace pg8 {
#define PG8_LAS __attribute__((address_space(3)))
typedef unsigned short bf16_t;
typedef short bf16x8 __attribute__((ext_vector_type(8)));
typedef float f32x4 __attribute__((ext_vector_type(4)));
typedef unsigned u32x4 __attribute__((ext_vector_type(4)));
constexpr int BM = 256, BK = 64, HALF = 128, HTB = HALF * BK * 2  , STAGE_BYTES = 8 * HTB, NXCD = 8, WGM = 8;

__host__ __device__ __forceinline__ int lds_byte(int r, int c) { const int st = (r >> 4) * 2 + (c >> 5), rr = r & 15, cc = c & 31, ob = rr * 64 + cc * 2; return st * 1024 + (ob ^ (((ob >> 9) & 1) << 5)); }
__host__ __device__ __forceinline__ void stage_rc(int b, int& R, int& C) { const int st = b / 1024, sb = b % 1024, swz = sb ^ (((sb >> 9) & 1) << 5); R = (st >> 1) * 16 + swz / 64; C = (st & 1) * 32 + (swz % 64) / 2; }
__host__ __device__ __forceinline__ int perm32(int rho) { const int n = rho >> 4, i = rho & 15; return 8 * (i >> 2) + 4 * n + (i & 3); }

struct Unit { int pm, pn; };
struct Gemm { const bf16_t* A; const bf16_t* Bt; int M, N, K, lda; };

struct StaticOrder {
    int nM, nN, nwg, G, c;
    __host__ __device__ void init(int M, int N, int G_, int c_) { nM = M / BM; nN = N / BM; nwg = nM * nN; G = G_; c = c_; }
    __host__ __device__ bool next(int i, Unit& u) const {
        const long L = (long)i * G + c; if (L >= nwg) return false;
        int wgid = (int)L; { const int q = nwg / NXCD, r = nwg % NXCD, xcd = wgid % NXCD, off = wgid / NXCD; wgid = (xcd < r ? xcd * (q + 1) : r * (q + 1) + (xcd - r) * q) + off; }
        const int nig = WGM * nN, gid = wgid / nig, fm = gid * WGM, gsz = (nM - fm) < WGM ? (nM - fm) : WGM;
        u.pm = fm + ((wgid % nig) % gsz); u.pn = (wgid % nig) / gsz; return true;
    }
    __device__ __forceinline__ void a_ready(const Unit&) const {}
    __device__ __forceinline__ void done(const Unit&) const {}
};
template <class Epi, class Sched, bool STAMP = false>
__device__ __forceinline__ void gemm_phase(PG8_LAS unsigned char* lds, const Gemm g, const Sched& S, const Epi& E, unsigned long long* stamps) {
    const int tid = ltid(), wid = __builtin_amdgcn_readfirstlane(tid >> 6), lane = tid & 63, wr = wid >> 2, wc = wid & 3, fr = lane & 15, fq = lane >> 4;
    const int K = g.K, nt = K / BK;
    int ts_lo = 0, ts_hi = 0, nts = 0; const unsigned long long rt_entry = STAMP ? (unsigned long long)wall_clock64() : 0ull;
#define PG8_STAMP() do { if (STAMP && wid == 0 && nts < 64) { const unsigned long long _c = (unsigned long long)clock64(); \
        ts_lo = (lane == nts) ? (int)(unsigned)_c : ts_lo; ts_hi = (lane == nts) ? (int)(unsigned)(_c >> 32) : ts_hi; ++nts; } } while (0)
    PG8_STAMP();
    unsigned voffA[2], voffB[2];
#pragma unroll
    for (int i = 0; i < 2; ++i) { int R, C; stage_rc(tid * 16 + i * 8192, R, C); const int Rb = Epi::PERM ? ((R & ~31) + perm32(R & 31)) : R;
        voffA[i] = (unsigned)(R * g.lda + C) * 2u; voffB[i] = (unsigned)(Rb * K + C) * 2u; }
    const size_t kstep = (size_t)(BK * 2);
    const size_t hstep = (size_t)HALF * K * 2;
    const size_t tstep = 2 * hstep;
    const size_t hstepA = (size_t)HALF * g.lda * 2, tstepA = 2 * hstepA;
    const unsigned ldsw = (unsigned)wid * 1024u;
    const int aoff = lds_byte(wr * 64 + fr, fq * 8), boff = lds_byte(wc * 32 + fr, fq * 8);
#define PG8_SA(b, h) (((b) * 2 + (h)) * HTB)
#define PG8_SB(b, h) ((4 + (b) * 2 + (h)) * HTB)
#define PG8_STAGE(bufoff, gbase, voff) do { _Pragma("unroll") for (int _i = 0; _i < 2; ++_i) \
        __builtin_amdgcn_global_load_lds((const unsigned*)((const char*)(gbase) + (voff)[_i]), (PG8_LAS unsigned*)(lds + (bufoff) + ldsw + _i * 8192), 16, 0, 0); } while (0)
#define PG8_LDA(dst, b, h) do { _Pragma("unroll") for (int m = 0; m < 4; ++m) _Pragma("unroll") for (int k = 0; k < 2; ++k) dst[m][k] = *(const PG8_LAS bf16x8*)(lds + PG8_SA(b, h) + aoff + m * 2048 + k * 1024); } while (0)
#define PG8_LDB(dst, b, h) do { _Pragma("unroll") for (int n = 0; n < 2; ++n) _Pragma("unroll") for (int k = 0; k < 2; ++k) dst[n][k] = *(const PG8_LAS bf16x8*)(lds + PG8_SB(b, h) + boff + n * 2048 + k * 1024); } while (0)
#define PG8_MMA(ai, bj, At, Bt) do { __builtin_amdgcn_s_setprio(1); _Pragma("unroll") for (int m = 0; m < 4; ++m) _Pragma("unroll") for (int n = 0; n < 2; ++n) _Pragma("unroll") for (int k = 0; k < 2; ++k) \
        acc[ai][bj][m][n] = __builtin_amdgcn_mfma_f32_16x16x32_bf16(Bt[n][k], At[m][k], acc[ai][bj][m][n], 0, 0, 0); __builtin_amdgcn_s_setprio(0); } while (0)
#define PG8_WAIT_V(n) asm volatile("s_waitcnt vmcnt(" #n ")" ::: "memory")
#define PG8_WAIT_L(n) asm volatile("s_waitcnt lgkmcnt(" #n ")" ::: "memory")
#define PG8_BAR __builtin_amdgcn_s_barrier()
#define PG8_SCHED __builtin_amdgcn_sched_barrier(0)
    Unit cur, nxt; int ui = 0;
    if (!S.next(0, cur)) return;
    f32x4 acc[2][2][4][2];
#pragma unroll
    for (int a = 0; a < 2; ++a)
#pragma unroll
        for (int b = 0; b < 2; ++b)
#pragma unroll
            for (int m = 0; m < 4; ++m)
#pragma unroll
                for (int n = 0; n < 2; ++n) acc[a][b][m][n] = (f32x4){0.f, 0.f, 0.f, 0.f};
    bf16x8 At[4][2], B0[2][2], B1[2][2];
    const char* cA = (const char*)g.A + (size_t)cur.pm * tstepA; const char* cB = (const char*)g.Bt + (size_t)cur.pn * tstep;
    S.a_ready(cur);
    PG8_STAGE(PG8_SB(0, 0), cB, voffB); PG8_STAGE(PG8_SA(0, 0), cA, voffA); PG8_STAGE(PG8_SB(0, 1), cB + hstep, voffB); PG8_STAGE(PG8_SA(0, 1), cA + hstepA, voffA);
    if (wr == 1) PG8_BAR;
    PG8_WAIT_V(4); PG8_BAR;
    PG8_STAGE(PG8_SB(1, 0), cB + kstep, voffB); PG8_STAGE(PG8_SA(1, 0), cA + kstep, voffA); PG8_STAGE(PG8_SB(1, 1), cB + hstep + kstep, voffB);
    PG8_WAIT_V(6); PG8_BAR;
    PG8_STAMP();
    for (;;) {
        const bool has_next = S.next(ui + 1, nxt);
        const char* nA = has_next ? (const char*)g.A + (size_t)nxt.pm * tstepA : cA; const char* nB = has_next ? (const char*)g.Bt + (size_t)nxt.pn * tstep : cB;
        for (int t = 0; t < nt; t += 2) {
            const bool last = (t == nt - 2);
            const char* a1 = cA + (size_t)(t + 1) * kstep;
            const char* a2 = last ? nA : cA + (size_t)(t + 2) * kstep; const char* b2 = last ? nB : cB + (size_t)(t + 2) * kstep;
            const char* a3 = a2 + kstep; const char* b3 = b2 + kstep;
            if (last && has_next) S.a_ready(nxt);
            PG8_LDB(B0, 0, 0); PG8_SCHED; PG8_LDA(At, 0, 0); PG8_STAGE(PG8_SA(1, 1), a1 + hstepA, voffA);
            PG8_WAIT_L(8); PG8_BAR; PG8_WAIT_L(0); PG8_MMA(0, 0, At, B0); PG8_BAR; PG8_SCHED;
            PG8_LDB(B1, 0, 1); PG8_STAGE(PG8_SB(0, 0), b2, voffB);
            PG8_BAR; PG8_WAIT_L(0); PG8_MMA(0, 1, At, B1); PG8_BAR;
            PG8_LDA(At, 0, 1); PG8_STAGE(PG8_SA(0, 0), a2, voffA);
            PG8_BAR; PG8_WAIT_L(0); PG8_MMA(1, 0, At, B0); PG8_BAR; PG8_SCHED;
            PG8_STAGE(PG8_SB(0, 1), b2 + hstep, voffB);
            PG8_WAIT_V(6); PG8_BAR; PG8_MMA(1, 1, At, B1); PG8_BAR;
            PG8_LDB(B0, 1, 0); PG8_SCHED; PG8_LDA(At, 1, 0); PG8_STAGE(PG8_SA(0, 1), a2 + hstepA, voffA);
            PG8_WAIT_L(8); PG8_BAR; PG8_WAIT_L(0); PG8_MMA(0, 0, At, B0); PG8_BAR; PG8_SCHED;
            PG8_LDB(B1, 1, 1); PG8_STAGE(PG8_SB(1, 0), b3, voffB);
            PG8_BAR; PG8_WAIT_L(0); PG8_MMA(0, 1, At, B1); PG8_BAR;
            PG8_LDA(At, 1, 1); PG8_STAGE(PG8_SA(1, 0), a3, voffA);
            PG8_BAR; PG8_WAIT_L(0); PG8_MMA(1, 0, At, B0); PG8_BAR; PG8_SCHED;
            PG8_STAGE(PG8_SB(1, 1), b3 + hstep, voffB);
            PG8_WAIT_V(6); PG8_BAR; PG8_MMA(1, 1, At, B1); PG8_BAR;
        }
        PG8_STAMP();
        if constexpr (!Epi::AFTER_DRAIN) { E(acc, cur, wr, wc, fr, fq); S.done(cur); }
        PG8_STAMP();
        if (!has_next) break;
#pragma unroll
        for (int a = 0; a < 2; ++a)
#pragma unroll
            for (int b = 0; b < 2; ++b)
#pragma unroll
                for (int m = 0; m < 4; ++m)
#pragma unroll
                    for (int n = 0; n < 2; ++n) acc[a][b][m][n] = (f32x4){0.f, 0.f, 0.f, 0.f};
        cur = nxt; cA = nA; cB = nB; ++ui;
    }
    PG8_WAIT_V(0);
    if (wr == 0) PG8_BAR;
    PG8_BAR;
    if constexpr (Epi::AFTER_DRAIN) { E.fused(acc, cur, wr, wc, fr, fq, lds, wid, lane); S.done(cur); }
    PG8_STAMP();
    if (STAMP && wid == 0) { stamps[lane] = lane < nts ? (((unsigned long long)(unsigned)ts_hi << 32) | (unsigned)ts_lo) : 0ull;
        if (lane == 62) stamps[62] = rt_entry; if (lane == 63) stamps[63] = (unsigned long long)wall_clock64(); }
#undef PG8_STAMP
#undef PG8_SA
#undef PG8_SB
#undef PG8_STAGE
#undef PG8_LDA
#undef PG8_LDB
#undef PG8_MMA
#undef PG8_WAIT_V
#undef PG8_WAIT_L
#undef PG8_BAR
#undef PG8_SCHED
}
}

DI uint4 pack8_bf16(const pg8::f32x4& v0, const pg8::f32x4& v1) {
  uint4 w; w.x = pk2(v0[0], v0[1]); w.y = pk2(v0[2], v0[3]); w.z = pk2(v1[0], v1[1]); w.w = pk2(v1[2], v1[3]); return w;
}
struct EpiRouteBf16 {
  static constexpr bool PERM = true, AFTER_DRAIN = false;
  char* ws;
  DI void operator()(const pg8::f32x4 (&acc)[2][2][4][2], const pg8::Unit& u, int wr, int wc, int fr, int fq) const {
    const int row0 = u.pm * 256 + wr * 64 + fr;
    u16* base; int ld, colt;
    if (u.pn < 2) { base = (u16*)(ws + OFF_B); ld = 512; colt = u.pn * 256; }
    else if (u.pn < 6) { base = (u16*)(ws + OFF_C); ld = 1024; colt = u.pn * 256 - 512; }
    else { base = (u16*)(ws + OFF_R); ld = 1536; colt = u.pn * 256 - 1536; }
    const int col0 = colt + wc * 32 + 8 * fq;
#pragma unroll
    for (int ai = 0; ai < 2; ++ai)
#pragma unroll
      for (int m = 0; m < 4; ++m) {
        u16* rowp = base + (size_t)(row0 + ai * 128 + m * 16) * ld + col0;
#pragma unroll
        for (int bj = 0; bj < 2; ++bj) *(uint4*)(rowp + bj * 128) = pack8_bf16(acc[ai][bj][m][0], acc[ai][bj][m][1]);
      }
  }
};
template <int ACT  > struct EpiActBf16 {
  static constexpr bool PERM = true, AFTER_DRAIN = false;
  u16* O; int ldc;
  DI void operator()(const pg8::f32x4 (&acc)[2][2][4][2], const pg8::Unit& u, int wr, int wc, int fr, int fq) const {
    const int row0 = u.pm * 256 + wr * 64 + fr, col0 = u.pn * 256 + wc * 32 + 8 * fq;
#pragma unroll
    for (int ai = 0; ai < 2; ++ai)
#pragma unroll
      for (int m = 0; m < 4; ++m) {
        u16* rowp = O + (size_t)(row0 + ai * 128 + m * 16) * ldc + col0;
#pragma unroll
        for (int bj = 0; bj < 2; ++bj) {
          pg8::f32x4 v0 = acc[ai][bj][m][0], v1 = acc[ai][bj][m][1];
#pragma unroll
          for (int j = 0; j < 4; ++j) {
            if (ACT == 1) { v0[j] = sigmoidf_(v0[j]); v1[j] = sigmoidf_(v1[j]); }
            else if (ACT == 2) { const float a = fmaxf(v0[j], 0.f), b = fmaxf(v1[j], 0.f); v0[j] = a * a; v1[j] = b * b; }
          }
          *(uint4*)(rowp + bj * 128) = pack8_bf16(v0, v1);
        }
      }
  }
};
struct EpiResid {
  static constexpr bool PERM = false, AFTER_DRAIN = false;
  const float* xs; const float* cs; float* xo; float* co; const float* gbase;
  DI void operator()(const pg8::f32x4 (&acc)[2][2][4][2], const pg8::Unit& u, int wr, int wc, int fr, int fq) const {
    const int rowt = u.pm * 256;
    const int row0 = rowt + wr * 64 + fr, col0 = u.pn * 256 + wc * 32 + 4 * fq;
    const bool lat = rowt < ML;
    const int mrow = lat ? (rowt >> 13) : 8;
    const float* gate = gbase + (size_t)mrow * 6144;
    const float* src = lat ? xs : cs - (size_t)ML * 1024;
    float* dst = lat ? xo : co - (size_t)ML * 1024;
    pg8::f32x4 gv[2][2];
#pragma unroll
    for (int bj = 0; bj < 2; ++bj)
#pragma unroll
      for (int n = 0; n < 2; ++n) gv[bj][n] = *(const pg8::f32x4*)(gate + col0 + bj * 128 + n * 16);
#pragma unroll
    for (int ai = 0; ai < 2; ++ai)
#pragma unroll
      for (int m = 0; m < 4; ++m) {
        const size_t off = (size_t)(row0 + ai * 128 + m * 16) * 1024 + col0;
#pragma unroll
        for (int bj = 0; bj < 2; ++bj)
#pragma unroll
          for (int n = 0; n < 2; ++n) {
            const pg8::f32x4 xv = *(const pg8::f32x4*)(src + off + bj * 128 + n * 16);
            *(pg8::f32x4*)(dst + off + bj * 128 + n * 16) = xv + gv[bj][n] * acc[ai][bj][m][n];
          }
      }
  }
};
template <class Epi>
DI void run_gemm256(const u16* A, const u16* Bt, int M, int N, int K, const Epi& E, char* lds, int lda = 0) {
  pg8::Gemm g; g.A = A; g.Bt = Bt; g.M = M; g.N = N; g.K = K; g.lda = lda ? lda : K;
  pg8::StaticOrder S; S.init(M, N, (int)gridDim.x, lbid());
  pg8::gemm_phase<Epi, pg8::StaticOrder, false>((PG8_LAS unsigned char*)lds, g, S, E, nullptr);
  __syncthreads();
}

DI void conv_job(const float* __restrict__ src, int ld, int K, int col0, int nvalid, int npad, u16* __restrict__ dst,
                 int& off, float* ts) {
  const int tid = ltid();
  const int tk = K >> 6, tn = npad >> 6, ntiles = tk * tn;
  const int G = gridDim.x;
  int first = ((int)lbid() - (off % G) + G) % G;
  for (int tile = first; tile < ntiles; tile += G) {
    const int k0 = (tile % tk) * 64, n0 = (tile / tk) * 64;
    {
      const int cc = tid & 63, rg = tid >> 6;
      const bool ok = (n0 + cc) < nvalid;
#pragma unroll
      for (int i = 0; i < 8; ++i) {
        const int rr = rg * 8 + i;
        ts[rr * 65 + cc] = ok ? src[(size_t)(k0 + rr) * ld + col0 + n0 + cc] : 0.f;
      }
    }
    __syncthreads();
    {
      const int kk = tid & 63, ng = tid >> 6;
#pragma unroll
      for (int i = 0; i < 8; ++i) {
        const int nn = ng * 8 + i;
        dst[(size_t)(n0 + nn) * K + k0 + kk] = f2bf(ts[kk * 65 + nn]);
      }
    }
    __syncthreads();
  }
  off += ntiles;
}

DI void phase0(const Params& p, char* ldsc) {
  float* ldsf = (float*)ldsc;
  const int tid = ltid();
  const int G = gridDim.x;
  int off = 0;
  for (int l = 0; l < 4; ++l) {
    u16* wl = (u16*)(p.ws + OFF_W) + (size_t)l * W_LAYER;
    conv_job(p.w_in + (size_t)l * 1024 * NIN, NIN, 1024, 0, 2976, 3072, wl + WO_T1, off, ldsf);
    conv_job(p.w_in + (size_t)l * 1024 * NIN, NIN, 1024, 2976, 3072, 3072, wl + WO_TG, off, ldsf);
    conv_job(p.w_q_b + (size_t)l * 384 * 768, 768, 384, 0, 768, 768, wl + WO_QB, off, ldsf);
    conv_job(p.w_kv_b + (size_t)l * 256 * 1024, 1024, 256, 0, 1024, 1024, wl + WO_KVB, off, ldsf);
    for (int nb = 0; nb < 3; ++nb)
      conv_job(p.w_branch + (size_t)(l * 3 + nb) * 512 * 1024, 1024, 512, 0, 1024, 1024, wl + WO_BR + (size_t)nb * 1024 * 512, off, ldsf);
    conv_job(p.w_out + (size_t)l * 1024 * 1024, 1024, 1024, 0, 1024, 1024, wl + WO_OUT, off, ldsf);
    conv_job(p.w_mlp1 + (size_t)l * 1024 * 4096, 4096, 1024, 0, 4096, 4096, wl + WO_W1, off, ldsf);
    conv_job(p.w_mlp2 + (size_t)l * 4096 * 1024, 1024, 4096, 0, 1024, 1024, wl + WO_W2, off, ldsf);
  }
  {
    float* sc = ldsf;
    float* red = ldsf + 9 * 1024;
    for (int i = tid; i < 9 * 1024; i += 512) {
      float v = (i < 8 * 1024) ? p.c[i] : p.c_ctx[i - 8 * 1024];
      sc[i] = v / (1.0f + expf(-v));
    }
    __syncthreads();
    float* mods = (float*)(p.ws + OFF_MODS);
    const int ol = tid & 63, kg = tid >> 6;
    for (int item = lbid(); item < 384; item += G) {
      const int l = item / 96, o = (item % 96) * 64 + ol;
      const float* wp = p.w_mod + (size_t)l * 1024 * 6144 + o;
      float acc[9];
#pragma unroll
      for (int b = 0; b < 9; ++b) acc[b] = 0.f;
#pragma unroll 4
      for (int k = kg * 128; k < kg * 128 + 128; ++k) {
        const float wv = wp[(size_t)k * 6144];
#pragma unroll
        for (int b = 0; b < 9; ++b) acc[b] += sc[b * 1024 + k] * wv;
      }
#pragma unroll
      for (int b = 0; b < 9; ++b) red[(kg * 9 + b) * 64 + ol] = acc[b];
      __syncthreads();
      for (int i = tid; i < 576; i += 512) {
        const int b = i >> 6, o2 = i & 63;
        float s = 0.f;
#pragma unroll
        for (int g = 0; g < 8; ++g) s += red[(g * 9 + b) * 64 + o2];
        const int oc = (item % 96) * 64 + o2;
        mods[(size_t)(l * 9 + b) * 6144 + oc] = s + p.b_mod[l * 6144 + oc];
      }
      __syncthreads();
    }
  }
  {
    const int gt = lbid() * 512 + tid, GT = G * 512;
    float* rg = (float*)(p.ws + OFF_ROPEG);
    float* rm = (float*)(p.ws + OFF_ROPEM);
    float* tw = (float*)(p.ws + OFF_TW);
    for (int i = gt; i < LSEQ * 32; i += GT) {
      const int t = i >> 5, a = i & 31;
      const float pos = (a < 16) ? (float)(t >> 6) : (float)(t & 63);
      const float inv = powf(10000.0f, -(float)(a & 15) / 16.0f);
      const float ang = pos * inv;
      rg[2 * i] = cosf(ang);
      rg[2 * i + 1] = sinf(ang);
    }
    for (int i = gt; i < LSEQ * 16; i += GT) {
      const int t = i >> 4, a = i & 15;
      const float pos = (a < 8) ? (float)(t >> 6) : (float)(t & 63);
      const float inv = powf(10000.0f, -(float)(a & 7) / 8.0f);
      const float ang = pos * inv;
      rm[2 * i] = cosf(ang);
      rm[2 * i + 1] = sinf(ang);
    }
    for (int i = gt; i < FFTN; i += GT) {
      float sn, cs;
      sincospif(2.0f * (float)i / (float)FFTN, &sn, &cs);
      tw[2 * i] = cs;
      tw[2 * i + 1] = -sn;
    }
  }
}

DI void phase_rownorm(const Params& p, int l, int which, int nrows) {
  const int tid = ltid(), lane = tid & 63, w = tid >> 6;
  u16* hn = (u16*)(p.ws + OFF_A);
  const float* g = (which ? p.norm_mlp_g : p.norm_mix_g) + l * 1024;
  const bool first = (which == 0 && l == 0);
  const float* xs = first ? p.x : p.out;
  const float* cs = first ? p.ctx : (const float*)(p.ws + OFF_CTX);
  const int stride = gridDim.x * 8;
  for (int r = lbid() * 8 + w; r < nrows; r += 2 * stride) {
    int rr[2]; rr[0] = r; rr[1] = r + stride;
    const bool has2 = rr[1] < nrows;
    if (!has2) rr[1] = r;
    rr[0] = __builtin_amdgcn_readfirstlane(rr[0]);
    rr[1] = __builtin_amdgcn_readfirstlane(rr[1]);
    float4 v[2][4];
    float ss[2] = {0.f, 0.f};
#pragma unroll
    for (int q = 0; q < 2; ++q) {
      const float* src = (rr[q] < ML) ? xs + (size_t)rr[q] * 1024 : cs + (size_t)(rr[q] - ML) * 1024;
#pragma unroll
      for (int i = 0; i < 4; ++i) v[q][i] = *(const float4*)(src + 4 * (lane + 64 * i));
    }
#pragma unroll
    for (int q = 0; q < 2; ++q) {
#pragma unroll
      for (int i = 0; i < 4; ++i) ss[q] += v[q][i].x * v[q][i].x + v[q][i].y * v[q][i].y + v[q][i].z * v[q][i].z + v[q][i].w * v[q][i].w;
      ss[q] = wave_sum(ss[q]);
    }
#pragma unroll
    for (int q = 0; q < 2; ++q) {
      if (q == 1 && !has2) break;
      const int mrow = (rr[q] < ML) ? (rr[q] >> 13) : 8;
      const float* shift = mods_ptr(p, l, mrow, which ? 3 : 0);
      const float* scale = mods_ptr(p, l, mrow, which ? 4 : 1);
      const float rstd = rsqrtf(ss[q] * (1.0f / 1024.0f) + EPSV);
#pragma unroll
      for (int i = 0; i < 4; ++i) {
        const int c0 = 4 * (lane + 64 * i);
        const float4 gg = *(const float4*)(g + c0), sh = *(const float4*)(shift + c0), sc = *(const float4*)(scale + c0);
        const float o0 = v[q][i].x * rstd * gg.x * (1.f + sc.x) + sh.x;
        const float o1 = v[q][i].y * rstd * gg.y * (1.f + sc.y) + sh.y;
        const float o2 = v[q][i].z * rstd * gg.z * (1.f + sc.z) + sh.z;
        const float o3 = v[q][i].w * rstd * gg.w * (1.f + sc.w) + sh.w;
        uint2 pk;
        pk.x = pk2(o0, o1);
        pk.y = pk2(o2, o3);
        *(uint2*)(hn + (size_t)rr[q] * 1024 + c0) = pk;
      }
    }
  }
}

DI void filter_tiles(const Params& p, int l, int Lf, int cstride, float* __restrict__ kdst, float* __restrict__ part, float* lds) {
  const int tid = ltid(), lane = tid & 63, w = tid >> 6;
  float* zs = lds;
  float* h1s = lds + 64 * 33;
  float* h2s = h1s + 64 * 65;
  float* w3s = h2s + 64 * 65;
  const float* f1w = p.hy_f1_w + l * 33 * 64;
  const float* f1b = p.hy_f1_b + l * 64;
  const float* f2w = p.hy_f2_w + l * 64 * 64;
  const float* f2b = p.hy_f2_b + l * 64;
  const float* sf = p.hy_sin_freq + l * 128;
  const float* f3w = p.hy_f3_w + (size_t)l * 64 * 1024;
  const int nitem = (Lf >> 6) * 4;
  const float min_decay = logf(1e-2f) / 1.5f, max_decay = logf(1e-2f) / 0.3f;
  for (int item = lbid(); item < nitem; item += gridDim.x) {
    const int tile = item >> 2, quarter = item & 3;
    const int t0 = tile * 64;
    for (int idx = tid; idx < 64 * 33; idx += 512) {
      const int tt = idx / 33, e = idx - tt * 33;
      const int t = t0 + tt;
      float val;
      if (e == 0) {
        val = (float)t / (float)(Lf - 1);
      } else {
        const float wt = 6.283185307179586f * (float)t / (float)Lf;
        const int bi = (e - 1) & 15;
        const float f = 1e-4f + (float)bi * ((15.0f - 1e-4f) / 15.0f);
        val = (e <= 16) ? cosf(f * wt) : -sinf(f * wt);
      }
      zs[idx] = val;
    }
    for (int idx = tid; idx < 64 * 64; idx += 512) {
      const int i = idx >> 6, c4 = (idx & 63) * 4;
      *(float4*)(w3s + i * 256 + c4) = *(const float4*)(f3w + i * 1024 + quarter * 256 + c4);
    }
    __syncthreads();
    {
      const int tt = tid & 63, jg = tid >> 6;
#pragma unroll 1
      for (int jj = 0; jj < 8; ++jj) {
        const int j = jg * 8 + jj;
        float a = f1b[j];
#pragma unroll 3
        for (int e = 0; e < 33; ++e) a += zs[tt * 33 + e] * f1w[e * 64 + j];
        h1s[tt * 65 + j] = sinf(sf[j] * a);
      }
    }
    __syncthreads();
    {
      const int tt = tid & 63, jg = tid >> 6;
#pragma unroll 1
      for (int jj = 0; jj < 8; ++jj) {
        const int j = jg * 8 + jj;
        float a = f2b[j];
#pragma unroll 4
        for (int e = 0; e < 64; ++e) a += h1s[tt * 65 + e] * f2w[e * 64 + j];
        h2s[tt * 65 + j] = sinf(sf[64 + j] * a);
      }
    }
    __syncthreads();
    {
      const int tt = lane, t = t0 + tt;
      const float tn = (float)t / (float)(Lf - 1);
#pragma unroll 1
      for (int ob = w * 32; ob < w * 32 + 32; ob += 16) {
        float acc[16];
#pragma unroll
        for (int q = 0; q < 16; ++q) acc[q] = 0.f;
#pragma unroll 4
        for (int i = 0; i < 64; ++i) {
          const float hv = h2s[tt * 65 + i];
          const float* wr = w3s + i * 256 + ob;
#pragma unroll
          for (int q4 = 0; q4 < 4; ++q4) {
            const float4 wv = *(const float4*)(wr + 4 * q4);
            acc[4 * q4] += hv * wv.x; acc[4 * q4 + 1] += hv * wv.y; acc[4 * q4 + 2] += hv * wv.z; acc[4 * q4 + 3] += hv * wv.w;
          }
        }
#pragma unroll
        for (int q = 0; q < 16; ++q) {
          const int o = quarter * 256 + ob + q, dir = o >> 9, c = o & 511;
          const float delta = fabsf(min_decay + (float)c * ((max_decay - min_decay) / 511.0f));
          float val = acc[q] * expf(-tn * delta);
          int pos;
          if (dir == 0) pos = t;
          else if (t == 0) { pos = Lf; val = 0.f; }
          else pos = 2 * Lf - t;
          kdst[(size_t)c * cstride + pos] = val;
          const float s2 = wave_sum(val * val);
          if (lane == 0) part[tile * 1024 + o] = s2;
        }
      }
    }
    __syncthreads();
  }
}

DI int fsw(int i) { return (i & ~15) | ((((i >> 2) + (i >> 6)) & 3) << 2) | (i & 3); }

DI void r16_fwd(float (&xr)[16], float (&xi)[16]) {
#pragma unroll
  for (int st = 0; st < 2; ++st) {
    const int q = (st == 0) ? 4 : 1;
#pragma unroll
    for (int bi = 0; bi < 4; ++bi) {
      const int j = bi & (q - 1), g = bi / q;
      const int i0 = g * 4 * q + j, i1 = i0 + q, i2 = i1 + q, i3 = i2 + q;
      const float ar = xr[i0], ai = xi[i0], br = xr[i1], bi_ = xi[i1], cr = xr[i2], ci = xi[i2], dr = xr[i3], di = xi[i3];
      const float t0r = ar + cr, t0i = ai + ci, t1r = ar - cr, t1i = ai - ci;
      const float t2r = br + dr, t2i = bi_ + di;
      const float er = br - dr, ei = bi_ - di;
      const float t3r = ei, t3i = -er;
      const float y1r = t1r + t3r, y1i = t1i + t3i, y2r = t0r - t2r, y2i = t0i - t2i, y3r = t1r - t3r, y3i = t1i - t3i;
      xr[i0] = t0r + t2r; xi[i0] = t0i + t2i;
      if (q == 1 || j == 0) {
        xr[i1] = y1r; xi[i1] = y1i; xr[i2] = y2r; xi[i2] = y2i; xr[i3] = y3r; xi[i3] = y3i;
      } else {
        const float ang = -6.283185307179586f * (float)j / (float)(4 * q);
        const float w1r = __builtin_cosf(ang), w1i = __builtin_sinf(ang);
        const float w2r = __builtin_cosf(2.f * ang), w2i = __builtin_sinf(2.f * ang);
        const float w3r = __builtin_cosf(3.f * ang), w3i = __builtin_sinf(3.f * ang);
        xr[i1] = y1r * w1r - y1i * w1i; xi[i1] = y1r * w1i + y1i * w1r;
        xr[i2] = y2r * w2r - y2i * w2i; xi[i2] = y2r * w2i + y2i * w2r;
        xr[i3] = y3r * w3r - y3i * w3i; xi[i3] = y3r * w3i + y3i * w3r;
      }
    }
  }
}
DI void r16_inv(float (&xr)[16], float (&xi)[16]) {
#pragma unroll
  for (int st = 0; st < 2; ++st) {
    const int q = (st == 0) ? 1 : 4;
#pragma unroll
    for (int bi = 0; bi < 4; ++bi) {
      const int j = bi & (q - 1), g = bi / q;
      const int i0 = g * 4 * q + j, i1 = i0 + q, i2 = i1 + q, i3 = i2 + q;
      const float ar = xr[i0], ai = xi[i0];
      float br = xr[i1], bi_ = xi[i1], cr = xr[i2], ci = xi[i2], dr = xr[i3], di = xi[i3];
      if (!(q == 1 || j == 0)) {
        const float ang = 6.283185307179586f * (float)j / (float)(4 * q);
        const float w1r = __builtin_cosf(ang), w1i = __builtin_sinf(ang);
        const float w2r = __builtin_cosf(2.f * ang), w2i = __builtin_sinf(2.f * ang);
        const float w3r = __builtin_cosf(3.f * ang), w3i = __builtin_sinf(3.f * ang);
        const float b0 = br, c0 = cr, d0 = dr;
        br = b0 * w1r - bi_ * w1i; bi_ = b0 * w1i + bi_ * w1r;
        cr = c0 * w2r - ci * w2i;  ci = c0 * w2i + ci * w2r;
        dr = d0 * w3r - di * w3i;  di = d0 * w3i + di * w3r;
      }
      const float t0r = ar + cr, t0i = ai + ci, t1r = ar - cr, t1i = ai - ci;
      const float t2r = br + dr, t2i = bi_ + di;
      const float er = br - dr, ei = bi_ - di;
      const float t3r = -ei, t3i = er;
      xr[i0] = t0r + t2r; xi[i0] = t0i + t2i;
      xr[i1] = t1r + t3r; xi[i1] = t1i + t3i;
      xr[i2] = t0r - t2r; xi[i2] = t0i - t2i;
      xr[i3] = t1r - t3r; xi[i3] = t1i - t3i;
    }
  }
}

template <bool INV>
DI void fft_lds_stage(float* re, float* im, const float2* __restrict__ tw, const int s) {
  const int tid = ltid();
  const int qs = 12 - 2 * s;
  const int q = 1 << qs;
  float2 wb = tw[(tid & (q - 1)) << (2 * s)];
  if (INV) wb.y = -wb.y;
  float vr[8][4], vi[8][4];
  int idx[8][4];
#pragma unroll
  for (int k = 0; k < 8; ++k) {
    const int bi = tid + 512 * k;
    const int j = bi & (q - 1), g = bi >> qs;
    const int l0 = (g << (qs + 2)) + j;
#pragma unroll
    for (int m = 0; m < 4; ++m) { idx[k][m] = fsw(l0 + m * q); vr[k][m] = re[idx[k][m]]; vi[k][m] = im[idx[k][m]]; }
  }
#pragma unroll
  for (int k = 0; k < 8; ++k) {
    const int delta = (512 * k) & (q - 1);
    const float ang = (INV ? 6.283185307179586f : -6.283185307179586f) * (float)(delta << (2 * s)) / 16384.0f;
    const float cr_ = __builtin_cosf(ang), ci_ = __builtin_sinf(ang);
    const float w1r = (delta == 0) ? wb.x : wb.x * cr_ - wb.y * ci_;
    const float w1i = (delta == 0) ? wb.y : wb.x * ci_ + wb.y * cr_;
    const float w2r = w1r * w1r - w1i * w1i, w2i = 2.f * w1r * w1i;
    const float w3r = w2r * w1r - w2i * w1i, w3i = w2r * w1i + w2i * w1r;
    if (!INV) {
      const float ar = vr[k][0], ai = vi[k][0], br = vr[k][1], bi_ = vi[k][1], cr = vr[k][2], ci = vi[k][2], dr = vr[k][3], di = vi[k][3];
      const float t0r = ar + cr, t0i = ai + ci, t1r = ar - cr, t1i = ai - ci;
      const float t2r = br + dr, t2i = bi_ + di;
      const float er = br - dr, ei = bi_ - di;
      const float t3r = ei, t3i = -er;
      const float y1r = t1r + t3r, y1i = t1i + t3i, y2r = t0r - t2r, y2i = t0i - t2i, y3r = t1r - t3r, y3i = t1i - t3i;
      re[idx[k][0]] = t0r + t2r; im[idx[k][0]] = t0i + t2i;
      re[idx[k][1]] = y1r * w1r - y1i * w1i; im[idx[k][1]] = y1r * w1i + y1i * w1r;
      re[idx[k][2]] = y2r * w2r - y2i * w2i; im[idx[k][2]] = y2r * w2i + y2i * w2r;
      re[idx[k][3]] = y3r * w3r - y3i * w3i; im[idx[k][3]] = y3r * w3i + y3i * w3r;
    } else {
      const float ar = vr[k][0], ai = vi[k][0];
      const float br = vr[k][1] * w1r - vi[k][1] * w1i, bi_ = vr[k][1] * w1i + vi[k][1] * w1r;
      const float cr = vr[k][2] * w2r - vi[k][2] * w2i, ci = vr[k][2] * w2i + vi[k][2] * w2r;
      const float dr = vr[k][3] * w3r - vi[k][3] * w3i, di = vr[k][3] * w3i + vi[k][3] * w3r;
      const float t0r = ar + cr, t0i = ai + ci, t1r = ar - cr, t1i = ai - ci;
      const float t2r = br + dr, t2i = bi_ + di;
      const float er = br - dr, ei = bi_ - di;
      const float t3r = -ei, t3i = er;
      re[idx[k][0]] = t0r + t2r; im[idx[k][0]] = t0i + t2i;
      re[idx[k][1]] = t1r + t3r; im[idx[k][1]] = t1i + t3i;
      re[idx[k][2]] = t0r - t2r; im[idx[k][2]] = t0i - t2i;
      re[idx[k][3]] = t1r - t3r; im[idx[k][3]] = t1i - t3i;
    }
  }
  __syncthreads();
}
DI void fft_fwd4(float* re, float* im, const float2* __restrict__ tw) {
  fft_lds_stage<false>(re, im, tw, 0);
  fft_lds_stage<false>(re, im, tw, 1);
  fft_lds_stage<false>(re, im, tw, 2);
  fft_lds_stage<false>(re, im, tw, 3);
  fft_lds_stage<false>(re, im, tw, 4);
}
DI void fft_inv4(float* re, float* im, const float2* __restrict__ tw) {
  fft_lds_stage<true>(re, im, tw, 4);
  fft_lds_stage<true>(re, im, tw, 3);
  fft_lds_stage<true>(re, im, tw, 2);
  fft_lds_stage<true>(re, im, tw, 1);
  fft_lds_stage<true>(re, im, tw, 0);
}
DI void r16_load(const float* re, const float* im, int b, float (&xr)[16], float (&xi)[16]) {
#pragma unroll
  for (int c = 0; c < 4; ++c) {
    const int ph = 16 * b + 4 * ((c + (b >> 2)) & 3);
    const float4 vr = *(const float4*)(re + ph), vi = *(const float4*)(im + ph);
    xr[4 * c] = vr.x; xr[4 * c + 1] = vr.y; xr[4 * c + 2] = vr.z; xr[4 * c + 3] = vr.w;
    xi[4 * c] = vi.x; xi[4 * c + 1] = vi.y; xi[4 * c + 2] = vi.z; xi[4 * c + 3] = vi.w;
  }
}
DI void r16_store(float* re, float* im, int b, const float (&xr)[16], const float (&xi)[16]) {
#pragma unroll
  for (int c = 0; c < 4; ++c) {
    const int ph = 16 * b + 4 * ((c + (b >> 2)) & 3);
    *(float4*)(re + ph) = make_float4(xr[4 * c], xr[4 * c + 1], xr[4 * c + 2], xr[4 * c + 3]);
    *(float4*)(im + ph) = make_float4(xi[4 * c], xi[4 * c + 1], xi[4 * c + 2], xi[4 * c + 3]);
  }
}

DI void phase_filter_fft(const Params& p, int l, float* lds) {
  const int tid = ltid();
  float* re = lds;
  float* im = lds + FFTN;
  float* kf = (float*)(p.ws + OFF_KF);
  const float2* tw = (const float2*)(p.ws + OFF_TW);
  const float* part = (const float*)(p.ws + OFF_PART);
  for (int c = lbid(); c < 512; c += gridDim.x) {
    float* slot = kf + (size_t)c * (2 * FFTN);
    float pv = 0.f;
    if (tid < 128) pv = part[tid * 1024 + c] + part[tid * 1024 + 512 + c];
    pv = wave_sum(pv);
    if ((tid & 63) == 0) lds[tid >> 6] = pv;
    __syncthreads();
    const float ssq = lds[0] + lds[1];
    __syncthreads();
    const float sc = rsqrtf(ssq + EPSV) * (1.0f / (float)FFTN);
    for (int i = tid; i < FFTN; i += 512) { const int ph = fsw(i); re[ph] = slot[i] * sc; im[ph] = 0.f; }
    __syncthreads();
    fft_fwd4(re, im, tw);
    {
      float2* so = (float2*)slot;
#pragma unroll 1
      for (int b = tid; b < 1024; b += 512) {
        float xr[16], xi[16];
        r16_load(re, im, b, xr, xi);
        r16_fwd(xr, xi);
#pragma unroll
        for (int e = 0; e < 16; ++e) { float2 v; v.x = xr[e]; v.y = xi[e]; so[e * 1024 + b] = v; }
      }
    }
    __syncthreads();
  }
}

DI void phase_gemm1(const Params& p, int l, u16* lds) {
  const u16* hn = (const u16*)(p.ws + OFF_A);
  const u16* wt = (const u16*)(p.ws + OFF_W) + (size_t)l * W_LAYER + WO_T1;
  const int NT = 24, nitems = (MALL / 256) * NT;
  for (int it_ = lbid(); it_ < ((nitems + 255) & ~255); it_ += gridDim.x) {
    const int item = xcd_remap(it_);
    if (item >= nitems) continue;
    const int mt = item / NT, nt = item % NT;
    const int m0 = mt * 256, n0 = nt * 128;
    f32x16 acc[2][2];
    ACC_ZERO(acc);
    gemm_mainloop(hn + (size_t)m0 * 1024, 1024, wt + (size_t)n0 * 1024, 1024, 1024, acc, lds);
    u16* dst; int ld, cofs;
    if (nt < 4) { dst = (u16*)(p.ws + OFF_B); ld = 512; cofs = 0; }
    else if (nt < 12) { dst = (u16*)(p.ws + OFF_C); ld = 1024; cofs = 512; }
    else { dst = (u16*)(p.ws + OFF_R); ld = 1536; cofs = 1536; }
    stage_store_bf16(acc, dst, ld, m0, n0 - cofs, lds);
  }
}

DI void phase_h1(const Params& p, int l, float* lds) {
  const int tid = ltid();
  const u16* U12 = (const u16*)(p.ws + OFF_C);
  float* zT = (float*)(p.ws + OFF_A);
  const float* sw = p.hy_short_w + l * 3 * 1536;
  const int nlat = 8 * 128 * 8, nctx = (l < 3) ? 8 * 4 * 8 : 0;
  int par = 0;
  for (int item = lbid(); item < nlat + nctx; item += gridDim.x) {
    float* xs = lds + par * (2 * 66 * 65);
    float* vs = xs + 66 * 65;
    par ^= 1;
    int b, tt0, c0, Ls, rowbase; size_t zbase;
    if (item < nlat) { b = item >> 10; tt0 = ((item >> 3) & 127) * 64; c0 = (item & 7) * 64; Ls = LSEQ; rowbase = b * LSEQ; zbase = (size_t)b * 512 * LSEQ; }
    else { const int it = item - nlat; b = it >> 5; tt0 = ((it >> 3) & 3) * 64; c0 = (it & 7) * 64; Ls = LCTX; rowbase = ML + b * LCTX; zbase = (size_t)ZC_OFF + (size_t)b * 512 * LCTX; }
    for (int ch = tid; ch < 66 * 16; ch += 512) {
      const int arr = ch / 528, rem = ch - arr * 528;
      const int rr = rem >> 3, cc8 = (rem & 7) * 8;
      const int t = tt0 - 1 + rr;
      float* dstp = (arr ? vs : xs) + rr * 65 + cc8;
      if (t >= 0 && t < Ls) {
        const uint4 v = *(const uint4*)(U12 + (size_t)(rowbase + t) * 1024 + arr * 512 + c0 + cc8);
        const unsigned uu[4] = {v.x, v.y, v.z, v.w};
#pragma unroll
        for (int i = 0; i < 4; ++i) { dstp[2 * i] = __uint_as_float(uu[i] << 16); dstp[2 * i + 1] = __uint_as_float(uu[i] & 0xffff0000u); }
      } else {
#pragma unroll
        for (int i = 0; i < 8; ++i) dstp[i] = 0.f;
      }
    }
    __syncthreads();
    {
      const int tt = tid & 63, cgp = tid >> 6;
#pragma unroll
      for (int i = 0; i < 8; ++i) {
        const int cc = cgp * 8 + i, c = c0 + cc;
        float x1 = 0.f, vv = 0.f;
#pragma unroll
        for (int j = 0; j < 3; ++j) {
          x1 += sw[j * 1536 + 512 + c] * xs[(tt + j) * 65 + cc];
          vv += sw[j * 1536 + 1024 + c] * vs[(tt + j) * 65 + cc];
        }
        zT[zbase + (size_t)c * Ls + tt0 + tt] = x1 * vv;
      }
    }
  }
  __syncthreads();
}

DI void phase_p3(const Params& p, int l, float* lds) {
  const int tid = ltid(), lane = tid & 63, w = tid >> 6;
  u16* R = (u16*)(p.ws + OFF_R);
  const float* ropeg = (const float*)(p.ws + OFF_ROPEG);
  const float qscale = 0.125f * LOG2E;
  const int hq = lane >> 3, j = lane & 7;
  float gq[8], gk[8], ga[6], gv[4];
#pragma unroll
  for (int i = 0; i < 8; ++i) { gq[i] = p.gqa_q_norm[l * 64 + 8 * j + i]; gk[i] = p.gqa_k_norm[l * 64 + 8 * j + i]; }
#pragma unroll
  for (int i = 0; i < 6; ++i) ga[i] = p.mla_q_a_norm[l * 384 + 6 * lane + i];
#pragma unroll
  for (int i = 0; i < 4; ++i) gv[i] = p.mla_kv_a_norm[l * 256 + 4 * lane + i];
  const float sgn = (j < 4) ? -1.f : 1.f;
  for (int r = lbid() * 8 + w; r < MALL; r += gridDim.x * 8) {
    u16* rowp = R + (size_t)r * 1536;
    const bool lat = r < ML;
    const int t = r & (LSEQ - 1);
    const uint4 qv = *(const uint4*)(rowp + hq * 64 + 8 * j);
    const uint4 kv = *(const uint4*)(rowp + 512 + (hq & 1) * 64 + 8 * j);
    const unsigned c0 = *(const unsigned*)(rowp + 768 + 6 * lane), c1 = *(const unsigned*)(rowp + 768 + 6 * lane + 2),
                   c2 = *(const unsigned*)(rowp + 768 + 6 * lane + 4);
    const uint2 dv = *(const uint2*)(rowp + 1152 + 4 * lane);
    float cs[8], sn[8];
    {
      const float4* rp = (const float4*)(ropeg + ((size_t)t * 32 + 8 * (j & 3)) * 2);
#pragma unroll
      for (int i = 0; i < 4; ++i) {
        const float4 v = rp[i];
        cs[2 * i] = lat ? v.x : 1.f; sn[2 * i] = lat ? v.y * sgn : 0.f;
        cs[2 * i + 1] = lat ? v.z : 1.f; sn[2 * i + 1] = lat ? v.w * sgn : 0.f;
      }
    }
    float q[8], k[8];
    {
      const unsigned qu[4] = {qv.x, qv.y, qv.z, qv.w}, ku[4] = {kv.x, kv.y, kv.z, kv.w};
#pragma unroll
      for (int i = 0; i < 4; ++i) {
        q[2 * i] = __uint_as_float(qu[i] << 16); q[2 * i + 1] = __uint_as_float(qu[i] & 0xffff0000u);
        k[2 * i] = __uint_as_float(ku[i] << 16); k[2 * i + 1] = __uint_as_float(ku[i] & 0xffff0000u);
      }
    }
    float sq = 0.f, sk = 0.f;
#pragma unroll
    for (int i = 0; i < 8; ++i) { sq += q[i] * q[i]; sk += k[i] * k[i]; }
    sq += __shfl_xor(sq, 1); sq += __shfl_xor(sq, 2); sq += __shfl_xor(sq, 4);
    sk += __shfl_xor(sk, 1); sk += __shfl_xor(sk, 2); sk += __shfl_xor(sk, 4);
    const float rq = rsqrtf(sq * (1.0f / 64.0f) + EPSV) * qscale, rk = rsqrtf(sk * (1.0f / 64.0f) + EPSV);
#pragma unroll
    for (int i = 0; i < 8; ++i) { q[i] *= rq * gq[i]; k[i] *= rk * gk[i]; }
    float qp[8], kp[8];
#pragma unroll
    for (int i = 0; i < 8; ++i) { qp[i] = __shfl_xor(q[i], 4); kp[i] = __shfl_xor(k[i], 4); }
#pragma unroll
    for (int i = 0; i < 8; ++i) { q[i] = q[i] * cs[i] + qp[i] * sn[i]; k[i] = k[i] * cs[i] + kp[i] * sn[i]; }
    float a[6], d[4];
    a[0] = __uint_as_float(c0 << 16); a[1] = __uint_as_float(c0 & 0xffff0000u);
    a[2] = __uint_as_float(c1 << 16); a[3] = __uint_as_float(c1 & 0xffff0000u);
    a[4] = __uint_as_float(c2 << 16); a[5] = __uint_as_float(c2 & 0xffff0000u);
    d[0] = __uint_as_float(dv.x << 16); d[1] = __uint_as_float(dv.x & 0xffff0000u);
    d[2] = __uint_as_float(dv.y << 16); d[3] = __uint_as_float(dv.y & 0xffff0000u);
    float s3 = 0.f, s4 = 0.f;
#pragma unroll
    for (int i = 0; i < 6; ++i) s3 += a[i] * a[i];
#pragma unroll
    for (int i = 0; i < 4; ++i) s4 += d[i] * d[i];
    s3 = wave_sum(s3); s4 = wave_sum(s4);
    const float r3 = rsqrtf(s3 * (1.0f / 384.0f) + EPSV), r4 = rsqrtf(s4 * (1.0f / 256.0f) + EPSV);
    {
      uint4 o;
      o.x = pk2(q[0], q[1]); o.y = pk2(q[2], q[3]); o.z = pk2(q[4], q[5]); o.w = pk2(q[6], q[7]);
      *(uint4*)(rowp + hq * 64 + 8 * j) = o;
      if (lane < 16) {
        o.x = pk2(k[0], k[1]); o.y = pk2(k[2], k[3]); o.z = pk2(k[4], k[5]); o.w = pk2(k[6], k[7]);
        *(uint4*)(rowp + 512 + hq * 64 + 8 * j) = o;
      }
      *(unsigned*)(rowp + 768 + 6 * lane) = pk2(a[0] * r3 * ga[0], a[1] * r3 * ga[1]);
      *(unsigned*)(rowp + 768 + 6 * lane + 2) = pk2(a[2] * r3 * ga[2], a[3] * r3 * ga[3]);
      *(unsigned*)(rowp + 768 + 6 * lane + 4) = pk2(a[4] * r3 * ga[4], a[5] * r3 * ga[5]);
      uint2 od;
      od.x = pk2(d[0] * r4 * gv[0], d[1] * r4 * gv[1]); od.y = pk2(d[2] * r4 * gv[2], d[3] * r4 * gv[3]);
      *(uint2*)(rowp + 1152 + 4 * lane) = od;
    }
  }
}

DI void phase_h2(const Params& p, int l, float* lds) {
  const int tid = ltid(), lane = tid & 63, w = tid >> 6;
  float* zT = (float*)(p.ws + OFF_A);
  const float2* kf = (const float2*)(p.ws + OFF_KF);
  const float2* tw = (const float2*)(p.ws + OFF_TW);
  const float* skip = p.hy_skip + l * 512;
  float* re = lds;
  float* im = lds + FFTN;
  float za[16], zb[16], na[16], nb_[16];
  {
    const int it0 = lbid();
    if (it0 < 2048) {
      const int c0 = it0 >> 2, bp0 = it0 & 3;
      const float* s1 = zT + ((size_t)(2 * bp0) * 512 + c0) * LSEQ;
      const float* s2 = zT + ((size_t)(2 * bp0 + 1) * 512 + c0) * LSEQ;
#pragma unroll
      for (int k = 0; k < 16; ++k) { na[k] = s1[tid + 512 * k]; nb_[k] = s2[tid + 512 * k]; }
    }
  }
  for (int item = lbid(); item < 2048; item += gridDim.x) {
    const int c = item >> 2, bp = item & 3;
    float* z1 = zT + ((size_t)(2 * bp) * 512 + c) * LSEQ;
    float* z2 = zT + ((size_t)(2 * bp + 1) * 512 + c) * LSEQ;
#pragma unroll
    for (int k = 0; k < 16; ++k) {
      const int i = tid + 512 * k;
      za[k] = na[k]; zb[k] = nb_[k];
      const int p0 = fsw(i), p1 = fsw(i + LSEQ);
      re[p0] = za[k]; im[p0] = zb[k]; re[p1] = 0.f; im[p1] = 0.f;
    }
    __syncthreads();
    fft_fwd4(re, im, tw);
    {
      const float2* kc = kf + (size_t)c * FFTN;
#pragma unroll 1
      for (int b = tid; b < 1024; b += 512) {
        float xr[16], xi[16];
        r16_load(re, im, b, xr, xi);
        r16_fwd(xr, xi);
#pragma unroll
        for (int e = 0; e < 16; ++e) {
          const float2 k = kc[e * 1024 + b];
          const float a = xr[e], b2 = xi[e];
          xr[e] = a * k.x - b2 * k.y;
          xi[e] = a * k.y + b2 * k.x;
        }
        r16_inv(xr, xi);
        r16_store(re, im, b, xr, xi);
      }
    }
    {
      const int nit = item + gridDim.x;
      if (nit < 2048) {
        const int cn = nit >> 2, bpn = nit & 3;
        const float* s1 = zT + ((size_t)(2 * bpn) * 512 + cn) * LSEQ;
        const float* s2 = zT + ((size_t)(2 * bpn + 1) * 512 + cn) * LSEQ;
#pragma unroll
        for (int k = 0; k < 16; ++k) {
          na[k] = __builtin_bit_cast(float, *(const volatile unsigned*)(s1 + tid + 512 * k));
          nb_[k] = __builtin_bit_cast(float, *(const volatile unsigned*)(s2 + tid + 512 * k));
        }
      }
    }
    __syncthreads();
    fft_inv4(re, im, tw);
    const float sk = skip[c];
#pragma unroll
    for (int k = 0; k < 16; ++k) {
      const int i = tid + 512 * k;
      const int p0 = fsw(i);
      z1[i] = re[p0] + za[k] * sk;
      z2[i] = im[p0] + zb[k] * sk;
    }
    __syncthreads();
  }
  if (l < 3) {
    const float* kcb = (const float*)(p.ws + OFF_KC);
    const float* partc = (const float*)(p.ws + OFF_PART) + 128 * 1024;
    float* zs = lds + w * 768;
    float* ks = zs + 256;
    for (int item = lbid(); item < 512; item += gridDim.x) {
      const int b = item >> 6, c = (item & 63) * 8 + w;
      float* z = zT + (size_t)ZC_OFF + ((size_t)b * 512 + c) * LCTX;
      float pv = (lane < 4) ? partc[lane * 1024 + c] + partc[lane * 1024 + 512 + c] : 0.f;
      pv = wave_sum(pv);
      const float sc = rsqrtf(pv + EPSV);
      for (int i = lane; i < 256; i += 64) zs[i] = z[i];
      for (int i = lane; i < 512; i += 64) ks[i] = kcb[c * 512 + i] * sc;
      __syncthreads();
      const float sk = skip[c];
      float acc[4] = {0.f, 0.f, 0.f, 0.f};
      for (int s = 0; s < 256; ++s) {
        const float zv = zs[s];
#pragma unroll
        for (int i = 0; i < 4; ++i) acc[i] += ks[(lane + 64 * i - s) & 511] * zv;
      }
#pragma unroll
      for (int i = 0; i < 4; ++i) z[lane + 64 * i] = acc[i] + zs[lane + 64 * i] * sk;
      __syncthreads();
    }
  }
}

DI void phase_h3(const Params& p, int l, float* lds) {
  const int tid = ltid();
  const u16* U0 = (const u16*)(p.ws + OFF_B);
  const float* zT = (const float*)(p.ws + OFF_A);
  u16* Y = (u16*)(p.ws + OFF_Y);
  const float* sw = p.hy_short_w + l * 3 * 1536;
  const int nlat = 8 * 128 * 8, nctx = (l < 3) ? 8 * 4 * 8 : 0;
  int par = 0;
  for (int item = lbid(); item < nlat + nctx; item += gridDim.x) {
    float* xs = lds + par * (66 * 65 + 64 * 65);
    float* ys = xs + 66 * 65;
    par ^= 1;
    int b, tt0, c0, Ls, rowbase; size_t zbase;
    if (item < nlat) { b = item >> 10; tt0 = ((item >> 3) & 127) * 64; c0 = (item & 7) * 64; Ls = LSEQ; rowbase = b * LSEQ; zbase = (size_t)b * 512 * LSEQ; }
    else { const int it = item - nlat; b = it >> 5; tt0 = ((it >> 3) & 3) * 64; c0 = (it & 7) * 64; Ls = LCTX; rowbase = ML + b * LCTX; zbase = (size_t)ZC_OFF + (size_t)b * 512 * LCTX; }
    for (int ch = tid; ch < 66 * 8; ch += 512) {
      const int rr = ch >> 3, cc8 = (ch & 7) * 8;
      const int t = tt0 - 1 + rr;
      float* dstp = xs + rr * 65 + cc8;
      if (t >= 0 && t < Ls) {
        const uint4 v = *(const uint4*)(U0 + (size_t)(rowbase + t) * 512 + c0 + cc8);
        const unsigned uu[4] = {v.x, v.y, v.z, v.w};
#pragma unroll
        for (int i = 0; i < 4; ++i) { dstp[2 * i] = __uint_as_float(uu[i] << 16); dstp[2 * i + 1] = __uint_as_float(uu[i] & 0xffff0000u); }
      } else {
#pragma unroll
        for (int i = 0; i < 8; ++i) dstp[i] = 0.f;
      }
    }
    {
      const int tt = tid & 63, cgp = tid >> 6;
#pragma unroll
      for (int i = 0; i < 8; ++i) {
        const int cc = cgp * 8 + i;
        ys[cc * 65 + tt] = zT[zbase + (size_t)(c0 + cc) * Ls + tt0 + tt];
      }
    }
    __syncthreads();
    {
      const int cc = tid & 63, tg = tid >> 6, c = c0 + cc;
      const float w0 = sw[c], w1 = sw[1536 + c], w2 = sw[2 * 1536 + c];
#pragma unroll
      for (int i = 0; i < 8; ++i) {
        const int tt = tg * 8 + i;
        const float x0 = w0 * xs[tt * 65 + cc] + w1 * xs[(tt + 1) * 65 + cc] + w2 * xs[(tt + 2) * 65 + cc];
        Y[(size_t)(rowbase + tt0 + tt) * 1536 + c] = f2bf(x0 * ys[cc * 65 + tt]);
      }
    }
  }
  __syncthreads();
}

DI void phase_p4(const Params& p, int l, u16* lds) {
  const u16* R = (const u16*)(p.ws + OFF_R);
  u16* QK = (u16*)(p.ws + OFF_A);
  const u16* wl = (const u16*)(p.ws + OFF_W) + (size_t)l * W_LAYER;
  const int NT = 14, nitems = (MALL / 256) * NT;
  for (int it_ = lbid(); it_ < ((nitems + 255) & ~255); it_ += gridDim.x) {
    const int item = xcd_remap(it_);
    if (item >= nitems) continue;
    const int mt = item / NT, nt = item % NT;
    const int m0 = mt * 256;
    f32x16 acc[2][2];
    ACC_ZERO(acc);
    int n0;
    if (nt < 6) { n0 = nt * 128; gemm_mainloop(R + (size_t)m0 * 1536 + 768, 1536, wl + WO_QB + (size_t)n0 * 384, 384, 384, acc, lds); }
    else { n0 = (nt - 6) * 128; gemm_mainloop(R + (size_t)m0 * 1536 + 1152, 1536, wl + WO_KVB + (size_t)n0 * 256, 256, 256, acc, lds); n0 += 768; }
    stage_store_bf16(acc, QK, 1792, m0, n0, lds);
  }
}

DI void phase_p5(const Params& p, int l, float* lds) {
  const int tid = ltid(), lane = tid & 63, w = tid >> 6;
  u16* QK = (u16*)(p.ws + OFF_A);
  u16* KM = (u16*)(p.ws + OFF_KM);
  const u16* R = (const u16*)(p.ws + OFF_R);
  const float* qn = p.mla_q_norm + l * 96;
  const float* kn = p.mla_k_norm + l * 96;
  const float* ropem = (const float*)(p.ws + OFF_ROPEM);
  const float qscale = 0.10206207261596575f * LOG2E;
  const bool act = lane < 48;
  const int hd = act ? lane / 6 : 0, j = act ? lane - hd * 6 : 0;
  float gq[16], gk[16];
#pragma unroll
  for (int i = 0; i < 16; ++i) { gq[i] = qn[16 * j + i]; gk[i] = kn[16 * j + i]; }
  for (int r = lbid() * 8 + w; r < MALL; r += gridDim.x * 8) {
    u16* rowp = QK + (size_t)r * 1792;
    const u16* qsrc = rowp + hd * 96 + 16 * j;
    const u16* ksrc = (j < 4) ? rowp + 768 + hd * 128 + 16 * j : R + (size_t)r * 1536 + 1408 + 16 * (j - 4);
    const uint4 qa = *(const uint4*)(qsrc), qb = *(const uint4*)(qsrc + 8);
    const uint4 ka = *(const uint4*)(ksrc), kb = *(const uint4*)(ksrc + 8);
    float q[16], k[16];
    {
      const unsigned qu[8] = {qa.x, qa.y, qa.z, qa.w, qb.x, qb.y, qb.z, qb.w};
      const unsigned ku[8] = {ka.x, ka.y, ka.z, ka.w, kb.x, kb.y, kb.z, kb.w};
#pragma unroll
      for (int i = 0; i < 8; ++i) {
        q[2 * i] = __uint_as_float(qu[i] << 16); q[2 * i + 1] = __uint_as_float(qu[i] & 0xffff0000u);
        k[2 * i] = __uint_as_float(ku[i] << 16); k[2 * i + 1] = __uint_as_float(ku[i] & 0xffff0000u);
      }
    }
    float sq = 0.f, sk = 0.f;
#pragma unroll
    for (int i = 0; i < 16; ++i) { sq += q[i] * q[i]; sk += k[i] * k[i]; }
    float tq = 0.f, tk = 0.f;
#pragma unroll
    for (int u = 0; u < 6; ++u) { tq += __shfl(sq, hd * 6 + u); tk += __shfl(sk, hd * 6 + u); }
    const float rq = rsqrtf(tq * (1.0f / 96.0f) + EPSV) * qscale, rk = rsqrtf(tk * (1.0f / 96.0f) + EPSV);
#pragma unroll
    for (int i = 0; i < 16; ++i) { q[i] *= rq * gq[i]; k[i] *= rk * gk[i]; }
    const bool lat = r < ML;
    const int t = r & (LSEQ - 1);
    const int plane = (j == 4) ? lane + 1 : lane - 1;
    const bool rot = lat && act && (j >= 4);
    const float sgn = (j == 4) ? -1.f : 1.f;
    float qp[16], kp[16];
#pragma unroll
    for (int i = 0; i < 16; ++i) { qp[i] = __shfl(q[i], plane); kp[i] = __shfl(k[i], plane); }
    const float* rp = ropem + (size_t)t * 32;
#pragma unroll
    for (int i = 0; i < 16; ++i) {
      const float cs = rot ? rp[2 * i] : 1.f, sn = rot ? rp[2 * i + 1] * sgn : 0.f;
      q[i] = q[i] * cs + qp[i] * sn;
      k[i] = k[i] * cs + kp[i] * sn;
    }
    if (act) {
      uint4 o0, o1;
      o0.x = pk2(q[0], q[1]); o0.y = pk2(q[2], q[3]); o0.z = pk2(q[4], q[5]); o0.w = pk2(q[6], q[7]);
      o1.x = pk2(q[8], q[9]); o1.y = pk2(q[10], q[11]); o1.z = pk2(q[12], q[13]); o1.w = pk2(q[14], q[15]);
      *(uint4*)(rowp + hd * 96 + 16 * j) = o0;
      *(uint4*)(rowp + hd * 96 + 16 * j + 8) = o1;
      o0.x = pk2(k[0], k[1]); o0.y = pk2(k[2], k[3]); o0.z = pk2(k[4], k[5]); o0.w = pk2(k[6], k[7]);
      o1.x = pk2(k[8], k[9]); o1.y = pk2(k[10], k[11]); o1.z = pk2(k[12], k[13]); o1.w = pk2(k[14], k[15]);
      u16* kd = KM + (size_t)r * 768 + hd * 96 + 16 * j;
      *(uint4*)(kd) = o0;
      *(uint4*)(kd + 8) = o1;
    }
  }
}

template <int DQK>
DI void attn_block(const u16* __restrict__ Qp, int q_ld, const u16* __restrict__ Kp, int k_ld, const u16* __restrict__ Vp,
                   int v_ld, u16* __restrict__ Op, int o_ld, int qrow0, int nq, int qt0, int s0_row0, int s0_n, int s0_t0,
                   int masked0, int s1_row0, int s1_n, float sink_l2, int has_sink, u16* lds) {
  constexpr int KS = DQK + 8, NS = DQK / 16, CPK = DQK / 8;
  const int tid = ltid(), lane = tid & 63, w = tid >> 6, l32 = lane & 31, hh = lane >> 5;
  u16* Ks = lds;
  u16* Vt = lds + 2 * 64 * KS;
  bf16x8 qf[2][NS];
  f32x16 ot[2][2];
  float m[2], lsum[2];
#pragma unroll
  for (int qs = 0; qs < 2; ++qs) {
    const int qi = 64 * w + 32 * qs + l32;
    const int qr = qrow0 + ((qi < nq) ? qi : nq - 1);
#pragma unroll
    for (int s = 0; s < NS; ++s) qf[qs][s] = *(const bf16x8*)(Qp + (size_t)qr * q_ld + 16 * s + 8 * hh);
#pragma unroll
    for (int i = 0; i < 16; ++i) { ot[qs][0][i] = 0.f; ot[qs][1][i] = 0.f; }
    m[qs] = -1e30f; lsum[qs] = 0.f;
  }
  const int nt0 = s0_n >> 6, nt = nt0 + (s1_n >> 6);
  const int kkey0 = tid / CPK, kch0 = tid - kkey0 * CPK;
  const int c1 = tid + 512;
  const bool has1 = c1 < 64 * CPK;
  const int kkey1 = has1 ? c1 / CPK : 0, kch1 = has1 ? c1 - kkey1 * CPK : 0;
  const int vkey = tid & 63, vch = tid >> 6;
  uint4 rk0, rk1, rv;
  rk1 = make_uint4(0, 0, 0, 0);
  {
    const int row0 = (0 < nt0) ? s0_row0 : s1_row0;
    rk0 = *(const uint4*)(Kp + (size_t)(row0 + kkey0) * k_ld + kch0 * 8);
    if (has1) rk1 = *(const uint4*)(Kp + (size_t)(row0 + kkey1) * k_ld + kch1 * 8);
    rv = *(const uint4*)(Vp + (size_t)(row0 + vkey) * v_ld + vch * 8);
  }
  {
    *(uint4*)(Ks + kkey0 * KS + kch0 * 8) = rk0;
    if (has1) *(uint4*)(Ks + kkey1 * KS + kch1 * 8) = rk1;
    const unsigned uu[4] = {rv.x, rv.y, rv.z, rv.w};
#pragma unroll
    for (int i = 0; i < 4; ++i) {
      Vt[(vch * 8 + 2 * i) * 68 + vkey] = (u16)(uu[i] & 0xffffu);
      Vt[(vch * 8 + 2 * i + 1) * 68 + vkey] = (u16)(uu[i] >> 16);
    }
  }
  __syncthreads();
  const int tql = qt0 + 64 * w;
  for (int j = 0; j < nt; ++j) {
    const int cur = j & 1;
    {
      const int jn = (j + 1 < nt) ? j + 1 : j;
      const int row0 = (jn < nt0) ? s0_row0 + 64 * jn : s1_row0 + 64 * (jn - nt0);
      rk0 = VLOAD16(Kp + (size_t)(row0 + kkey0) * k_ld + kch0 * 8);
      if (DQK == 96) rk1 = VLOAD16(Kp + (size_t)(row0 + kkey1) * k_ld + kch1 * 8);
      rv = VLOAD16(Vp + (size_t)(row0 + vkey) * v_ld + vch * 8);
    }
    __builtin_amdgcn_sched_barrier(0);
    const bool mtile = masked0 && (j < nt0);
    const int tk0 = s0_t0 + 64 * j;
    bool active = true;
    if (mtile) active = (tk0 + 63 >= tql - 128) && (tk0 <= tql + 63 + 128);
    if (active) {
      const u16* kb = Ks + cur * 64 * KS + l32 * KS + hh * 8;
      f32x16 st[2][2];
#pragma unroll
      for (int i = 0; i < 16; ++i) { st[0][0][i] = 0.f; st[0][1][i] = 0.f; st[1][0][i] = 0.f; st[1][1][i] = 0.f; }
#pragma unroll
      for (int s = 0; s < NS; ++s) {
        const bf16x8 a0 = *(const bf16x8*)(kb + s * 16);
        const bf16x8 a1 = *(const bf16x8*)(kb + 32 * KS + s * 16);
        st[0][0] = MFMA(a0, qf[0][s], st[0][0]);
        st[0][1] = MFMA(a1, qf[0][s], st[0][1]);
        st[1][0] = MFMA(a0, qf[1][s], st[1][0]);
        st[1][1] = MFMA(a1, qf[1][s], st[1][1]);
      }
#pragma unroll
      for (int qs = 0; qs < 2; ++qs) {
        if (mtile) {
          const int tq = tql + 32 * qs + l32;
#pragma unroll
          for (int kt = 0; kt < 2; ++kt)
#pragma unroll
            for (int rg = 0; rg < 16; ++rg) {
              const int tk = tk0 + 32 * kt + (rg & 3) + 8 * (rg >> 2) + 4 * hh;
              const int dlt = tk - tq;
              if (dlt > 128 || dlt < -128) st[qs][kt][rg] = -1e30f;
            }
        }
        float mloc = st[qs][0][0];
#pragma unroll
        for (int rg = 1; rg < 16; ++rg) mloc = fmaxf(mloc, st[qs][0][rg]);
#pragma unroll
        for (int rg = 0; rg < 16; ++rg) mloc = fmaxf(mloc, st[qs][1][rg]);
        mloc = fmaxf(mloc, __shfl_xor(mloc, 32));
        const bool grow = mloc > m[qs] + 8.0f;
        if (__builtin_amdgcn_ballot_w64(grow) != 0ull) {
          const float mnew = fmaxf(m[qs], mloc);
          const float alpha = __builtin_amdgcn_exp2f(m[qs] - mnew);
          m[qs] = mnew;
          lsum[qs] *= alpha;
          const f32x2_t a2 = {alpha, alpha};
#pragma unroll
          for (int i = 0; i < 8; ++i) {
            f32x2_t o0 = {ot[qs][0][2 * i], ot[qs][0][2 * i + 1]}, o1 = {ot[qs][1][2 * i], ot[qs][1][2 * i + 1]};
            o0 *= a2; o1 *= a2;
            ot[qs][0][2 * i] = o0.x; ot[qs][0][2 * i + 1] = o0.y; ot[qs][1][2 * i] = o1.x; ot[qs][1][2 * i + 1] = o1.y;
          }
        }
        const f32x2_t nm2 = {-m[qs], -m[qs]};
        f32x2_t ps2 = {0.f, 0.f};
#pragma unroll
        for (int kt = 0; kt < 2; ++kt)
#pragma unroll
          for (int rg = 0; rg < 16; rg += 2) {
            f32x2_t sv = {st[qs][kt][rg], st[qs][kt][rg + 1]};
            sv += nm2;
            float p0 = __builtin_amdgcn_exp2f(sv.x), p1 = __builtin_amdgcn_exp2f(sv.y);
            if (mtile) { p0 = (st[qs][kt][rg] < -1e29f) ? 0.f : p0; p1 = (st[qs][kt][rg + 1] < -1e29f) ? 0.f : p1; }
            st[qs][kt][rg] = p0; st[qs][kt][rg + 1] = p1;
            const f32x2_t pv = {p0, p1};
            ps2 += pv;
          }
        lsum[qs] += ps2.x + ps2.y;
        __builtin_amdgcn_sched_barrier(0);
      }
      const u16* vb = Vt + cur * 64 * 68 + l32 * 68 + 4 * hh;
#pragma unroll
      for (int kt = 0; kt < 2; ++kt)
#pragma unroll
        for (int s = 0; s < 2; ++s) {
          bf16x8 pf[2];
#pragma unroll
          for (int qs = 0; qs < 2; ++qs) {
            unsigned pw[4];
#pragma unroll
            for (int i = 0; i < 4; ++i) pw[i] = pk2(st[qs][kt][8 * s + 2 * i], st[qs][kt][8 * s + 2 * i + 1]);
            const uint4 pu = make_uint4(pw[0], pw[1], pw[2], pw[3]);
            pf[qs] = __builtin_bit_cast(bf16x8, pu);
          }
#pragma unroll
          for (int dt = 0; dt < 2; ++dt) {
            const u16* vp = vb + dt * 32 * 68 + 32 * kt + 16 * s;
            const uint2 lo = *(const uint2*)(vp);
            const uint2 hi = *(const uint2*)(vp + 8);
            const uint4 au = make_uint4(lo.x, lo.y, hi.x, hi.y);
            const bf16x8 vf = __builtin_bit_cast(bf16x8, au);
            ot[0][dt] = MFMA(vf, pf[0], ot[0][dt]);
            ot[1][dt] = MFMA(vf, pf[1], ot[1][dt]);
          }
        }
    }
    __builtin_amdgcn_sched_barrier(0);
    {
      u16* Kw = Ks + (cur ^ 1) * 64 * KS;
      u16* Vw = Vt + (cur ^ 1) * 64 * 68;
      *(uint4*)(Kw + kkey0 * KS + kch0 * 8) = rk0;
      if (has1) *(uint4*)(Kw + kkey1 * KS + kch1 * 8) = rk1;
      const unsigned uu[4] = {rv.x, rv.y, rv.z, rv.w};
#pragma unroll
      for (int i = 0; i < 4; ++i) {
        Vw[(vch * 8 + 2 * i) * 68 + vkey] = (u16)(uu[i] & 0xffffu);
        Vw[(vch * 8 + 2 * i + 1) * 68 + vkey] = (u16)(uu[i] >> 16);
      }
    }
    __syncthreads();
  }
#pragma unroll
  for (int qs = 0; qs < 2; ++qs) {
    float ltot = lsum[qs] + __shfl_xor(lsum[qs], 32);
    if (has_sink) ltot += __builtin_amdgcn_exp2f(sink_l2 - m[qs]);
    const float inv = 1.0f / ltot;
    if (64 * w + 32 * qs + l32 < nq) {
#pragma unroll
      for (int dt = 0; dt < 2; ++dt)
#pragma unroll
        for (int g = 0; g < 4; ++g) {
          uint2 pk;
          pk.x = pk2(ot[qs][dt][4 * g] * inv, ot[qs][dt][4 * g + 1] * inv);
          pk.y = pk2(ot[qs][dt][4 * g + 2] * inv, ot[qs][dt][4 * g + 3] * inv);
          *(uint2*)(Op + (size_t)(qrow0 + 64 * w + 32 * qs + l32) * o_ld + dt * 32 + 8 * g + 4 * hh) = pk;
        }
    }
  }
}

DI void phase_attn(const Params& p, int l, u16* lds) {
  const u16* R = (const u16*)(p.ws + OFF_R);
  const u16* QK = (const u16*)(p.ws + OFF_A);
  const u16* KM = (const u16*)(p.ws + OFF_KM);
  u16* Y = (u16*)(p.ws + OFF_Y);
  const float* sink = p.gqa_sink + l * 8;
  const int n_mla = 1024, n_gqa = 1024, n_ctx = (l < 3) ? 128 : 0;
  const int n_all = n_mla + n_gqa + n_ctx;
  for (int it_ = lbid(); it_ < ((n_all + 255) & ~255); it_ += gridDim.x) {
    const int item = xcd_remap(it_);
    if (item >= n_all) continue;
    int kind, qb, hd, b, isctx;
    if (item < n_mla) { kind = 0; isctx = 0; qb = item & 15; hd = (item >> 4) & 7; b = item >> 7; }
    else if (item < n_mla + n_gqa) { const int it = item - n_mla; kind = 1; isctx = 0; qb = it & 15; hd = (it >> 4) & 7; b = it >> 7; }
    else { const int it = item - n_mla - n_gqa; isctx = 1; qb = 0; hd = it & 7; b = (it >> 3) & 7; kind = it >> 6; }
    const int crow0 = ML + b * LCTX;
    if (kind == 0) {
      int qrow0, nq, qt0, s0r, s0n, s1n;
      if (isctx) { qrow0 = crow0; nq = LCTX; qt0 = 0; s0r = crow0; s0n = LCTX; s1n = 0; }
      else { qrow0 = b * LSEQ + qb * 512; nq = 512; qt0 = qb * 512; s0r = b * LSEQ; s0n = LSEQ; s1n = LCTX; }
      attn_block<96>(QK + hd * 96, 1792, KM + hd * 96, 768, QK + 768 + hd * 128 + 64, 1792, Y + 1024 + hd * 64, 1536,
                     qrow0, nq, qt0, s0r, s0n, 0, 0, crow0, s1n, 0.f, 0, lds);
    } else {
      const int kvh = hd >> 2;
      int qrow0, nq, qt0, s0r, s0n, s0t, msk, s1n;
      if (isctx) { qrow0 = crow0; nq = LCTX; qt0 = 0; s0r = crow0; s0n = LCTX; s0t = 0; msk = 0; s1n = 0; }
      else {
        const int t0 = qb * 512;
        const int lo = (t0 - 128 < 0) ? 0 : t0 - 128;
        const int hi = (t0 + 640 > LSEQ) ? LSEQ : t0 + 640;
        qrow0 = b * LSEQ + t0; nq = 512; qt0 = t0; s0r = b * LSEQ + lo; s0n = hi - lo; s0t = lo; msk = 1; s1n = LCTX;
      }
      attn_block<64>(R + hd * 64, 1536, R + 512 + kvh * 64, 1536, R + 640 + kvh * 64, 1536, Y + 512 + hd * 64, 1536,
                     qrow0, nq, qt0, s0r, s0n, s0t, msk, crow0, s1n, sink[hd] * LOG2E, 1, lds);
    }
  }
}

DI void phase_p7a(const Params& p, int l, int nrows, u16* lds) {
  const u16* hn = (const u16*)(p.ws + OFF_A);
  const u16* wt = (const u16*)(p.ws + OFF_W) + (size_t)l * W_LAYER + WO_TG;
  u16* Gt = (u16*)(p.ws + OFF_B);
  const int NT = 24, nitems = (nrows / 256) * NT;
  for (int it_ = lbid(); it_ < ((nitems + 255) & ~255); it_ += gridDim.x) {
    const int item = xcd_remap(it_);
    if (item >= nitems) continue;
    const int m0 = (item / NT) * 256, n0 = (item % NT) * 128;
    f32x16 acc[2][2];
    ACC_ZERO(acc);
    gemm_mainloop(hn + (size_t)m0 * 1024, 1024, wt + (size_t)n0 * 1024, 1024, 1024, acc, lds);
    ACC_FOREACH(acc, m0, n0, { acc[mi_][ni_][r_] = sigmoidf_(val); });
    stage_store_bf16(acc, Gt, 3072, m0, n0, lds);
  }
}
DI void phase_p7b(const Params& p, int l, int nrows, u16* lds) {
  const u16* Y = (const u16*)(p.ws + OFF_Y);
  const u16* Gt = (const u16*)(p.ws + OFF_B);
  const u16* wb = (const u16*)(p.ws + OFF_W) + (size_t)l * W_LAYER + WO_BR;
  u16* mg = (u16*)(p.ws + OFF_A);
  const int NT = 8, nitems = (nrows / 256) * NT;
  for (int it_ = lbid(); it_ < ((nitems + 255) & ~255); it_ += gridDim.x) {
    const int item = xcd_remap(it_);
    if (item >= nitems) continue;
    const int m0 = (item / NT) * 256, n0 = (item % NT) * 128;
    f32x16 mrg[2][2];
    ACC_ZERO(mrg);
#pragma unroll 1
    for (int nb = 0; nb < 3; ++nb) {
      f32x16 acc[2][2];
      ACC_ZERO(acc);
      gemm_mainloop<true>(Y + (size_t)m0 * 1536 + nb * 512, 1536, wb + (size_t)nb * 1024 * 512 + (size_t)n0 * 512, 512, 512, acc, lds);
      {
        u16* gs = lds;
        const int tid = ltid();
#pragma unroll
        for (int i = 0; i < 8; ++i) {
          const int ch = tid + 512 * i, rr = ch >> 4, c16 = ch & 15;
          const uint4 v = *(const uint4*)(Gt + (size_t)(m0 + rr) * 3072 + nb * 1024 + n0 + c16 * 8);
          *(uint4*)(gs + rr * 136 + c16 * 8) = v;
        }
        __syncthreads();
        ACC_FOREACH(acc, 0, 0, { mrg[mi_][ni_][r_] += bf2f(gs[row * 136 + col]) * val; });
        __syncthreads();
      }
    }
    stage_store_bf16(mrg, mg, 1024, m0, n0, lds);
  }
}
DI void phase_p8(const Params& p, int l, int nrows, u16* lds) {
  const u16* mg = (const u16*)(p.ws + OFF_A);
  const u16* wt = (const u16*)(p.ws + OFF_W) + (size_t)l * W_LAYER + WO_OUT;
  const float* xs = (l == 0) ? p.x : p.out;
  const float* cs = (l == 0) ? p.ctx : (const float*)(p.ws + OFF_CTX);
  float* cd = (float*)(p.ws + OFF_CTX);
  const int NT = 8, nitems = (nrows / 256) * NT;
  for (int it_ = lbid(); it_ < ((nitems + 255) & ~255); it_ += gridDim.x) {
    const int item = xcd_remap(it_);
    if (item >= nitems) continue;
    const int m0 = (item / NT) * 256, n0 = (item % NT) * 128;
    f32x16 acc[2][2];
    ACC_ZERO(acc);
    gemm_mainloop(mg + (size_t)m0 * 1024, 1024, wt + (size_t)n0 * 1024, 1024, 1024, acc, lds);
    const int mrow = (m0 < ML) ? (m0 >> 13) : 8;
    const float* gate = mods_ptr(p, l, mrow, 2);
    ACC_FOREACH(acc, m0, n0, {
      const float g = gate[col];
      if (row < ML) p.out[(size_t)row * 1024 + col] = xs[(size_t)row * 1024 + col] + g * val;
      else cd[(size_t)(row - ML) * 1024 + col] = cs[(size_t)(row - ML) * 1024 + col] + g * val;
    });
  }
}
DI void phase_p10(const Params& p, int l, int nrows, u16* lds) {
  const u16* hn = (const u16*)(p.ws + OFF_A);
  const u16* wt = (const u16*)(p.ws + OFF_W) + (size_t)l * W_LAYER + WO_W1;
  u16* h1 = (u16*)(p.ws + OFF_B);
  const int NT = 32, nitems = (nrows / 256) * NT;
  for (int it_ = lbid(); it_ < ((nitems + 255) & ~255); it_ += gridDim.x) {
    const int item = xcd_remap(it_);
    if (item >= nitems) continue;
    const int m0 = (item / NT) * 256, n0 = (item % NT) * 128;
    f32x16 acc[2][2];
    ACC_ZERO(acc);
    gemm_mainloop(hn + (size_t)m0 * 1024, 1024, wt + (size_t)n0 * 1024, 1024, 1024, acc, lds);
    ACC_FOREACH(acc, m0, n0, { const float rl = fmaxf(val, 0.f); acc[mi_][ni_][r_] = rl * rl; });
    stage_store_bf16(acc, h1, 4096, m0, n0, lds);
  }
}
DI void phase_p11(const Params& p, int l, int nrows, u16* lds) {
  const u16* h1 = (const u16*)(p.ws + OFF_B);
  const u16* wt = (const u16*)(p.ws + OFF_W) + (size_t)l * W_LAYER + WO_W2;
  float* cd = (float*)(p.ws + OFF_CTX);
  const int NT = 8, nitems = (nrows / 256) * NT;
  for (int it_ = lbid(); it_ < ((nitems + 255) & ~255); it_ += gridDim.x) {
    const int item = xcd_remap(it_);
    if (item >= nitems) continue;
    const int m0 = (item / NT) * 256, n0 = (item % NT) * 128;
    f32x16 acc[2][2];
    ACC_ZERO(acc);
    gemm_mainloop(h1 + (size_t)m0 * 4096, 4096, wt + (size_t)n0 * 4096, 4096, 4096, acc, lds);
    const int mrow = (m0 < ML) ? (m0 >> 13) : 8;
    const float* gate = mods_ptr(p, l, mrow, 5);
    ACC_FOREACH(acc, m0, n0, {
      const float g = gate[col];
      float* dp = (row < ML) ? p.out + (size_t)row * 1024 + col : cd + (size_t)(row - ML) * 1024 + col;
      *dp = *dp + g * val;
    });
  }
}

DI void phase_gemm1_b(const Params& p, int l, char* lds) {
  EpiRouteBf16 E; E.ws = p.ws;
  run_gemm256((const u16*)(p.ws + OFF_A), (const u16*)(p.ws + OFF_W) + (size_t)l * W_LAYER + WO_T1, MALL, 3072, 1024, E, lds);
}
DI void phase_p4_b(const Params& p, int l, char* lds) {
  const u16* R = (const u16*)(p.ws + OFF_R);
  const u16* wl = (const u16*)(p.ws + OFF_W) + (size_t)l * W_LAYER;
  EpiActBf16<0> E; E.ldc = 1792;
  E.O = (u16*)(p.ws + OFF_A);
  run_gemm256(R + 768, wl + WO_QB, MALL, 768, 384, E, lds, 1536);
  E.O = (u16*)(p.ws + OFF_A) + 768;
  run_gemm256(R + 1152, wl + WO_KVB, MALL, 1024, 256, E, lds, 1536);
}
DI void phase_p7a_b(const Params& p, int l, int nrows, char* lds) {
  EpiActBf16<1> E; E.O = (u16*)(p.ws + OFF_B); E.ldc = 3072;
  run_gemm256((const u16*)(p.ws + OFF_A), (const u16*)(p.ws + OFF_W) + (size_t)l * W_LAYER + WO_TG, nrows, 3072, 1024, E, lds);
}
DI void phase_p10_b(const Params& p, int l, int nrows, char* lds) {
  EpiActBf16<2> E; E.O = (u16*)(p.ws + OFF_B); E.ldc = 4096;
  run_gemm256((const u16*)(p.ws + OFF_A), (const u16*)(p.ws + OFF_W) + (size_t)l * W_LAYER + WO_W1, nrows, 4096, 1024, E, lds);
}
DI void phase_p8_b(const Params& p, int l, int nrows, char* lds) {
  EpiResid E;
  E.xs = (l == 0) ? p.x : p.out; E.cs = (l == 0) ? p.ctx : (const float*)(p.ws + OFF_CTX);
  E.xo = p.out; E.co = (float*)(p.ws + OFF_CTX); E.gbase = mods_ptr(p, l, 0, 2);
  run_gemm256((const u16*)(p.ws + OFF_A), (const u16*)(p.ws + OFF_W) + (size_t)l * W_LAYER + WO_OUT, nrows, 1024, 1024, E, lds);
}
DI void phase_p11_b(const Params& p, int l, int nrows, char* lds) {
  EpiResid E;
  E.xs = p.out; E.cs = (const float*)(p.ws + OFF_CTX);
  E.xo = p.out; E.co = (float*)(p.ws + OFF_CTX); E.gbase = mods_ptr(p, l, 0, 5);
  run_gemm256((const u16*)(p.ws + OFF_B), (const u16*)(p.ws + OFF_W) + (size_t)l * W_LAYER + WO_W2, nrows, 1024, 4096, E, lds);
}

#define OFF_BAR 985907200ull
#define XB_TMO      128
#define XB_XCNT(j)  (256  + 64 * (j))
#define XB_XSUB(j)  (1280 + 64 * (j))
#define XB_XGEN(j)  (2304 + 64 * (j))
#define XB_TOP      3328
#define XB_TOPGEN   3392
#define XCD_BAR_WORDS 3456
#define XB_SPIN_CAP (1u << 18)
#define LAS __attribute__((address_space(3)))
DI unsigned xb_ld(unsigned* p) { return __hip_atomic_load(p, __ATOMIC_RELAXED, __HIP_MEMORY_SCOPE_AGENT); }
DI unsigned xb_add(unsigned* p, unsigned v) { return __hip_atomic_fetch_add(p, v, __ATOMIC_RELAXED, __HIP_MEMORY_SCOPE_AGENT); }
DI unsigned xb_xcc_id() { return (unsigned)__builtin_amdgcn_s_getreg((3 << 11) | 20) & 0xFu; }
#define XB_SPIN(cond, bar) do { unsigned _sp = 0; while (cond) { __builtin_amdgcn_s_sleep(1); \
    if ((++_sp & 255u) == 0u) { if (xb_ld(&(bar)[XB_TMO])) break; if (_sp > XB_SPIN_CAP) { atomicAdd(&(bar)[XB_TMO], 1u); break; } } } } while (0)
struct XcdBarrier { unsigned* bar; unsigned x; volatile LAS unsigned* st; };
DI XcdBarrier xcd_barrier_post(unsigned* bar, volatile LAS unsigned* st) {
  XcdBarrier b; b.bar = bar; b.x = xb_xcc_id(); b.st = st;
  if (threadIdx.x == 0) (void)xb_add(&bar[XB_XCNT(b.x)], 1u);
  return b;
}
DI void xcd_barrier_complete(unsigned* bar, unsigned x, unsigned& nloc, unsigned& nx) {
  const unsigned G = gridDim.x * gridDim.y * gridDim.z;
  unsigned sum, cnt, mine, sp = 0u;
  for (;;) {
    sum = 0u; cnt = 0u; mine = 0u;
#pragma unroll
    for (unsigned j = 0; j < 16; ++j) { const unsigned c = xb_ld(&bar[XB_XCNT(j)]); sum += c; cnt += (c > 0u) ? 1u : 0u; mine = (j == x) ? c : mine; }
    if (sum == G) break;
    __builtin_amdgcn_s_sleep(1);
    if ((++sp & 255u) == 0u) { if (xb_ld(&bar[XB_TMO])) break; if (sp > XB_SPIN_CAP) { atomicAdd(&bar[XB_TMO], 1u); break; } }
  }
  nloc = mine > 0u ? mine : 1u; nx = cnt > 0u ? cnt : 1u;
}
DI void xcd_barrier(const XcdBarrier& b) {
  asm volatile("s_waitcnt vmcnt(0) lgkmcnt(0)" ::: "memory");
  __syncthreads();
  if (threadIdx.x == 0) {
    unsigned* bar = b.bar;
    __builtin_amdgcn_s_waitcnt(0);
    unsigned nloc = b.st[0], nx = b.st[1];
    if (nloc == 0u) { xcd_barrier_complete(bar, b.x, nloc, nx); b.st[0] = nloc; b.st[1] = nx; }
    const unsigned old = xb_add(&bar[XB_XSUB(b.x)], 1u);
    const unsigned gen = old / nloc;
    if (old + 1u == (gen + 1u) * nloc) {
      __builtin_amdgcn_fence(__ATOMIC_RELEASE, "agent");
      asm volatile("s_waitcnt vmcnt(0)" ::: "memory");
      const unsigned og = xb_add(&bar[XB_TOP], 1u);
      const unsigned tg = og / nx;
      if (og + 1u == (tg + 1u) * nx) xb_add(&bar[XB_TOPGEN], 1u);
      else XB_SPIN(xb_ld(&bar[XB_TOPGEN]) == tg, bar);
      __builtin_amdgcn_fence(__ATOMIC_ACQUIRE, "agent");
      xb_add(&bar[XB_XGEN(b.x)], 1u);
      asm volatile("s_waitcnt vmcnt(0)" ::: "memory");
    } else {
      XB_SPIN(xb_ld(&bar[XB_XGEN(b.x)]) == gen, bar);
      __builtin_amdgcn_fence(__ATOMIC_ACQUIRE, "agent");
      asm volatile("s_waitcnt vmcnt(0)" ::: "memory");
    }
  }
  __syncthreads();
}

DI void gsync(cg::grid_group& grid) {
  asm volatile("s_waitcnt vmcnt(0) lgkmcnt(0)" ::: "memory");
  grid.sync();
  if (ltid() < 64) {
    __builtin_amdgcn_fence(__ATOMIC_ACQUIRE, "agent");
    asm volatile("s_waitcnt vmcnt(0)" ::: "memory");
  }
  __syncthreads();
}

__global__ void __launch_bounds__(512) fwd_megakernel(Params p) {
  __shared__ __attribute__((aligned(16))) char lds[131072];
  __shared__ uint4 xb_words;
  cg::grid_group grid = cg::this_grid();
  if (threadIdx.x == 0) xb_words = make_uint4(0u, 0u, 0u, 0u);
  __syncthreads();
  const XcdBarrier xb = xcd_barrier_post((unsigned*)(p.ws + OFF_BAR), (volatile LAS unsigned*)&xb_words);
  phase0(p, lds);
  gsync(grid);
  for (int l = 0; l < 4; ++l) {
    const int nrows2 = (l < 3) ? MALL : ML;
#ifdef PROBE_SYNC10
    for (int q = 0; q < 10; ++q) xcd_barrier(xb);
#endif
#ifdef PROBE_FILT
    filter_tiles(p, l, LSEQ, 2 * FFTN, (float*)(p.ws + OFF_KF), (float*)(p.ws + OFF_PART), (float*)lds);
    xcd_barrier(xb);
    phase_filter_fft(p, l, (float*)lds);
    xcd_barrier(xb);
#endif
    phase_rownorm(p, l, 0, MALL);
#ifdef PROBE_ELEM
    phase_rownorm(p, l, 0, MALL);
    phase_rownorm(p, l, 0, MALL);
    phase_rownorm(p, l, 0, MALL);
#endif
    filter_tiles(p, l, LSEQ, 2 * FFTN, (float*)(p.ws + OFF_KF), (float*)(p.ws + OFF_PART), (float*)lds);
    if (l < 3) filter_tiles(p, l, LCTX, 512, (float*)(p.ws + OFF_KC), (float*)(p.ws + OFF_PART) + 128 * 1024, (float*)lds);
    xcd_barrier(xb);
    phase_gemm1_b(p, l, lds);
#ifdef PROBE_BIGG
    phase_gemm1_b(p, l, lds);
#endif
    phase_filter_fft(p, l, (float*)lds);
    xcd_barrier(xb);
    phase_h1(p, l, (float*)lds);
#ifdef PROBE_ELEM
    phase_h1(p, l, (float*)lds);
#endif
    phase_p3(p, l, (float*)lds);
    xcd_barrier(xb);
    phase_h2(p, l, (float*)lds);
    xcd_barrier(xb);
#ifdef PROBE_H2
    phase_h1(p, l, (float*)lds);
    xcd_barrier(xb);
    phase_h2(p, l, (float*)lds);
    xcd_barrier(xb);
#endif
    phase_h3(p, l, (float*)lds);
#ifdef PROBE_ELEM
    phase_h3(p, l, (float*)lds);
#endif
    xcd_barrier(xb);
    phase_p4(p, l, (u16*)lds);
#ifdef PROBE_SMALLG
    phase_p4(p, l, (u16*)lds);
#endif
    xcd_barrier(xb);
    phase_p5(p, l, (float*)lds);
    xcd_barrier(xb);
#ifdef PROBE_P45
    phase_p4(p, l, (u16*)lds);
    xcd_barrier(xb);
    phase_p5(p, l, (float*)lds);
    xcd_barrier(xb);
#endif
    phase_attn(p, l, (u16*)lds);
#ifdef PROBE_ATTN2
    xcd_barrier(xb);
    phase_attn(p, l, (u16*)lds);
#endif
    xcd_barrier(xb);
    phase_rownorm(p, l, 0, nrows2);
    xcd_barrier(xb);
    phase_p7a_b(p, l, nrows2, lds);
#ifdef PROBE_BIGG
    phase_p7a_b(p, l, nrows2, lds);
#endif
    xcd_barrier(xb);
    phase_p7b(p, l, nrows2, (u16*)lds);
#ifdef PROBE_SMALLG
    phase_p7b(p, l, nrows2, (u16*)lds);
#endif
    xcd_barrier(xb);
    phase_p8_b(p, l, nrows2, lds);
    xcd_barrier(xb);
    phase_rownorm(p, l, 1, nrows2);
    xcd_barrier(xb);
    phase_p10_b(p, l, nrows2, lds);
#ifdef PROBE_BIGG
    phase_p10_b(p, l, nrows2, lds);
#endif
    xcd_barrier(xb);
    phase_p11_b(p, l, nrows2, lds);
    xcd_barrier(xb);
  }
}

extern "C" void kernel_launch(void* const* d_in, const int* in_sizes, int n_in, void* d_out, int out_size, void* d_ws,
                              size_t ws_size, hipStream_t stream) {
  static int grid_blocks = 0;
  if (!grid_blocks) {
    int dev = 0, cus = 0, per_cu = 0;
    hipGetDevice(&dev);
    hipDeviceGetAttribute(&cus, hipDeviceAttributeMultiprocessorCount, dev);
    hipOccupancyMaxActiveBlocksPerMultiprocessor(&per_cu, fwd_megakernel, 512, 0);
    if (per_cu < 1) per_cu = 1;
    if (per_cu > 1) per_cu = 1;
    grid_blocks = cus * per_cu;
  }
  Params p{};
  const float** pp = (const float**)&p;
  for (int i = 0; i < 30; ++i) pp[i] = (const float*)d_in[i];
  p.out = (float*)d_out;
  p.ws = (char*)d_ws;
  hipMemsetAsync((char*)d_ws + OFF_BAR, 0, XCD_BAR_WORDS * sizeof(unsigned), stream);
  void* args[] = {&p};
  hipError_t e = hipLaunchCooperativeKernel((void*)fwd_megakernel, dim3(grid_blocks), dim3(512), args, 0, stream);
  if (e != hipSuccess) fprintf(stderr, "cooperative launch failed: %s (grid %d)\n", hipGetErrorString(e), grid_blocks);
}
```

```cpp
#include <hip/hip_runtime.h>
#include <hip/hip_cooperative_groups.h>
#include <cstdio>
namespace cg = cooperative_groups;

typedef unsigned short u16;
typedef short bf16x8 __attribute__((ext_vector_type(8)));
typedef float f32x16 __attribute__((ext_vector_type(16)));
typedef unsigned u32x4 __attribute__((ext_vector_type(4)));
#define VLOAD16(ptr) __builtin_bit_cast(uint4, *(const volatile u32x4*)(ptr))
typedef __bf16 bf16x2_t __attribute__((ext_vector_type(2)));
typedef float f32x2_t __attribute__((ext_vector_type(2)));
#define DI __device__ __forceinline__
#define MFMA(a, b, c) __builtin_amdgcn_mfma_f32_32x32x16_bf16((a), (b), (c), 0, 0, 0)

#define DM 1024
#define NBATCH 8
#define LSEQ 8192
#define LCTX 256
#define ML 65536
#define MC 2048
#define MALL 67584
#define NIN 6048
#define FFTN 16384
#define EPSV 1e-6f
#define LOG2E 1.4426950408889634f

#define W_LAYER 17858560ull
#define WO_T1 0ull
#define WO_TG 3145728ull
#define WO_QB 6291456ull
#define WO_KVB 6586368ull
#define WO_BR 6848512ull
#define WO_OUT 8421376ull
#define WO_W1 9469952ull
#define WO_W2 13664256ull
#define OFF_W 0ull
#define OFF_CTX 142868480ull
#define OFF_KF 151257088ull
#define OFF_KC 218365952ull
#define OFF_MODS 219414528ull
#define OFF_SUMSQ 220299264ull
#define OFF_ROPEG 220315648ull
#define OFF_ROPEM 222412800ull
#define OFF_TW 223461376ull
#define OFF_A 223592448ull
#define OFF_B 362004480ull
#define OFF_C 431210496ull
#define OFF_R 569622528ull
#define OFF_Y 777240576ull
#define OFF_KM (OFF_A + 242221056ull)
#define OFF_PART 984858624ull
#define ZC_OFF 33554432

struct Params {
  const float *x, *c, *ctx, *c_ctx, *w_mod, *b_mod, *norm_mix_g, *norm_mlp_g, *w_in, *hy_short_w, *hy_f1_w, *hy_f1_b,
      *hy_f2_w, *hy_f2_b, *hy_sin_freq, *hy_f3_w, *hy_skip, *gqa_q_norm, *gqa_k_norm, *gqa_sink, *mla_q_a_norm,
      *mla_kv_a_norm, *w_q_b, *w_kv_b, *mla_q_norm, *mla_k_norm, *w_branch, *w_out, *w_mlp1, *w_mlp2;
  float* out;
  char* ws;
};

DI int ltid() { int t = threadIdx.x; asm volatile("" : "+v"(t)); return t; }
DI int lbid() { int t = blockIdx.x; asm volatile("" : "+s"(t)); return t; }
DI u16 f2bf(float x) { return __builtin_bit_cast(u16, (__bf16)x); }
DI float bf2f(u16 v) { return __uint_as_float(((unsigned)v) << 16); }
DI unsigned pk2(float a, float b) {
  f32x2_t f = {a, b};
  return __builtin_bit_cast(unsigned, __builtin_convertvector(f, bf16x2_t));
}
DI float wave_sum(float v) {
#pragma unroll
  for (int o = 32; o > 0; o >>= 1) v += __shfl_xor(v, o);
  return v;
}
DI float sigmoidf_(float x) { return 1.0f / (1.0f + __expf(-x)); }
DI const float* mods_ptr(const Params& p, int l, int mrow, int j) {
  return (const float*)(p.ws + OFF_MODS) + ((size_t)(l * 9 + mrow) * 6144 + j * 1024);
}

template <bool LOWREG = false>
DI void gemm_mainloop(const u16* __restrict__ Ag, int lda, const u16* __restrict__ Bg, int ldb, int K,
                      f32x16 (&acc)[2][2], u16* lds) {
  const int tid = ltid(), lane = tid & 63, w = tid >> 6, l32 = lane & 31, hh = lane >> 5;
  const int wm = w >> 1, wn = w & 1;
  u16* As = lds;
  u16* Bs = lds + 2 * 256 * 72;
  const int arow = tid >> 3, ach = tid & 7;
  const u16* ap = Ag + (size_t)arow * lda + ach * 8;
  const u16* bp = Bg + (size_t)arow * ldb + ach * 8;
  const int nk = K >> 6;
  uint4 ra0[4], rb0[2], ra1[4], rb1[2];
#define G_LOAD(RA, RB, T)                                                                   \
  {                                                                                         \
    const int t_ = ((T) < nk) ? (T) : nk - 1;                                               \
    _Pragma("unroll") for (int i = 0; i < 4; ++i) RA[i] = VLOAD16(ap + (size_t)(64 * i) * lda + 64 * t_); \
    _Pragma("unroll") for (int i = 0; i < 2; ++i) RB[i] = VLOAD16(bp + (size_t)(64 * i) * ldb + 64 * t_); \
  }
#define G_STORE(RA, RB, BUF)                                                                \
  {                                                                                         \
    u16* Aw = As + (BUF) * 256 * 72;                                                        \
    u16* Bw = Bs + (BUF) * 128 * 72;                                                        \
    _Pragma("unroll") for (int i = 0; i < 4; ++i) *(uint4*)(Aw + (arow + 64 * i) * 72 + ach * 8) = RA[i]; \
    _Pragma("unroll") for (int i = 0; i < 2; ++i) *(uint4*)(Bw + (arow + 64 * i) * 72 + ach * 8) = RB[i]; \
  }
#define G_COMPUTE(BUF, RA, RB, WBUF)                                                        \
  {                                                                                         \
    const u16* as = As + (BUF) * 256 * 72 + (wm * 64 + l32) * 72 + hh * 8;                  \
    const u16* bs = Bs + (BUF) * 128 * 72 + (wn * 64 + l32) * 72 + hh * 8;                  \
    u16* Aw = As + (WBUF) * 256 * 72 + arow * 72 + ach * 8;                                 \
    u16* Bw = Bs + (WBUF) * 128 * 72 + arow * 72 + ach * 8;                                 \
    _Pragma("unroll") for (int s = 0; s < 4; ++s) {                                         \
      bf16x8 a0 = *(const bf16x8*)(as + s * 16), a1 = *(const bf16x8*)(as + 32 * 72 + s * 16); \
      bf16x8 b0 = *(const bf16x8*)(bs + s * 16), b1 = *(const bf16x8*)(bs + 32 * 72 + s * 16); \
      acc[0][0] = MFMA(a0, b0, acc[0][0]);                                                  \
      acc[0][1] = MFMA(a0, b1, acc[0][1]);                                                  \
      acc[1][0] = MFMA(a1, b0, acc[1][0]);                                                  \
      acc[1][1] = MFMA(a1, b1, acc[1][1]);                                                  \
      if (s == 0) { *(uint4*)(Aw) = RA[0]; *(uint4*)(Aw + 64 * 72) = RA[1]; }               \
      if (s == 1) { *(uint4*)(Aw + 128 * 72) = RA[2]; *(uint4*)(Aw + 192 * 72) = RA[3]; }   \
      if (s == 2) { *(uint4*)(Bw) = RB[0]; *(uint4*)(Bw + 64 * 72) = RB[1]; }               \
      if (LOWREG) __builtin_amdgcn_sched_barrier(0);                                        \
    }                                                                                       \
  }
  G_LOAD(ra0, rb0, 0);
  G_LOAD(ra1, rb1, 1);
  __builtin_amdgcn_sched_barrier(0);
  G_STORE(ra0, rb0, 0);
  __syncthreads();
  for (int kt = 0; kt < nk; kt += 2) {
    G_LOAD(ra0, rb0, kt + 2);
    __builtin_amdgcn_sched_barrier(0);
    G_COMPUTE(0, ra1, rb1, 1);
    __syncthreads();
    G_LOAD(ra1, rb1, kt + 3);
    __builtin_amdgcn_sched_barrier(0);
    G_COMPUTE(1, ra0, rb0, 0);
    __syncthreads();
  }
#undef G_LOAD
#undef G_STORE
#undef G_COMPUTE
}

DI int xcd_remap(int it) { const int r = it & 255; return (it & ~255) + ((r & 7) << 5) + (r >> 3); }

#define ACC_ZERO(acc)                                                                      \
  _Pragma("unroll") for (int mi_ = 0; mi_ < 2; ++mi_) _Pragma("unroll") for (int ni_ = 0; ni_ < 2; ++ni_) \
      _Pragma("unroll") for (int r_ = 0; r_ < 16; ++r_) acc[mi_][ni_][r_] = 0.f;

#define ACC_FOREACH(acc, m0, n0, BODY)                                                     \
  {                                                                                        \
    const int lane_ = ltid() & 63, w_ = ltid() >> 6;                             \
    const int l32_ = lane_ & 31, hh_ = lane_ >> 5, wm_ = w_ >> 1, wn_ = w_ & 1;            \
    _Pragma("unroll") for (int mi_ = 0; mi_ < 2; ++mi_) _Pragma("unroll") for (int ni_ = 0; ni_ < 2; ++ni_) { \
        __builtin_amdgcn_sched_barrier(0);                                                 \
        _Pragma("unroll") for (int r_ = 0; r_ < 16; ++r_) {                                \
      const int row = (m0) + wm_ * 64 + mi_ * 32 + (r_ & 3) + 8 * (r_ >> 2) + 4 * hh_;     \
      const int col = (n0) + wn_ * 64 + ni_ * 32 + l32_;                                   \
      const float val = acc[mi_][ni_][r_];                                                    \
      BODY                                                                                 \
    } }                                                                                    \
  }

DI void stage_store_bf16(f32x16 (&acc)[2][2], u16* __restrict__ dst, int ld, int m0, int c0, u16* lds) {
  u16* cs = lds;
  ACC_FOREACH(acc, 0, 0, { cs[row * 136 + col] = f2bf(val); });
  __syncthreads();
  const int tid = ltid();
#pragma unroll
  for (int i = 0; i < 8; ++i) {
    const int ch = tid + 512 * i, rr = ch >> 4, c16 = ch & 15;
    const uint4 v = *(const uint4*)(cs + rr * 136 + c16 * 8);
    *(uint4*)(dst + (size_t)(m0 + rr) * ld + c0 + c16 * 8) = v;
  }
  __syncthreads();
}

namespace pg8 {
#define PG8_LAS __attribute__((address_space(3)))
typedef unsigned short bf16_t;
typedef short bf16x8 __attribute__((ext_vector_type(8)));
typedef float f32x4 __attribute__((ext_vector_type(4)));
typedef unsigned u32x4 __attribute__((ext_vector_type(4)));
constexpr int BM = 256, BK = 64, HALF = 128, HTB = HALF * BK * 2  , STAGE_BYTES = 8 * HTB, NXCD = 8, WGM = 8;

__host__ __device__ __forceinline__ int lds_byte(int r, int c) { const int st = (r >> 4) * 2 + (c >> 5), rr = r & 15, cc = c & 31, ob = rr * 64 + cc * 2; return st * 1024 + (ob ^ (((ob >> 9) & 1) << 5)); }
__host__ __device__ __forceinline__ void stage_rc(int b, int& R, int& C) { const int st = b / 1024, sb = b % 1024, swz = sb ^ (((sb >> 9) & 1) << 5); R = (st >> 1) * 16 + swz / 64; C = (st & 1) * 32 + (swz % 64) / 2; }
__host__ __device__ __forceinline__ int perm32(int rho) { const int n = rho >> 4, i = rho & 15; return 8 * (i >> 2) + 4 * n + (i & 3); }

struct Unit { int pm, pn; };
struct Gemm { const bf16_t* A; const bf16_t* Bt; int M, N, K, lda; };

struct StaticOrder {
    int nM, nN, nwg, G, c;
    __host__ __device__ void init(int M, int N, int G_, int c_) { nM = M / BM; nN = N / BM; nwg = nM * nN; G = G_; c = c_; }
    __host__ __device__ bool next(int i, Unit& u) const {
        const long L = (long)i * G + c; if (L >= nwg) return false;
        int wgid = (int)L; { const int q = nwg / NXCD, r = nwg % NXCD, xcd = wgid % NXCD, off = wgid / NXCD; wgid = (xcd < r ? xcd * (q + 1) : r * (q + 1) + (xcd - r) * q) + off; }
        const int nig = WGM * nN, gid = wgid / nig, fm = gid * WGM, gsz = (nM - fm) < WGM ? (nM - fm) : WGM;
        u.pm = fm + ((wgid % nig) % gsz); u.pn = (wgid % nig) / gsz; return true;
    }
    __device__ __forceinline__ void a_ready(const Unit&) const {}
    __device__ __forceinline__ void done(const Unit&) const {}
};
template <class Epi, class Sched, bool STAMP = false>
__device__ __forceinline__ void gemm_phase(PG8_LAS unsigned char* lds, const Gemm g, const Sched& S, const Epi& E, unsigned long long* stamps) {
    const int tid = ltid(), wid = __builtin_amdgcn_readfirstlane(tid >> 6), lane = tid & 63, wr = wid >> 2, wc = wid & 3, fr = lane & 15, fq = lane >> 4;
    const int K = g.K, nt = K / BK;
    int ts_lo = 0, ts_hi = 0, nts = 0; const unsigned long long rt_entry = STAMP ? (unsigned long long)wall_clock64() : 0ull;
#define PG8_STAMP() do { if (STAMP && wid == 0 && nts < 64) { const unsigned long long _c = (unsigned long long)clock64(); \
        ts_lo = (lane == nts) ? (int)(unsigned)_c : ts_lo; ts_hi = (lane == nts) ? (int)(unsigned)(_c >> 32) : ts_hi; ++nts; } } while (0)
    PG8_STAMP();
    unsigned voffA[2], voffB[2];
#pragma unroll
    for (int i = 0; i < 2; ++i) { int R, C; stage_rc(tid * 16 + i * 8192, R, C); const int Rb = Epi::PERM ? ((R & ~31) + perm32(R & 31)) : R;
        voffA[i] = (unsigned)(R * g.lda + C) * 2u; voffB[i] = (unsigned)(Rb * K + C) * 2u; }
    const size_t kstep = (size_t)(BK * 2);
    const size_t hstep = (size_t)HALF * K * 2;
    const size_t tstep = 2 * hstep;
    const size_t hstepA = (size_t)HALF * g.lda * 2, tstepA = 2 * hstepA;
    const unsigned ldsw = (unsigned)wid * 1024u;
    const int aoff = lds_byte(wr * 64 + fr, fq * 8), boff = lds_byte(wc * 32 + fr, fq * 8);
#define PG8_SA(b, h) (((b) * 2 + (h)) * HTB)
#define PG8_SB(b, h) ((4 + (b) * 2 + (h)) * HTB)
#define PG8_STAGE(bufoff, gbase, voff) do { _Pragma("unroll") for (int _i = 0; _i < 2; ++_i) \
        __builtin_amdgcn_global_load_lds((const unsigned*)((const char*)(gbase) + (voff)[_i]), (PG8_LAS unsigned*)(lds + (bufoff) + ldsw + _i * 8192), 16, 0, 0); } while (0)
#define PG8_LDA(dst, b, h) do { _Pragma("unroll") for (int m = 0; m < 4; ++m) _Pragma("unroll") for (int k = 0; k < 2; ++k) dst[m][k] = *(const PG8_LAS bf16x8*)(lds + PG8_SA(b, h) + aoff + m * 2048 + k * 1024); } while (0)
#define PG8_LDB(dst, b, h) do { _Pragma("unroll") for (int n = 0; n < 2; ++n) _Pragma("unroll") for (int k = 0; k < 2; ++k) dst[n][k] = *(const PG8_LAS bf16x8*)(lds + PG8_SB(b, h) + boff + n * 2048 + k * 1024); } while (0)
#define PG8_MMA(ai, bj, At, Bt) do { __builtin_amdgcn_s_setprio(1); _Pragma("unroll") for (int m = 0; m < 4; ++m) _Pragma("unroll") for (int n = 0; n < 2; ++n) _Pragma("unroll") for (int k = 0; k < 2; ++k) \
        acc[ai][bj][m][n] = __builtin_amdgcn_mfma_f32_16x16x32_bf16(Bt[n][k], At[m][k], acc[ai][bj][m][n], 0, 0, 0); __builtin_amdgcn_s_setprio(0); } while (0)
#define PG8_WAIT_V(n) asm volatile("s_waitcnt vmcnt(" #n ")" ::: "memory")
#define PG8_WAIT_L(n) asm volatile("s_waitcnt lgkmcnt(" #n ")" ::: "memory")
#define PG8_BAR __builtin_amdgcn_s_barrier()
#define PG8_SCHED __builtin_amdgcn_sched_barrier(0)
    Unit cur, nxt; int ui = 0;
    if (!S.next(0, cur)) return;
    f32x4 acc[2][2][4][2];
#pragma unroll
    for (int a = 0; a < 2; ++a)
#pragma unroll
        for (int b = 0; b < 2; ++b)
#pragma unroll
            for (int m = 0; m < 4; ++m)
#pragma unroll
                for (int n = 0; n < 2; ++n) acc[a][b][m][n] = (f32x4){0.f, 0.f, 0.f, 0.f};
    bf16x8 At[4][2], B0[2][2], B1[2][2];
    const char* cA = (const char*)g.A + (size_t)cur.pm * tstepA; const char* cB = (const char*)g.Bt + (size_t)cur.pn * tstep;
    S.a_ready(cur);
    PG8_STAGE(PG8_SB(0, 0), cB, voffB); PG8_STAGE(PG8_SA(0, 0), cA, voffA); PG8_STAGE(PG8_SB(0, 1), cB + hstep, voffB); PG8_STAGE(PG8_SA(0, 1), cA + hstepA, voffA);
    if (wr == 1) PG8_BAR;
    PG8_WAIT_V(4); PG8_BAR;
    PG8_STAGE(PG8_SB(1, 0), cB + kstep, voffB); PG8_STAGE(PG8_SA(1, 0), cA + kstep, voffA); PG8_STAGE(PG8_SB(1, 1), cB + hstep + kstep, voffB);
    PG8_WAIT_V(6); PG8_BAR;
    PG8_STAMP();
    for (;;) {
        const bool has_next = S.next(ui + 1, nxt);
        const char* nA = has_next ? (const char*)g.A + (size_t)nxt.pm * tstepA : cA; const char* nB = has_next ? (const char*)g.Bt + (size_t)nxt.pn * tstep : cB;
        for (int t = 0; t < nt; t += 2) {
            const bool last = (t == nt - 2);
            const char* a1 = cA + (size_t)(t + 1) * kstep;
            const char* a2 = last ? nA : cA + (size_t)(t + 2) * kstep; const char* b2 = last ? nB : cB + (size_t)(t + 2) * kstep;
            const char* a3 = a2 + kstep; const char* b3 = b2 + kstep;
            if (last && has_next) S.a_ready(nxt);
            PG8_LDB(B0, 0, 0); PG8_SCHED; PG8_LDA(At, 0, 0); PG8_STAGE(PG8_SA(1, 1), a1 + hstepA, voffA);
            PG8_WAIT_L(8); PG8_BAR; PG8_WAIT_L(0); PG8_MMA(0, 0, At, B0); PG8_BAR; PG8_SCHED;
            PG8_LDB(B1, 0, 1); PG8_STAGE(PG8_SB(0, 0), b2, voffB);
            PG8_BAR; PG8_WAIT_L(0); PG8_MMA(0, 1, At, B1); PG8_BAR;
            PG8_LDA(At, 0, 1); PG8_STAGE(PG8_SA(0, 0), a2, voffA);
            PG8_BAR; PG8_WAIT_L(0); PG8_MMA(1, 0, At, B0); PG8_BAR; PG8_SCHED;
            PG8_STAGE(PG8_SB(0, 1), b2 + hstep, voffB);
            PG8_WAIT_V(6); PG8_BAR; PG8_MMA(1, 1, At, B1); PG8_BAR;
            PG8_LDB(B0, 1, 0); PG8_SCHED; PG8_LDA(At, 1, 0); PG8_STAGE(PG8_SA(0, 1), a2 + hstepA, voffA);
            PG8_WAIT_L(8); PG8_BAR; PG8_WAIT_L(0); PG8_MMA(0, 0, At, B0); PG8_BAR; PG8_SCHED;
            PG8_LDB(B1, 1, 1); PG8_STAGE(PG8_SB(1, 0), b3, voffB);
            PG8_BAR; PG8_WAIT_L(0); PG8_MMA(0, 1, At, B1); PG8_BAR;
            PG8_LDA(At, 1, 1); PG8_STAGE(PG8_SA(1, 0), a3, voffA);
            PG8_BAR; PG8_WAIT_L(0); PG8_MMA(1, 0, At, B0); PG8_BAR; PG8_SCHED;
            PG8_STAGE(PG8_SB(1, 1), b3 + hstep, voffB);
            PG8_WAIT_V(6); PG8_BAR; PG8_MMA(1, 1, At, B1); PG8_BAR;
        }
        PG8_STAMP();
        if constexpr (!Epi::AFTER_DRAIN) { E(acc, cur, wr, wc, fr, fq); S.done(cur); }
        PG8_STAMP();
        if (!has_next) break;
#pragma unroll
        for (int a = 0; a < 2; ++a)
#pragma unroll
            for (int b = 0; b < 2; ++b)
#pragma unroll
                for (int m = 0; m < 4; ++m)
#pragma unroll
                    for (int n = 0; n < 2; ++n) acc[a][b][m][n] = (f32x4){0.f, 0.f, 0.f, 0.f};
        cur = nxt; cA = nA; cB = nB; ++ui;
    }
    PG8_WAIT_V(0);
    if (wr == 0) PG8_BAR;
    PG8_BAR;
    if constexpr (Epi::AFTER_DRAIN) { E.fused(acc, cur, wr, wc, fr, fq, lds, wid, lane); S.done(cur); }
    PG8_STAMP();
    if (STAMP && wid == 0) { stamps[lane] = lane < nts ? (((unsigned long long)(unsigned)ts_hi << 32) | (unsigned)ts_lo) : 0ull;
        if (lane == 62) stamps[62] = rt_entry; if (lane == 63) stamps[63] = (unsigned long long)wall_clock64(); }
#undef PG8_STAMP
#undef PG8_SA
#undef PG8_SB
#undef PG8_STAGE
#undef PG8_LDA
#undef PG8_LDB
#undef PG8_MMA
#undef PG8_WAIT_V
#undef PG8_WAIT_L
#undef PG8_BAR
#undef PG8_SCHED
}
}

DI uint4 pack8_bf16(const pg8::f32x4& v0, const pg8::f32x4& v1) {
  uint4 w; w.x = pk2(v0[0], v0[1]); w.y = pk2(v0[2], v0[3]); w.z = pk2(v1[0], v1[1]); w.w = pk2(v1[2], v1[3]); return w;
}
struct EpiRouteBf16 {
  static constexpr bool PERM = true, AFTER_DRAIN = false;
  char* ws;
  DI void operator()(const pg8::f32x4 (&acc)[2][2][4][2], const pg8::Unit& u, int wr, int wc, int fr, int fq) const {
    const int row0 = u.pm * 256 + wr * 64 + fr;
    u16* base; int ld, colt;
    if (u.pn < 2) { base = (u16*)(ws + OFF_B); ld = 512; colt = u.pn * 256; }
    else if (u.pn < 6) { base = (u16*)(ws + OFF_C); ld = 1024; colt = u.pn * 256 - 512; }
    else { base = (u16*)(ws + OFF_R); ld = 1536; colt = u.pn * 256 - 1536; }
    const int col0 = colt + wc * 32 + 8 * fq;
#pragma unroll
    for (int ai = 0; ai < 2; ++ai)
#pragma unroll
      for (int m = 0; m < 4; ++m) {
        u16* rowp = base + (size_t)(row0 + ai * 128 + m * 16) * ld + col0;
#pragma unroll
        for (int bj = 0; bj < 2; ++bj) *(uint4*)(rowp + bj * 128) = pack8_bf16(acc[ai][bj][m][0], acc[ai][bj][m][1]);
      }
  }
};
template <int ACT  > struct EpiActBf16 {
  static constexpr bool PERM = true, AFTER_DRAIN = false;
  u16* O; int ldc;
  DI void operator()(const pg8::f32x4 (&acc)[2][2][4][2], const pg8::Unit& u, int wr, int wc, int fr, int fq) const {
    const int row0 = u.pm * 256 + wr * 64 + fr, col0 = u.pn * 256 + wc * 32 + 8 * fq;
#pragma unroll
    for (int ai = 0; ai < 2; ++ai)
#pragma unroll
      for (int m = 0; m < 4; ++m) {
        u16* rowp = O + (size_t)(row0 + ai * 128 + m * 16) * ldc + col0;
#pragma unroll
        for (int bj = 0; bj < 2; ++bj) {
          pg8::f32x4 v0 = acc[ai][bj][m][0], v1 = acc[ai][bj][m][1];
#pragma unroll
          for (int j = 0; j < 4; ++j) {
            if (ACT == 1) { v0[j] = sigmoidf_(v0[j]); v1[j] = sigmoidf_(v1[j]); }
            else if (ACT == 2) { const float a = fmaxf(v0[j], 0.f), b = fmaxf(v1[j], 0.f); v0[j] = a * a; v1[j] = b * b; }
          }
          *(uint4*)(rowp + bj * 128) = pack8_bf16(v0, v1);
        }
      }
  }
};
struct EpiResid {
  static constexpr bool PERM = false, AFTER_DRAIN = false;
  const float* xs; const float* cs; float* xo; float* co; const float* gbase;
  DI void operator()(const pg8::f32x4 (&acc)[2][2][4][2], const pg8::Unit& u, int wr, int wc, int fr, int fq) const {
    const int rowt = u.pm * 256;
    const int row0 = rowt + wr * 64 + fr, col0 = u.pn * 256 + wc * 32 + 4 * fq;
    const bool lat = rowt < ML;
    const int mrow = lat ? (rowt >> 13) : 8;
    const float* gate = gbase + (size_t)mrow * 6144;
    const float* src = lat ? xs : cs - (size_t)ML * 1024;
    float* dst = lat ? xo : co - (size_t)ML * 1024;
    pg8::f32x4 gv[2][2];
#pragma unroll
    for (int bj = 0; bj < 2; ++bj)
#pragma unroll
      for (int n = 0; n < 2; ++n) gv[bj][n] = *(const pg8::f32x4*)(gate + col0 + bj * 128 + n * 16);
#pragma unroll
    for (int ai = 0; ai < 2; ++ai)
#pragma unroll
      for (int m = 0; m < 4; ++m) {
        const size_t off = (size_t)(row0 + ai * 128 + m * 16) * 1024 + col0;
#pragma unroll
        for (int bj = 0; bj < 2; ++bj)
#pragma unroll
          for (int n = 0; n < 2; ++n) {
            const pg8::f32x4 xv = *(const pg8::f32x4*)(src + off + bj * 128 + n * 16);
            *(pg8::f32x4*)(dst + off + bj * 128 + n * 16) = xv + gv[bj][n] * acc[ai][bj][m][n];
          }
      }
  }
};
template <class Epi>
DI void run_gemm256(const u16* A, const u16* Bt, int M, int N, int K, const Epi& E, char* lds, int lda = 0) {
  pg8::Gemm g; g.A = A; g.Bt = Bt; g.M = M; g.N = N; g.K = K; g.lda = lda ? lda : K;
  pg8::StaticOrder S; S.init(M, N, (int)gridDim.x, lbid());
  pg8::gemm_phase<Epi, pg8::StaticOrder, false>((PG8_LAS unsigned char*)lds, g, S, E, nullptr);
  __syncthreads();
}

DI void conv_job(const float* __restrict__ src, int ld, int K, int col0, int nvalid, int npad, u16* __restrict__ dst,
                 int& off, float* ts) {
  const int tid = ltid();
  const int tk = K >> 6, tn = npad >> 6, ntiles = tk * tn;
  const int G = gridDim.x;
  int first = ((int)lbid() - (off % G) + G) % G;
  for (int tile = first; tile < ntiles; tile += G) {
    const int k0 = (tile % tk) * 64, n0 = (tile / tk) * 64;
    {
      const int cc = tid & 63, rg = tid >> 6;
      const bool ok = (n0 + cc) < nvalid;
#pragma unroll
      for (int i = 0; i < 8; ++i) {
        const int rr = rg * 8 + i;
        ts[rr * 65 + cc] = ok ? src[(size_t)(k0 + rr) * ld + col0 + n0 + cc] : 0.f;
      }
    }
    __syncthreads();
    {
      const int kk = tid & 63, ng = tid >> 6;
#pragma unroll
      for (int i = 0; i < 8; ++i) {
        const int nn = ng * 8 + i;
        dst[(size_t)(n0 + nn) * K + k0 + kk] = f2bf(ts[kk * 65 + nn]);
      }
    }
    __syncthreads();
  }
  off += ntiles;
}

DI void phase0(const Params& p, char* ldsc) {
  float* ldsf = (float*)ldsc;
  const int tid = ltid();
  const int G = gridDim.x;
  int off = 0;
  for (int l = 0; l < 4; ++l) {
    u16* wl = (u16*)(p.ws + OFF_W) + (size_t)l * W_LAYER;
    conv_job(p.w_in + (size_t)l * 1024 * NIN, NIN, 1024, 0, 2976, 3072, wl + WO_T1, off, ldsf);
    conv_job(p.w_in + (size_t)l * 1024 * NIN, NIN, 1024, 2976, 3072, 3072, wl + WO_TG, off, ldsf);
    conv_job(p.w_q_b + (size_t)l * 384 * 768, 768, 384, 0, 768, 768, wl + WO_QB, off, ldsf);
    conv_job(p.w_kv_b + (size_t)l * 256 * 1024, 1024, 256, 0, 1024, 1024, wl + WO_KVB, off, ldsf);
    for (int nb = 0; nb < 3; ++nb)
      conv_job(p.w_branch + (size_t)(l * 3 + nb) * 512 * 1024, 1024, 512, 0, 1024, 1024, wl + WO_BR + (size_t)nb * 1024 * 512, off, ldsf);
    conv_job(p.w_out + (size_t)l * 1024 * 1024, 1024, 1024, 0, 1024, 1024, wl + WO_OUT, off, ldsf);
    conv_job(p.w_mlp1 + (size_t)l * 1024 * 4096, 4096, 1024, 0, 4096, 4096, wl + WO_W1, off, ldsf);
    conv_job(p.w_mlp2 + (size_t)l * 4096 * 1024, 1024, 4096, 0, 1024, 1024, wl + WO_W2, off, ldsf);
  }
  {
    float* sc = ldsf;
    float* red = ldsf + 9 * 1024;
    for (int i = tid; i < 9 * 1024; i += 512) {
      float v = (i < 8 * 1024) ? p.c[i] : p.c_ctx[i - 8 * 1024];
      sc[i] = v / (1.0f + expf(-v));
    }
    __syncthreads();
    float* mods = (float*)(p.ws + OFF_MODS);
    const int ol = tid & 63, kg = tid >> 6;
    for (int item = lbid(); item < 384; item += G) {
      const int l = item / 96, o = (item % 96) * 64 + ol;
      const float* wp = p.w_mod + (size_t)l * 1024 * 6144 + o;
      float acc[9];
#pragma unroll
      for (int b = 0; b < 9; ++b) acc[b] = 0.f;
#pragma unroll 4
      for (int k = kg * 128; k < kg * 128 + 128; ++k) {
        const float wv = wp[(size_t)k * 6144];
#pragma unroll
        for (int b = 0; b < 9; ++b) acc[b] += sc[b * 1024 + k] * wv;
      }
#pragma unroll
      for (int b = 0; b < 9; ++b) red[(kg * 9 + b) * 64 + ol] = acc[b];
      __syncthreads();
      for (int i = tid; i < 576; i += 512) {
        const int b = i >> 6, o2 = i & 63;
        float s = 0.f;
#pragma unroll
        for (int g = 0; g < 8; ++g) s += red[(g * 9 + b) * 64 + o2];
        const int oc = (item % 96) * 64 + o2;
        mods[(size_t)(l * 9 + b) * 6144 + oc] = s + p.b_mod[l * 6144 + oc];
      }
      __syncthreads();
    }
  }
  {
    const int gt = lbid() * 512 + tid, GT = G * 512;
    float* rg = (float*)(p.ws + OFF_ROPEG);
    float* rm = (float*)(p.ws + OFF_ROPEM);
    float* tw = (float*)(p.ws + OFF_TW);
    for (int i = gt; i < LSEQ * 32; i += GT) {
      const int t = i >> 5, a = i & 31;
      const float pos = (a < 16) ? (float)(t >> 6) : (float)(t & 63);
      const float inv = powf(10000.0f, -(float)(a & 15) / 16.0f);
      const float ang = pos * inv;
      rg[2 * i] = cosf(ang);
      rg[2 * i + 1] = sinf(ang);
    }
    for (int i = gt; i < LSEQ * 16; i += GT) {
      const int t = i >> 4, a = i & 15;
      const float pos = (a < 8) ? (float)(t >> 6) : (float)(t & 63);
      const float inv = powf(10000.0f, -(float)(a & 7) / 8.0f);
      const float ang = pos * inv;
      rm[2 * i] = cosf(ang);
      rm[2 * i + 1] = sinf(ang);
    }
    for (int i = gt; i < FFTN; i += GT) {
      float sn, cs;
      sincospif(2.0f * (float)i / (float)FFTN, &sn, &cs);
      tw[2 * i] = cs;
      tw[2 * i + 1] = -sn;
    }
  }
}

DI void phase_rownorm(const Params& p, int l, int which, int nrows) {
  const int tid = ltid(), lane = tid & 63, w = tid >> 6;
  u16* hn = (u16*)(p.ws + OFF_A);
  const float* g = (which ? p.norm_mlp_g : p.norm_mix_g) + l * 1024;
  const bool first = (which == 0 && l == 0);
  const float* xs = first ? p.x : p.out;
  const float* cs = first ? p.ctx : (const float*)(p.ws + OFF_CTX);
  const int stride = gridDim.x * 8;
  for (int r = lbid() * 8 + w; r < nrows; r += 2 * stride) {
    int rr[2]; rr[0] = r; rr[1] = r + stride;
    const bool has2 = rr[1] < nrows;
    if (!has2) rr[1] = r;
    rr[0] = __builtin_amdgcn_readfirstlane(rr[0]);
    rr[1] = __builtin_amdgcn_readfirstlane(rr[1]);
    float4 v[2][4];
    float ss[2] = {0.f, 0.f};
#pragma unroll
    for (int q = 0; q < 2; ++q) {
      const float* src = (rr[q] < ML) ? xs + (size_t)rr[q] * 1024 : cs + (size_t)(rr[q] - ML) * 1024;
#pragma unroll
      for (int i = 0; i < 4; ++i) v[q][i] = *(const float4*)(src + 4 * (lane + 64 * i));
    }
#pragma unroll
    for (int q = 0; q < 2; ++q) {
#pragma unroll
      for (int i = 0; i < 4; ++i) ss[q] += v[q][i].x * v[q][i].x + v[q][i].y * v[q][i].y + v[q][i].z * v[q][i].z + v[q][i].w * v[q][i].w;
      ss[q] = wave_sum(ss[q]);
    }
#pragma unroll
    for (int q = 0; q < 2; ++q) {
      if (q == 1 && !has2) break;
      const int mrow = (rr[q] < ML) ? (rr[q] >> 13) : 8;
      const float* shift = mods_ptr(p, l, mrow, which ? 3 : 0);
      const float* scale = mods_ptr(p, l, mrow, which ? 4 : 1);
      const float rstd = rsqrtf(ss[q] * (1.0f / 1024.0f) + EPSV);
#pragma unroll
      for (int i = 0; i < 4; ++i) {
        const int c0 = 4 * (lane + 64 * i);
        const float4 gg = *(const float4*)(g + c0), sh = *(const float4*)(shift + c0), sc = *(const float4*)(scale + c0);
        const float o0 = v[q][i].x * rstd * gg.x * (1.f + sc.x) + sh.x;
        const float o1 = v[q][i].y * rstd * gg.y * (1.f + sc.y) + sh.y;
        const float o2 = v[q][i].z * rstd * gg.z * (1.f + sc.z) + sh.z;
        const float o3 = v[q][i].w * rstd * gg.w * (1.f + sc.w) + sh.w;
        uint2 pk;
        pk.x = pk2(o0, o1);
        pk.y = pk2(o2, o3);
        *(uint2*)(hn + (size_t)rr[q] * 1024 + c0) = pk;
      }
    }
  }
}

DI void filter_tiles(const Params& p, int l, int Lf, int cstride, float* __restrict__ kdst, float* __restrict__ part, float* lds) {
  const int tid = ltid(), lane = tid & 63, w = tid >> 6;
  float* zs = lds;
  float* h1s = lds + 64 * 33;
  float* h2s = h1s + 64 * 65;
  float* w3s = h2s + 64 * 65;
  const float* f1w = p.hy_f1_w + l * 33 * 64;
  const float* f1b = p.hy_f1_b + l * 64;
  const float* f2w = p.hy_f2_w + l * 64 * 64;
  const float* f2b = p.hy_f2_b + l * 64;
  const float* sf = p.hy_sin_freq + l * 128;
  const float* f3w = p.hy_f3_w + (size_t)l * 64 * 1024;
  const int nitem = (Lf >> 6) * 4;
  const float min_decay = logf(1e-2f) / 1.5f, max_decay = logf(1e-2f) / 0.3f;
  for (int item = lbid(); item < nitem; item += gridDim.x) {
    const int tile = item >> 2, quarter = item & 3;
    const int t0 = tile * 64;
    for (int idx = tid; idx < 64 * 33; idx += 512) {
      const int tt = idx / 33, e = idx - tt * 33;
      const int t = t0 + tt;
      float val;
      if (e == 0) {
        val = (float)t / (float)(Lf - 1);
      } else {
        const float wt = 6.283185307179586f * (float)t / (float)Lf;
        const int bi = (e - 1) & 15;
        const float f = 1e-4f + (float)bi * ((15.0f - 1e-4f) / 15.0f);
        val = (e <= 16) ? cosf(f * wt) : -sinf(f * wt);
      }
      zs[idx] = val;
    }
    for (int idx = tid; idx < 64 * 64; idx += 512) {
      const int i = idx >> 6, c4 = (idx & 63) * 4;
      *(float4*)(w3s + i * 256 + c4) = *(const float4*)(f3w + i * 1024 + quarter * 256 + c4);
    }
    __syncthreads();
    {
      const int tt = tid & 63, jg = tid >> 6;
#pragma unroll 1
      for (int jj = 0; jj < 8; ++jj) {
        const int j = jg * 8 + jj;
        float a = f1b[j];
#pragma unroll 3
        for (int e = 0; e < 33; ++e) a += zs[tt * 33 + e] * f1w[e * 64 + j];
        h1s[tt * 65 + j] = sinf(sf[j] * a);
      }
    }
    __syncthreads();
    {
      const int tt = tid & 63, jg = tid >> 6;
#pragma unroll 1
      for (int jj = 0; jj < 8; ++jj) {
        const int j = jg * 8 + jj;
        float a = f2b[j];
#pragma unroll 4
        for (int e = 0; e < 64; ++e) a += h1s[tt * 65 + e] * f2w[e * 64 + j];
        h2s[tt * 65 + j] = sinf(sf[64 + j] * a);
      }
    }
    __syncthreads();
    {
      const int tt = lane, t = t0 + tt;
      const float tn = (float)t / (float)(Lf - 1);
#pragma unroll 1
      for (int ob = w * 32; ob < w * 32 + 32; ob += 16) {
        float acc[16];
#pragma unroll
        for (int q = 0; q < 16; ++q) acc[q] = 0.f;
#pragma unroll 4
        for (int i = 0; i < 64; ++i) {
          const float hv = h2s[tt * 65 + i];
          const float* wr = w3s + i * 256 + ob;
#pragma unroll
          for (int q4 = 0; q4 < 4; ++q4) {
            const float4 wv = *(const float4*)(wr + 4 * q4);
            acc[4 * q4] += hv * wv.x; acc[4 * q4 + 1] += hv * wv.y; acc[4 * q4 + 2] += hv * wv.z; acc[4 * q4 + 3] += hv * wv.w;
          }
        }
#pragma unroll
        for (int q = 0; q < 16; ++q) {
          const int o = quarter * 256 + ob + q, dir = o >> 9, c = o & 511;
          const float delta = fabsf(min_decay + (float)c * ((max_decay - min_decay) / 511.0f));
          float val = acc[q] * expf(-tn * delta);
          int pos;
          if (dir == 0) pos = t;
          else if (t == 0) { pos = Lf; val = 0.f; }
          else pos = 2 * Lf - t;
          kdst[(size_t)c * cstride + pos] = val;
          const float s2 = wave_sum(val * val);
          if (lane == 0) part[tile * 1024 + o] = s2;
        }
      }
    }
    __syncthreads();
  }
}

DI int fsw(int i) { return (i & ~15) | ((((i >> 2) + (i >> 6)) & 3) << 2) | (i & 3); }

DI void r16_fwd(float (&xr)[16], float (&xi)[16]) {
#pragma unroll
  for (int st = 0; st < 2; ++st) {
    const int q = (st == 0) ? 4 : 1;
#pragma unroll
    for (int bi = 0; bi < 4; ++bi) {
      const int j = bi & (q - 1), g = bi / q;
      const int i0 = g * 4 * q + j, i1 = i0 + q, i2 = i1 + q, i3 = i2 + q;
      const float ar = xr[i0], ai = xi[i0], br = xr[i1], bi_ = xi[i1], cr = xr[i2], ci = xi[i2], dr = xr[i3], di = xi[i3];
      const float t0r = ar + cr, t0i = ai + ci, t1r = ar - cr, t1i = ai - ci;
      const float t2r = br + dr, t2i = bi_ + di;
      const float er = br - dr, ei = bi_ - di;
      const float t3r = ei, t3i = -er;
      const float y1r = t1r + t3r, y1i = t1i + t3i, y2r = t0r - t2r, y2i = t0i - t2i, y3r = t1r - t3r, y3i = t1i - t3i;
      xr[i0] = t0r + t2r; xi[i0] = t0i + t2i;
      if (q == 1 || j == 0) {
        xr[i1] = y1r; xi[i1] = y1i; xr[i2] = y2r; xi[i2] = y2i; xr[i3] = y3r; xi[i3] = y3i;
      } else {
        const float ang = -6.283185307179586f * (float)j / (float)(4 * q);
        const float w1r = __builtin_cosf(ang), w1i = __builtin_sinf(ang);
        const float w2r = __builtin_cosf(2.f * ang), w2i = __builtin_sinf(2.f * ang);
        const float w3r = __builtin_cosf(3.f * ang), w3i = __builtin_sinf(3.f * ang);
        xr[i1] = y1r * w1r - y1i * w1i; xi[i1] = y1r * w1i + y1i * w1r;
        xr[i2] = y2r * w2r - y2i * w2i; xi[i2] = y2r * w2i + y2i * w2r;
        xr[i3] = y3r * w3r - y3i * w3i; xi[i3] = y3r * w3i + y3i * w3r;
      }
    }
  }
}
DI void r16_inv(float (&xr)[16], float (&xi)[16]) {
#pragma unroll
  for (int st = 0; st < 2; ++st) {
    const int q = (st == 0) ? 1 : 4;
#pragma unroll
    for (int bi = 0; bi < 4; ++bi) {
      const int j = bi & (q - 1), g = bi / q;
      const int i0 = g * 4 * q + j, i1 = i0 + q, i2 = i1 + q, i3 = i2 + q;
      const float ar = xr[i0], ai = xi[i0];
      float br = xr[i1], bi_ = xi[i1], cr = xr[i2], ci = xi[i2], dr = xr[i3], di = xi[i3];
      if (!(q == 1 || j == 0)) {
        const float ang = 6.283185307179586f * (float)j / (float)(4 * q);
        const float w1r = __builtin_cosf(ang), w1i = __builtin_sinf(ang);
        const float w2r = __builtin_cosf(2.f * ang), w2i = __builtin_sinf(2.f * ang);
        const float w3r = __builtin_cosf(3.f * ang), w3i = __builtin_sinf(3.f * ang);
        const float b0 = br, c0 = cr, d0 = dr;
        br = b0 * w1r - bi_ * w1i; bi_ = b0 * w1i + bi_ * w1r;
        cr = c0 * w2r - ci * w2i;  ci = c0 * w2i + ci * w2r;
        dr = d0 * w3r - di * w3i;  di = d0 * w3i + di * w3r;
      }
      const float t0r = ar + cr, t0i = ai + ci, t1r = ar - cr, t1i = ai - ci;
      const float t2r = br + dr, t2i = bi_ + di;
      const float er = br - dr, ei = bi_ - di;
      const float t3r = -ei, t3i = er;
      xr[i0] = t0r + t2r; xi[i0] = t0i + t2i;
      xr[i1] = t1r + t3r; xi[i1] = t1i + t3i;
      xr[i2] = t0r - t2r; xi[i2] = t0i - t2i;
      xr[i3] = t1r - t3r; xi[i3] = t1i - t3i;
    }
  }
}

template <bool INV>
DI void fft_lds_stage(float* re, float* im, const float2* __restrict__ tw, const int s) {
  const int tid = ltid();
  const int qs = 12 - 2 * s;
  const int q = 1 << qs;
  float2 wb = tw[(tid & (q - 1)) << (2 * s)];
  if (INV) wb.y = -wb.y;
  float vr[8][4], vi[8][4];
  int idx[8][4];
#pragma unroll
  for (int k = 0; k < 8; ++k) {
    const int bi = tid + 512 * k;
    const int j = bi & (q - 1), g = bi >> qs;
    const int l0 = (g << (qs + 2)) + j;
#pragma unroll
    for (int m = 0; m < 4; ++m) { idx[k][m] = fsw(l0 + m * q); vr[k][m] = re[idx[k][m]]; vi[k][m] = im[idx[k][m]]; }
  }
#pragma unroll
  for (int k = 0; k < 8; ++k) {
    const int delta = (512 * k) & (q - 1);
    const float ang = (INV ? 6.283185307179586f : -6.283185307179586f) * (float)(delta << (2 * s)) / 16384.0f;
    const float cr_ = __builtin_cosf(ang), ci_ = __builtin_sinf(ang);
    const float w1r = (delta == 0) ? wb.x : wb.x * cr_ - wb.y * ci_;
    const float w1i = (delta == 0) ? wb.y : wb.x * ci_ + wb.y * cr_;
    const float w2r = w1r * w1r - w1i * w1i, w2i = 2.f * w1r * w1i;
    const float w3r = w2r * w1r - w2i * w1i, w3i = w2r * w1i + w2i * w1r;
    if (!INV) {
      const float ar = vr[k][0], ai = vi[k][0], br = vr[k][1], bi_ = vi[k][1], cr = vr[k][2], ci = vi[k][2], dr = vr[k][3], di = vi[k][3];
      const float t0r = ar + cr, t0i = ai + ci, t1r = ar - cr, t1i = ai - ci;
      const float t2r = br + dr, t2i = bi_ + di;
      const float er = br - dr, ei = bi_ - di;
      const float t3r = ei, t3i = -er;
      const float y1r = t1r + t3r, y1i = t1i + t3i, y2r = t0r - t2r, y2i = t0i - t2i, y3r = t1r - t3r, y3i = t1i - t3i;
      re[idx[k][0]] = t0r + t2r; im[idx[k][0]] = t0i + t2i;
      re[idx[k][1]] = y1r * w1r - y1i * w1i; im[idx[k][1]] = y1r * w1i + y1i * w1r;
      re[idx[k][2]] = y2r * w2r - y2i * w2i; im[idx[k][2]] = y2r * w2i + y2i * w2r;
      re[idx[k][3]] = y3r * w3r - y3i * w3i; im[idx[k][3]] = y3r * w3i + y3i * w3r;
    } else {
      const float ar = vr[k][0], ai = vi[k][0];
      const float br = vr[k][1] * w1r - vi[k][1] * w1i, bi_ = vr[k][1] * w1i + vi[k][1] * w1r;
      const float cr = vr[k][2] * w2r - vi[k][2] * w2i, ci = vr[k][2] * w2i + vi[k][2] * w2r;
      const float dr = vr[k][3] * w3r - vi[k][3] * w3i, di = vr[k][3] * w3i + vi[k][3] * w3r;
      const float t0r = ar + cr, t0i = ai + ci, t1r = ar - cr, t1i = ai - ci;
      const float t2r = br + dr, t2i = bi_ + di;
      const float er = br - dr, ei = bi_ - di;
      const float t3r = -ei, t3i = er;
      re[idx[k][0]] = t0r + t2r; im[idx[k][0]] = t0i + t2i;
      re[idx[k][1]] = t1r + t3r; im[idx[k][1]] = t1i + t3i;
      re[idx[k][2]] = t0r - t2r; im[idx[k][2]] = t0i - t2i;
      re[idx[k][3]] = t1r - t3r; im[idx[k][3]] = t1i - t3i;
    }
  }
  __syncthreads();
}
DI void fft_fwd4(float* re, float* im, const float2* __restrict__ tw) {
  fft_lds_stage<false>(re, im, tw, 0);
  fft_lds_stage<false>(re, im, tw, 1);
  fft_lds_stage<false>(re, im, tw, 2);
  fft_lds_stage<false>(re, im, tw, 3);
  fft_lds_stage<false>(re, im, tw, 4);
}
DI void fft_inv4(float* re, float* im, const float2* __restrict__ tw) {
  fft_lds_stage<true>(re, im, tw, 4);
  fft_lds_stage<true>(re, im, tw, 3);
  fft_lds_stage<true>(re, im, tw, 2);
  fft_lds_stage<true>(re, im, tw, 1);
  fft_lds_stage<true>(re, im, tw, 0);
}
DI void r16_load(const float* re, const float* im, int b, float (&xr)[16], float (&xi)[16]) {
#pragma unroll
  for (int c = 0; c < 4; ++c) {
    const int ph = 16 * b + 4 * ((c + (b >> 2)) & 3);
    const float4 vr = *(const float4*)(re + ph), vi = *(const float4*)(im + ph);
    xr[4 * c] = vr.x; xr[4 * c + 1] = vr.y; xr[4 * c + 2] = vr.z; xr[4 * c + 3] = vr.w;
    xi[4 * c] = vi.x; xi[4 * c + 1] = vi.y; xi[4 * c + 2] = vi.z; xi[4 * c + 3] = vi.w;
  }
}
DI void r16_store(float* re, float* im, int b, const float (&xr)[16], const float (&xi)[16]) {
#pragma unroll
  for (int c = 0; c < 4; ++c) {
    const int ph = 16 * b + 4 * ((c + (b >> 2)) & 3);
    *(float4*)(re + ph) = make_float4(xr[4 * c], xr[4 * c + 1], xr[4 * c + 2], xr[4 * c + 3]);
    *(float4*)(im + ph) = make_float4(xi[4 * c], xi[4 * c + 1], xi[4 * c + 2], xi[4 * c + 3]);
  }
}

DI void phase_filter_fft(const Params& p, int l, float* lds) {
  const int tid = ltid();
  float* re = lds;
  float* im = lds + FFTN;
  float* kf = (float*)(p.ws + OFF_KF);
  const float2* tw = (const float2*)(p.ws + OFF_TW);
  const float* part = (const float*)(p.ws + OFF_PART);
  for (int c = lbid(); c < 512; c += gridDim.x) {
    float* slot = kf + (size_t)c * (2 * FFTN);
    float pv = 0.f;
    if (tid < 128) pv = part[tid * 1024 + c] + part[tid * 1024 + 512 + c];
    pv = wave_sum(pv);
    if ((tid & 63) == 0) lds[tid >> 6] = pv;
    __syncthreads();
    const float ssq = lds[0] + lds[1];
    __syncthreads();
    const float sc = rsqrtf(ssq + EPSV) * (1.0f / (float)FFTN);
    for (int i = tid; i < FFTN; i += 512) { const int ph = fsw(i); re[ph] = slot[i] * sc; im[ph] = 0.f; }
    __syncthreads();
    fft_fwd4(re, im, tw);
    {
      float2* so = (float2*)slot;
#pragma unroll 1
      for (int b = tid; b < 1024; b += 512) {
        float xr[16], xi[16];
        r16_load(re, im, b, xr, xi);
        r16_fwd(xr, xi);
#pragma unroll
        for (int e = 0; e < 16; ++e) { float2 v; v.x = xr[e]; v.y = xi[e]; so[e * 1024 + b] = v; }
      }
    }
    __syncthreads();
  }
}

DI void phase_gemm1(const Params& p, int l, u16* lds) {
  const u16* hn = (const u16*)(p.ws + OFF_A);
  const u16* wt = (const u16*)(p.ws + OFF_W) + (size_t)l * W_LAYER + WO_T1;
  const int NT = 24, nitems = (MALL / 256) * NT;
  for (int it_ = lbid(); it_ < ((nitems + 255) & ~255); it_ += gridDim.x) {
    const int item = xcd_remap(it_);
    if (item >= nitems) continue;
    const int mt = item / NT, nt = item % NT;
    const int m0 = mt * 256, n0 = nt * 128;
    f32x16 acc[2][2];
    ACC_ZERO(acc);
    gemm_mainloop(hn + (size_t)m0 * 1024, 1024, wt + (size_t)n0 * 1024, 1024, 1024, acc, lds);
    u16* dst; int ld, cofs;
    if (nt < 4) { dst = (u16*)(p.ws + OFF_B); ld = 512; cofs = 0; }
    else if (nt < 12) { dst = (u16*)(p.ws + OFF_C); ld = 1024; cofs = 512; }
    else { dst = (u16*)(p.ws + OFF_R); ld = 1536; cofs = 1536; }
    stage_store_bf16(acc, dst, ld, m0, n0 - cofs, lds);
  }
}

DI void phase_h1(const Params& p, int l, float* lds) {
  const int tid = ltid();
  const u16* U12 = (const u16*)(p.ws + OFF_C);
  float* zT = (float*)(p.ws + OFF_A);
  const float* sw = p.hy_short_w + l * 3 * 1536;
  const int nlat = 8 * 128 * 8, nctx = (l < 3) ? 8 * 4 * 8 : 0;
  int par = 0;
  float wx[8][3], wv[8][3];
  {
    const int cb = (lbid() & 7) * 64 + (tid >> 6) * 8;
#pragma unroll
    for (int i = 0; i < 8; ++i)
#pragma unroll
      for (int j = 0; j < 3; ++j) { wx[i][j] = sw[j * 1536 + 512 + cb + i]; wv[i][j] = sw[j * 1536 + 1024 + cb + i]; }
  }
  for (int item = lbid(); item < nlat + nctx; item += gridDim.x) {
    float* xs = lds + par * (2 * 66 * 65);
    float* vs = xs + 66 * 65;
    par ^= 1;
    int b, tt0, c0, Ls, rowbase; size_t zbase;
    if (item < nlat) { b = item >> 10; tt0 = ((item >> 3) & 127) * 64; c0 = (item & 7) * 64; Ls = LSEQ; rowbase = b * LSEQ; zbase = (size_t)b * 512 * LSEQ; }
    else { const int it = item - nlat; b = it >> 5; tt0 = ((it >> 3) & 3) * 64; c0 = (it & 7) * 64; Ls = LCTX; rowbase = ML + b * LCTX; zbase = (size_t)ZC_OFF + (size_t)b * 512 * LCTX; }
    for (int ch = tid; ch < 66 * 16; ch += 512) {
      const int arr = ch / 528, rem = ch - arr * 528;
      const int rr = rem >> 3, cc8 = (rem & 7) * 8;
      const int t = tt0 - 1 + rr;
      float* dstp = (arr ? vs : xs) + rr * 65 + cc8;
      if (t >= 0 && t < Ls) {
        const uint4 v = *(const uint4*)(U12 + (size_t)(rowbase + t) * 1024 + arr * 512 + c0 + cc8);
        const unsigned uu[4] = {v.x, v.y, v.z, v.w};
#pragma unroll
        for (int i = 0; i < 4; ++i) { dstp[2 * i] = __uint_as_float(uu[i] << 16); dstp[2 * i + 1] = __uint_as_float(uu[i] & 0xffff0000u); }
      } else {
#pragma unroll
        for (int i = 0; i < 8; ++i) dstp[i] = 0.f;
      }
    }
    __syncthreads();
    {
      const int tt = tid & 63, cgp = tid >> 6;
#pragma unroll
      for (int i = 0; i < 8; ++i) {
        const int cc = cgp * 8 + i, c = c0 + cc;
        float x1 = 0.f, vv = 0.f;
#pragma unroll
        for (int j = 0; j < 3; ++j) {
          x1 += wx[i][j] * xs[(tt + j) * 65 + cc];
          vv += wv[i][j] * vs[(tt + j) * 65 + cc];
        }
        zT[zbase + (size_t)c * Ls + tt0 + tt] = x1 * vv;
      }
    }
  }
  __syncthreads();
}

DI void phase_p3(const Params& p, int l, float* lds) {
  const int tid = ltid(), lane = tid & 63, w = tid >> 6;
  u16* R = (u16*)(p.ws + OFF_R);
  const float* ropeg = (const float*)(p.ws + OFF_ROPEG);
  const float qscale = 0.125f * LOG2E;
  const int hq = lane >> 3, j = lane & 7;
  float gq[8], gk[8], ga[6], gv[4];
#pragma unroll
  for (int i = 0; i < 8; ++i) { gq[i] = p.gqa_q_norm[l * 64 + 8 * j + i]; gk[i] = p.gqa_k_norm[l * 64 + 8 * j + i]; }
#pragma unroll
  for (int i = 0; i < 6; ++i) ga[i] = p.mla_q_a_norm[l * 384 + 6 * lane + i];
#pragma unroll
  for (int i = 0; i < 4; ++i) gv[i] = p.mla_kv_a_norm[l * 256 + 4 * lane + i];
  const float sgn = (j < 4) ? -1.f : 1.f;
  for (int r = lbid() * 8 + w; r < MALL; r += gridDim.x * 8) {
    u16* rowp = R + (size_t)r * 1536;
    const bool lat = r < ML;
    const int t = r & (LSEQ - 1);
    const uint4 qv = *(const uint4*)(rowp + hq * 64 + 8 * j);
    const uint4 kv = *(const uint4*)(rowp + 512 + (hq & 1) * 64 + 8 * j);
    const unsigned c0 = *(const unsigned*)(rowp + 768 + 6 * lane), c1 = *(const unsigned*)(rowp + 768 + 6 * lane + 2),
                   c2 = *(const unsigned*)(rowp + 768 + 6 * lane + 4);
    const uint2 dv = *(const uint2*)(rowp + 1152 + 4 * lane);
    float cs[8], sn[8];
    {
      const float4* rp = (const float4*)(ropeg + ((size_t)t * 32 + 8 * (j & 3)) * 2);
#pragma unroll
      for (int i = 0; i < 4; ++i) {
        const float4 v = rp[i];
        cs[2 * i] = lat ? v.x : 1.f; sn[2 * i] = lat ? v.y * sgn : 0.f;
        cs[2 * i + 1] = lat ? v.z : 1.f; sn[2 * i + 1] = lat ? v.w * sgn : 0.f;
      }
    }
    float q[8], k[8];
    {
      const unsigned qu[4] = {qv.x, qv.y, qv.z, qv.w}, ku[4] = {kv.x, kv.y, kv.z, kv.w};
#pragma unroll
      for (int i = 0; i < 4; ++i) {
        q[2 * i] = __uint_as_float(qu[i] << 16); q[2 * i + 1] = __uint_as_float(qu[i] & 0xffff0000u);
        k[2 * i] = __uint_as_float(ku[i] << 16); k[2 * i + 1] = __uint_as_float(ku[i] & 0xffff0000u);
      }
    }
    float sq = 0.f, sk = 0.f;
#pragma unroll
    for (int i = 0; i < 8; ++i) { sq += q[i] * q[i]; sk += k[i] * k[i]; }
    sq += __shfl_xor(sq, 1); sq += __shfl_xor(sq, 2); sq += __shfl_xor(sq, 4);
    sk += __shfl_xor(sk, 1); sk += __shfl_xor(sk, 2); sk += __shfl_xor(sk, 4);
    const float rq = rsqrtf(sq * (1.0f / 64.0f) + EPSV) * qscale, rk = rsqrtf(sk * (1.0f / 64.0f) + EPSV);
#pragma unroll
    for (int i = 0; i < 8; ++i) { q[i] *= rq * gq[i]; k[i] *= rk * gk[i]; }
    float qp[8], kp[8];
#pragma unroll
    for (int i = 0; i < 8; ++i) { qp[i] = __shfl_xor(q[i], 4); kp[i] = __shfl_xor(k[i], 4); }
#pragma unroll
    for (int i = 0; i < 8; ++i) { q[i] = q[i] * cs[i] + qp[i] * sn[i]; k[i] = k[i] * cs[i] + kp[i] * sn[i]; }
    float a[6], d[4];
    a[0] = __uint_as_float(c0 << 16); a[1] = __uint_as_float(c0 & 0xffff0000u);
    a[2] = __uint_as_float(c1 << 16); a[3] = __uint_as_float(c1 & 0xffff0000u);
    a[4] = __uint_as_float(c2 << 16); a[5] = __uint_as_float(c2 & 0xffff0000u);
    d[0] = __uint_as_float(dv.x << 16); d[1] = __uint_as_float(dv.x & 0xffff0000u);
    d[2] = __uint_as_float(dv.y << 16); d[3] = __uint_as_float(dv.y & 0xffff0000u);
    float s3 = 0.f, s4 = 0.f;
#pragma unroll
    for (int i = 0; i < 6; ++i) s3 += a[i] * a[i];
#pragma unroll
    for (int i = 0; i < 4; ++i) s4 += d[i] * d[i];
    s3 = wave_sum(s3); s4 = wave_sum(s4);
    const float r3 = rsqrtf(s3 * (1.0f / 384.0f) + EPSV), r4 = rsqrtf(s4 * (1.0f / 256.0f) + EPSV);
    {
      uint4 o;
      o.x = pk2(q[0], q[1]); o.y = pk2(q[2], q[3]); o.z = pk2(q[4], q[5]); o.w = pk2(q[6], q[7]);
      *(uint4*)(rowp + hq * 64 + 8 * j) = o;
      if (lane < 16) {
        o.x = pk2(k[0], k[1]); o.y = pk2(k[2], k[3]); o.z = pk2(k[4], k[5]); o.w = pk2(k[6], k[7]);
        *(uint4*)(rowp + 512 + hq * 64 + 8 * j) = o;
      }
      *(unsigned*)(rowp + 768 + 6 * lane) = pk2(a[0] * r3 * ga[0], a[1] * r3 * ga[1]);
      *(unsigned*)(rowp + 768 + 6 * lane + 2) = pk2(a[2] * r3 * ga[2], a[3] * r3 * ga[3]);
      *(unsigned*)(rowp + 768 + 6 * lane + 4) = pk2(a[4] * r3 * ga[4], a[5] * r3 * ga[5]);
      uint2 od;
      od.x = pk2(d[0] * r4 * gv[0], d[1] * r4 * gv[1]); od.y = pk2(d[2] * r4 * gv[2], d[3] * r4 * gv[3]);
      *(uint2*)(rowp + 1152 + 4 * lane) = od;
    }
  }
}

DI void phase_h2(const Params& p, int l, float* lds) {
  const int tid = ltid(), lane = tid & 63, w = tid >> 6;
  float* zT = (float*)(p.ws + OFF_A);
  const float2* kf = (const float2*)(p.ws + OFF_KF);
  const float2* tw = (const float2*)(p.ws + OFF_TW);
  const float* skip = p.hy_skip + l * 512;
  float* re = lds;
  float* im = lds + FFTN;
  float za[16], zb[16], na[16], nb_[16];
  {
    const int it0 = lbid();
    if (it0 < 2048) {
      const int c0 = it0 >> 2, bp0 = it0 & 3;
      const float* s1 = zT + ((size_t)(2 * bp0) * 512 + c0) * LSEQ;
      const float* s2 = zT + ((size_t)(2 * bp0 + 1) * 512 + c0) * LSEQ;
#pragma unroll
      for (int k = 0; k < 16; ++k) { na[k] = s1[tid + 512 * k]; nb_[k] = s2[tid + 512 * k]; }
    }
  }
  for (int item = lbid(); item < 2048; item += gridDim.x) {
    const int c = item >> 2, bp = item & 3;
    float* z1 = zT + ((size_t)(2 * bp) * 512 + c) * LSEQ;
    float* z2 = zT + ((size_t)(2 * bp + 1) * 512 + c) * LSEQ;
#pragma unroll
    for (int k = 0; k < 16; ++k) {
      const int i = tid + 512 * k;
      za[k] = na[k]; zb[k] = nb_[k];
      const int p0 = fsw(i), p1 = fsw(i + LSEQ);
      re[p0] = za[k]; im[p0] = zb[k]; re[p1] = 0.f; im[p1] = 0.f;
    }
    __syncthreads();
    fft_fwd4(re, im, tw);
    {
      const float2* kc = kf + (size_t)c * FFTN;
#pragma unroll 1
      for (int b = tid; b < 1024; b += 512) {
        float xr[16], xi[16];
        r16_load(re, im, b, xr, xi);
        r16_fwd(xr, xi);
#pragma unroll
        for (int e = 0; e < 16; ++e) {
          const float2 k = kc[e * 1024 + b];
          const float a = xr[e], b2 = xi[e];
          xr[e] = a * k.x - b2 * k.y;
          xi[e] = a * k.y + b2 * k.x;
        }
        r16_inv(xr, xi);
        r16_store(re, im, b, xr, xi);
      }
    }
    {
      const int nit = item + gridDim.x;
      if (nit < 2048) {
        const int cn = nit >> 2, bpn = nit & 3;
        const float* s1 = zT + ((size_t)(2 * bpn) * 512 + cn) * LSEQ;
        const float* s2 = zT + ((size_t)(2 * bpn + 1) * 512 + cn) * LSEQ;
#pragma unroll
        for (int k = 0; k < 16; ++k) {
          na[k] = __builtin_bit_cast(float, *(const volatile unsigned*)(s1 + tid + 512 * k));
          nb_[k] = __builtin_bit_cast(float, *(const volatile unsigned*)(s2 + tid + 512 * k));
        }
      }
    }
    __syncthreads();
    fft_inv4(re, im, tw);
    const float sk = skip[c];
#pragma unroll
    for (int k = 0; k < 16; ++k) {
      const int i = tid + 512 * k;
      const int p0 = fsw(i);
      z1[i] = re[p0] + za[k] * sk;
      z2[i] = im[p0] + zb[k] * sk;
    }
    __syncthreads();
  }
  if (l < 3) {
    const float* kcb = (const float*)(p.ws + OFF_KC);
    const float* partc = (const float*)(p.ws + OFF_PART) + 128 * 1024;
    float* zs = lds + w * 768;
    float* ks = zs + 256;
    for (int item = lbid(); item < 512; item += gridDim.x) {
      const int b = item >> 6, c = (item & 63) * 8 + w;
      float* z = zT + (size_t)ZC_OFF + ((size_t)b * 512 + c) * LCTX;
      float pv = (lane < 4) ? partc[lane * 1024 + c] + partc[lane * 1024 + 512 + c] : 0.f;
      pv = wave_sum(pv);
      const float sc = rsqrtf(pv + EPSV);
      for (int i = lane; i < 256; i += 64) zs[i] = z[i];
      for (int i = lane; i < 512; i += 64) ks[i] = kcb[c * 512 + i] * sc;
      __syncthreads();
      const float sk = skip[c];
      float acc[4] = {0.f, 0.f, 0.f, 0.f};
      for (int s = 0; s < 256; ++s) {
        const float zv = zs[s];
#pragma unroll
        for (int i = 0; i < 4; ++i) acc[i] += ks[(lane + 64 * i - s) & 511] * zv;
      }
#pragma unroll
      for (int i = 0; i < 4; ++i) z[lane + 64 * i] = acc[i] + zs[lane + 64 * i] * sk;
      __syncthreads();
    }
  }
}

DI void phase_h3(const Params& p, int l, float* lds) {
  const int tid = ltid();
  const u16* U0 = (const u16*)(p.ws + OFF_B);
  const float* zT = (const float*)(p.ws + OFF_A);
  u16* Y = (u16*)(p.ws + OFF_Y);
  const float* sw = p.hy_short_w + l * 3 * 1536;
  const int nlat = 8 * 128 * 8, nctx = (l < 3) ? 8 * 4 * 8 : 0;
  int par = 0;
  for (int item = lbid(); item < nlat + nctx; item += gridDim.x) {
    float* xs = lds + par * (66 * 65 + 64 * 65);
    float* ys = xs + 66 * 65;
    par ^= 1;
    int b, tt0, c0, Ls, rowbase; size_t zbase;
    if (item < nlat) { b = item >> 10; tt0 = ((item >> 3) & 127) * 64; c0 = (item & 7) * 64; Ls = LSEQ; rowbase = b * LSEQ; zbase = (size_t)b * 512 * LSEQ; }
    else { const int it = item - nlat; b = it >> 5; tt0 = ((it >> 3) & 3) * 64; c0 = (it & 7) * 64; Ls = LCTX; rowbase = ML + b * LCTX; zbase = (size_t)ZC_OFF + (size_t)b * 512 * LCTX; }
    for (int ch = tid; ch < 66 * 8; ch += 512) {
      const int rr = ch >> 3, cc8 = (ch & 7) * 8;
      const int t = tt0 - 1 + rr;
      float* dstp = xs + rr * 65 + cc8;
      if (t >= 0 && t < Ls) {
        const uint4 v = *(const uint4*)(U0 + (size_t)(rowbase + t) * 512 + c0 + cc8);
        const unsigned uu[4] = {v.x, v.y, v.z, v.w};
#pragma unroll
        for (int i = 0; i < 4; ++i) { dstp[2 * i] = __uint_as_float(uu[i] << 16); dstp[2 * i + 1] = __uint_as_float(uu[i] & 0xffff0000u); }
      } else {
#pragma unroll
        for (int i = 0; i < 8; ++i) dstp[i] = 0.f;
      }
    }
    {
      const int tt = tid & 63, cgp = tid >> 6;
#pragma unroll
      for (int i = 0; i < 8; ++i) {
        const int cc = cgp * 8 + i;
        ys[cc * 65 + tt] = zT[zbase + (size_t)(c0 + cc) * Ls + tt0 + tt];
      }
    }
    __syncthreads();
    {
      const int cc = tid & 63, tg = tid >> 6, c = c0 + cc;
      const float w0 = sw[c], w1 = sw[1536 + c], w2 = sw[2 * 1536 + c];
#pragma unroll
      for (int i = 0; i < 8; ++i) {
        const int tt = tg * 8 + i;
        const float x0 = w0 * xs[tt * 65 + cc] + w1 * xs[(tt + 1) * 65 + cc] + w2 * xs[(tt + 2) * 65 + cc];
        Y[(size_t)(rowbase + tt0 + tt) * 1536 + c] = f2bf(x0 * ys[cc * 65 + tt]);
      }
    }
  }
  __syncthreads();
}

DI void phase_p4(const Params& p, int l, u16* lds) {
  const u16* R = (const u16*)(p.ws + OFF_R);
  u16* QK = (u16*)(p.ws + OFF_A);
  const u16* wl = (const u16*)(p.ws + OFF_W) + (size_t)l * W_LAYER;
  const int NT = 14, nitems = (MALL / 256) * NT;
  for (int it_ = lbid(); it_ < ((nitems + 255) & ~255); it_ += gridDim.x) {
    const int item = xcd_remap(it_);
    if (item >= nitems) continue;
    const int mt = item / NT, nt = item % NT;
    const int m0 = mt * 256;
    f32x16 acc[2][2];
    ACC_ZERO(acc);
    int n0;
    if (nt < 6) { n0 = nt * 128; gemm_mainloop(R + (size_t)m0 * 1536 + 768, 1536, wl + WO_QB + (size_t)n0 * 384, 384, 384, acc, lds); }
    else { n0 = (nt - 6) * 128; gemm_mainloop(R + (size_t)m0 * 1536 + 1152, 1536, wl + WO_KVB + (size_t)n0 * 256, 256, 256, acc, lds); n0 += 768; }
    stage_store_bf16(acc, QK, 1792, m0, n0, lds);
  }
}

DI void phase_p5(const Params& p, int l, float* lds) {
  const int tid = ltid(), lane = tid & 63, w = tid >> 6;
  u16* QK = (u16*)(p.ws + OFF_A);
  u16* KM = (u16*)(p.ws + OFF_KM);
  const u16* R = (const u16*)(p.ws + OFF_R);
  const float* qn = p.mla_q_norm + l * 96;
  const float* kn = p.mla_k_norm + l * 96;
  const float* ropem = (const float*)(p.ws + OFF_ROPEM);
  const float qscale = 0.10206207261596575f * LOG2E;
  const bool act = lane < 48;
  const int hd = act ? lane / 6 : 0, j = act ? lane - hd * 6 : 0;
  float gq[16], gk[16];
#pragma unroll
  for (int i = 0; i < 16; ++i) { gq[i] = qn[16 * j + i]; gk[i] = kn[16 * j + i]; }
  for (int r = lbid() * 8 + w; r < MALL; r += gridDim.x * 8) {
    u16* rowp = QK + (size_t)r * 1792;
    const u16* qsrc = rowp + hd * 96 + 16 * j;
    const u16* ksrc = (j < 4) ? rowp + 768 + hd * 128 + 16 * j : R + (size_t)r * 1536 + 1408 + 16 * (j - 4);
    const uint4 qa = *(const uint4*)(qsrc), qb = *(const uint4*)(qsrc + 8);
    const uint4 ka = *(const uint4*)(ksrc), kb = *(const uint4*)(ksrc + 8);
    float q[16], k[16];
    {
      const unsigned qu[8] = {qa.x, qa.y, qa.z, qa.w, qb.x, qb.y, qb.z, qb.w};
      const unsigned ku[8] = {ka.x, ka.y, ka.z, ka.w, kb.x, kb.y, kb.z, kb.w};
#pragma unroll
      for (int i = 0; i < 8; ++i) {
        q[2 * i] = __uint_as_float(qu[i] << 16); q[2 * i + 1] = __uint_as_float(qu[i] & 0xffff0000u);
        k[2 * i] = __uint_as_float(ku[i] << 16); k[2 * i + 1] = __uint_as_float(ku[i] & 0xffff0000u);
      }
    }
    float sq = 0.f, sk = 0.f;
#pragma unroll
    for (int i = 0; i < 16; ++i) { sq += q[i] * q[i]; sk += k[i] * k[i]; }
    float tq = 0.f, tk = 0.f;
#pragma unroll
    for (int u = 0; u < 6; ++u) { tq += __shfl(sq, hd * 6 + u); tk += __shfl(sk, hd * 6 + u); }
    const float rq = rsqrtf(tq * (1.0f / 96.0f) + EPSV) * qscale, rk = rsqrtf(tk * (1.0f / 96.0f) + EPSV);
#pragma unroll
    for (int i = 0; i < 16; ++i) { q[i] *= rq * gq[i]; k[i] *= rk * gk[i]; }
    const bool lat = r < ML;
    const int t = r & (LSEQ - 1);
    const int plane = (j == 4) ? lane + 1 : lane - 1;
    const bool rot = lat && act && (j >= 4);
    const float sgn = (j == 4) ? -1.f : 1.f;
    float qp[16], kp[16];
#pragma unroll
    for (int i = 0; i < 16; ++i) { qp[i] = __shfl(q[i], plane); kp[i] = __shfl(k[i], plane); }
    const float* rp = ropem + (size_t)t * 32;
#pragma unroll
    for (int i = 0; i < 16; ++i) {
      const float cs = rot ? rp[2 * i] : 1.f, sn = rot ? rp[2 * i + 1] * sgn : 0.f;
      q[i] = q[i] * cs + qp[i] * sn;
      k[i] = k[i] * cs + kp[i] * sn;
    }
    if (act) {
      uint4 o0, o1;
      o0.x = pk2(q[0], q[1]); o0.y = pk2(q[2], q[3]); o0.z = pk2(q[4], q[5]); o0.w = pk2(q[6], q[7]);
      o1.x = pk2(q[8], q[9]); o1.y = pk2(q[10], q[11]); o1.z = pk2(q[12], q[13]); o1.w = pk2(q[14], q[15]);
      *(uint4*)(rowp + hd * 96 + 16 * j) = o0;
      *(uint4*)(rowp + hd * 96 + 16 * j + 8) = o1;
      o0.x = pk2(k[0], k[1]); o0.y = pk2(k[2], k[3]); o0.z = pk2(k[4], k[5]); o0.w = pk2(k[6], k[7]);
      o1.x = pk2(k[8], k[9]); o1.y = pk2(k[10], k[11]); o1.z = pk2(k[12], k[13]); o1.w = pk2(k[14], k[15]);
      u16* kd = KM + (size_t)r * 768 + hd * 96 + 16 * j;
      *(uint4*)(kd) = o0;
      *(uint4*)(kd + 8) = o1;
    }
  }
}

template <int DQK>
DI void attn_block(const u16* __restrict__ Qp, int q_ld, const u16* __restrict__ Kp, int k_ld, const u16* __restrict__ Vp,
                   int v_ld, u16* __restrict__ Op, int o_ld, int qrow0, int nq, int qt0, int s0_row0, int s0_n, int s0_t0,
                   int masked0, int s1_row0, int s1_n, float sink_l2, int has_sink, u16* lds) {
  constexpr int KS = DQK + 8, NS = DQK / 16, CPK = DQK / 8;
  const int tid = ltid(), lane = tid & 63, w = tid >> 6, l32 = lane & 31, hh = lane >> 5;
  u16* Ks = lds;
  u16* Vt = lds + 2 * 64 * KS;
  bf16x8 qf[2][NS];
  f32x16 ot[2][2];
  float m[2], lsum[2];
#pragma unroll
  for (int qs = 0; qs < 2; ++qs) {
    const int qi = 64 * w + 32 * qs + l32;
    const int qr = qrow0 + ((qi < nq) ? qi : nq - 1);
#pragma unroll
    for (int s = 0; s < NS; ++s) qf[qs][s] = *(const bf16x8*)(Qp + (size_t)qr * q_ld + 16 * s + 8 * hh);
#pragma unroll
    for (int i = 0; i < 16; ++i) { ot[qs][0][i] = 0.f; ot[qs][1][i] = 0.f; }
    m[qs] = -1e30f; lsum[qs] = 0.f;
  }
  const int nt0 = s0_n >> 6, nt = nt0 + (s1_n >> 6);
  const int kkey0 = tid / CPK, kch0 = tid - kkey0 * CPK;
  const int c1 = tid + 512;
  const bool has1 = c1 < 64 * CPK;
  const int kkey1 = has1 ? c1 / CPK : 0, kch1 = has1 ? c1 - kkey1 * CPK : 0;
  const int vkey = tid & 63, vch = tid >> 6;
  uint4 rk0, rk1, rv;
  rk1 = make_uint4(0, 0, 0, 0);
  {
    const int row0 = (0 < nt0) ? s0_row0 : s1_row0;
    rk0 = *(const uint4*)(Kp + (size_t)(row0 + kkey0) * k_ld + kch0 * 8);
    if (has1) rk1 = *(const uint4*)(Kp + (size_t)(row0 + kkey1) * k_ld + kch1 * 8);
    rv = *(const uint4*)(Vp + (size_t)(row0 + vkey) * v_ld + vch * 8);
  }
  {
    *(uint4*)(Ks + kkey0 * KS + kch0 * 8) = rk0;
    if (has1) *(uint4*)(Ks + kkey1 * KS + kch1 * 8) = rk1;
    const unsigned uu[4] = {rv.x, rv.y, rv.z, rv.w};
#pragma unroll
    for (int i = 0; i < 4; ++i) {
      Vt[(vch * 8 + 2 * i) * 68 + vkey] = (u16)(uu[i] & 0xffffu);
      Vt[(vch * 8 + 2 * i + 1) * 68 + vkey] = (u16)(uu[i] >> 16);
    }
  }
  __syncthreads();
  const int tql = qt0 + 64 * w;
  for (int j = 0; j < nt; ++j) {
    const int cur = j & 1;
    {
      const int jn = (j + 1 < nt) ? j + 1 : j;
      const int row0 = (jn < nt0) ? s0_row0 + 64 * jn : s1_row0 + 64 * (jn - nt0);
      rk0 = VLOAD16(Kp + (size_t)(row0 + kkey0) * k_ld + kch0 * 8);
      if (DQK == 96) rk1 = VLOAD16(Kp + (size_t)(row0 + kkey1) * k_ld + kch1 * 8);
      rv = VLOAD16(Vp + (size_t)(row0 + vkey) * v_ld + vch * 8);
    }
    __builtin_amdgcn_sched_barrier(0);
    const bool mtile = masked0 && (j < nt0);
    const int tk0 = s0_t0 + 64 * j;
    bool active = true;
    if (mtile) active = (tk0 + 63 >= tql - 128) && (tk0 <= tql + 63 + 128);
    if (active) {
      const u16* kb = Ks + cur * 64 * KS + l32 * KS + hh * 8;
      f32x16 st[2][2];
#pragma unroll
      for (int i = 0; i < 16; ++i) { st[0][0][i] = 0.f; st[0][1][i] = 0.f; st[1][0][i] = 0.f; st[1][1][i] = 0.f; }
#pragma unroll
      for (int s = 0; s < NS; ++s) {
        const bf16x8 a0 = *(const bf16x8*)(kb + s * 16);
        const bf16x8 a1 = *(const bf16x8*)(kb + 32 * KS + s * 16);
        st[0][0] = MFMA(a0, qf[0][s], st[0][0]);
        st[0][1] = MFMA(a1, qf[0][s], st[0][1]);
        st[1][0] = MFMA(a0, qf[1][s], st[1][0]);
        st[1][1] = MFMA(a1, qf[1][s], st[1][1]);
      }
#pragma unroll
      for (int qs = 0; qs < 2; ++qs) {
        if (mtile) {
          const int tq = tql + 32 * qs + l32;
#pragma unroll
          for (int kt = 0; kt < 2; ++kt)
#pragma unroll
            for (int rg = 0; rg < 16; ++rg) {
              const int tk = tk0 + 32 * kt + (rg & 3) + 8 * (rg >> 2) + 4 * hh;
              const int dlt = tk - tq;
              if (dlt > 128 || dlt < -128) st[qs][kt][rg] = -1e30f;
            }
        }
        float mloc = st[qs][0][0];
#pragma unroll
        for (int rg = 1; rg < 16; ++rg) mloc = fmaxf(mloc, st[qs][0][rg]);
#pragma unroll
        for (int rg = 0; rg < 16; ++rg) mloc = fmaxf(mloc, st[qs][1][rg]);
        mloc = fmaxf(mloc, __shfl_xor(mloc, 32));
        const bool grow = mloc > m[qs] + 8.0f;
        if (__builtin_amdgcn_ballot_w64(grow) != 0ull) {
          const float mnew = fmaxf(m[qs], mloc);
          const float alpha = __builtin_amdgcn_exp2f(m[qs] - mnew);
          m[qs] = mnew;
          lsum[qs] *= alpha;
          const f32x2_t a2 = {alpha, alpha};
#pragma unroll
          for (int i = 0; i < 8; ++i) {
            f32x2_t o0 = {ot[qs][0][2 * i], ot[qs][0][2 * i + 1]}, o1 = {ot[qs][1][2 * i], ot[qs][1][2 * i + 1]};
            o0 *= a2; o1 *= a2;
            ot[qs][0][2 * i] = o0.x; ot[qs][0][2 * i + 1] = o0.y; ot[qs][1][2 * i] = o1.x; ot[qs][1][2 * i + 1] = o1.y;
          }
        }
        const f32x2_t nm2 = {-m[qs], -m[qs]};
        f32x2_t ps2 = {0.f, 0.f};
#pragma unroll
        for (int kt = 0; kt < 2; ++kt)
#pragma unroll
          for (int rg = 0; rg < 16; rg += 2) {
            f32x2_t sv = {st[qs][kt][rg], st[qs][kt][rg + 1]};
            sv += nm2;
            float p0 = __builtin_amdgcn_exp2f(sv.x), p1 = __builtin_amdgcn_exp2f(sv.y);
            if (mtile) { p0 = (st[qs][kt][rg] < -1e29f) ? 0.f : p0; p1 = (st[qs][kt][rg + 1] < -1e29f) ? 0.f : p1; }
            st[qs][kt][rg] = p0; st[qs][kt][rg + 1] = p1;
            const f32x2_t pv = {p0, p1};
            ps2 += pv;
          }
        lsum[qs] += ps2.x + ps2.y;
        __builtin_amdgcn_sched_barrier(0);
      }
      const u16* vb = Vt + cur * 64 * 68 + l32 * 68 + 4 * hh;
#pragma unroll
      for (int kt = 0; kt < 2; ++kt)
#pragma unroll
        for (int s = 0; s < 2; ++s) {
          bf16x8 pf[2];
#pragma unroll
          for (int qs = 0; qs < 2; ++qs) {
            unsigned pw[4];
#pragma unroll
            for (int i = 0; i < 4; ++i) pw[i] = pk2(st[qs][kt][8 * s + 2 * i], st[qs][kt][8 * s + 2 * i + 1]);
            const uint4 pu = make_uint4(pw[0], pw[1], pw[2], pw[3]);
            pf[qs] = __builtin_bit_cast(bf16x8, pu);
          }
#pragma unroll
          for (int dt = 0; dt < 2; ++dt) {
            const u16* vp = vb + dt * 32 * 68 + 32 * kt + 16 * s;
            const uint2 lo = *(const uint2*)(vp);
            const uint2 hi = *(const uint2*)(vp + 8);
            const uint4 au = make_uint4(lo.x, lo.y, hi.x, hi.y);
            const bf16x8 vf = __builtin_bit_cast(bf16x8, au);
            ot[0][dt] = MFMA(vf, pf[0], ot[0][dt]);
            ot[1][dt] = MFMA(vf, pf[1], ot[1][dt]);
          }
        }
    }
    __builtin_amdgcn_sched_barrier(0);
    {
      u16* Kw = Ks + (cur ^ 1) * 64 * KS;
      u16* Vw = Vt + (cur ^ 1) * 64 * 68;
      *(uint4*)(Kw + kkey0 * KS + kch0 * 8) = rk0;
      if (has1) *(uint4*)(Kw + kkey1 * KS + kch1 * 8) = rk1;
      const unsigned uu[4] = {rv.x, rv.y, rv.z, rv.w};
#pragma unroll
      for (int i = 0; i < 4; ++i) {
        Vw[(vch * 8 + 2 * i) * 68 + vkey] = (u16)(uu[i] & 0xffffu);
        Vw[(vch * 8 + 2 * i + 1) * 68 + vkey] = (u16)(uu[i] >> 16);
      }
    }
    __syncthreads();
  }
#pragma unroll
  for (int qs = 0; qs < 2; ++qs) {
    float ltot = lsum[qs] + __shfl_xor(lsum[qs], 32);
    if (has_sink) ltot += __builtin_amdgcn_exp2f(sink_l2 - m[qs]);
    const float inv = 1.0f / ltot;
    if (64 * w + 32 * qs + l32 < nq) {
#pragma unroll
      for (int dt = 0; dt < 2; ++dt)
#pragma unroll
        for (int g = 0; g < 4; ++g) {
          uint2 pk;
          pk.x = pk2(ot[qs][dt][4 * g] * inv, ot[qs][dt][4 * g + 1] * inv);
          pk.y = pk2(ot[qs][dt][4 * g + 2] * inv, ot[qs][dt][4 * g + 3] * inv);
          *(uint2*)(Op + (size_t)(qrow0 + 64 * w + 32 * qs + l32) * o_ld + dt * 32 + 8 * g + 4 * hh) = pk;
        }
    }
  }
}

DI void phase_attn(const Params& p, int l, u16* lds) {
  const u16* R = (const u16*)(p.ws + OFF_R);
  const u16* QK = (const u16*)(p.ws + OFF_A);
  const u16* KM = (const u16*)(p.ws + OFF_KM);
  u16* Y = (u16*)(p.ws + OFF_Y);
  const float* sink = p.gqa_sink + l * 8;
  const int n_mla = 1024, n_gqa = 1024, n_ctx = (l < 3) ? 128 : 0;
  const int n_all = n_mla + n_gqa + n_ctx;
  for (int it_ = lbid(); it_ < ((n_all + 255) & ~255); it_ += gridDim.x) {
    const int item = xcd_remap(it_);
    if (item >= n_all) continue;
    int kind, qb, hd, b, isctx;
    if (item < n_mla) { kind = 0; isctx = 0; qb = item & 15; hd = (item >> 4) & 7; b = item >> 7; }
    else if (item < n_mla + n_gqa) { const int it = item - n_mla; kind = 1; isctx = 0; qb = it & 15; hd = (it >> 4) & 7; b = it >> 7; }
    else { const int it = item - n_mla - n_gqa; isctx = 1; qb = 0; hd = it & 7; b = (it >> 3) & 7; kind = it >> 6; }
    const int crow0 = ML + b * LCTX;
    if (kind == 0) {
      int qrow0, nq, qt0, s0r, s0n, s1n;
      if (isctx) { qrow0 = crow0; nq = LCTX; qt0 = 0; s0r = crow0; s0n = LCTX; s1n = 0; }
      else { qrow0 = b * LSEQ + qb * 512; nq = 512; qt0 = qb * 512; s0r = b * LSEQ; s0n = LSEQ; s1n = LCTX; }
      attn_block<96>(QK + hd * 96, 1792, KM + hd * 96, 768, QK + 768 + hd * 128 + 64, 1792, Y + 1024 + hd * 64, 1536,
                     qrow0, nq, qt0, s0r, s0n, 0, 0, crow0, s1n, 0.f, 0, lds);
    } else {
      const int kvh = hd >> 2;
      int qrow0, nq, qt0, s0r, s0n, s0t, msk, s1n;
      if (isctx) { qrow0 = crow0; nq = LCTX; qt0 = 0; s0r = crow0; s0n = LCTX; s0t = 0; msk = 0; s1n = 0; }
      else {
        const int t0 = qb * 512;
        const int lo = (t0 - 128 < 0) ? 0 : t0 - 128;
        const int hi = (t0 + 640 > LSEQ) ? LSEQ : t0 + 640;
        qrow0 = b * LSEQ + t0; nq = 512; qt0 = t0; s0r = b * LSEQ + lo; s0n = hi - lo; s0t = lo; msk = 1; s1n = LCTX;
      }
      attn_block<64>(R + hd * 64, 1536, R + 512 + kvh * 64, 1536, R + 640 + kvh * 64, 1536, Y + 512 + hd * 64, 1536,
                     qrow0, nq, qt0, s0r, s0n, s0t, msk, crow0, s1n, sink[hd] * LOG2E, 1, lds);
    }
  }
}

DI void phase_p7a(const Params& p, int l, int nrows, u16* lds) {
  const u16* hn = (const u16*)(p.ws + OFF_A);
  const u16* wt = (const u16*)(p.ws + OFF_W) + (size_t)l * W_LAYER + WO_TG;
  u16* Gt = (u16*)(p.ws + OFF_B);
  const int NT = 24, nitems = (nrows / 256) * NT;
  for (int it_ = lbid(); it_ < ((nitems + 255) & ~255); it_ += gridDim.x) {
    const int item = xcd_remap(it_);
    if (item >= nitems) continue;
    const int m0 = (item / NT) * 256, n0 = (item % NT) * 128;
    f32x16 acc[2][2];
    ACC_ZERO(acc);
    gemm_mainloop(hn + (size_t)m0 * 1024, 1024, wt + (size_t)n0 * 1024, 1024, 1024, acc, lds);
    ACC_FOREACH(acc, m0, n0, { acc[mi_][ni_][r_] = sigmoidf_(val); });
    stage_store_bf16(acc, Gt, 3072, m0, n0, lds);
  }
}
DI void phase_p7b(const Params& p, int l, int nrows, u16* lds) {
  const u16* Y = (const u16*)(p.ws + OFF_Y);
  const u16* Gt = (const u16*)(p.ws + OFF_B);
  const u16* wb = (const u16*)(p.ws + OFF_W) + (size_t)l * W_LAYER + WO_BR;
  u16* mg = (u16*)(p.ws + OFF_A);
  const int NT = 8, nitems = (nrows / 256) * NT;
  for (int it_ = lbid(); it_ < ((nitems + 255) & ~255); it_ += gridDim.x) {
    const int item = xcd_remap(it_);
    if (item >= nitems) continue;
    const int m0 = (item / NT) * 256, n0 = (item % NT) * 128;
    f32x16 mrg[2][2];
    ACC_ZERO(mrg);
#pragma unroll 1
    for (int nb = 0; nb < 3; ++nb) {
      f32x16 acc[2][2];
      ACC_ZERO(acc);
      gemm_mainloop<true>(Y + (size_t)m0 * 1536 + nb * 512, 1536, wb + (size_t)nb * 1024 * 512 + (size_t)n0 * 512, 512, 512, acc, lds);
      {
        u16* gs = lds;
        const int tid = ltid();
#pragma unroll
        for (int i = 0; i < 8; ++i) {
          const int ch = tid + 512 * i, rr = ch >> 4, c16 = ch & 15;
          const uint4 v = *(const uint4*)(Gt + (size_t)(m0 + rr) * 3072 + nb * 1024 + n0 + c16 * 8);
          *(uint4*)(gs + rr * 136 + c16 * 8) = v;
        }
        __syncthreads();
        ACC_FOREACH(acc, 0, 0, { mrg[mi_][ni_][r_] += bf2f(gs[row * 136 + col]) * val; });
        __syncthreads();
      }
    }
    stage_store_bf16(mrg, mg, 1024, m0, n0, lds);
  }
}
DI void phase_p8(const Params& p, int l, int nrows, u16* lds) {
  const u16* mg = (const u16*)(p.ws + OFF_A);
  const u16* wt = (const u16*)(p.ws + OFF_W) + (size_t)l * W_LAYER + WO_OUT;
  const float* xs = (l == 0) ? p.x : p.out;
  const float* cs = (l == 0) ? p.ctx : (const float*)(p.ws + OFF_CTX);
  float* cd = (float*)(p.ws + OFF_CTX);
  const int NT = 8, nitems = (nrows / 256) * NT;
  for (int it_ = lbid(); it_ < ((nitems + 255) & ~255); it_ += gridDim.x) {
    const int item = xcd_remap(it_);
    if (item >= nitems) continue;
    const int m0 = (item / NT) * 256, n0 = (item % NT) * 128;
    f32x16 acc[2][2];
    ACC_ZERO(acc);
    gemm_mainloop(mg + (size_t)m0 * 1024, 1024, wt + (size_t)n0 * 1024, 1024, 1024, acc, lds);
    const int mrow = (m0 < ML) ? (m0 >> 13) : 8;
    const float* gate = mods_ptr(p, l, mrow, 2);
    ACC_FOREACH(acc, m0, n0, {
      const float g = gate[col];
      if (row < ML) p.out[(size_t)row * 1024 + col] = xs[(size_t)row * 1024 + col] + g * val;
      else cd[(size_t)(row - ML) * 1024 + col] = cs[(size_t)(row - ML) * 1024 + col] + g * val;
    });
  }
}
DI void phase_p10(const Params& p, int l, int nrows, u16* lds) {
  const u16* hn = (const u16*)(p.ws + OFF_A);
  const u16* wt = (const u16*)(p.ws + OFF_W) + (size_t)l * W_LAYER + WO_W1;
  u16* h1 = (u16*)(p.ws + OFF_B);
  const int NT = 32, nitems = (nrows / 256) * NT;
  for (int it_ = lbid(); it_ < ((nitems + 255) & ~255); it_ += gridDim.x) {
    const int item = xcd_remap(it_);
    if (item >= nitems) continue;
    const int m0 = (item / NT) * 256, n0 = (item % NT) * 128;
    f32x16 acc[2][2];
    ACC_ZERO(acc);
    gemm_mainloop(hn + (size_t)m0 * 1024, 1024, wt + (size_t)n0 * 1024, 1024, 1024, acc, lds);
    ACC_FOREACH(acc, m0, n0, { const float rl = fmaxf(val, 0.f); acc[mi_][ni_][r_] = rl * rl; });
    stage_store_bf16(acc, h1, 4096, m0, n0, lds);
  }
}
DI void phase_p11(const Params& p, int l, int nrows, u16* lds) {
  const u16* h1 = (const u16*)(p.ws + OFF_B);
  const u16* wt = (const u16*)(p.ws + OFF_W) + (size_t)l * W_LAYER + WO_W2;
  float* cd = (float*)(p.ws + OFF_CTX);
  const int NT = 8, nitems = (nrows / 256) * NT;
  for (int it_ = lbid(); it_ < ((nitems + 255) & ~255); it_ += gridDim.x) {
    const int item = xcd_remap(it_);
    if (item >= nitems) continue;
    const int m0 = (item / NT) * 256, n0 = (item % NT) * 128;
    f32x16 acc[2][2];
    ACC_ZERO(acc);
    gemm_mainloop(h1 + (size_t)m0 * 4096, 4096, wt + (size_t)n0 * 4096, 4096, 4096, acc, lds);
    const int mrow = (m0 < ML) ? (m0 >> 13) : 8;
    const float* gate = mods_ptr(p, l, mrow, 5);
    ACC_FOREACH(acc, m0, n0, {
      const float g = gate[col];
      float* dp = (row < ML) ? p.out + (size_t)row * 1024 + col : cd + (size_t)(row - ML) * 1024 + col;
      *dp = *dp + g * val;
    });
  }
}

DI void phase_gemm1_b(const Params& p, int l, char* lds) {
  EpiRouteBf16 E; E.ws = p.ws;
  run_gemm256((const u16*)(p.ws + OFF_A), (const u16*)(p.ws + OFF_W) + (size_t)l * W_LAYER + WO_T1, MALL, 3072, 1024, E, lds);
}
DI void phase_p4_b(const Params& p, int l, char* lds) {
  const u16* R = (const u16*)(p.ws + OFF_R);
  const u16* wl = (const u16*)(p.ws + OFF_W) + (size_t)l * W_LAYER;
  EpiActBf16<0> E; E.ldc = 1792;
  E.O = (u16*)(p.ws + OFF_A);
  run_gemm256(R + 768, wl + WO_QB, MALL, 768, 384, E, lds, 1536);
  E.O = (u16*)(p.ws + OFF_A) + 768;
  run_gemm256(R + 1152, wl + WO_KVB, MALL, 1024, 256, E, lds, 1536);
}
DI void phase_p7a_b(const Params& p, int l, int nrows, char* lds) {
  EpiActBf16<1> E; E.O = (u16*)(p.ws + OFF_B); E.ldc = 3072;
  run_gemm256((const u16*)(p.ws + OFF_A), (const u16*)(p.ws + OFF_W) + (size_t)l * W_LAYER + WO_TG, nrows, 3072, 1024, E, lds);
}
DI void phase_p10_b(const Params& p, int l, int nrows, char* lds) {
  EpiActBf16<2> E; E.O = (u16*)(p.ws + OFF_B); E.ldc = 4096;
  run_gemm256((const u16*)(p.ws + OFF_A), (const u16*)(p.ws + OFF_W) + (size_t)l * W_LAYER + WO_W1, nrows, 4096, 1024, E, lds);
}
DI void phase_p8_b(const Params& p, int l, int nrows, char* lds) {
  EpiResid E;
  E.xs = (l == 0) ? p.x : p.out; E.cs = (l == 0) ? p.ctx : (const float*)(p.ws + OFF_CTX);
  E.xo = p.out; E.co = (float*)(p.ws + OFF_CTX); E.gbase = mods_ptr(p, l, 0, 2);
  run_gemm256((const u16*)(p.ws + OFF_A), (const u16*)(p.ws + OFF_W) + (size_t)l * W_LAYER + WO_OUT, nrows, 1024, 1024, E, lds);
}
DI void phase_p11_b(const Params& p, int l, int nrows, char* lds) {
  EpiResid E;
  E.xs = p.out; E.cs = (const float*)(p.ws + OFF_CTX);
  E.xo = p.out; E.co = (float*)(p.ws + OFF_CTX); E.gbase = mods_ptr(p, l, 0, 5);
  run_gemm256((const u16*)(p.ws + OFF_B), (const u16*)(p.ws + OFF_W) + (size_t)l * W_LAYER + WO_W2, nrows, 1024, 4096, E, lds);
}

#define OFF_BAR 985907200ull
#define XB_TMO      128
#define XB_XCNT(j)  (256  + 64 * (j))
#define XB_XSUB(j)  (1280 + 64 * (j))
#define XB_XGEN(j)  (2304 + 64 * (j))
#define XB_TOP      3328
#define XB_TOPGEN   3392
#define XCD_BAR_WORDS 3456
#define XB_SPIN_CAP (1u << 18)
#define LAS __attribute__((address_space(3)))
DI unsigned xb_ld(unsigned* p) { return __hip_atomic_load(p, __ATOMIC_RELAXED, __HIP_MEMORY_SCOPE_AGENT); }
DI unsigned xb_add(unsigned* p, unsigned v) { return __hip_atomic_fetch_add(p, v, __ATOMIC_RELAXED, __HIP_MEMORY_SCOPE_AGENT); }
DI unsigned xb_xcc_id() { return (unsigned)__builtin_amdgcn_s_getreg((3 << 11) | 20) & 0xFu; }
#define XB_SPIN(cond, bar) do { unsigned _sp = 0; while (cond) { __builtin_amdgcn_s_sleep(1); \
    if ((++_sp & 255u) == 0u) { if (xb_ld(&(bar)[XB_TMO])) break; if (_sp > XB_SPIN_CAP) { atomicAdd(&(bar)[XB_TMO], 1u); break; } } } } while (0)
struct XcdBarrier { unsigned* bar; unsigned x; volatile LAS unsigned* st; };
DI XcdBarrier xcd_barrier_post(unsigned* bar, volatile LAS unsigned* st) {
  XcdBarrier b; b.bar = bar; b.x = xb_xcc_id(); b.st = st;
  if (threadIdx.x == 0) (void)xb_add(&bar[XB_XCNT(b.x)], 1u);
  return b;
}
DI void xcd_barrier_complete(unsigned* bar, unsigned x, unsigned& nloc, unsigned& nx) {
  const unsigned G = gridDim.x * gridDim.y * gridDim.z;
  unsigned sum, cnt, mine, sp = 0u;
  for (;;) {
    sum = 0u; cnt = 0u; mine = 0u;
#pragma unroll
    for (unsigned j = 0; j < 16; ++j) { const unsigned c = xb_ld(&bar[XB_XCNT(j)]); sum += c; cnt += (c > 0u) ? 1u : 0u; mine = (j == x) ? c : mine; }
    if (sum == G) break;
    __builtin_amdgcn_s_sleep(1);
    if ((++sp & 255u) == 0u) { if (xb_ld(&bar[XB_TMO])) break; if (sp > XB_SPIN_CAP) { atomicAdd(&bar[XB_TMO], 1u); break; } }
  }
  nloc = mine > 0u ? mine : 1u; nx = cnt > 0u ? cnt : 1u;
}
DI void xcd_barrier(const XcdBarrier& b) {
  asm volatile("s_waitcnt vmcnt(0) lgkmcnt(0)" ::: "memory");
  __syncthreads();
  if (threadIdx.x == 0) {
    unsigned* bar = b.bar;
    __builtin_amdgcn_s_waitcnt(0);
    unsigned nloc = b.st[0], nx = b.st[1];
    if (nloc == 0u) { xcd_barrier_complete(bar, b.x, nloc, nx); b.st[0] = nloc; b.st[1] = nx; }
    const unsigned old = xb_add(&bar[XB_XSUB(b.x)], 1u);
    const unsigned gen = old / nloc;
    if (old + 1u == (gen + 1u) * nloc) {
      __builtin_amdgcn_fence(__ATOMIC_RELEASE, "agent");
      asm volatile("s_waitcnt vmcnt(0)" ::: "memory");
      const unsigned og = xb_add(&bar[XB_TOP], 1u);
      const unsigned tg = og / nx;
      if (og + 1u == (tg + 1u) * nx) xb_add(&bar[XB_TOPGEN], 1u);
      else XB_SPIN(xb_ld(&bar[XB_TOPGEN]) == tg, bar);
      __builtin_amdgcn_fence(__ATOMIC_ACQUIRE, "agent");
      xb_add(&bar[XB_XGEN(b.x)], 1u);
      asm volatile("s_waitcnt vmcnt(0)" ::: "memory");
    } else {
      XB_SPIN(xb_ld(&bar[XB_XGEN(b.x)]) == gen, bar);
      __builtin_amdgcn_fence(__ATOMIC_ACQUIRE, "agent");
      asm volatile("s_waitcnt vmcnt(0)" ::: "memory");
    }
  }
  __syncthreads();
}

DI void gsync(cg::grid_group& grid) {
  asm volatile("s_waitcnt vmcnt(0) lgkmcnt(0)" ::: "memory");
  grid.sync();
  if (ltid() < 64) {
    __builtin_amdgcn_fence(__ATOMIC_ACQUIRE, "agent");
    asm volatile("s_waitcnt vmcnt(0)" ::: "memory");
  }
  __syncthreads();
}

__global__ void __launch_bounds__(512) fwd_megakernel(Params p) {
  __shared__ __attribute__((aligned(16))) char lds[131072];
  __shared__ uint4 xb_words;
  cg::grid_group grid = cg::this_grid();
  if (threadIdx.x == 0) xb_words = make_uint4(0u, 0u, 0u, 0u);
  __syncthreads();
  const XcdBarrier xb = xcd_barrier_post((unsigned*)(p.ws + OFF_BAR), (volatile LAS unsigned*)&xb_words);
  phase0(p, lds);
  gsync(grid);
  for (int l = 0; l < 4; ++l) {
    const int nrows2 = (l < 3) ? MALL : ML;
#ifdef PROBE_SYNC10
    for (int q = 0; q < 10; ++q) xcd_barrier(xb);
#endif
#ifdef PROBE_FILT
    filter_tiles(p, l, LSEQ, 2 * FFTN, (float*)(p.ws + OFF_KF), (float*)(p.ws + OFF_PART), (float*)lds);
    xcd_barrier(xb);
    phase_filter_fft(p, l, (float*)lds);
    xcd_barrier(xb);
#endif
    phase_rownorm(p, l, 0, MALL);
#ifdef PROBE_ELEM
    phase_rownorm(p, l, 0, MALL);
    phase_rownorm(p, l, 0, MALL);
    phase_rownorm(p, l, 0, MALL);
#endif
    filter_tiles(p, l, LSEQ, 2 * FFTN, (float*)(p.ws + OFF_KF), (float*)(p.ws + OFF_PART), (float*)lds);
    if (l < 3) filter_tiles(p, l, LCTX, 512, (float*)(p.ws + OFF_KC), (float*)(p.ws + OFF_PART) + 128 * 1024, (float*)lds);
    xcd_barrier(xb);
    phase_gemm1_b(p, l, lds);
#ifdef PROBE_BIGG
    phase_gemm1_b(p, l, lds);
#endif
    phase_filter_fft(p, l, (float*)lds);
    xcd_barrier(xb);
    phase_h1(p, l, (float*)lds);
#ifdef PROBE_ELEM
    phase_h1(p, l, (float*)lds);
#endif
    phase_p3(p, l, (float*)lds);
    xcd_barrier(xb);
    phase_h2(p, l, (float*)lds);
    xcd_barrier(xb);
#ifdef PROBE_H2
    phase_h1(p, l, (float*)lds);
    xcd_barrier(xb);
    phase_h2(p, l, (float*)lds);
    xcd_barrier(xb);
#endif
    phase_h3(p, l, (float*)lds);
#ifdef PROBE_ELEM
    phase_h3(p, l, (float*)lds);
#endif
    xcd_barrier(xb);
    phase_p4(p, l, (u16*)lds);
#ifdef PROBE_SMALLG
    phase_p4(p, l, (u16*)lds);
#endif
    xcd_barrier(xb);
    phase_p5(p, l, (float*)lds);
    xcd_barrier(xb);
#ifdef PROBE_P45
    phase_p4(p, l, (u16*)lds);
    xcd_barrier(xb);
    phase_p5(p, l, (float*)lds);
    xcd_barrier(xb);
#endif
    phase_attn(p, l, (u16*)lds);
#ifdef PROBE_ATTN2
    xcd_barrier(xb);
    phase_attn(p, l, (u16*)lds);
#endif
    xcd_barrier(xb);
    phase_rownorm(p, l, 0, nrows2);
    xcd_barrier(xb);
    phase_p7a_b(p, l, nrows2, lds);
#ifdef PROBE_BIGG
    phase_p7a_b(p, l, nrows2, lds);
#endif
    xcd_barrier(xb);
    phase_p7b(p, l, nrows2, (u16*)lds);
#ifdef PROBE_SMALLG
    phase_p7b(p, l, nrows2, (u16*)lds);
#endif
    xcd_barrier(xb);
    phase_p8_b(p, l, nrows2, lds);
    xcd_barrier(xb);
    phase_rownorm(p, l, 1, nrows2);
    xcd_barrier(xb);
    phase_p10_b(p, l, nrows2, lds);
#ifdef PROBE_BIGG
    phase_p10_b(p, l, nrows2, lds);
#endif
    xcd_barrier(xb);
    phase_p11_b(p, l, nrows2, lds);
    xcd_barrier(xb);
  }
}

extern "C" void kernel_launch(void* const* d_in, const int* in_sizes, int n_in, void* d_out, int out_size, void* d_ws,
                              size_t ws_size, hipStream_t stream) {
  static int grid_blocks = 0;
  if (!grid_blocks) {
    int dev = 0, cus = 0, per_cu = 0;
    hipGetDevice(&dev);
    hipDeviceGetAttribute(&cus, hipDeviceAttributeMultiprocessorCount, dev);
    hipOccupancyMaxActiveBlocksPerMultiprocessor(&per_cu, fwd_megakernel, 512, 0);
    if (per_cu < 1) per_cu = 1;
    if (per_cu > 1) per_cu = 1;
    grid_blocks = (cus * per_cu) & ~7;
    if (grid_blocks < 8) grid_blocks = 8;
  }
  Params p{};
  const float** pp = (const float**)&p;
  for (int i = 0; i < 30; ++i) pp[i] = (const float*)d_in[i];
  p.out = (float*)d_out;
  p.ws = (char*)d_ws;
  hipMemsetAsync((char*)d_ws + OFF_BAR, 0, XCD_BAR_WORDS * sizeof(unsigned), stream);
  void* args[] = {&p};
  hipError_t e = hipLaunchCooperativeKernel((void*)fwd_megakernel, dim3(grid_blocks), dim3(512), args, 0, stream);
  if (e != hipSuccess) fprintf(stderr, "cooperative launch failed: %s (grid %d)\n", hipGetErrorString(e), grid_blocks);
}
```

```cpp
#include <hip/hip_runtime.h>
#include <hip/hip_cooperative_groups.h>
#include <cstdio>
namespace cg = cooperative_groups;

typedef unsigned short u16;
typedef short bf16x8 __attribute__((ext_vector_type(8)));
typedef float f32x16 __attribute__((ext_vector_type(16)));
typedef unsigned u32x4 __attribute__((ext_vector_type(4)));
#define VLOAD16(ptr) __builtin_bit_cast(uint4, *(const volatile u32x4*)(ptr))
typedef __bf16 bf16x2_t __attribute__((ext_vector_type(2)));
typedef float f32x2_t __attribute__((ext_vector_type(2)));
#define DI __device__ __forceinline__
#define MFMA(a, b, c) __builtin_amdgcn_mfma_f32_32x32x16_bf16((a), (b), (c), 0, 0, 0)

#define DM 1024
#define NBATCH 8
#define LSEQ 8192
#define LCTX 256
#define ML 65536
#define MC 2048
#define MALL 67584
#define NIN 6048
#define FFTN 16384
#define EPSV 1e-6f
#define LOG2E 1.4426950408889634f

#define W_LAYER 17858560ull
#define WO_T1 0ull
#define WO_TG 3145728ull
#define WO_QB 6291456ull
#define WO_KVB 6586368ull
#define WO_BR 6848512ull
#define WO_OUT 8421376ull
#define WO_W1 9469952ull
#define WO_W2 13664256ull
#define OFF_W 0ull
#define OFF_CTX 142868480ull
#define OFF_KF 151257088ull
#define OFF_KC 218365952ull
#define OFF_MODS 219414528ull
#define OFF_SUMSQ 220299264ull
#define OFF_ROPEG 220315648ull
#define OFF_ROPEM 222412800ull
#define OFF_TW 223461376ull
#define OFF_A 223592448ull
#define OFF_B 362004480ull
#define OFF_C 431210496ull
#define OFF_R 569622528ull
#define OFF_Y 777240576ull
#define OFF_KM (OFF_A + 242221056ull)
#define OFF_PART 984858624ull
#define ZC_OFF 33554432

struct Params {
  const float *x, *c, *ctx, *c_ctx, *w_mod, *b_mod, *norm_mix_g, *norm_mlp_g, *w_in, *hy_short_w, *hy_f1_w, *hy_f1_b,
      *hy_f2_w, *hy_f2_b, *hy_sin_freq, *hy_f3_w, *hy_skip, *gqa_q_norm, *gqa_k_norm, *gqa_sink, *mla_q_a_norm,
      *mla_kv_a_norm, *w_q_b, *w_kv_b, *mla_q_norm, *mla_k_norm, *w_branch, *w_out, *w_mlp1, *w_mlp2;
  float* out;
  char* ws;
};

DI int ltid() { int t = threadIdx.x; asm volatile("" : "+v"(t)); return t; }
DI int lbid() { int t = blockIdx.x; asm volatile("" : "+s"(t)); return t; }
DI u16 f2bf(float x) { return __builtin_bit_cast(u16, (__bf16)x); }
DI float bf2f(u16 v) { return __uint_as_float(((unsigned)v) << 16); }
DI unsigned pk2(float a, float b) {
  f32x2_t f = {a, b};
  return __builtin_bit_cast(unsigned, __builtin_convertvector(f, bf16x2_t));
}
DI float wave_sum(float v) {
#pragma unroll
  for (int o = 32; o > 0; o >>= 1) v += __shfl_xor(v, o);
  return v;
}
DI float sigmoidf_(float x) { return 1.0f / (1.0f + __expf(-x)); }
DI const float* mods_ptr(const Params& p, int l, int mrow, int j) {
  return (const float*)(p.ws + OFF_MODS) + ((size_t)(l * 9 + mrow) * 6144 + j * 1024);
}

template <bool LOWREG = false>
DI void gemm_mainloop(const u16* __restrict__ Ag, int lda, const u16* __restrict__ Bg, int ldb, int K,
                      f32x16 (&acc)[2][2], u16* lds) {
  const int tid = ltid(), lane = tid & 63, w = tid >> 6, l32 = lane & 31, hh = lane >> 5;
  const int wm = w >> 1, wn = w & 1;
  u16* As = lds;
  u16* Bs = lds + 2 * 256 * 72;
  const int arow = tid >> 3, ach = tid & 7;
  const u16* ap = Ag + (size_t)arow * lda + ach * 8;
  const u16* bp = Bg + (size_t)arow * ldb + ach * 8;
  const int nk = K >> 6;
  uint4 ra0[4], rb0[2], ra1[4], rb1[2];
#define G_LOAD(RA, RB, T)                                                                   \
  {                                                                                         \
    const int t_ = ((T) < nk) ? (T) : nk - 1;                                               \
    _Pragma("unroll") for (int i = 0; i < 4; ++i) RA[i] = VLOAD16(ap + (size_t)(64 * i) * lda + 64 * t_); \
    _Pragma("unroll") for (int i = 0; i < 2; ++i) RB[i] = VLOAD16(bp + (size_t)(64 * i) * ldb + 64 * t_); \
  }
#define G_STORE(RA, RB, BUF)                                                                \
  {                                                                                         \
    u16* Aw = As + (BUF) * 256 * 72;                                                        \
    u16* Bw = Bs + (BUF) * 128 * 72;                                                        \
    _Pragma("unroll") for (int i = 0; i < 4; ++i) *(uint4*)(Aw + (arow + 64 * i) * 72 + ach * 8) = RA[i]; \
    _Pragma("unroll") for (int i = 0; i < 2; ++i) *(uint4*)(Bw + (arow + 64 * i) * 72 + ach * 8) = RB[i]; \
  }
#define G_COMPUTE(BUF, RA, RB, WBUF)                                                        \
  {                                                                                         \
    const u16* as = As + (BUF) * 256 * 72 + (wm * 64 + l32) * 72 + hh * 8;                  \
    const u16* bs = Bs + (BUF) * 128 * 72 + (wn * 64 + l32) * 72 + hh * 8;                  \
    u16* Aw = As + (WBUF) * 256 * 72 + arow * 72 + ach * 8;                                 \
    u16* Bw = Bs + (WBUF) * 128 * 72 + arow * 72 + ach * 8;                                 \
    _Pragma("unroll") for (int s = 0; s < 4; ++s) {                                         \
      bf16x8 a0 = *(const bf16x8*)(as + s * 16), a1 = *(const bf16x8*)(as + 32 * 72 + s * 16); \
      bf16x8 b0 = *(const bf16x8*)(bs + s * 16), b1 = *(const bf16x8*)(bs + 32 * 72 + s * 16); \
      acc[0][0] = MFMA(a0, b0, acc[0][0]);                                                  \
      acc[0][1] = MFMA(a0, b1, acc[0][1]);                                                  \
      acc[1][0] = MFMA(a1, b0, acc[1][0]);                                                  \
      acc[1][1] = MFMA(a1, b1, acc[1][1]);                                                  \
      if (s == 0) { *(uint4*)(Aw) = RA[0]; *(uint4*)(Aw + 64 * 72) = RA[1]; }               \
      if (s == 1) { *(uint4*)(Aw + 128 * 72) = RA[2]; *(uint4*)(Aw + 192 * 72) = RA[3]; }   \
      if (s == 2) { *(uint4*)(Bw) = RB[0]; *(uint4*)(Bw + 64 * 72) = RB[1]; }               \
      if (LOWREG) __builtin_amdgcn_sched_barrier(0);                                        \
    }                                                                                       \
  }
  G_LOAD(ra0, rb0, 0);
  G_LOAD(ra1, rb1, 1);
  __builtin_amdgcn_sched_barrier(0);
  G_STORE(ra0, rb0, 0);
  __syncthreads();
  for (int kt = 0; kt < nk; kt += 2) {
    G_LOAD(ra0, rb0, kt + 2);
    __builtin_amdgcn_sched_barrier(0);
    G_COMPUTE(0, ra1, rb1, 1);
    __syncthreads();
    G_LOAD(ra1, rb1, kt + 3);
    __builtin_amdgcn_sched_barrier(0);
    G_COMPUTE(1, ra0, rb0, 0);
    __syncthreads();
  }
#undef G_LOAD
#undef G_STORE
#undef G_COMPUTE
}

DI int xcd_remap(int it) { const int r = it & 255; return (it & ~255) + ((r & 7) << 5) + (r >> 3); }

#define ACC_ZERO(acc)                                                                      \
  _Pragma("unroll") for (int mi_ = 0; mi_ < 2; ++mi_) _Pragma("unroll") for (int ni_ = 0; ni_ < 2; ++ni_) \
      _Pragma("unroll") for (int r_ = 0; r_ < 16; ++r_) acc[mi_][ni_][r_] = 0.f;

#define ACC_FOREACH(acc, m0, n0, BODY)                                                     \
  {                                                                                        \
    const int lane_ = ltid() & 63, w_ = ltid() >> 6;                             \
    const int l32_ = lane_ & 31, hh_ = lane_ >> 5, wm_ = w_ >> 1, wn_ = w_ & 1;            \
    _Pragma("unroll") for (int mi_ = 0; mi_ < 2; ++mi_) _Pragma("unroll") for (int ni_ = 0; ni_ < 2; ++ni_) { \
        __builtin_amdgcn_sched_barrier(0);                                                 \
        _Pragma("unroll") for (int r_ = 0; r_ < 16; ++r_) {                                \
      const int row = (m0) + wm_ * 64 + mi_ * 32 + (r_ & 3) + 8 * (r_ >> 2) + 4 * hh_;     \
      const int col = (n0) + wn_ * 64 + ni_ * 32 + l32_;                                   \
      const float val = acc[mi_][ni_][r_];                                                    \
      BODY                                                                                 \
    } }                                                                                    \
  }

DI void stage_store_bf16(f32x16 (&acc)[2][2], u16* __restrict__ dst, int ld, int m0, int c0, u16* lds) {
  u16* cs = lds;
  ACC_FOREACH(acc, 0, 0, { cs[row * 136 + col] = f2bf(val); });
  __syncthreads();
  const int tid = ltid();
#pragma unroll
  for (int i = 0; i < 8; ++i) {
    const int ch = tid + 512 * i, rr = ch >> 4, c16 = ch & 15;
    const uint4 v = *(const uint4*)(cs + rr * 136 + c16 * 8);
    *(uint4*)(dst + (size_t)(m0 + rr) * ld + c0 + c16 * 8) = v;
  }
  __syncthreads();
}

namespace pg8 {
#define PG8_LAS __attribute__((address_space(3)))
typedef unsigned short bf16_t;
typedef short bf16x8 __attribute__((ext_vector_type(8)));
typedef float f32x4 __attribute__((ext_vector_type(4)));
typedef unsigned u32x4 __attribute__((ext_vector_type(4)));
constexpr int BM = 256, BK = 64, HALF = 128, HTB = HALF * BK * 2  , STAGE_BYTES = 8 * HTB, NXCD = 8, WGM = 8;

__host__ __device__ __forceinline__ int lds_byte(int r, int c) { const int st = (r >> 4) * 2 + (c >> 5), rr = r & 15, cc = c & 31, ob = rr * 64 + cc * 2; return st * 1024 + (ob ^ (((ob >> 9) & 1) << 5)); }
__host__ __device__ __forceinline__ void stage_rc(int b, int& R, int& C) { const int st = b / 1024, sb = b % 1024, swz = sb ^ (((sb >> 9) & 1) << 5); R = (st >> 1) * 16 + swz / 64; C = (st & 1) * 32 + (swz % 64) / 2; }
__host__ __device__ __forceinline__ int perm32(int rho) { const int n = rho >> 4, i = rho & 15; return 8 * (i >> 2) + 4 * n + (i & 3); }

struct Unit { int pm, pn; };
struct Gemm { const bf16_t* A; const bf16_t* Bt; int M, N, K, lda; };

struct StaticOrder {
    int nM, nN, nwg, G, c;
    __host__ __device__ void init(int M, int N, int G_, int c_) { nM = M / BM; nN = N / BM; nwg = nM * nN; G = G_; c = c_; }
    __host__ __device__ bool next(int i, Unit& u) const {
        const long L = (long)i * G + c; if (L >= nwg) return false;
        int wgid = (int)L; { const int q = nwg / NXCD, r = nwg % NXCD, xcd = wgid % NXCD, off = wgid / NXCD; wgid = (xcd < r ? xcd * (q + 1) : r * (q + 1) + (xcd - r) * q) + off; }
        const int nig = WGM * nN, gid = wgid / nig, fm = gid * WGM, gsz = (nM - fm) < WGM ? (nM - fm) : WGM;
        u.pm = fm + ((wgid % nig) % gsz); u.pn = (wgid % nig) / gsz; return true;
    }
    __device__ __forceinline__ void a_ready(const Unit&) const {}
    __device__ __forceinline__ void done(const Unit&) const {}
};
template <class Epi, class Sched, bool STAMP = false>
__device__ __forceinline__ void gemm_phase(PG8_LAS unsigned char* lds, const Gemm g, const Sched& S, const Epi& E, unsigned long long* stamps) {
    const int tid = ltid(), wid = __builtin_amdgcn_readfirstlane(tid >> 6), lane = tid & 63, wr = wid >> 2, wc = wid & 3, fr = lane & 15, fq = lane >> 4;
    const int K = g.K, nt = K / BK;
    int ts_lo = 0, ts_hi = 0, nts = 0; const unsigned long long rt_entry = STAMP ? (unsigned long long)wall_clock64() : 0ull;
#define PG8_STAMP() do { if (STAMP && wid == 0 && nts < 64) { const unsigned long long _c = (unsigned long long)clock64(); \
        ts_lo = (lane == nts) ? (int)(unsigned)_c : ts_lo; ts_hi = (lane == nts) ? (int)(unsigned)(_c >> 32) : ts_hi; ++nts; } } while (0)
    PG8_STAMP();
    unsigned voffA[2], voffB[2];
#pragma unroll
    for (int i = 0; i < 2; ++i) { int R, C; stage_rc(tid * 16 + i * 8192, R, C); const int Rb = Epi::PERM ? ((R & ~31) + perm32(R & 31)) : R;
        voffA[i] = (unsigned)(R * g.lda + C) * 2u; voffB[i] = (unsigned)(Rb * K + C) * 2u; }
    const size_t kstep = (size_t)(BK * 2);
    const size_t hstep = (size_t)HALF * K * 2;
    const size_t tstep = 2 * hstep;
    const size_t hstepA = (size_t)HALF * g.lda * 2, tstepA = 2 * hstepA;
    const unsigned ldsw = (unsigned)wid * 1024u;
    const int aoff = lds_byte(wr * 64 + fr, fq * 8), boff = lds_byte(wc * 32 + fr, fq * 8);
#define PG8_SA(b, h) (((b) * 2 + (h)) * HTB)
#define PG8_SB(b, h) ((4 + (b) * 2 + (h)) * HTB)
#define PG8_STAGE(bufoff, gbase, voff) do { _Pragma("unroll") for (int _i = 0; _i < 2; ++_i) \
        __builtin_amdgcn_global_load_lds((const unsigned*)((const char*)(gbase) + (voff)[_i]), (PG8_LAS unsigned*)(lds + (bufoff) + ldsw + _i * 8192), 16, 0, 0); } while (0)
#define PG8_LDA(dst, b, h) do { _Pragma("unroll") for (int m = 0; m < 4; ++m) _Pragma("unroll") for (int k = 0; k < 2; ++k) dst[m][k] = *(const PG8_LAS bf16x8*)(lds + PG8_SA(b, h) + aoff + m * 2048 + k * 1024); } while (0)
#define PG8_LDB(dst, b, h) do { _Pragma("unroll") for (int n = 0; n < 2; ++n) _Pragma("unroll") for (int k = 0; k < 2; ++k) dst[n][k] = *(const PG8_LAS bf16x8*)(lds + PG8_SB(b, h) + boff + n * 2048 + k * 1024); } while (0)
#define PG8_MMA(ai, bj, At, Bt) do { __builtin_amdgcn_s_setprio(1); _Pragma("unroll") for (int m = 0; m < 4; ++m) _Pragma("unroll") for (int n = 0; n < 2; ++n) _Pragma("unroll") for (int k = 0; k < 2; ++k) \
        acc[ai][bj][m][n] = __builtin_amdgcn_mfma_f32_16x16x32_bf16(Bt[n][k], At[m][k], acc[ai][bj][m][n], 0, 0, 0); __builtin_amdgcn_s_setprio(0); } while (0)
#define PG8_WAIT_V(n) asm volatile("s_waitcnt vmcnt(" #n ")" ::: "memory")
#define PG8_WAIT_L(n) asm volatile("s_waitcnt lgkmcnt(" #n ")" ::: "memory")
#define PG8_BAR __builtin_amdgcn_s_barrier()
#define PG8_SCHED __builtin_amdgcn_sched_barrier(0)
    Unit cur, nxt; int ui = 0;
    if (!S.next(0, cur)) return;
    f32x4 acc[2][2][4][2];
#pragma unroll
    for (int a = 0; a < 2; ++a)
#pragma unroll
        for (int b = 0; b < 2; ++b)
#pragma unroll
            for (int m = 0; m < 4; ++m)
#pragma unroll
                for (int n = 0; n < 2; ++n) acc[a][b][m][n] = (f32x4){0.f, 0.f, 0.f, 0.f};
    bf16x8 At[4][2], B0[2][2], B1[2][2];
    const char* cA = (const char*)g.A + (size_t)cur.pm * tstepA; const char* cB = (const char*)g.Bt + (size_t)cur.pn * tstep;
    S.a_ready(cur);
    PG8_STAGE(PG8_SB(0, 0), cB, voffB); PG8_STAGE(PG8_SA(0, 0), cA, voffA); PG8_STAGE(PG8_SB(0, 1), cB + hstep, voffB); PG8_STAGE(PG8_SA(0, 1), cA + hstepA, voffA);
    if (wr == 1) PG8_BAR;
    PG8_WAIT_V(4); PG8_BAR;
    PG8_STAGE(PG8_SB(1, 0), cB + kstep, voffB); PG8_STAGE(PG8_SA(1, 0), cA + kstep, voffA); PG8_STAGE(PG8_SB(1, 1), cB + hstep + kstep, voffB);
    PG8_WAIT_V(6); PG8_BAR;
    PG8_STAMP();
    for (;;) {
        const bool has_next = S.next(ui + 1, nxt);
        const char* nA = has_next ? (const char*)g.A + (size_t)nxt.pm * tstepA : cA; const char* nB = has_next ? (const char*)g.Bt + (size_t)nxt.pn * tstep : cB;
        for (int t = 0; t < nt; t += 2) {
            const bool last = (t == nt - 2);
            const char* a1 = cA + (size_t)(t + 1) * kstep;
            const char* a2 = last ? nA : cA + (size_t)(t + 2) * kstep; const char* b2 = last ? nB : cB + (size_t)(t + 2) * kstep;
            const char* a3 = a2 + kstep; const char* b3 = b2 + kstep;
            if (last && has_next) S.a_ready(nxt);
            PG8_LDB(B0, 0, 0); PG8_SCHED; PG8_LDA(At, 0, 0); PG8_STAGE(PG8_SA(1, 1), a1 + hstepA, voffA);
            PG8_WAIT_L(8); PG8_BAR; PG8_WAIT_L(0); PG8_MMA(0, 0, At, B0); PG8_BAR; PG8_SCHED;
            PG8_LDB(B1, 0, 1); PG8_STAGE(PG8_SB(0, 0), b2, voffB);
            PG8_BAR; PG8_WAIT_L(0); PG8_MMA(0, 1, At, B1); PG8_BAR;
            PG8_LDA(At, 0, 1); PG8_STAGE(PG8_SA(0, 0), a2, voffA);
            PG8_BAR; PG8_WAIT_L(0); PG8_MMA(1, 0, At, B0); PG8_BAR; PG8_SCHED;
            PG8_STAGE(PG8_SB(0, 1), b2 + hstep, voffB);
            PG8_WAIT_V(6); PG8_BAR; PG8_MMA(1, 1, At, B1); PG8_BAR;
            PG8_LDB(B0, 1, 0); PG8_SCHED; PG8_LDA(At, 1, 0); PG8_STAGE(PG8_SA(0, 1), a2 + hstepA, voffA);
            PG8_WAIT_L(8); PG8_BAR; PG8_WAIT_L(0); PG8_MMA(0, 0, At, B0); PG8_BAR; PG8_SCHED;
            PG8_LDB(B1, 1, 1); PG8_STAGE(PG8_SB(1, 0), b3, voffB);
            PG8_BAR; PG8_WAIT_L(0); PG8_MMA(0, 1, At, B1); PG8_BAR;
            PG8_LDA(At, 1, 1); PG8_STAGE(PG8_SA(1, 0), a3, voffA);
            PG8_BAR; PG8_WAIT_L(0); PG8_MMA(1, 0, At, B0); PG8_BAR; PG8_SCHED;
            PG8_STAGE(PG8_SB(1, 1), b3 + hstep, voffB);
            PG8_WAIT_V(6); PG8_BAR; PG8_MMA(1, 1, At, B1); PG8_BAR;
        }
        PG8_STAMP();
        if constexpr (!Epi::AFTER_DRAIN) { E(acc, cur, wr, wc, fr, fq); S.done(cur); }
        PG8_STAMP();
        if (!has_next) break;
#pragma unroll
        for (int a = 0; a < 2; ++a)
#pragma unroll
            for (int b = 0; b < 2; ++b)
#pragma unroll
                for (int m = 0; m < 4; ++m)
#pragma unroll
                    for (int n = 0; n < 2; ++n) acc[a][b][m][n] = (f32x4){0.f, 0.f, 0.f, 0.f};
        cur = nxt; cA = nA; cB = nB; ++ui;
    }
    PG8_WAIT_V(0);
    if (wr == 0) PG8_BAR;
    PG8_BAR;
    if constexpr (Epi::AFTER_DRAIN) { E.fused(acc, cur, wr, wc, fr, fq, lds, wid, lane); S.done(cur); }
    PG8_STAMP();
    if (STAMP && wid == 0) { stamps[lane] = lane < nts ? (((unsigned long long)(unsigned)ts_hi << 32) | (unsigned)ts_lo) : 0ull;
        if (lane == 62) stamps[62] = rt_entry; if (lane == 63) stamps[63] = (unsigned long long)wall_clock64(); }
#undef PG8_STAMP
#undef PG8_SA
#undef PG8_SB
#undef PG8_STAGE
#undef PG8_LDA
#undef PG8_LDB
#undef PG8_MMA
#undef PG8_WAIT_V
#undef PG8_WAIT_L
#undef PG8_BAR
#undef PG8_SCHED
}
}

DI uint4 pack8_bf16(const pg8::f32x4& v0, const pg8::f32x4& v1) {
  uint4 w; w.x = pk2(v0[0], v0[1]); w.y = pk2(v0[2], v0[3]); w.z = pk2(v1[0], v1[1]); w.w = pk2(v1[2], v1[3]); return w;
}
struct EpiRouteBf16 {
  static constexpr bool PERM = true, AFTER_DRAIN = false;
  char* ws;
  DI void operator()(const pg8::f32x4 (&acc)[2][2][4][2], const pg8::Unit& u, int wr, int wc, int fr, int fq) const {
    const int row0 = u.pm * 256 + wr * 64 + fr;
    u16* base; int ld, colt;
    if (u.pn < 2) { base = (u16*)(ws + OFF_B); ld = 512; colt = u.pn * 256; }
    else if (u.pn < 6) { base = (u16*)(ws + OFF_C); ld = 1024; colt = u.pn * 256 - 512; }
    else { base = (u16*)(ws + OFF_R); ld = 1536; colt = u.pn * 256 - 1536; }
    const int col0 = colt + wc * 32 + 8 * fq;
#pragma unroll
    for (int ai = 0; ai < 2; ++ai)
#pragma unroll
      for (int m = 0; m < 4; ++m) {
        u16* rowp = base + (size_t)(row0 + ai * 128 + m * 16) * ld + col0;
#pragma unroll
        for (int bj = 0; bj < 2; ++bj) *(uint4*)(rowp + bj * 128) = pack8_bf16(acc[ai][bj][m][0], acc[ai][bj][m][1]);
      }
  }
};
template <int ACT  > struct EpiActBf16 {
  static constexpr bool PERM = true, AFTER_DRAIN = false;
  u16* O; int ldc;
  DI void operator()(const pg8::f32x4 (&acc)[2][2][4][2], const pg8::Unit& u, int wr, int wc, int fr, int fq) const {
    const int row0 = u.pm * 256 + wr * 64 + fr, col0 = u.pn * 256 + wc * 32 + 8 * fq;
#pragma unroll
    for (int ai = 0; ai < 2; ++ai)
#pragma unroll
      for (int m = 0; m < 4; ++m) {
        u16* rowp = O + (size_t)(row0 + ai * 128 + m * 16) * ldc + col0;
#pragma unroll
        for (int bj = 0; bj < 2; ++bj) {
          pg8::f32x4 v0 = acc[ai][bj][m][0], v1 = acc[ai][bj][m][1];
#pragma unroll
          for (int j = 0; j < 4; ++j) {
            if (ACT == 1) { v0[j] = sigmoidf_(v0[j]); v1[j] = sigmoidf_(v1[j]); }
            else if (ACT == 2) { const float a = fmaxf(v0[j], 0.f), b = fmaxf(v1[j], 0.f); v0[j] = a * a; v1[j] = b * b; }
          }
          *(uint4*)(rowp + bj * 128) = pack8_bf16(v0, v1);
        }
      }
  }
};
struct EpiResid {
  static constexpr bool PERM = false, AFTER_DRAIN = false;
  const float* xs; const float* cs; float* xo; float* co; const float* gbase;
  DI void operator()(const pg8::f32x4 (&acc)[2][2][4][2], const pg8::Unit& u, int wr, int wc, int fr, int fq) const {
    const int rowt = u.pm * 256;
    const int row0 = rowt + wr * 64 + fr, col0 = u.pn * 256 + wc * 32 + 4 * fq;
    const bool lat = rowt < ML;
    const int mrow = lat ? (rowt >> 13) : 8;
    const float* gate = gbase + (size_t)mrow * 6144;
    const float* src = lat ? xs : cs - (size_t)ML * 1024;
    float* dst = lat ? xo : co - (size_t)ML * 1024;
    pg8::f32x4 gv[2][2];
#pragma unroll
    for (int bj = 0; bj < 2; ++bj)
#pragma unroll
      for (int n = 0; n < 2; ++n) gv[bj][n] = *(const pg8::f32x4*)(gate + col0 + bj * 128 + n * 16);
#pragma unroll
    for (int ai = 0; ai < 2; ++ai)
#pragma unroll
      for (int m = 0; m < 4; ++m) {
        const size_t off = (size_t)(row0 + ai * 128 + m * 16) * 1024 + col0;
#pragma unroll
        for (int bj = 0; bj < 2; ++bj)
#pragma unroll
          for (int n = 0; n < 2; ++n) {
            const pg8::f32x4 xv = *(const pg8::f32x4*)(src + off + bj * 128 + n * 16);
            *(pg8::f32x4*)(dst + off + bj * 128 + n * 16) = xv + gv[bj][n] * acc[ai][bj][m][n];
          }
      }
  }
};
template <class Epi>
DI void run_gemm256(const u16* A, const u16* Bt, int M, int N, int K, const Epi& E, char* lds, int lda = 0) {
  pg8::Gemm g; g.A = A; g.Bt = Bt; g.M = M; g.N = N; g.K = K; g.lda = lda ? lda : K;
  pg8::StaticOrder S; S.init(M, N, (int)gridDim.x, lbid());
  pg8::gemm_phase<Epi, pg8::StaticOrder, false>((PG8_LAS unsigned char*)lds, g, S, E, nullptr);
  __syncthreads();
}

DI void conv_job(const float* __restrict__ src, int ld, int K, int col0, int nvalid, int npad, u16* __restrict__ dst,
                 int& off, float* ts) {
  const int tid = ltid();
  const int tk = K >> 6, tn = npad >> 6, ntiles = tk * tn;
  const int G = gridDim.x;
  int first = ((int)lbid() - (off % G) + G) % G;
  for (int tile = first; tile < ntiles; tile += G) {
    const int k0 = (tile % tk) * 64, n0 = (tile / tk) * 64;
    {
      const int cc = tid & 63, rg = tid >> 6;
      const bool ok = (n0 + cc) < nvalid;
#pragma unroll
      for (int i = 0; i < 8; ++i) {
        const int rr = rg * 8 + i;
        ts[rr * 65 + cc] = ok ? src[(size_t)(k0 + rr) * ld + col0 + n0 + cc] : 0.f;
      }
    }
    __syncthreads();
    {
      const int kk = tid & 63, ng = tid >> 6;
#pragma unroll
      for (int i = 0; i < 8; ++i) {
        const int nn = ng * 8 + i;
        dst[(size_t)(n0 + nn) * K + k0 + kk] = f2bf(ts[kk * 65 + nn]);
      }
    }
    __syncthreads();
  }
  off += ntiles;
}

DI void phase0(const Params& p, char* ldsc) {
  float* ldsf = (float*)ldsc;
  const int tid = ltid();
  const int G = gridDim.x;
  int off = 0;
  for (int l = 0; l < 4; ++l) {
    u16* wl = (u16*)(p.ws + OFF_W) + (size_t)l * W_LAYER;
    conv_job(p.w_in + (size_t)l * 1024 * NIN, NIN, 1024, 0, 2976, 3072, wl + WO_T1, off, ldsf);
    conv_job(p.w_in + (size_t)l * 1024 * NIN, NIN, 1024, 2976, 3072, 3072, wl + WO_TG, off, ldsf);
    conv_job(p.w_q_b + (size_t)l * 384 * 768, 768, 384, 0, 768, 768, wl + WO_QB, off, ldsf);
    conv_job(p.w_kv_b + (size_t)l * 256 * 1024, 1024, 256, 0, 1024, 1024, wl + WO_KVB, off, ldsf);
    for (int nb = 0; nb < 3; ++nb)
      conv_job(p.w_branch + (size_t)(l * 3 + nb) * 512 * 1024, 1024, 512, 0, 1024, 1024, wl + WO_BR + (size_t)nb * 1024 * 512, off, ldsf);
    conv_job(p.w_out + (size_t)l * 1024 * 1024, 1024, 1024, 0, 1024, 1024, wl + WO_OUT, off, ldsf);
    conv_job(p.w_mlp1 + (size_t)l * 1024 * 4096, 4096, 1024, 0, 4096, 4096, wl + WO_W1, off, ldsf);
    conv_job(p.w_mlp2 + (size_t)l * 4096 * 1024, 1024, 4096, 0, 1024, 1024, wl + WO_W2, off, ldsf);
  }
  {
    float* sc = ldsf;
    float* red = ldsf + 9 * 1024;
    for (int i = tid; i < 9 * 1024; i += 512) {
      float v = (i < 8 * 1024) ? p.c[i] : p.c_ctx[i - 8 * 1024];
      sc[i] = v / (1.0f + expf(-v));
    }
    __syncthreads();
    float* mods = (float*)(p.ws + OFF_MODS);
    const int ol = tid & 63, kg = tid >> 6;
    for (int item = lbid(); item < 384; item += G) {
      const int l = item / 96, o = (item % 96) * 64 + ol;
      const float* wp = p.w_mod + (size_t)l * 1024 * 6144 + o;
      float acc[9];
#pragma unroll
      for (int b = 0; b < 9; ++b) acc[b] = 0.f;
#pragma unroll 4
      for (int k = kg * 128; k < kg * 128 + 128; ++k) {
        const float wv = wp[(size_t)k * 6144];
#pragma unroll
        for (int b = 0; b < 9; ++b) acc[b] += sc[b * 1024 + k] * wv;
      }
#pragma unroll
      for (int b = 0; b < 9; ++b) red[(kg * 9 + b) * 64 + ol] = acc[b];
      __syncthreads();
      for (int i = tid; i < 576; i += 512) {
        const int b = i >> 6, o2 = i & 63;
        float s = 0.f;
#pragma unroll
        for (int g = 0; g < 8; ++g) s += red[(g * 9 + b) * 64 + o2];
        const int oc = (item % 96) * 64 + o2;
        mods[(size_t)(l * 9 + b) * 6144 + oc] = s + p.b_mod[l * 6144 + oc];
      }
      __syncthreads();
    }
  }
  {
    const int gt = lbid() * 512 + tid, GT = G * 512;
    float* rg = (float*)(p.ws + OFF_ROPEG);
    float* rm = (float*)(p.ws + OFF_ROPEM);
    float* tw = (float*)(p.ws + OFF_TW);
    for (int i = gt; i < LSEQ * 32; i += GT) {
      const int t = i >> 5, a = i & 31;
      const float pos = (a < 16) ? (float)(t >> 6) : (float)(t & 63);
      const float inv = powf(10000.0f, -(float)(a & 15) / 16.0f);
      const float ang = pos * inv;
      rg[2 * i] = cosf(ang);
      rg[2 * i + 1] = sinf(ang);
    }
    for (int i = gt; i < LSEQ * 16; i += GT) {
      const int t = i >> 4, a = i & 15;
      const float pos = (a < 8) ? (float)(t >> 6) : (float)(t & 63);
      const float inv = powf(10000.0f, -(float)(a & 7) / 8.0f);
      const float ang = pos * inv;
      rm[2 * i] = cosf(ang);
      rm[2 * i + 1] = sinf(ang);
    }
    for (int i = gt; i < FFTN; i += GT) {
      float sn, cs;
      sincospif(2.0f * (float)i / (float)FFTN, &sn, &cs);
      tw[2 * i] = cs;
      tw[2 * i + 1] = -sn;
    }
  }
}

DI void phase_rownorm(const Params& p, int l, int which, int nrows) {
  const int tid = ltid(), lane = tid & 63, w = tid >> 6;
  u16* hn = (u16*)(p.ws + OFF_A);
  const float* g = (which ? p.norm_mlp_g : p.norm_mix_g) + l * 1024;
  const bool first = (which == 0 && l == 0);
  const float* xs = first ? p.x : p.out;
  const float* cs = first ? p.ctx : (const float*)(p.ws + OFF_CTX);
  const int stride = gridDim.x * 8;
  float4 gg_[4];
#pragma unroll
  for (int i = 0; i < 4; ++i) gg_[i] = *(const float4*)(g + 4 * (lane + 64 * i));
  for (int r = lbid() * 8 + w; r < nrows; r += 2 * stride) {
    int rr[2]; rr[0] = r; rr[1] = r + stride;
    const bool has2 = rr[1] < nrows;
    if (!has2) rr[1] = r;
    rr[0] = __builtin_amdgcn_readfirstlane(rr[0]);
    rr[1] = __builtin_amdgcn_readfirstlane(rr[1]);
    float4 v[2][4];
    float ss[2] = {0.f, 0.f};
#pragma unroll
    for (int q = 0; q < 2; ++q) {
      const float* src = (rr[q] < ML) ? xs + (size_t)rr[q] * 1024 : cs + (size_t)(rr[q] - ML) * 1024;
#pragma unroll
      for (int i = 0; i < 4; ++i) v[q][i] = *(const float4*)(src + 4 * (lane + 64 * i));
    }
#pragma unroll
    for (int q = 0; q < 2; ++q) {
#pragma unroll
      for (int i = 0; i < 4; ++i) ss[q] += v[q][i].x * v[q][i].x + v[q][i].y * v[q][i].y + v[q][i].z * v[q][i].z + v[q][i].w * v[q][i].w;
      ss[q] = wave_sum(ss[q]);
    }
#pragma unroll
    for (int q = 0; q < 2; ++q) {
      if (q == 1 && !has2) break;
      const int mrow = (rr[q] < ML) ? (rr[q] >> 13) : 8;
      const float* shift = mods_ptr(p, l, mrow, which ? 3 : 0);
      const float* scale = mods_ptr(p, l, mrow, which ? 4 : 1);
      const float rstd = rsqrtf(ss[q] * (1.0f / 1024.0f) + EPSV);
#pragma unroll
      for (int i = 0; i < 4; ++i) {
        const int c0 = 4 * (lane + 64 * i);
        const float4 gg = gg_[i], sh = *(const float4*)(shift + c0), sc = *(const float4*)(scale + c0);
        const float o0 = v[q][i].x * rstd * gg.x * (1.f + sc.x) + sh.x;
        const float o1 = v[q][i].y * rstd * gg.y * (1.f + sc.y) + sh.y;
        const float o2 = v[q][i].z * rstd * gg.z * (1.f + sc.z) + sh.z;
        const float o3 = v[q][i].w * rstd * gg.w * (1.f + sc.w) + sh.w;
        uint2 pk;
        pk.x = pk2(o0, o1);
        pk.y = pk2(o2, o3);
        *(uint2*)(hn + (size_t)rr[q] * 1024 + c0) = pk;
      }
    }
  }
}

DI void filter_tiles(const Params& p, int l, int Lf, int cstride, float* __restrict__ kdst, float* __restrict__ part, float* lds) {
  const int tid = ltid(), lane = tid & 63, w = tid >> 6;
  float* zs = lds;
  float* h1s = lds + 64 * 33;
  float* h2s = h1s + 64 * 65;
  float* w3s = h2s + 64 * 65;
  const float* f1w = p.hy_f1_w + l * 33 * 64;
  const float* f1b = p.hy_f1_b + l * 64;
  const float* f2w = p.hy_f2_w + l * 64 * 64;
  const float* f2b = p.hy_f2_b + l * 64;
  const float* sf = p.hy_sin_freq + l * 128;
  const float* f3w = p.hy_f3_w + (size_t)l * 64 * 1024;
  const int nitem = (Lf >> 6) * 4;
  const float min_decay = logf(1e-2f) / 1.5f, max_decay = logf(1e-2f) / 0.3f;
  for (int item = lbid(); item < nitem; item += gridDim.x) {
    const int tile = item >> 2, quarter = item & 3;
    const int t0 = tile * 64;
    for (int idx = tid; idx < 64 * 33; idx += 512) {
      const int tt = idx / 33, e = idx - tt * 33;
      const int t = t0 + tt;
      float val;
      if (e == 0) {
        val = (float)t / (float)(Lf - 1);
      } else {
        const float wt = 6.283185307179586f * (float)t / (float)Lf;
        const int bi = (e - 1) & 15;
        const float f = 1e-4f + (float)bi * ((15.0f - 1e-4f) / 15.0f);
        val = (e <= 16) ? cosf(f * wt) : -sinf(f * wt);
      }
      zs[idx] = val;
    }
    for (int idx = tid; idx < 64 * 64; idx += 512) {
      const int i = idx >> 6, c4 = (idx & 63) * 4;
      *(float4*)(w3s + i * 256 + c4) = *(const float4*)(f3w + i * 1024 + quarter * 256 + c4);
    }
    __syncthreads();
    {
      const int tt = tid & 63, jg = tid >> 6;
#pragma unroll 1
      for (int jj = 0; jj < 8; ++jj) {
        const int j = jg * 8 + jj;
        float a = f1b[j];
#pragma unroll 3
        for (int e = 0; e < 33; ++e) a += zs[tt * 33 + e] * f1w[e * 64 + j];
        h1s[tt * 65 + j] = sinf(sf[j] * a);
      }
    }
    __syncthreads();
    {
      const int tt = tid & 63, jg = tid >> 6;
#pragma unroll 1
      for (int jj = 0; jj < 8; ++jj) {
        const int j = jg * 8 + jj;
        float a = f2b[j];
#pragma unroll 4
        for (int e = 0; e < 64; ++e) a += h1s[tt * 65 + e] * f2w[e * 64 + j];
        h2s[tt * 65 + j] = sinf(sf[64 + j] * a);
      }
    }
    __syncthreads();
    {
      const int tt = lane, t = t0 + tt;
      const float tn = (float)t / (float)(Lf - 1);
#pragma unroll 1
      for (int ob = w * 32; ob < w * 32 + 32; ob += 16) {
        float acc[16];
#pragma unroll
        for (int q = 0; q < 16; ++q) acc[q] = 0.f;
#pragma unroll 4
        for (int i = 0; i < 64; ++i) {
          const float hv = h2s[tt * 65 + i];
          const float* wr = w3s + i * 256 + ob;
#pragma unroll
          for (int q4 = 0; q4 < 4; ++q4) {
            const float4 wv = *(const float4*)(wr + 4 * q4);
            acc[4 * q4] += hv * wv.x; acc[4 * q4 + 1] += hv * wv.y; acc[4 * q4 + 2] += hv * wv.z; acc[4 * q4 + 3] += hv * wv.w;
          }
        }
#pragma unroll
        for (int q = 0; q < 16; ++q) {
          const int o = quarter * 256 + ob + q, dir = o >> 9, c = o & 511;
          const float delta = fabsf(min_decay + (float)c * ((max_decay - min_decay) / 511.0f));
          float val = acc[q] * expf(-tn * delta);
          int pos;
          if (dir == 0) pos = t;
          else if (t == 0) { pos = Lf; val = 0.f; }
          else pos = 2 * Lf - t;
          kdst[(size_t)c * cstride + pos] = val;
          const float s2 = wave_sum(val * val);
          if (lane == 0) part[tile * 1024 + o] = s2;
        }
      }
    }
    __syncthreads();
  }
}

DI int fsw(int i) { return (i & ~15) | ((((i >> 2) + (i >> 6)) & 3) << 2) | (i & 3); }

DI void r16_fwd(float (&xr)[16], float (&xi)[16]) {
#pragma unroll
  for (int st = 0; st < 2; ++st) {
    const int q = (st == 0) ? 4 : 1;
#pragma unroll
    for (int bi = 0; bi < 4; ++bi) {
      const int j = bi & (q - 1), g = bi / q;
      const int i0 = g * 4 * q + j, i1 = i0 + q, i2 = i1 + q, i3 = i2 + q;
      const float ar = xr[i0], ai = xi[i0], br = xr[i1], bi_ = xi[i1], cr = xr[i2], ci = xi[i2], dr = xr[i3], di = xi[i3];
      const float t0r = ar + cr, t0i = ai + ci, t1r = ar - cr, t1i = ai - ci;
      const float t2r = br + dr, t2i = bi_ + di;
      const float er = br - dr, ei = bi_ - di;
      const float t3r = ei, t3i = -er;
      const float y1r = t1r + t3r, y1i = t1i + t3i, y2r = t0r - t2r, y2i = t0i - t2i, y3r = t1r - t3r, y3i = t1i - t3i;
      xr[i0] = t0r + t2r; xi[i0] = t0i + t2i;
      if (q == 1 || j == 0) {
        xr[i1] = y1r; xi[i1] = y1i; xr[i2] = y2r; xi[i2] = y2i; xr[i3] = y3r; xi[i3] = y3i;
      } else {
        const float ang = -6.283185307179586f * (float)j / (float)(4 * q);
        const float w1r = __builtin_cosf(ang), w1i = __builtin_sinf(ang);
        const float w2r = __builtin_cosf(2.f * ang), w2i = __builtin_sinf(2.f * ang);
        const float w3r = __builtin_cosf(3.f * ang), w3i = __builtin_sinf(3.f * ang);
        xr[i1] = y1r * w1r - y1i * w1i; xi[i1] = y1r * w1i + y1i * w1r;
        xr[i2] = y2r * w2r - y2i * w2i; xi[i2] = y2r * w2i + y2i * w2r;
        xr[i3] = y3r * w3r - y3i * w3i; xi[i3] = y3r * w3i + y3i * w3r;
      }
    }
  }
}
DI void r16_inv(float (&xr)[16], float (&xi)[16]) {
#pragma unroll
  for (int st = 0; st < 2; ++st) {
    const int q = (st == 0) ? 1 : 4;
#pragma unroll
    for (int bi = 0; bi < 4; ++bi) {
      const int j = bi & (q - 1), g = bi / q;
      const int i0 = g * 4 * q + j, i1 = i0 + q, i2 = i1 + q, i3 = i2 + q;
      const float ar = xr[i0], ai = xi[i0];
      float br = xr[i1], bi_ = xi[i1], cr = xr[i2], ci = xi[i2], dr = xr[i3], di = xi[i3];
      if (!(q == 1 || j == 0)) {
        const float ang = 6.283185307179586f * (float)j / (float)(4 * q);
        const float w1r = __builtin_cosf(ang), w1i = __builtin_sinf(ang);
        const float w2r = __builtin_cosf(2.f * ang), w2i = __builtin_sinf(2.f * ang);
        const float w3r = __builtin_cosf(3.f * ang), w3i = __builtin_sinf(3.f * ang);
        const float b0 = br, c0 = cr, d0 = dr;
        br = b0 * w1r - bi_ * w1i; bi_ = b0 * w1i + bi_ * w1r;
        cr = c0 * w2r - ci * w2i;  ci = c0 * w2i + ci * w2r;
        dr = d0 * w3r - di * w3i;  di = d0 * w3i + di * w3r;
      }
      const float t0r = ar + cr, t0i = ai + ci, t1r = ar - cr, t1i = ai - ci;
      const float t2r = br + dr, t2i = bi_ + di;
      const float er = br - dr, ei = bi_ - di;
      const float t3r = -ei, t3i = er;
      xr[i0] = t0r + t2r; xi[i0] = t0i + t2i;
      xr[i1] = t1r + t3r; xi[i1] = t1i + t3i;
      xr[i2] = t0r - t2r; xi[i2] = t0i - t2i;
      xr[i3] = t1r - t3r; xi[i3] = t1i - t3i;
    }
  }
}

template <bool INV>
DI void fft_lds_stage(float* re, float* im, const float2* __restrict__ tw, const int s) {
  const int tid = ltid();
  const int qs = 12 - 2 * s;
  const int q = 1 << qs;
  float2 wb = tw[(tid & (q - 1)) << (2 * s)];
  if (INV) wb.y = -wb.y;
  float vr[8][4], vi[8][4];
  int idx[8][4];
#pragma unroll
  for (int k = 0; k < 8; ++k) {
    const int bi = tid + 512 * k;
    const int j = bi & (q - 1), g = bi >> qs;
    const int l0 = (g << (qs + 2)) + j;
#pragma unroll
    for (int m = 0; m < 4; ++m) { idx[k][m] = fsw(l0 + m * q); vr[k][m] = re[idx[k][m]]; vi[k][m] = im[idx[k][m]]; }
  }
#pragma unroll
  for (int k = 0; k < 8; ++k) {
    const int delta = (512 * k) & (q - 1);
    const float ang = (INV ? 6.283185307179586f : -6.283185307179586f) * (float)(delta << (2 * s)) / 16384.0f;
    const float cr_ = __builtin_cosf(ang), ci_ = __builtin_sinf(ang);
    const float w1r = (delta == 0) ? wb.x : wb.x * cr_ - wb.y * ci_;
    const float w1i = (delta == 0) ? wb.y : wb.x * ci_ + wb.y * cr_;
    const float w2r = w1r * w1r - w1i * w1i, w2i = 2.f * w1r * w1i;
    const float w3r = w2r * w1r - w2i * w1i, w3i = w2r * w1i + w2i * w1r;
    if (!INV) {
      const float ar = vr[k][0], ai = vi[k][0], br = vr[k][1], bi_ = vi[k][1], cr = vr[k][2], ci = vi[k][2], dr = vr[k][3], di = vi[k][3];
      const float t0r = ar + cr, t0i = ai + ci, t1r = ar - cr, t1i = ai - ci;
      const float t2r = br + dr, t2i = bi_ + di;
      const float er = br - dr, ei = bi_ - di;
      const float t3r = ei, t3i = -er;
      const float y1r = t1r + t3r, y1i = t1i + t3i, y2r = t0r - t2r, y2i = t0i - t2i, y3r = t1r - t3r, y3i = t1i - t3i;
      re[idx[k][0]] = t0r + t2r; im[idx[k][0]] = t0i + t2i;
      re[idx[k][1]] = y1r * w1r - y1i * w1i; im[idx[k][1]] = y1r * w1i + y1i * w1r;
      re[idx[k][2]] = y2r * w2r - y2i * w2i; im[idx[k][2]] = y2r * w2i + y2i * w2r;
      re[idx[k][3]] = y3r * w3r - y3i * w3i; im[idx[k][3]] = y3r * w3i + y3i * w3r;
    } else {
      const float ar = vr[k][0], ai = vi[k][0];
      const float br = vr[k][1] * w1r - vi[k][1] * w1i, bi_ = vr[k][1] * w1i + vi[k][1] * w1r;
      const float cr = vr[k][2] * w2r - vi[k][2] * w2i, ci = vr[k][2] * w2i + vi[k][2] * w2r;
      const float dr = vr[k][3] * w3r - vi[k][3] * w3i, di = vr[k][3] * w3i + vi[k][3] * w3r;
      const float t0r = ar + cr, t0i = ai + ci, t1r = ar - cr, t1i = ai - ci;
      const float t2r = br + dr, t2i = bi_ + di;
      const float er = br - dr, ei = bi_ - di;
      const float t3r = -ei, t3i = er;
      re[idx[k][0]] = t0r + t2r; im[idx[k][0]] = t0i + t2i;
      re[idx[k][1]] = t1r + t3r; im[idx[k][1]] = t1i + t3i;
      re[idx[k][2]] = t0r - t2r; im[idx[k][2]] = t0i - t2i;
      re[idx[k][3]] = t1r - t3r; im[idx[k][3]] = t1i - t3i;
    }
  }
  __syncthreads();
}
DI void fft_fwd4(float* re, float* im, const float2* __restrict__ tw) {
  fft_lds_stage<false>(re, im, tw, 0);
  fft_lds_stage<false>(re, im, tw, 1);
  fft_lds_stage<false>(re, im, tw, 2);
  fft_lds_stage<false>(re, im, tw, 3);
  fft_lds_stage<false>(re, im, tw, 4);
}
DI void fft_inv4(float* re, float* im, const float2* __restrict__ tw) {
  fft_lds_stage<true>(re, im, tw, 4);
  fft_lds_stage<true>(re, im, tw, 3);
  fft_lds_stage<true>(re, im, tw, 2);
  fft_lds_stage<true>(re, im, tw, 1);
  fft_lds_stage<true>(re, im, tw, 0);
}
DI void r16_load(const float* re, const float* im, int b, float (&xr)[16], float (&xi)[16]) {
#pragma unroll
  for (int c = 0; c < 4; ++c) {
    const int ph = 16 * b + 4 * ((c + (b >> 2)) & 3);
    const float4 vr = *(const float4*)(re + ph), vi = *(const float4*)(im + ph);
    xr[4 * c] = vr.x; xr[4 * c + 1] = vr.y; xr[4 * c + 2] = vr.z; xr[4 * c + 3] = vr.w;
    xi[4 * c] = vi.x; xi[4 * c + 1] = vi.y; xi[4 * c + 2] = vi.z; xi[4 * c + 3] = vi.w;
  }
}
DI void r16_store(float* re, float* im, int b, const float (&xr)[16], const float (&xi)[16]) {
#pragma unroll
  for (int c = 0; c < 4; ++c) {
    const int ph = 16 * b + 4 * ((c + (b >> 2)) & 3);
    *(float4*)(re + ph) = make_float4(xr[4 * c], xr[4 * c + 1], xr[4 * c + 2], xr[4 * c + 3]);
    *(float4*)(im + ph) = make_float4(xi[4 * c], xi[4 * c + 1], xi[4 * c + 2], xi[4 * c + 3]);
  }
}

DI void phase_filter_fft(const Params& p, int l, float* lds) {
  const int tid = ltid();
  float* re = lds;
  float* im = lds + FFTN;
  float* kf = (float*)(p.ws + OFF_KF);
  const float2* tw = (const float2*)(p.ws + OFF_TW);
  const float* part = (const float*)(p.ws + OFF_PART);
  for (int c = lbid(); c < 512; c += gridDim.x) {
    float* slot = kf + (size_t)c * (2 * FFTN);
    float pv = 0.f;
    if (tid < 128) pv = part[tid * 1024 + c] + part[tid * 1024 + 512 + c];
    pv = wave_sum(pv);
    if ((tid & 63) == 0) lds[tid >> 6] = pv;
    __syncthreads();
    const float ssq = lds[0] + lds[1];
    __syncthreads();
    const float sc = rsqrtf(ssq + EPSV) * (1.0f / (float)FFTN);
    for (int i = tid; i < FFTN; i += 512) { const int ph = fsw(i); re[ph] = slot[i] * sc; im[ph] = 0.f; }
    __syncthreads();
    fft_fwd4(re, im, tw);
    {
      float2* so = (float2*)slot;
#pragma unroll 1
      for (int b = tid; b < 1024; b += 512) {
        float xr[16], xi[16];
        r16_load(re, im, b, xr, xi);
        r16_fwd(xr, xi);
#pragma unroll
        for (int e = 0; e < 16; ++e) { float2 v; v.x = xr[e]; v.y = xi[e]; so[e * 1024 + b] = v; }
      }
    }
    __syncthreads();
  }
}

DI void phase_gemm1(const Params& p, int l, u16* lds) {
  const u16* hn = (const u16*)(p.ws + OFF_A);
  const u16* wt = (const u16*)(p.ws + OFF_W) + (size_t)l * W_LAYER + WO_T1;
  const int NT = 24, nitems = (MALL / 256) * NT;
  for (int it_ = lbid(); it_ < ((nitems + 255) & ~255); it_ += gridDim.x) {
    const int item = xcd_remap(it_);
    if (item >= nitems) continue;
    const int mt = item / NT, nt = item % NT;
    const int m0 = mt * 256, n0 = nt * 128;
    f32x16 acc[2][2];
    ACC_ZERO(acc);
    gemm_mainloop(hn + (size_t)m0 * 1024, 1024, wt + (size_t)n0 * 1024, 1024, 1024, acc, lds);
    u16* dst; int ld, cofs;
    if (nt < 4) { dst = (u16*)(p.ws + OFF_B); ld = 512; cofs = 0; }
    else if (nt < 12) { dst = (u16*)(p.ws + OFF_C); ld = 1024; cofs = 512; }
    else { dst = (u16*)(p.ws + OFF_R); ld = 1536; cofs = 1536; }
    stage_store_bf16(acc, dst, ld, m0, n0 - cofs, lds);
  }
}

DI void phase_h1(const Params& p, int l, float* lds) {
  const int tid = ltid();
  const u16* U12 = (const u16*)(p.ws + OFF_C);
  float* zT = (float*)(p.ws + OFF_A);
  const float* sw = p.hy_short_w + l * 3 * 1536;
  const int nlat = 8 * 128 * 8, nctx = (l < 3) ? 8 * 4 * 8 : 0;
  int par = 0;
  float wx[8][3], wv[8][3];
  {
    const int cb = (lbid() & 7) * 64 + (tid >> 6) * 8;
#pragma unroll
    for (int i = 0; i < 8; ++i)
#pragma unroll
      for (int j = 0; j < 3; ++j) { wx[i][j] = sw[j * 1536 + 512 + cb + i]; wv[i][j] = sw[j * 1536 + 1024 + cb + i]; }
  }
  for (int item = lbid(); item < nlat + nctx; item += gridDim.x) {
    float* xs = lds + par * (2 * 66 * 65);
    float* vs = xs + 66 * 65;
    par ^= 1;
    int b, tt0, c0, Ls, rowbase; size_t zbase;
    if (item < nlat) { b = item >> 10; tt0 = ((item >> 3) & 127) * 64; c0 = (item & 7) * 64; Ls = LSEQ; rowbase = b * LSEQ; zbase = (size_t)b * 512 * LSEQ; }
    else { const int it = item - nlat; b = it >> 5; tt0 = ((it >> 3) & 3) * 64; c0 = (it & 7) * 64; Ls = LCTX; rowbase = ML + b * LCTX; zbase = (size_t)ZC_OFF + (size_t)b * 512 * LCTX; }
    for (int ch = tid; ch < 66 * 16; ch += 512) {
      const int arr = ch / 528, rem = ch - arr * 528;
      const int rr = rem >> 3, cc8 = (rem & 7) * 8;
      const int t = tt0 - 1 + rr;
      float* dstp = (arr ? vs : xs) + rr * 65 + cc8;
      if (t >= 0 && t < Ls) {
        const uint4 v = *(const uint4*)(U12 + (size_t)(rowbase + t) * 1024 + arr * 512 + c0 + cc8);
        const unsigned uu[4] = {v.x, v.y, v.z, v.w};
#pragma unroll
        for (int i = 0; i < 4; ++i) { dstp[2 * i] = __uint_as_float(uu[i] << 16); dstp[2 * i + 1] = __uint_as_float(uu[i] & 0xffff0000u); }
      } else {
#pragma unroll
        for (int i = 0; i < 8; ++i) dstp[i] = 0.f;
      }
    }
    __syncthreads();
    {
      const int tt = tid & 63, cgp = tid >> 6;
#pragma unroll
      for (int i = 0; i < 8; ++i) {
        const int cc = cgp * 8 + i, c = c0 + cc;
        float x1 = 0.f, vv = 0.f;
#pragma unroll
        for (int j = 0; j < 3; ++j) {
          x1 += wx[i][j] * xs[(tt + j) * 65 + cc];
          vv += wv[i][j] * vs[(tt + j) * 65 + cc];
        }
        zT[zbase + (size_t)c * Ls + tt0 + tt] = x1 * vv;
      }
    }
  }
  __syncthreads();
}

DI void phase_p3(const Params& p, int l, float* lds) {
  const int tid = ltid(), lane = tid & 63, w = tid >> 6;
  u16* R = (u16*)(p.ws + OFF_R);
  const float* ropeg = (const float*)(p.ws + OFF_ROPEG);
  const float qscale = 0.125f * LOG2E;
  const int hq = lane >> 3, j = lane & 7;
  float gq[8], gk[8], ga[6], gv[4];
#pragma unroll
  for (int i = 0; i < 8; ++i) { gq[i] = p.gqa_q_norm[l * 64 + 8 * j + i]; gk[i] = p.gqa_k_norm[l * 64 + 8 * j + i]; }
#pragma unroll
  for (int i = 0; i < 6; ++i) ga[i] = p.mla_q_a_norm[l * 384 + 6 * lane + i];
#pragma unroll
  for (int i = 0; i < 4; ++i) gv[i] = p.mla_kv_a_norm[l * 256 + 4 * lane + i];
  const float sgn = (j < 4) ? -1.f : 1.f;
  for (int r = lbid() * 8 + w; r < MALL; r += gridDim.x * 8) {
    u16* rowp = R + (size_t)r * 1536;
    const bool lat = r < ML;
    const int t = r & (LSEQ - 1);
    const uint4 qv = *(const uint4*)(rowp + hq * 64 + 8 * j);
    const uint4 kv = *(const uint4*)(rowp + 512 + (hq & 1) * 64 + 8 * j);
    const unsigned c0 = *(const unsigned*)(rowp + 768 + 6 * lane), c1 = *(const unsigned*)(rowp + 768 + 6 * lane + 2),
                   c2 = *(const unsigned*)(rowp + 768 + 6 * lane + 4);
    const uint2 dv = *(const uint2*)(rowp + 1152 + 4 * lane);
    float cs[8], sn[8];
    {
      const float4* rp = (const float4*)(ropeg + ((size_t)t * 32 + 8 * (j & 3)) * 2);
#pragma unroll
      for (int i = 0; i < 4; ++i) {
        const float4 v = rp[i];
        cs[2 * i] = lat ? v.x : 1.f; sn[2 * i] = lat ? v.y * sgn : 0.f;
        cs[2 * i + 1] = lat ? v.z : 1.f; sn[2 * i + 1] = lat ? v.w * sgn : 0.f;
      }
    }
    float q[8], k[8];
    {
      const unsigned qu[4] = {qv.x, qv.y, qv.z, qv.w}, ku[4] = {kv.x, kv.y, kv.z, kv.w};
#pragma unroll
      for (int i = 0; i < 4; ++i) {
        q[2 * i] = __uint_as_float(qu[i] << 16); q[2 * i + 1] = __uint_as_float(qu[i] & 0xffff0000u);
        k[2 * i] = __uint_as_float(ku[i] << 16); k[2 * i + 1] = __uint_as_float(ku[i] & 0xffff0000u);
      }
    }
    float sq = 0.f, sk = 0.f;
#pragma unroll
    for (int i = 0; i < 8; ++i) { sq += q[i] * q[i]; sk += k[i] * k[i]; }
    sq += __shfl_xor(sq, 1); sq += __shfl_xor(sq, 2); sq += __shfl_xor(sq, 4);
    sk += __shfl_xor(sk, 1); sk += __shfl_xor(sk, 2); sk += __shfl_xor(sk, 4);
    const float rq = rsqrtf(sq * (1.0f / 64.0f) + EPSV) * qscale, rk = rsqrtf(sk * (1.0f / 64.0f) + EPSV);
#pragma unroll
    for (int i = 0; i < 8; ++i) { q[i] *= rq * gq[i]; k[i] *= rk * gk[i]; }
    float qp[8], kp[8];
#pragma unroll
    for (int i = 0; i < 8; ++i) { qp[i] = __shfl_xor(q[i], 4); kp[i] = __shfl_xor(k[i], 4); }
#pragma unroll
    for (int i = 0; i < 8; ++i) { q[i] = q[i] * cs[i] + qp[i] * sn[i]; k[i] = k[i] * cs[i] + kp[i] * sn[i]; }
    float a[6], d[4];
    a[0] = __uint_as_float(c0 << 16); a[1] = __uint_as_float(c0 & 0xffff0000u);
    a[2] = __uint_as_float(c1 << 16); a[3] = __uint_as_float(c1 & 0xffff0000u);
    a[4] = __uint_as_float(c2 << 16); a[5] = __uint_as_float(c2 & 0xffff0000u);
    d[0] = __uint_as_float(dv.x << 16); d[1] = __uint_as_float(dv.x & 0xffff0000u);
    d[2] = __uint_as_float(dv.y << 16); d[3] = __uint_as_float(dv.y & 0xffff0000u);
    float s3 = 0.f, s4 = 0.f;
#pragma unroll
    for (int i = 0; i < 6; ++i) s3 += a[i] * a[i];
#pragma unroll
    for (int i = 0; i < 4; ++i) s4 += d[i] * d[i];
    s3 = wave_sum(s3); s4 = wave_sum(s4);
    const float r3 = rsqrtf(s3 * (1.0f / 384.0f) + EPSV), r4 = rsqrtf(s4 * (1.0f / 256.0f) + EPSV);
    {
      uint4 o;
      o.x = pk2(q[0], q[1]); o.y = pk2(q[2], q[3]); o.z = pk2(q[4], q[5]); o.w = pk2(q[6], q[7]);
      *(uint4*)(rowp + hq * 64 + 8 * j) = o;
      if (lane < 16) {
        o.x = pk2(k[0], k[1]); o.y = pk2(k[2], k[3]); o.z = pk2(k[4], k[5]); o.w = pk2(k[6], k[7]);
        *(uint4*)(rowp + 512 + hq * 64 + 8 * j) = o;
      }
      *(unsigned*)(rowp + 768 + 6 * lane) = pk2(a[0] * r3 * ga[0], a[1] * r3 * ga[1]);
      *(unsigned*)(rowp + 768 + 6 * lane + 2) = pk2(a[2] * r3 * ga[2], a[3] * r3 * ga[3]);
      *(unsigned*)(rowp + 768 + 6 * lane + 4) = pk2(a[4] * r3 * ga[4], a[5] * r3 * ga[5]);
      uint2 od;
      od.x = pk2(d[0] * r4 * gv[0], d[1] * r4 * gv[1]); od.y = pk2(d[2] * r4 * gv[2], d[3] * r4 * gv[3]);
      *(uint2*)(rowp + 1152 + 4 * lane) = od;
    }
  }
}

DI void phase_h2(const Params& p, int l, float* lds) {
  const int tid = ltid(), lane = tid & 63, w = tid >> 6;
  float* zT = (float*)(p.ws + OFF_A);
  const float2* kf = (const float2*)(p.ws + OFF_KF);
  const float2* tw = (const float2*)(p.ws + OFF_TW);
  const float* skip = p.hy_skip + l * 512;
  float* re = lds;
  float* im = lds + FFTN;
  float za[16], zb[16], na[16], nb_[16];
  {
    const int it0 = lbid();
    if (it0 < 2048) {
      const int c0 = it0 >> 2, bp0 = it0 & 3;
      const float* s1 = zT + ((size_t)(2 * bp0) * 512 + c0) * LSEQ;
      const float* s2 = zT + ((size_t)(2 * bp0 + 1) * 512 + c0) * LSEQ;
#pragma unroll
      for (int k = 0; k < 16; ++k) { na[k] = s1[tid + 512 * k]; nb_[k] = s2[tid + 512 * k]; }
    }
  }
  for (int item = lbid(); item < 2048; item += gridDim.x) {
    const int c = item >> 2, bp = item & 3;
    float* z1 = zT + ((size_t)(2 * bp) * 512 + c) * LSEQ;
    float* z2 = zT + ((size_t)(2 * bp + 1) * 512 + c) * LSEQ;
#pragma unroll
    for (int k = 0; k < 16; ++k) {
      const int i = tid + 512 * k;
      za[k] = na[k]; zb[k] = nb_[k];
      const int p0 = fsw(i), p1 = fsw(i + LSEQ);
      re[p0] = za[k]; im[p0] = zb[k]; re[p1] = 0.f; im[p1] = 0.f;
    }
    __syncthreads();
    fft_fwd4(re, im, tw);
    {
      const float2* kc = kf + (size_t)c * FFTN;
#pragma unroll 1
      for (int b = tid; b < 1024; b += 512) {
        float xr[16], xi[16];
        r16_load(re, im, b, xr, xi);
        r16_fwd(xr, xi);
#pragma unroll
        for (int e = 0; e < 16; ++e) {
          const float2 k = kc[e * 1024 + b];
          const float a = xr[e], b2 = xi[e];
          xr[e] = a * k.x - b2 * k.y;
          xi[e] = a * k.y + b2 * k.x;
        }
        r16_inv(xr, xi);
        r16_store(re, im, b, xr, xi);
      }
    }
    {
      const int nit = item + gridDim.x;
      if (nit < 2048) {
        const int cn = nit >> 2, bpn = nit & 3;
        const float* s1 = zT + ((size_t)(2 * bpn) * 512 + cn) * LSEQ;
        const float* s2 = zT + ((size_t)(2 * bpn + 1) * 512 + cn) * LSEQ;
#pragma unroll
        for (int k = 0; k < 16; ++k) {
          na[k] = __builtin_bit_cast(float, *(const volatile unsigned*)(s1 + tid + 512 * k));
          nb_[k] = __builtin_bit_cast(float, *(const volatile unsigned*)(s2 + tid + 512 * k));
        }
      }
    }
    __syncthreads();
    fft_inv4(re, im, tw);
    const float sk = skip[c];
#pragma unroll
    for (int k = 0; k < 16; ++k) {
      const int i = tid + 512 * k;
      const int p0 = fsw(i);
      z1[i] = re[p0] + za[k] * sk;
      z2[i] = im[p0] + zb[k] * sk;
    }
    __syncthreads();
  }
  if (l < 3) {
    const float* kcb = (const float*)(p.ws + OFF_KC);
    const float* partc = (const float*)(p.ws + OFF_PART) + 128 * 1024;
    float* zs = lds + w * 768;
    float* ks = zs + 256;
    for (int item = lbid(); item < 512; item += gridDim.x) {
      const int b = item >> 6, c = (item & 63) * 8 + w;
      float* z = zT + (size_t)ZC_OFF + ((size_t)b * 512 + c) * LCTX;
      float pv = (lane < 4) ? partc[lane * 1024 + c] + partc[lane * 1024 + 512 + c] : 0.f;
      pv = wave_sum(pv);
      const float sc = rsqrtf(pv + EPSV);
      for (int i = lane; i < 256; i += 64) zs[i] = z[i];
      for (int i = lane; i < 512; i += 64) ks[i] = kcb[c * 512 + i] * sc;
      __syncthreads();
      const float sk = skip[c];
      float acc[4] = {0.f, 0.f, 0.f, 0.f};
      for (int s = 0; s < 256; ++s) {
        const float zv = zs[s];
#pragma unroll
        for (int i = 0; i < 4; ++i) acc[i] += ks[(lane + 64 * i - s) & 511] * zv;
      }
#pragma unroll
      for (int i = 0; i < 4; ++i) z[lane + 64 * i] = acc[i] + zs[lane + 64 * i] * sk;
      __syncthreads();
    }
  }
}

DI void phase_h3(const Params& p, int l, float* lds) {
  const int tid = ltid();
  const u16* U0 = (const u16*)(p.ws + OFF_B);
  const float* zT = (const float*)(p.ws + OFF_A);
  u16* Y = (u16*)(p.ws + OFF_Y);
  const float* sw = p.hy_short_w + l * 3 * 1536;
  const int nlat = 8 * 128 * 8, nctx = (l < 3) ? 8 * 4 * 8 : 0;
  int par = 0;
  const int hc = (lbid() & 7) * 64 + (tid & 63);
  const float hw0 = sw[hc], hw1 = sw[1536 + hc], hw2 = sw[2 * 1536 + hc];
  for (int item = lbid(); item < nlat + nctx; item += gridDim.x) {
    float* xs = lds + par * (66 * 65 + 64 * 65);
    float* ys = xs + 66 * 65;
    par ^= 1;
    int b, tt0, c0, Ls, rowbase; size_t zbase;
    if (item < nlat) { b = item >> 10; tt0 = ((item >> 3) & 127) * 64; c0 = (item & 7) * 64; Ls = LSEQ; rowbase = b * LSEQ; zbase = (size_t)b * 512 * LSEQ; }
    else { const int it = item - nlat; b = it >> 5; tt0 = ((it >> 3) & 3) * 64; c0 = (it & 7) * 64; Ls = LCTX; rowbase = ML + b * LCTX; zbase = (size_t)ZC_OFF + (size_t)b * 512 * LCTX; }
    for (int ch = tid; ch < 66 * 8; ch += 512) {
      const int rr = ch >> 3, cc8 = (ch & 7) * 8;
      const int t = tt0 - 1 + rr;
      float* dstp = xs + rr * 65 + cc8;
      if (t >= 0 && t < Ls) {
        const uint4 v = *(const uint4*)(U0 + (size_t)(rowbase + t) * 512 + c0 + cc8);
        const unsigned uu[4] = {v.x, v.y, v.z, v.w};
#pragma unroll
        for (int i = 0; i < 4; ++i) { dstp[2 * i] = __uint_as_float(uu[i] << 16); dstp[2 * i + 1] = __uint_as_float(uu[i] & 0xffff0000u); }
      } else {
#pragma unroll
        for (int i = 0; i < 8; ++i) dstp[i] = 0.f;
      }
    }
    {
      const int tt = tid & 63, cgp = tid >> 6;
#pragma unroll
      for (int i = 0; i < 8; ++i) {
        const int cc = cgp * 8 + i;
        ys[cc * 65 + tt] = zT[zbase + (size_t)(c0 + cc) * Ls + tt0 + tt];
      }
    }
    __syncthreads();
    {
      const int cc = tid & 63, tg = tid >> 6, c = c0 + cc;
      const float w0 = hw0, w1 = hw1, w2 = hw2;
#pragma unroll
      for (int i = 0; i < 8; ++i) {
        const int tt = tg * 8 + i;
        const float x0 = w0 * xs[tt * 65 + cc] + w1 * xs[(tt + 1) * 65 + cc] + w2 * xs[(tt + 2) * 65 + cc];
        Y[(size_t)(rowbase + tt0 + tt) * 1536 + c] = f2bf(x0 * ys[cc * 65 + tt]);
      }
    }
  }
  __syncthreads();
}

DI void phase_p4(const Params& p, int l, u16* lds) {
  const u16* R = (const u16*)(p.ws + OFF_R);
  u16* QK = (u16*)(p.ws + OFF_A);
  const u16* wl = (const u16*)(p.ws + OFF_W) + (size_t)l * W_LAYER;
  const int NT = 14, nitems = (MALL / 256) * NT;
  for (int it_ = lbid(); it_ < ((nitems + 255) & ~255); it_ += gridDim.x) {
    const int item = xcd_remap(it_);
    if (item >= nitems) continue;
    const int mt = item / NT, nt = item % NT;
    const int m0 = mt * 256;
    f32x16 acc[2][2];
    ACC_ZERO(acc);
    int n0;
    if (nt < 6) { n0 = nt * 128; gemm_mainloop(R + (size_t)m0 * 1536 + 768, 1536, wl + WO_QB + (size_t)n0 * 384, 384, 384, acc, lds); }
    else { n0 = (nt - 6) * 128; gemm_mainloop(R + (size_t)m0 * 1536 + 1152, 1536, wl + WO_KVB + (size_t)n0 * 256, 256, 256, acc, lds); n0 += 768; }
    stage_store_bf16(acc, QK, 1792, m0, n0, lds);
  }
}

DI void phase_p5(const Params& p, int l, float* lds) {
  const int tid = ltid(), lane = tid & 63, w = tid >> 6;
  u16* QK = (u16*)(p.ws + OFF_A);
  u16* KM = (u16*)(p.ws + OFF_KM);
  const u16* R = (const u16*)(p.ws + OFF_R);
  const float* qn = p.mla_q_norm + l * 96;
  const float* kn = p.mla_k_norm + l * 96;
  const float* ropem = (const float*)(p.ws + OFF_ROPEM);
  const float qscale = 0.10206207261596575f * LOG2E;
  const bool act = lane < 48;
  const int hd = act ? lane / 6 : 0, j = act ? lane - hd * 6 : 0;
  float gq[16], gk[16];
#pragma unroll
  for (int i = 0; i < 16; ++i) { gq[i] = qn[16 * j + i]; gk[i] = kn[16 * j + i]; }
  for (int r = lbid() * 8 + w; r < MALL; r += gridDim.x * 8) {
    u16* rowp = QK + (size_t)r * 1792;
    const u16* qsrc = rowp + hd * 96 + 16 * j;
    const u16* ksrc = (j < 4) ? rowp + 768 + hd * 128 + 16 * j : R + (size_t)r * 1536 + 1408 + 16 * (j - 4);
    const uint4 qa = *(const uint4*)(qsrc), qb = *(const uint4*)(qsrc + 8);
    const uint4 ka = *(const uint4*)(ksrc), kb = *(const uint4*)(ksrc + 8);
    float q[16], k[16];
    {
      const unsigned qu[8] = {qa.x, qa.y, qa.z, qa.w, qb.x, qb.y, qb.z, qb.w};
      const unsigned ku[8] = {ka.x, ka.y, ka.z, ka.w, kb.x, kb.y, kb.z, kb.w};
#pragma unroll
      for (int i = 0; i < 8; ++i) {
        q[2 * i] = __uint_as_float(qu[i] << 16); q[2 * i + 1] = __uint_as_float(qu[i] & 0xffff0000u);
        k[2 * i] = __uint_as_float(ku[i] << 16); k[2 * i + 1] = __uint_as_float(ku[i] & 0xffff0000u);
      }
    }
    float sq = 0.f, sk = 0.f;
#pragma unroll
    for (int i = 0; i < 16; ++i) { sq += q[i] * q[i]; sk += k[i] * k[i]; }
    float tq = 0.f, tk = 0.f;
#pragma unroll
    for (int u = 0; u < 6; ++u) { tq += __shfl(sq, hd * 6 + u); tk += __shfl(sk, hd * 6 + u); }
    const float rq = rsqrtf(tq * (1.0f / 96.0f) + EPSV) * qscale, rk = rsqrtf(tk * (1.0f / 96.0f) + EPSV);
#pragma unroll
    for (int i = 0; i < 16; ++i) { q[i] *= rq * gq[i]; k[i] *= rk * gk[i]; }
    const bool lat = r < ML;
    const int t = r & (LSEQ - 1);
    const int plane = (j == 4) ? lane + 1 : lane - 1;
    const bool rot = lat && act && (j >= 4);
    const float sgn = (j == 4) ? -1.f : 1.f;
    float qp[16], kp[16];
#pragma unroll
    for (int i = 0; i < 16; ++i) { qp[i] = __shfl(q[i], plane); kp[i] = __shfl(k[i], plane); }
    const float* rp = ropem + (size_t)t * 32;
#pragma unroll
    for (int i = 0; i < 16; ++i) {
      const float cs = rot ? rp[2 * i] : 1.f, sn = rot ? rp[2 * i + 1] * sgn : 0.f;
      q[i] = q[i] * cs + qp[i] * sn;
      k[i] = k[i] * cs + kp[i] * sn;
    }
    if (act) {
      uint4 o0, o1;
      o0.x = pk2(q[0], q[1]); o0.y = pk2(q[2], q[3]); o0.z = pk2(q[4], q[5]); o0.w = pk2(q[6], q[7]);
      o1.x = pk2(q[8], q[9]); o1.y = pk2(q[10], q[11]); o1.z = pk2(q[12], q[13]); o1.w = pk2(q[14], q[15]);
      *(uint4*)(rowp + hd * 96 + 16 * j) = o0;
      *(uint4*)(rowp + hd * 96 + 16 * j + 8) = o1;
      o0.x = pk2(k[0], k[1]); o0.y = pk2(k[2], k[3]); o0.z = pk2(k[4], k[5]); o0.w = pk2(k[6], k[7]);
      o1.x = pk2(k[8], k[9]); o1.y = pk2(k[10], k[11]); o1.z = pk2(k[12], k[13]); o1.w = pk2(k[14], k[15]);
      u16* kd = KM + (size_t)r * 768 + hd * 96 + 16 * j;
      *(uint4*)(kd) = o0;
      *(uint4*)(kd + 8) = o1;
    }
  }
}

template <int DQK>
DI void attn_block(const u16* __restrict__ Qp, int q_ld, const u16* __restrict__ Kp, int k_ld, const u16* __restrict__ Vp,
                   int v_ld, u16* __restrict__ Op, int o_ld, int qrow0, int nq, int qt0, int s0_row0, int s0_n, int s0_t0,
                   int masked0, int s1_row0, int s1_n, float sink_l2, int has_sink, u16* lds) {
  constexpr int KS = DQK + 8, NS = DQK / 16, CPK = DQK / 8;
  const int tid = ltid(), lane = tid & 63, w = tid >> 6, l32 = lane & 31, hh = lane >> 5;
  u16* Ks = lds;
  u16* Vt = lds + 2 * 64 * KS;
  bf16x8 qf[2][NS];
  f32x16 ot[2][2];
  float m[2], lsum[2];
#pragma unroll
  for (int qs = 0; qs < 2; ++qs) {
    const int qi = 64 * w + 32 * qs + l32;
    const int qr = qrow0 + ((qi < nq) ? qi : nq - 1);
#pragma unroll
    for (int s = 0; s < NS; ++s) qf[qs][s] = *(const bf16x8*)(Qp + (size_t)qr * q_ld + 16 * s + 8 * hh);
#pragma unroll
    for (int i = 0; i < 16; ++i) { ot[qs][0][i] = 0.f; ot[qs][1][i] = 0.f; }
    m[qs] = -1e30f; lsum[qs] = 0.f;
  }
  const int nt0 = s0_n >> 6, nt = nt0 + (s1_n >> 6);
  const int kkey0 = tid / CPK, kch0 = tid - kkey0 * CPK;
  const int c1 = tid + 512;
  const bool has1 = c1 < 64 * CPK;
  const int kkey1 = has1 ? c1 / CPK : 0, kch1 = has1 ? c1 - kkey1 * CPK : 0;
  const int vkey = tid & 63, vch = tid >> 6;
  uint4 rk0, rk1, rv;
  rk1 = make_uint4(0, 0, 0, 0);
  {
    const int row0 = (0 < nt0) ? s0_row0 : s1_row0;
    rk0 = *(const uint4*)(Kp + (size_t)(row0 + kkey0) * k_ld + kch0 * 8);
    if (has1) rk1 = *(const uint4*)(Kp + (size_t)(row0 + kkey1) * k_ld + kch1 * 8);
    rv = *(const uint4*)(Vp + (size_t)(row0 + vkey) * v_ld + vch * 8);
  }
  {
    *(uint4*)(Ks + kkey0 * KS + kch0 * 8) = rk0;
    if (has1) *(uint4*)(Ks + kkey1 * KS + kch1 * 8) = rk1;
    const unsigned uu[4] = {rv.x, rv.y, rv.z, rv.w};
#pragma unroll
    for (int i = 0; i < 4; ++i) {
      Vt[(vch * 8 + 2 * i) * 68 + vkey] = (u16)(uu[i] & 0xffffu);
      Vt[(vch * 8 + 2 * i + 1) * 68 + vkey] = (u16)(uu[i] >> 16);
    }
  }
  __syncthreads();
  const int tql = qt0 + 64 * w;
  for (int j = 0; j < nt; ++j) {
    const int cur = j & 1;
    {
      const int jn = (j + 1 < nt) ? j + 1 : j;
      const int row0 = (jn < nt0) ? s0_row0 + 64 * jn : s1_row0 + 64 * (jn - nt0);
      rk0 = VLOAD16(Kp + (size_t)(row0 + kkey0) * k_ld + kch0 * 8);
      if (DQK == 96) rk1 = VLOAD16(Kp + (size_t)(row0 + kkey1) * k_ld + kch1 * 8);
      rv = VLOAD16(Vp + (size_t)(row0 + vkey) * v_ld + vch * 8);
    }
    __builtin_amdgcn_sched_barrier(0);
    const bool mtile = masked0 && (j < nt0);
    const int tk0 = s0_t0 + 64 * j;
    bool active = true;
    if (mtile) active = (tk0 + 63 >= tql - 128) && (tk0 <= tql + 63 + 128);
    if (active) {
      const u16* kb = Ks + cur * 64 * KS + l32 * KS + hh * 8;
      f32x16 st[2][2];
#pragma unroll
      for (int i = 0; i < 16; ++i) { st[0][0][i] = 0.f; st[0][1][i] = 0.f; st[1][0][i] = 0.f; st[1][1][i] = 0.f; }
#pragma unroll
      for (int s = 0; s < NS; ++s) {
        const bf16x8 a0 = *(const bf16x8*)(kb + s * 16);
        const bf16x8 a1 = *(const bf16x8*)(kb + 32 * KS + s * 16);
        st[0][0] = MFMA(a0, qf[0][s], st[0][0]);
        st[0][1] = MFMA(a1, qf[0][s], st[0][1]);
        st[1][0] = MFMA(a0, qf[1][s], st[1][0]);
        st[1][1] = MFMA(a1, qf[1][s], st[1][1]);
      }
#pragma unroll
      for (int qs = 0; qs < 2; ++qs) {
        if (mtile) {
          const int tq = tql + 32 * qs + l32;
#pragma unroll
          for (int kt = 0; kt < 2; ++kt)
#pragma unroll
            for (int rg = 0; rg < 16; ++rg) {
              const int tk = tk0 + 32 * kt + (rg & 3) + 8 * (rg >> 2) + 4 * hh;
              const int dlt = tk - tq;
              if (dlt > 128 || dlt < -128) st[qs][kt][rg] = -1e30f;
            }
        }
        float mloc = st[qs][0][0];
#pragma unroll
        for (int rg = 1; rg < 16; ++rg) mloc = fmaxf(mloc, st[qs][0][rg]);
#pragma unroll
        for (int rg = 0; rg < 16; ++rg) mloc = fmaxf(mloc, st[qs][1][rg]);
        mloc = fmaxf(mloc, __shfl_xor(mloc, 32));
        const bool grow = mloc > m[qs] + 8.0f;
        if (__builtin_amdgcn_ballot_w64(grow) != 0ull) {
          const float mnew = fmaxf(m[qs], mloc);
          const float alpha = __builtin_amdgcn_exp2f(m[qs] - mnew);
          m[qs] = mnew;
          lsum[qs] *= alpha;
          const f32x2_t a2 = {alpha, alpha};
#pragma unroll
          for (int i = 0; i < 8; ++i) {
            f32x2_t o0 = {ot[qs][0][2 * i], ot[qs][0][2 * i + 1]}, o1 = {ot[qs][1][2 * i], ot[qs][1][2 * i + 1]};
            o0 *= a2; o1 *= a2;
            ot[qs][0][2 * i] = o0.x; ot[qs][0][2 * i + 1] = o0.y; ot[qs][1][2 * i] = o1.x; ot[qs][1][2 * i + 1] = o1.y;
          }
        }
        const f32x2_t nm2 = {-m[qs], -m[qs]};
        f32x2_t ps2 = {0.f, 0.f};
#pragma unroll
        for (int kt = 0; kt < 2; ++kt)
#pragma unroll
          for (int rg = 0; rg < 16; rg += 2) {
            f32x2_t sv = {st[qs][kt][rg], st[qs][kt][rg + 1]};
            sv += nm2;
            float p0 = __builtin_amdgcn_exp2f(sv.x), p1 = __builtin_amdgcn_exp2f(sv.y);
            if (mtile) { p0 = (st[qs][kt][rg] < -1e29f) ? 0.f : p0; p1 = (st[qs][kt][rg + 1] < -1e29f) ? 0.f : p1; }
            st[qs][kt][rg] = p0; st[qs][kt][rg + 1] = p1;
            const f32x2_t pv = {p0, p1};
            ps2 += pv;
          }
        lsum[qs] += ps2.x + ps2.y;
        __builtin_amdgcn_sched_barrier(0);
      }
      const u16* vb = Vt + cur * 64 * 68 + l32 * 68 + 4 * hh;
#pragma unroll
      for (int kt = 0; kt < 2; ++kt)
#pragma unroll
        for (int s = 0; s < 2; ++s) {
          bf16x8 pf[2];
#pragma unroll
          for (int qs = 0; qs < 2; ++qs) {
            unsigned pw[4];
#pragma unroll
            for (int i = 0; i < 4; ++i) pw[i] = pk2(st[qs][kt][8 * s + 2 * i], st[qs][kt][8 * s + 2 * i + 1]);
            const uint4 pu = make_uint4(pw[0], pw[1], pw[2], pw[3]);
            pf[qs] = __builtin_bit_cast(bf16x8, pu);
          }
#pragma unroll
          for (int dt = 0; dt < 2; ++dt) {
            const u16* vp = vb + dt * 32 * 68 + 32 * kt + 16 * s;
            const uint2 lo = *(const uint2*)(vp);
            const uint2 hi = *(const uint2*)(vp + 8);
            const uint4 au = make_uint4(lo.x, lo.y, hi.x, hi.y);
            const bf16x8 vf = __builtin_bit_cast(bf16x8, au);
            ot[0][dt] = MFMA(vf, pf[0], ot[0][dt]);
            ot[1][dt] = MFMA(vf, pf[1], ot[1][dt]);
          }
        }
    }
    __builtin_amdgcn_sched_barrier(0);
    {
      u16* Kw = Ks + (cur ^ 1) * 64 * KS;
      u16* Vw = Vt + (cur ^ 1) * 64 * 68;
      *(uint4*)(Kw + kkey0 * KS + kch0 * 8) = rk0;
      if (has1) *(uint4*)(Kw + kkey1 * KS + kch1 * 8) = rk1;
      const unsigned uu[4] = {rv.x, rv.y, rv.z, rv.w};
#pragma unroll
      for (int i = 0; i < 4; ++i) {
        Vw[(vch * 8 + 2 * i) * 68 + vkey] = (u16)(uu[i] & 0xffffu);
        Vw[(vch * 8 + 2 * i + 1) * 68 + vkey] = (u16)(uu[i] >> 16);
      }
    }
    __syncthreads();
  }
#pragma unroll
  for (int qs = 0; qs < 2; ++qs) {
    float ltot = lsum[qs] + __shfl_xor(lsum[qs], 32);
    if (has_sink) ltot += __builtin_amdgcn_exp2f(sink_l2 - m[qs]);
    const float inv = 1.0f / ltot;
    if (64 * w + 32 * qs + l32 < nq) {
#pragma unroll
      for (int dt = 0; dt < 2; ++dt)
#pragma unroll
        for (int g = 0; g < 4; ++g) {
          uint2 pk;
          pk.x = pk2(ot[qs][dt][4 * g] * inv, ot[qs][dt][4 * g + 1] * inv);
          pk.y = pk2(ot[qs][dt][4 * g + 2] * inv, ot[qs][dt][4 * g + 3] * inv);
          *(uint2*)(Op + (size_t)(qrow0 + 64 * w + 32 * qs + l32) * o_ld + dt * 32 + 8 * g + 4 * hh) = pk;
        }
    }
  }
}

DI void phase_attn(const Params& p, int l, u16* lds) {
  const u16* R = (const u16*)(p.ws + OFF_R);
  const u16* QK = (const u16*)(p.ws + OFF_A);
  const u16* KM = (const u16*)(p.ws + OFF_KM);
  u16* Y = (u16*)(p.ws + OFF_Y);
  const float* sink = p.gqa_sink + l * 8;
  const int n_mla = 1024, n_gqa = 1024, n_ctx = (l < 3) ? 128 : 0;
  const int n_all = n_mla + n_gqa + n_ctx;
  for (int it_ = lbid(); it_ < ((n_all + 255) & ~255); it_ += gridDim.x) {
    const int item = xcd_remap(it_);
    if (item >= n_all) continue;
    int kind, qb, hd, b, isctx;
    if (item < n_mla) { kind = 0; isctx = 0; qb = item & 15; hd = (item >> 4) & 7; b = item >> 7; }
    else if (item < n_mla + n_gqa) { const int it = item - n_mla; kind = 1; isctx = 0; qb = it & 15; hd = (it >> 4) & 7; b = it >> 7; }
    else { const int it = item - n_mla - n_gqa; isctx = 1; qb = 0; hd = it & 7; b = (it >> 3) & 7; kind = it >> 6; }
    const int crow0 = ML + b * LCTX;
    if (kind == 0) {
      int qrow0, nq, qt0, s0r, s0n, s1n;
      if (isctx) { qrow0 = crow0; nq = LCTX; qt0 = 0; s0r = crow0; s0n = LCTX; s1n = 0; }
      else { qrow0 = b * LSEQ + qb * 512; nq = 512; qt0 = qb * 512; s0r = b * LSEQ; s0n = LSEQ; s1n = LCTX; }
      attn_block<96>(QK + hd * 96, 1792, KM + hd * 96, 768, QK + 768 + hd * 128 + 64, 1792, Y + 1024 + hd * 64, 1536,
                     qrow0, nq, qt0, s0r, s0n, 0, 0, crow0, s1n, 0.f, 0, lds);
    } else {
      const int kvh = hd >> 2;
      int qrow0, nq, qt0, s0r, s0n, s0t, msk, s1n;
      if (isctx) { qrow0 = crow0; nq = LCTX; qt0 = 0; s0r = crow0; s0n = LCTX; s0t = 0; msk = 0; s1n = 0; }
      else {
        const int t0 = qb * 512;
        const int lo = (t0 - 128 < 0) ? 0 : t0 - 128;
        const int hi = (t0 + 640 > LSEQ) ? LSEQ : t0 + 640;
        qrow0 = b * LSEQ + t0; nq = 512; qt0 = t0; s0r = b * LSEQ + lo; s0n = hi - lo; s0t = lo; msk = 1; s1n = LCTX;
      }
      attn_block<64>(R + hd * 64, 1536, R + 512 + kvh * 64, 1536, R + 640 + kvh * 64, 1536, Y + 512 + hd * 64, 1536,
                     qrow0, nq, qt0, s0r, s0n, s0t, msk, crow0, s1n, sink[hd] * LOG2E, 1, lds);
    }
  }
}

DI void phase_p7a(const Params& p, int l, int nrows, u16* lds) {
  const u16* hn = (const u16*)(p.ws + OFF_A);
  const u16* wt = (const u16*)(p.ws + OFF_W) + (size_t)l * W_LAYER + WO_TG;
  u16* Gt = (u16*)(p.ws + OFF_B);
  const int NT = 24, nitems = (nrows / 256) * NT;
  for (int it_ = lbid(); it_ < ((nitems + 255) & ~255); it_ += gridDim.x) {
    const int item = xcd_remap(it_);
    if (item >= nitems) continue;
    const int m0 = (item / NT) * 256, n0 = (item % NT) * 128;
    f32x16 acc[2][2];
    ACC_ZERO(acc);
    gemm_mainloop(hn + (size_t)m0 * 1024, 1024, wt + (size_t)n0 * 1024, 1024, 1024, acc, lds);
    ACC_FOREACH(acc, m0, n0, { acc[mi_][ni_][r_] = sigmoidf_(val); });
    stage_store_bf16(acc, Gt, 3072, m0, n0, lds);
  }
}
DI void phase_p7b(const Params& p, int l, int nrows, u16* lds) {
  const u16* Y = (const u16*)(p.ws + OFF_Y);
  const u16* Gt = (const u16*)(p.ws + OFF_B);
  const u16* wb = (const u16*)(p.ws + OFF_W) + (size_t)l * W_LAYER + WO_BR;
  u16* mg = (u16*)(p.ws + OFF_A);
  const int NT = 8, nitems = (nrows / 256) * NT;
  for (int it_ = lbid(); it_ < ((nitems + 255) & ~255); it_ += gridDim.x) {
    const int item = xcd_remap(it_);
    if (item >= nitems) continue;
    const int m0 = (item / NT) * 256, n0 = (item % NT) * 128;
    f32x16 mrg[2][2];
    ACC_ZERO(mrg);
#pragma unroll 1
    for (int nb = 0; nb < 3; ++nb) {
      f32x16 acc[2][2];
      ACC_ZERO(acc);
      gemm_mainloop<true>(Y + (size_t)m0 * 1536 + nb * 512, 1536, wb + (size_t)nb * 1024 * 512 + (size_t)n0 * 512, 512, 512, acc, lds);
      {
        u16* gs = lds;
        const int tid = ltid();
#pragma unroll
        for (int i = 0; i < 8; ++i) {
          const int ch = tid + 512 * i, rr = ch >> 4, c16 = ch & 15;
          const uint4 v = *(const uint4*)(Gt + (size_t)(m0 + rr) * 3072 + nb * 1024 + n0 + c16 * 8);
          *(uint4*)(gs + rr * 136 + c16 * 8) = v;
        }
        __syncthreads();
        ACC_FOREACH(acc, 0, 0, { mrg[mi_][ni_][r_] += bf2f(gs[row * 136 + col]) * val; });
        __syncthreads();
      }
    }
    stage_store_bf16(mrg, mg, 1024, m0, n0, lds);
  }
}
DI void phase_p8(const Params& p, int l, int nrows, u16* lds) {
  const u16* mg = (const u16*)(p.ws + OFF_A);
  const u16* wt = (const u16*)(p.ws + OFF_W) + (size_t)l * W_LAYER + WO_OUT;
  const float* xs = (l == 0) ? p.x : p.out;
  const float* cs = (l == 0) ? p.ctx : (const float*)(p.ws + OFF_CTX);
  float* cd = (float*)(p.ws + OFF_CTX);
  const int NT = 8, nitems = (nrows / 256) * NT;
  for (int it_ = lbid(); it_ < ((nitems + 255) & ~255); it_ += gridDim.x) {
    const int item = xcd_remap(it_);
    if (item >= nitems) continue;
    const int m0 = (item / NT) * 256, n0 = (item % NT) * 128;
    f32x16 acc[2][2];
    ACC_ZERO(acc);
    gemm_mainloop(mg + (size_t)m0 * 1024, 1024, wt + (size_t)n0 * 1024, 1024, 1024, acc, lds);
    const int mrow = (m0 < ML) ? (m0 >> 13) : 8;
    const float* gate = mods_ptr(p, l, mrow, 2);
    ACC_FOREACH(acc, m0, n0, {
      const float g = gate[col];
      if (row < ML) p.out[(size_t)row * 1024 + col] = xs[(size_t)row * 1024 + col] + g * val;
      else cd[(size_t)(row - ML) * 1024 + col] = cs[(size_t)(row - ML) * 1024 + col] + g * val;
    });
  }
}
DI void phase_p10(const Params& p, int l, int nrows, u16* lds) {
  const u16* hn = (const u16*)(p.ws + OFF_A);
  const u16* wt = (const u16*)(p.ws + OFF_W) + (size_t)l * W_LAYER + WO_W1;
  u16* h1 = (u16*)(p.ws + OFF_B);
  const int NT = 32, nitems = (nrows / 256) * NT;
  for (int it_ = lbid(); it_ < ((nitems + 255) & ~255); it_ += gridDim.x) {
    const int item = xcd_remap(it_);
    if (item >= nitems) continue;
    const int m0 = (item / NT) * 256, n0 = (item % NT) * 128;
    f32x16 acc[2][2];
    ACC_ZERO(acc);
    gemm_mainloop(hn + (size_t)m0 * 1024, 1024, wt + (size_t)n0 * 1024, 1024, 1024, acc, lds);
    ACC_FOREACH(acc, m0, n0, { const float rl = fmaxf(val, 0.f); acc[mi_][ni_][r_] = rl * rl; });
    stage_store_bf16(acc, h1, 4096, m0, n0, lds);
  }
}
DI void phase_p11(const Params& p, int l, int nrows, u16* lds) {
  const u16* h1 = (const u16*)(p.ws + OFF_B);
  const u16* wt = (const u16*)(p.ws + OFF_W) + (size_t)l * W_LAYER + WO_W2;
  float* cd = (float*)(p.ws + OFF_CTX);
  const int NT = 8, nitems = (nrows / 256) * NT;
  for (int it_ = lbid(); it_ < ((nitems + 255) & ~255); it_ += gridDim.x) {
    const int item = xcd_remap(it_);
    if (item >= nitems) continue;
    const int m0 = (item / NT) * 256, n0 = (item % NT) * 128;
    f32x16 acc[2][2];
    ACC_ZERO(acc);
    gemm_mainloop(h1 + (size_t)m0 * 4096, 4096, wt + (size_t)n0 * 4096, 4096, 4096, acc, lds);
    const int mrow = (m0 < ML) ? (m0 >> 13) : 8;
    const float* gate = mods_ptr(p, l, mrow, 5);
    ACC_FOREACH(acc, m0, n0, {
      const float g = gate[col];
      float* dp = (row < ML) ? p.out + (size_t)row * 1024 + col : cd + (size_t)(row - ML) * 1024 + col;
      *dp = *dp + g * val;
    });
  }
}

DI void phase_gemm1_b(const Params& p, int l, char* lds) {
  EpiRouteBf16 E; E.ws = p.ws;
  run_gemm256((const u16*)(p.ws + OFF_A), (const u16*)(p.ws + OFF_W) + (size_t)l * W_LAYER + WO_T1, MALL, 3072, 1024, E, lds);
}
DI void phase_p4_b(const Params& p, int l, char* lds) {
  const u16* R = (const u16*)(p.ws + OFF_R);
  const u16* wl = (const u16*)(p.ws + OFF_W) + (size_t)l * W_LAYER;
  EpiActBf16<0> E; E.ldc = 1792;
  E.O = (u16*)(p.ws + OFF_A);
  run_gemm256(R + 768, wl + WO_QB, MALL, 768, 384, E, lds, 1536);
  E.O = (u16*)(p.ws + OFF_A) + 768;
  run_gemm256(R + 1152, wl + WO_KVB, MALL, 1024, 256, E, lds, 1536);
}
DI void phase_p7a_b(const Params& p, int l, int nrows, char* lds) {
  EpiActBf16<1> E; E.O = (u16*)(p.ws + OFF_B); E.ldc = 3072;
  run_gemm256((const u16*)(p.ws + OFF_A), (const u16*)(p.ws + OFF_W) + (size_t)l * W_LAYER + WO_TG, nrows, 3072, 1024, E, lds);
}
DI void phase_p10_b(const Params& p, int l, int nrows, char* lds) {
  EpiActBf16<2> E; E.O = (u16*)(p.ws + OFF_B); E.ldc = 4096;
  run_gemm256((const u16*)(p.ws + OFF_A), (const u16*)(p.ws + OFF_W) + (size_t)l * W_LAYER + WO_W1, nrows, 4096, 1024, E, lds);
}
DI void phase_p8_b(const Params& p, int l, int nrows, char* lds) {
  EpiResid E;
  E.xs = (l == 0) ? p.x : p.out; E.cs = (l == 0) ? p.ctx : (const float*)(p.ws + OFF_CTX);
  E.xo = p.out; E.co = (float*)(p.ws + OFF_CTX); E.gbase = mods_ptr(p, l, 0, 2);
  run_gemm256((const u16*)(p.ws + OFF_A), (const u16*)(p.ws + OFF_W) + (size_t)l * W_LAYER + WO_OUT, nrows, 1024, 1024, E, lds);
}
DI void phase_p11_b(const Params& p, int l, int nrows, char* lds) {
  EpiResid E;
  E.xs = p.out; E.cs = (const float*)(p.ws + OFF_CTX);
  E.xo = p.out; E.co = (float*)(p.ws + OFF_CTX); E.gbase = mods_ptr(p, l, 0, 5);
  run_gemm256((const u16*)(p.ws + OFF_B), (const u16*)(p.ws + OFF_W) + (size_t)l * W_LAYER + WO_W2, nrows, 1024, 4096, E, lds);
}

#define OFF_BAR 985907200ull
#define XB_TMO      128
#define XB_XCNT(j)  (256  + 64 * (j))
#define XB_XSUB(j)  (1280 + 64 * (j))
#define XB_XGEN(j)  (2304 + 64 * (j))
#define XB_TOP      3328
#define XB_TOPGEN   3392
#define XCD_BAR_WORDS 3456
#define XB_SPIN_CAP (1u << 18)
#define LAS __attribute__((address_space(3)))
DI unsigned xb_ld(unsigned* p) { return __hip_atomic_load(p, __ATOMIC_RELAXED, __HIP_MEMORY_SCOPE_AGENT); }
DI unsigned xb_add(unsigned* p, unsigned v) { return __hip_atomic_fetch_add(p, v, __ATOMIC_RELAXED, __HIP_MEMORY_SCOPE_AGENT); }
DI unsigned xb_xcc_id() { return (unsigned)__builtin_amdgcn_s_getreg((3 << 11) | 20) & 0xFu; }
#define XB_SPIN(cond, bar) do { unsigned _sp = 0; while (cond) { __builtin_amdgcn_s_sleep(1); \
    if ((++_sp & 255u) == 0u) { if (xb_ld(&(bar)[XB_TMO])) break; if (_sp > XB_SPIN_CAP) { atomicAdd(&(bar)[XB_TMO], 1u); break; } } } } while (0)
struct XcdBarrier { unsigned* bar; unsigned x; volatile LAS unsigned* st; };
DI XcdBarrier xcd_barrier_post(unsigned* bar, volatile LAS unsigned* st) {
  XcdBarrier b; b.bar = bar; b.x = xb_xcc_id(); b.st = st;
  if (threadIdx.x == 0) (void)xb_add(&bar[XB_XCNT(b.x)], 1u);
  return b;
}
DI void xcd_barrier_complete(unsigned* bar, unsigned x, unsigned& nloc, unsigned& nx) {
  const unsigned G = gridDim.x * gridDim.y * gridDim.z;
  unsigned sum, cnt, mine, sp = 0u;
  for (;;) {
    sum = 0u; cnt = 0u; mine = 0u;
#pragma unroll
    for (unsigned j = 0; j < 16; ++j) { const unsigned c = xb_ld(&bar[XB_XCNT(j)]); sum += c; cnt += (c > 0u) ? 1u : 0u; mine = (j == x) ? c : mine; }
    if (sum == G) break;
    __builtin_amdgcn_s_sleep(1);
    if ((++sp & 255u) == 0u) { if (xb_ld(&bar[XB_TMO])) break; if (sp > XB_SPIN_CAP) { atomicAdd(&bar[XB_TMO], 1u); break; } }
  }
  nloc = mine > 0u ? mine : 1u; nx = cnt > 0u ? cnt : 1u;
}
DI void xcd_barrier(const XcdBarrier& b) {
  asm volatile("s_waitcnt vmcnt(0) lgkmcnt(0)" ::: "memory");
  __syncthreads();
  if (threadIdx.x == 0) {
    unsigned* bar = b.bar;
    __builtin_amdgcn_s_waitcnt(0);
    unsigned nloc = b.st[0], nx = b.st[1];
    if (nloc == 0u) { xcd_barrier_complete(bar, b.x, nloc, nx); b.st[0] = nloc; b.st[1] = nx; }
    const unsigned old = xb_add(&bar[XB_XSUB(b.x)], 1u);
    const unsigned gen = old / nloc;
    if (old + 1u == (gen + 1u) * nloc) {
      __builtin_amdgcn_fence(__ATOMIC_RELEASE, "agent");
      asm volatile("s_waitcnt vmcnt(0)" ::: "memory");
      const unsigned og = xb_add(&bar[XB_TOP], 1u);
      const unsigned tg = og / nx;
      if (og + 1u == (tg + 1u) * nx) xb_add(&bar[XB_TOPGEN], 1u);
      else XB_SPIN(xb_ld(&bar[XB_TOPGEN]) == tg, bar);
      __builtin_amdgcn_fence(__ATOMIC_ACQUIRE, "agent");
      xb_add(&bar[XB_XGEN(b.x)], 1u);
      asm volatile("s_waitcnt vmcnt(0)" ::: "memory");
    } else {
      XB_SPIN(xb_ld(&bar[XB_XGEN(b.x)]) == gen, bar);
      __builtin_amdgcn_fence(__ATOMIC_ACQUIRE, "agent");
      asm volatile("s_waitcnt vmcnt(0)" ::: "memory");
    }
  }
  __syncthreads();
}

DI void gsync(cg::grid_group& grid) {
  asm volatile("s_waitcnt vmcnt(0) lgkmcnt(0)" ::: "memory");
  grid.sync();
  if (ltid() < 64) {
    __builtin_amdgcn_fence(__ATOMIC_ACQUIRE, "agent");
    asm volatile("s_waitcnt vmcnt(0)" ::: "memory");
  }
  __syncthreads();
}

__global__ void __launch_bounds__(512) fwd_megakernel(Params p) {
  __shared__ __attribute__((aligned(16))) char lds[131072];
  __shared__ uint4 xb_words;
  cg::grid_group grid = cg::this_grid();
  if (threadIdx.x == 0) xb_words = make_uint4(0u, 0u, 0u, 0u);
  __syncthreads();
  const XcdBarrier xb = xcd_barrier_post((unsigned*)(p.ws + OFF_BAR), (volatile LAS unsigned*)&xb_words);
  phase0(p, lds);
  gsync(grid);
  for (int l = 0; l < 4; ++l) {
    const int nrows2 = (l < 3) ? MALL : ML;
#ifdef PROBE_SYNC10
    for (int q = 0; q < 10; ++q) xcd_barrier(xb);
#endif
#ifdef PROBE_FILT
    filter_tiles(p, l, LSEQ, 2 * FFTN, (float*)(p.ws + OFF_KF), (float*)(p.ws + OFF_PART), (float*)lds);
    xcd_barrier(xb);
    phase_filter_fft(p, l, (float*)lds);
    xcd_barrier(xb);
#endif
    phase_rownorm(p, l, 0, MALL);
#ifdef PROBE_ELEM
    phase_rownorm(p, l, 0, MALL);
    phase_rownorm(p, l, 0, MALL);
    phase_rownorm(p, l, 0, MALL);
#endif
    filter_tiles(p, l, LSEQ, 2 * FFTN, (float*)(p.ws + OFF_KF), (float*)(p.ws + OFF_PART), (float*)lds);
    if (l < 3) filter_tiles(p, l, LCTX, 512, (float*)(p.ws + OFF_KC), (float*)(p.ws + OFF_PART) + 128 * 1024, (float*)lds);
    xcd_barrier(xb);
    phase_gemm1_b(p, l, lds);
#ifdef PROBE_BIGG
    phase_gemm1_b(p, l, lds);
#endif
    phase_filter_fft(p, l, (float*)lds);
    xcd_barrier(xb);
    phase_h1(p, l, (float*)lds);
#ifdef PROBE_ELEM
    phase_h1(p, l, (float*)lds);
#endif
    phase_p3(p, l, (float*)lds);
    xcd_barrier(xb);
    phase_h2(p, l, (float*)lds);
    xcd_barrier(xb);
#ifdef PROBE_H2
    phase_h1(p, l, (float*)lds);
    xcd_barrier(xb);
    phase_h2(p, l, (float*)lds);
    xcd_barrier(xb);
#endif
    phase_h3(p, l, (float*)lds);
#ifdef PROBE_ELEM
    phase_h3(p, l, (float*)lds);
#endif
    xcd_barrier(xb);
    phase_p4(p, l, (u16*)lds);
#ifdef PROBE_SMALLG
    phase_p4(p, l, (u16*)lds);
#endif
    xcd_barrier(xb);
    phase_p5(p, l, (float*)lds);
    xcd_barrier(xb);
#ifdef PROBE_P45
    phase_p4(p, l, (u16*)lds);
    xcd_barrier(xb);
    phase_p5(p, l, (float*)lds);
    xcd_barrier(xb);
#endif
    phase_attn(p, l, (u16*)lds);
#ifdef PROBE_ATTN2
    xcd_barrier(xb);
    phase_attn(p, l, (u16*)lds);
#endif
    xcd_barrier(xb);
    phase_rownorm(p, l, 0, nrows2);
    xcd_barrier(xb);
    phase_p7a_b(p, l, nrows2, lds);
#ifdef PROBE_BIGG
    phase_p7a_b(p, l, nrows2, lds);
#endif
    xcd_barrier(xb);
    phase_p7b(p, l, nrows2, (u16*)lds);
#ifdef PROBE_SMALLG
    phase_p7b(p, l, nrows2, (u16*)lds);
#endif
    xcd_barrier(xb);
    phase_p8_b(p, l, nrows2, lds);
    xcd_barrier(xb);
    phase_rownorm(p, l, 1, nrows2);
    xcd_barrier(xb);
    phase_p10_b(p, l, nrows2, lds);
#ifdef PROBE_BIGG
    phase_p10_b(p, l, nrows2, lds);
#endif
    xcd_barrier(xb);
    phase_p11_b(p, l, nrows2, lds);
    xcd_barrier(xb);
  }
}

extern "C" void kernel_launch(void* const* d_in, const int* in_sizes, int n_in, void* d_out, int out_size, void* d_ws,
                              size_t ws_size, hipStream_t stream) {
  static int grid_blocks = 0;
  if (!grid_blocks) {
    int dev = 0, cus = 0, per_cu = 0;
    hipGetDevice(&dev);
    hipDeviceGetAttribute(&cus, hipDeviceAttributeMultiprocessorCount, dev);
    hipOccupancyMaxActiveBlocksPerMultiprocessor(&per_cu, fwd_megakernel, 512, 0);
    if (per_cu < 1) per_cu = 1;
    if (per_cu > 1) per_cu = 1;
    grid_blocks = (cus * per_cu) & ~7;
    if (grid_blocks < 8) grid_blocks = 8;
  }
  Params p{};
  const float** pp = (const float**)&p;
  for (int i = 0; i < 30; ++i) pp[i] = (const float*)d_in[i];
  p.out = (float*)d_out;
  p.ws = (char*)d_ws;
  hipMemsetAsync((char*)d_ws + OFF_BAR, 0, XCD_BAR_WORDS * sizeof(unsigned), stream);
  void* args[] = {&p};
  hipError_t e = hipLaunchCooperativeKernel((void*)fwd_megakernel, dim3(grid_blocks), dim3(512), args, 0, stream);
  if (e != hipSuccess) fprintf(stderr, "cooperative launch failed: %s (grid %d)\n", hipGetErrorString(e), grid_blocks);
}
```
